# Optimizing an MI355X kernel written in HIP

```python
import math
import jax, jax.numpy as jnp
from jax import lax
import numpy as np

D_MODEL = 1024
BATCH = 1
SEQ = 16384
DEPTH = 1

GDN_HEADS = 8
GDN_DK = 128
GDN_DV = 128
GDN_CONV = 4
GDN_CHUNK = 64
MB_HEADS = 8
MB_KV_HEADS = 2
MB_HD = 128
MB_BLOCK = 256
MB_TOPK = 3
MB_QCHUNK = 64
ROT_DIM = MB_HD // 4
ROPE_THETA = 500000.0
N_EXPERTS = 256
TOP_K = 8
N_GROUPS = 8
TOPK_GROUPS = 4
EXPERT_DIM = 256
SHARED_DIM = 256
ROUTED_SCALE = 2.5
MOE_BLOCK = 128
DEEPNORM_ALPHA = (2.0 * DEPTH) ** 0.25
DEEPNORM_BETA = (8.0 * DEPTH) ** -0.25
LN_EPS = 1e-5
MASK_NEG = -1e30

CONV_CH = 2 * GDN_HEADS * GDN_DK + GDN_HEADS * GDN_DV
SPLIT_SIZES = (CONV_CH, GDN_HEADS * GDN_DV, GDN_HEADS, GDN_HEADS,
               MB_HEADS * MB_HD, MB_KV_HEADS * MB_HD, MB_KV_HEADS * MB_HD,
               D_MODEL, D_MODEL)
IN_COLS = sum(SPLIT_SIZES)

kernel_name = 'hybrid_gdn_moba_moe_deepnorm'


def layer_norm(x, g, b):
    xf = x.astype(jnp.float32)
    mu = jnp.mean(xf, -1, keepdims=True)
    var = jnp.mean(jnp.square(xf - mu), -1, keepdims=True)
    return ((xf - mu) * lax.rsqrt(var + LN_EPS) * g + b).astype(x.dtype)


def l2norm(x):
    return x * lax.rsqrt(jnp.sum(x * x, -1, keepdims=True) + 1e-6)


def causal_short_conv(u, w):
    c = u.shape[-1]
    return lax.conv_general_dilated(u, w[:, None, :].astype(u.dtype), window_strides=(1,),
                                    padding=[(w.shape[0] - 1, 0)],
                                    dimension_numbers=('NWC', 'WIO', 'NWC'),
                                    feature_group_count=c)


def partial_rope(x, pos):
    half = ROT_DIM // 2
    inv = ROPE_THETA ** (-jnp.arange(half, dtype=jnp.float32) / half)
    ang = pos.astype(jnp.float32)[:, None] * inv[None, :]
    cos, sin = jnp.cos(ang), jnp.sin(ang)
    xr = x[..., :ROT_DIM].astype(jnp.float32)
    x1, x2 = xr[..., :half], xr[..., half:]
    rot = jnp.concatenate([x1 * cos - x2 * sin, x2 * cos + x1 * sin], -1).astype(x.dtype)
    return jnp.concatenate([rot, x[..., ROT_DIM:]], -1)


def gated_deltanet(q, k, v, beta, g):
    f32 = jnp.float32
    q, k, v, beta, g = (a.astype(f32) for a in (q, k, v, beta, g))
    B, H, T, dk = q.shape
    dv = v.shape[-1]
    C = GDN_CHUNK
    N = T // C
    q, k, v = (a.reshape(B, H, N, C, a.shape[-1]) for a in (q, k, v))
    beta = beta.reshape(B, H, N, C)
    gc = jnp.cumsum(g.reshape(B, H, N, C), axis=-1)
    idx = jnp.arange(C)
    tril = idx[:, None] >= idx[None, :]
    strict = idx[:, None] > idx[None, :]
    diff = gc[..., :, None] - gc[..., None, :]
    L = jnp.where(tril, jnp.exp(jnp.where(tril, diff, 0.0)), 0.0)
    kb = k * beta[..., None]
    A = jnp.einsum('bhncd,bhnsd->bhncs', kb, k) * L
    M = jnp.eye(C, dtype=f32) + jnp.where(strict, A, 0.0)
    rhs = jnp.concatenate([v * beta[..., None], kb * jnp.exp(gc)[..., None]], -1)
    sol = lax.linalg.triangular_solve(M, rhs, left_side=True, lower=True, unit_diagonal=True)
    u, w = sol[..., :dv], sol[..., dv:]
    qg = q * jnp.exp(gc)[..., None]
    kd = k * jnp.exp(gc[..., -1:] - gc)[..., None]
    glast = jnp.exp(gc[..., -1])
    Aqk = jnp.einsum('bhncd,bhnsd->bhncs', q, k) * L

    def step(S, inp):
        qg_i, w_i, u_i, kd_i, A_i, gl_i = inp
        v_new = u_i - jnp.einsum('bhcd,bhde->bhce', w_i, S)
        o = jnp.einsum('bhcd,bhde->bhce', qg_i, S) + jnp.einsum('bhcs,bhse->bhce', A_i, v_new)
        S = S * gl_i[..., None, None] + jnp.einsum('bhcd,bhce->bhde', kd_i, v_new)
        return S, o

    xs = tuple(jnp.moveaxis(a, 2, 0) for a in (qg, w, u, kd, Aqk, glast))
    S0 = jnp.zeros((B, H, dk, dv), f32)
    _, o = lax.scan(step, S0, xs)
    return jnp.moveaxis(o, 0, 2).reshape(B, H, T, dv)


def moba_attention(q, k, v):
    B, Hq, T, hd = q.shape
    G = k.shape[1]
    R = Hq // G
    Tp = -(-T // MB_BLOCK) * MB_BLOCK
    pad = ((0, 0), (0, 0), (0, Tp - T), (0, 0))
    q, k, v = jnp.pad(q, pad), jnp.pad(k, pad), jnp.pad(v, pad)
    NB = Tp // MB_BLOCK
    k_sel = min(MB_TOPK, NB)
    q = q.reshape(B, G, R, Tp, hd)
    kb = k.reshape(B, G, NB, MB_BLOCK, hd)
    vb = v.reshape(B, G, NB, MB_BLOCK, hd)
    kmean = jnp.mean(kb.astype(jnp.float32), axis=3)
    scale = hd ** -0.5
    bi = jnp.arange(B)[:, None, None, None, None]
    gi = jnp.arange(G)[None, :, None, None, None]
    Q = MB_QCHUNK

    def one_chunk(c):
        t0 = c * Q
        qc = lax.dynamic_slice_in_dim(q, t0, Q, axis=3)
        blk = t0 // MB_BLOCK
        gate = jnp.einsum('bgrqd,bgnd->bgrqn', qc.astype(jnp.float32), kmean)
        gate = jnp.where(jnp.arange(NB) < blk, gate, -jnp.inf)
        _, sel = lax.top_k(gate, k_sel)
        slot_ok = jnp.arange(k_sel) < blk
        ks = kb[bi, gi, sel]
        vs = vb[bi, gi, sel]
        s_sel = jnp.einsum('bgrqd,bgrqskd->bgrqsk', qc, ks).astype(jnp.float32) * scale
        s_sel = jnp.where(slot_ok[:, None], s_sel, MASK_NEG).reshape(B, G, R, Q, k_sel * MB_BLOCK)
        k_own = lax.dynamic_slice_in_dim(kb, blk, 1, axis=2)[:, :, 0]
        v_own = lax.dynamic_slice_in_dim(vb, blk, 1, axis=2)[:, :, 0]
        s_own = jnp.einsum('bgrqd,bgkd->bgrqk', qc, k_own).astype(jnp.float32) * scale
        qpos = t0 + jnp.arange(Q)
        kpos = blk * MB_BLOCK + jnp.arange(MB_BLOCK)
        s_own = jnp.where(kpos[None, :] <= qpos[:, None], s_own, MASK_NEG)
        p = jax.nn.softmax(jnp.concatenate([s_sel, s_own], -1), axis=-1).astype(v.dtype)
        p_sel = p[..., :k_sel * MB_BLOCK].reshape(B, G, R, Q, k_sel, MB_BLOCK)
        p_own = p[..., k_sel * MB_BLOCK:]
        return (jnp.einsum('bgrqsk,bgrqskd->bgrqd', p_sel, vs)
                + jnp.einsum('bgrqk,bgkd->bgrqd', p_own, v_own))

    out = lax.map(one_chunk, jnp.arange(Tp // Q))
    out = jnp.moveaxis(out, 0, 3).reshape(B, G, R, Tp, hd)[:, :, :, :T]
    return out.reshape(B, Hq, T, hd)


def token_mixer(x, w_in, conv_w, gdn_a_log, gdn_dt_bias, gdn_norm_w,
                w_gdn_proj, w_moba_proj, w_out):
    B, T, D = x.shape
    z = x @ w_in
    offs = np.cumsum(SPLIT_SIZES)[:-1].tolist()
    conv_in, gdn_gate, gdn_b, gdn_a, mb_q, mb_k, mb_v, gate_gdn, gate_mb = jnp.split(z, offs, -1)

    def heads(a, h):
        return a.reshape(B, T, h, -1).transpose(0, 2, 1, 3)

    c = jax.nn.silu(causal_short_conv(conv_in, conv_w))
    qk = GDN_HEADS * GDN_DK
    q, k, v = jnp.split(c, [qk, 2 * qk], -1)
    q = l2norm(heads(q, GDN_HEADS).astype(jnp.float32)) * (GDN_DK ** -0.5)
    k = l2norm(heads(k, GDN_HEADS).astype(jnp.float32))
    v = heads(v, GDN_HEADS)
    beta = jax.nn.sigmoid(gdn_b.astype(jnp.float32)).transpose(0, 2, 1)
    g = (-jnp.exp(gdn_a_log.astype(jnp.float32))
         * jax.nn.softplus(gdn_a.astype(jnp.float32) + gdn_dt_bias.astype(jnp.float32))).transpose(0, 2, 1)
    o = gated_deltanet(q, k, v, beta, g)
    o = o * lax.rsqrt(jnp.mean(o * o, -1, keepdims=True) + 1e-6) * gdn_norm_w.astype(jnp.float32)
    o = o.transpose(0, 2, 1, 3).reshape(B, T, GDN_HEADS * GDN_DV).astype(x.dtype) * jax.nn.silu(gdn_gate)
    y_gdn = o @ w_gdn_proj

    pos = jnp.arange(T)
    mq = partial_rope(heads(mb_q, MB_HEADS), pos)
    mk = partial_rope(heads(mb_k, MB_KV_HEADS), pos)
    mv = heads(mb_v, MB_KV_HEADS)
    a = moba_attention(mq, mk, mv)
    y_mb = a.transpose(0, 2, 1, 3).reshape(B, T, MB_HEADS * MB_HD) @ w_moba_proj

    m = jax.nn.sigmoid(gate_gdn) * y_gdn + jax.nn.sigmoid(gate_mb) * y_mb
    return m @ w_out


def moe_ffn(h, router_w, router_bias, exp_w_gate, exp_w_up, exp_w_down,
            sh_w_gate, sh_w_up, sh_w_down):
    B, T, D = h.shape
    N = B * T
    E = N_EXPERTS
    xt = h.reshape(N, D)
    scores = jax.nn.sigmoid((xt @ router_w).astype(jnp.float32))
    choice = scores + router_bias.astype(jnp.float32)
    group_score = lax.top_k(choice.reshape(N, N_GROUPS, E // N_GROUPS), 2)[0].sum(-1)
    _, gidx = lax.top_k(group_score, TOPK_GROUPS)
    gmask = jnp.any(gidx[:, :, None] == jnp.arange(N_GROUPS)[None, None, :], axis=1)
    choice = jnp.where(jnp.repeat(gmask, E // N_GROUPS, axis=1), choice, -jnp.inf)
    _, eidx = lax.top_k(choice, TOP_K)
    wts = jnp.take_along_axis(scores, eidx, axis=1)
    wts = wts / (jnp.sum(wts, -1, keepdims=True) + 1e-20) * ROUTED_SCALE

    NK = N * TOP_K
    e_flat = eidx.reshape(NK)
    tok_flat = jnp.arange(NK) // TOP_K
    w_flat = wts.reshape(NK)
    order = jnp.argsort(e_flat)
    e_s, tok_s, w_s = e_flat[order], tok_flat[order], w_flat[order]
    counts = jnp.bincount(e_flat, length=E)
    padded = (counts + MOE_BLOCK - 1) // MOE_BLOCK * MOE_BLOCK
    start = jnp.cumsum(counts) - counts
    pend = jnp.cumsum(padded)
    pstart = pend - padded
    dest = pstart[e_s] + jnp.arange(NK) - start[e_s]
    n_blocks = -(-NK // MOE_BLOCK) + E
    R = n_blocks * MOE_BLOCK
    row_tok = jnp.full((R,), N, jnp.int32).at[dest].set(tok_s.astype(jnp.int32))
    row_w = jnp.zeros((R,), jnp.float32).at[dest].set(w_s)
    blk_exp = jnp.minimum(jnp.searchsorted(pend, jnp.arange(n_blocks) * MOE_BLOCK, side='right'), E - 1)
    x_pad = jnp.concatenate([xt, jnp.zeros((1, D), xt.dtype)], 0)
    x_rows = x_pad[row_tok].reshape(n_blocks, MOE_BLOCK, D)

    def expert_block(args):
        xb, e = args
        hb = jax.nn.silu(xb @ exp_w_gate[e]) * (xb @ exp_w_up[e])
        return hb @ exp_w_down[e]

    y_rows = lax.map(expert_block, (x_rows, blk_exp)).reshape(R, D)
    routed = jax.ops.segment_sum(y_rows * row_w[:, None].astype(y_rows.dtype), row_tok,
                                 num_segments=N + 1)[:N]
    shared = (jax.nn.silu(xt @ sh_w_gate) * (xt @ sh_w_up)) @ sh_w_down
    return (routed + shared).reshape(B, T, D)


def setup_inputs(seed: int = 0) -> dict:
    key = jax.random.key(seed)
    ks = jax.random.split(key, 24)
    d = D_MODEL
    f32 = jnp.float32

    def nrm(k, shape, fan_in, scale=1.0):
        return jax.random.normal(k, shape, f32) * (scale * fan_in ** -0.5)

    dt = jnp.exp(jax.random.uniform(ks[4], (GDN_HEADS,), f32) * (math.log(0.1) - math.log(0.001))
                 + math.log(0.001))
    return {
        'x': jax.random.normal(ks[0], (BATCH, SEQ, d), f32),
        'w_in': nrm(ks[1], (d, IN_COLS), d),
        'conv_w': nrm(ks[2], (GDN_CONV, CONV_CH), GDN_CONV),
        'gdn_a_log': jnp.log(jax.random.uniform(ks[3], (GDN_HEADS,), f32, 1.0, 16.0)),
        'gdn_dt_bias': dt + jnp.log(-jnp.expm1(-dt)),
        'gdn_norm_w': 1.0 + 0.02 * jax.random.normal(ks[5], (GDN_DV,), f32),
        'w_gdn_proj': nrm(ks[6], (GDN_HEADS * GDN_DV, d), GDN_HEADS * GDN_DV, DEEPNORM_BETA),
        'w_moba_proj': nrm(ks[7], (MB_HEADS * MB_HD, d), MB_HEADS * MB_HD, DEEPNORM_BETA),
        'w_out': nrm(ks[8], (d, d), d, DEEPNORM_BETA),
        'ln1_g': 1.0 + 0.02 * jax.random.normal(ks[9], (d,), f32),
        'ln1_b': 0.02 * jax.random.normal(ks[10], (d,), f32),
        'router_w': nrm(ks[11], (d, N_EXPERTS), d),
        'router_bias': 0.01 * jax.random.normal(ks[12], (N_EXPERTS,), f32),
        'exp_w_gate': nrm(ks[13], (N_EXPERTS, d, EXPERT_DIM), d),
        'exp_w_up': nrm(ks[14], (N_EXPERTS, d, EXPERT_DIM), d),
        'exp_w_down': nrm(ks[15], (N_EXPERTS, EXPERT_DIM, d), EXPERT_DIM, DEEPNORM_BETA),
        'sh_w_gate': nrm(ks[16], (d, SHARED_DIM), d),
        'sh_w_up': nrm(ks[17], (d, SHARED_DIM), d),
        'sh_w_down': nrm(ks[18], (SHARED_DIM, d), SHARED_DIM, DEEPNORM_BETA),
        'ln2_g': 1.0 + 0.02 * jax.random.normal(ks[19], (d,), f32),
        'ln2_b': 0.02 * jax.random.normal(ks[20], (d,), f32),
    }


def reference(x, w_in, conv_w, gdn_a_log, gdn_dt_bias, gdn_norm_w, w_gdn_proj, w_moba_proj,
              w_out, ln1_g, ln1_b, router_w, router_bias, exp_w_gate, exp_w_up, exp_w_down,
              sh_w_gate, sh_w_up, sh_w_down, ln2_g, ln2_b):
    h = x
    for _ in range(DEPTH):
        mix = token_mixer(h, w_in, conv_w, gdn_a_log, gdn_dt_bias, gdn_norm_w,
                          w_gdn_proj, w_moba_proj, w_out)
        h = layer_norm(DEEPNORM_ALPHA * h + mix, ln1_g, ln1_b)
        ffn = moe_ffn(h, router_w, router_bias, exp_w_gate, exp_w_up, exp_w_down,
                      sh_w_gate, sh_w_up, sh_w_down)
        h = layer_norm(DEEPNORM_ALPHA * h + ffn, ln2_g, ln2_b)
    return h
```

```cpp
#include <hip/hip_runtime.h>
#include <cstdio>
#include <cstdint>
#include <cmath>

#ifndef STAGE
#define STAGE 4
#endif
#ifndef N_LAUNCH_SPLIT
#define N_LAUNCH_SPLIT 0
#endif

#define GAS __attribute__((address_space(1)))
#define LAS __attribute__((address_space(3)))
typedef unsigned short bf16;
typedef unsigned v4u __attribute__((ext_vector_type(4)));
typedef unsigned v2u __attribute__((ext_vector_type(2)));
typedef float f32x4 __attribute__((ext_vector_type(4)));
typedef float f32x2 __attribute__((ext_vector_type(2)));
typedef short bf16x8 __attribute__((ext_vector_type(8)));
typedef short bf16x4 __attribute__((ext_vector_type(4)));
#define LDS_WAIT() asm volatile("s_waitcnt lgkmcnt(0)" ::: "memory")
#define VM_WAIT() asm volatile("s_waitcnt vmcnt(0)" ::: "memory")

__device__ __forceinline__ unsigned f2bf(float f) { unsigned u = __builtin_bit_cast(unsigned, f); return (u + 0x7fffu + ((u >> 16) & 1u)) >> 16; }
__device__ __forceinline__ unsigned pk2(float lo, float hi) { return f2bf(lo) | (f2bf(hi) << 16); }
__device__ __forceinline__ float bf2f(unsigned b) { return __builtin_bit_cast(float, b << 16); }
__device__ __forceinline__ float bflo(unsigned w) { return __builtin_bit_cast(float, w << 16); }
__device__ __forceinline__ float bfhi(unsigned w) { return __builtin_bit_cast(float, w & 0xffff0000u); }
__device__ __forceinline__ unsigned pk4_fp8(float a, float b, float c, float d) { unsigned w = 0u; w = __builtin_amdgcn_cvt_pk_fp8_f32(a, b, w, false); w = __builtin_amdgcn_cvt_pk_fp8_f32(c, d, w, true); return w; }
__device__ __forceinline__ float sigmoidf_(float x) { return __builtin_amdgcn_rcpf(1.f + __builtin_amdgcn_exp2f(-1.4426950408889634f * x)); }
__device__ __forceinline__ float siluf_(float x) { return x * __builtin_amdgcn_rcpf(1.f + __builtin_amdgcn_exp2f(-1.4426950408889634f * x)); }
__device__ __forceinline__ float wave_sum(float v) {
#pragma unroll
    for (int o = 1; o < 64; o <<= 1) v += __shfl_xor(v, o);
    return v;
}

constexpr int T = 16384, D = 1024;
constexpr int NIN = 7936;
constexpr int NEXP = 256, TOPK = 8, EDIM = 256;
constexpr int RMAX = T * TOPK + NEXP * 256;
constexpr float LN_EPS = 1e-5f;
constexpr float DN_ALPHA = 1.189207115002721f;

constexpr size_t MiB = 1u << 20;
constexpr size_t WS_CTL = 0, CTL_ZERO_BYTES = 1 * MiB;
constexpr size_t WS_ROPE = 1 * MiB;
constexpr size_t WS_GL = 3 * MiB;
constexpr size_t WS_EIDX = 4 * MiB;
constexpr size_t WS_WTS = 4 * MiB + 512 * 1024;
constexpr size_t WS_ROWTOK = 5 * MiB;
constexpr size_t WS_ROWDST = 6 * MiB;
constexpr size_t WS_TILEE = 7 * MiB;
constexpr size_t WS_WIN = 8 * MiB;
constexpr size_t WS_WGP = 24 * MiB, WS_WMP = 26 * MiB, WS_WOUT = 28 * MiB;
constexpr size_t WS_ROUTER = 30 * MiB;
constexpr size_t WS_SHGU = 30 * MiB + 512 * 1024;
constexpr size_t WS_SHD = 31 * MiB + 512 * 1024;
constexpr size_t WS_EXPGU = 32 * MiB;
constexpr size_t WS_EXPD = 288 * MiB;
constexpr size_t WS_XB = 416 * MiB;
constexpr size_t WS_CONVIN = 448 * MiB;
constexpr size_t WS_PO = 416 * MiB;
constexpr size_t WS_GG = 544 * MiB, WS_MQ = 576 * MiB, WS_MK = 608 * MiB, WS_MV = 616 * MiB, WS_SGG = 624 * MiB, WS_SGM = 656 * MiB;
constexpr size_t WS_BETA = 688 * MiB, WS_GLOG = 688 * MiB + 512 * 1024;
constexpr size_t WS_GDNP = 690 * MiB;
constexpr size_t WS_O = 834 * MiB;
constexpr size_t WS_LISTS = 898 * MiB, WS_LSE = 914 * MiB, WS_OG = 916 * MiB, WS_A2 = 948 * MiB, WS_MBUF = 980 * MiB;
constexpr size_t WS_HF = 690 * MiB;
constexpr size_t WS_HB = 754 * MiB;
constexpr size_t WS_LOGITS = 787 * MiB;
constexpr size_t WS_LOGITS2 = 544 * MiB;
constexpr size_t WS_HS = 808 * MiB;
constexpr size_t WS_SHY = 816 * MiB;
constexpr size_t WS_HEXP = 848 * MiB;
constexpr size_t WS_YR = 416 * MiB;
constexpr size_t WS_END = 1024 * MiB;
constexpr int CW_BAR = 4096;
constexpr int CW_MOBA_CNT = 8192, CW_QHEAD = 8448, CW_MOE_CNT = 8704, CW_MOE_FILL = 8960;
constexpr int CW_CONVQ = 9300;
constexpr int CW_BAR2 = 40960;
constexpr int CW_PROG = 32768;
constexpr int CW_KMEAN = 16384;

constexpr int LDS_BYTES = 155648;
constexpr int MISC_OFF = 153600;
constexpr int NWAVES = 8;

#define XB_TMO      128
#define XB_XCNT(j)  (256  + 64 * (j))
#define XB_XSUB(j)  (1280 + 64 * (j))
#define XB_XGEN(j)  (2304 + 64 * (j))
#define XB_TOP      3328
#define XB_TOPGEN   3392
#define XCD_BAR_WORDS 3456
#define XB_SPIN_CAP (1u << 18)
__device__ __forceinline__ unsigned xb_ld(unsigned* p)              { return __hip_atomic_load(p, __ATOMIC_RELAXED, __HIP_MEMORY_SCOPE_AGENT); }
__device__ __forceinline__ unsigned xb_add(unsigned* p, unsigned v) { return __hip_atomic_fetch_add(p, v, __ATOMIC_RELAXED, __HIP_MEMORY_SCOPE_AGENT); }
__device__ __forceinline__ unsigned xb_xcc_id() { return (unsigned)__builtin_amdgcn_s_getreg((3 << 11) | 20) & 0xFu; }
#define XB_SPIN(cond, bar) do { unsigned _sp = 0; while (cond) { __builtin_amdgcn_s_sleep(1); \
    if ((++_sp & 255u) == 0u) { if (xb_ld(&(bar)[XB_TMO])) break; if (_sp > XB_SPIN_CAP) { atomicAdd(&(bar)[XB_TMO], 1u); break; } } } } while (0)
struct XcdBarrier { unsigned* bar; unsigned x; volatile LAS unsigned* st; unsigned gtot; };
__device__ __forceinline__ XcdBarrier xcd_barrier_post(unsigned* bar, volatile LAS unsigned* st) {
    XcdBarrier b; b.bar = bar; b.x = xb_xcc_id(); b.st = st; b.gtot = gridDim.x * gridDim.y * gridDim.z;
    if (threadIdx.x == 0) (void)xb_add(&bar[XB_XCNT(b.x)], 1u);
    return b;
}
__device__ __forceinline__ void xcd_barrier_complete(unsigned* bar, unsigned x, unsigned& nloc, unsigned& nx, const unsigned G) {
    unsigned sum, cnt, mine, sp = 0u;
    for (;;) {
        sum = 0u; cnt = 0u; mine = 0u;
#pragma unroll
        for (unsigned j = 0; j < 16; ++j) { const unsigned c = xb_ld(&bar[XB_XCNT(j)]); sum += c; cnt += (c > 0u) ? 1u : 0u; mine = (j == x) ? c : mine; }
        if (sum == G) break;
        __builtin_amdgcn_s_sleep(1);
        if ((++sp & 255u) == 0u) { if (xb_ld(&bar[XB_TMO])) break; if (sp > XB_SPIN_CAP) { atomicAdd(&bar[XB_TMO], 1u); break; } }
    }
    nloc = mine > 0u ? mine : 1u; nx = cnt > 0u ? cnt : 1u;
}
__device__ __forceinline__ void xcd_barrier(const XcdBarrier& b) {
    asm volatile("s_waitcnt vmcnt(0)" ::: "memory");
    __syncthreads();
    if (threadIdx.x == 0) {
        unsigned* bar = b.bar;
        __builtin_amdgcn_s_waitcnt(0);
        unsigned nloc = b.st[0], nx = b.st[1];
        if (nloc == 0u) { xcd_barrier_complete(bar, b.x, nloc, nx, b.gtot); b.st[0] = nloc; b.st[1] = nx; }
        const unsigned old = xb_add(&bar[XB_XSUB(b.x)], 1u);
        const unsigned gen = old / nloc;
        if (old + 1u == (gen + 1u) * nloc) {
            __builtin_amdgcn_fence(__ATOMIC_RELEASE, "agent");
            asm volatile("s_waitcnt vmcnt(0)" ::: "memory");
            const unsigned og = xb_add(&bar[XB_TOP], 1u);
            const unsigned tg = og / nx;
            if (og + 1u == (tg + 1u) * nx) xb_add(&bar[XB_TOPGEN], 1u);
            else XB_SPIN(xb_ld(&bar[XB_TOPGEN]) == tg, bar);
            __builtin_amdgcn_fence(__ATOMIC_ACQUIRE, "agent");
            xb_add(&bar[XB_XGEN(b.x)], 1u);
            asm volatile("s_waitcnt vmcnt(0)" ::: "memory");
        } else {
            XB_SPIN(xb_ld(&bar[XB_XGEN(b.x)]) == gen, bar);
            __builtin_amdgcn_fence(__ATOMIC_ACQUIRE, "agent");
            asm volatile("s_waitcnt vmcnt(0)" ::: "memory");
        }
    }
    __syncthreads();
}

namespace pg8 {
typedef int v4i __attribute__((ext_vector_type(4)));
typedef int v8i __attribute__((ext_vector_type(8)));
constexpr int BM = 256, BK = 64, HALF = 128, HTB = HALF * BK * 2, STAGE_BYTES = 8 * HTB, NXCD = 8, WGM = 8;
__host__ __device__ __forceinline__ int lds_byte(int r, int c) { const int st = (r >> 4) * 2 + (c >> 5), rr = r & 15, cc = c & 31, ob = rr * 64 + cc * 2; return st * 1024 + (ob ^ (((ob >> 9) & 1) << 5)); }
__host__ __device__ __forceinline__ void stage_rc(int b, int& R, int& C) { const int st = b / 1024, sb = b % 1024, swz = sb ^ (((sb >> 9) & 1) << 5); R = (st >> 1) * 16 + swz / 64; C = (st & 1) * 32 + (swz % 64) / 2; }
__host__ __device__ __forceinline__ int perm32(int rho) { const int n = rho >> 4, i = rho & 15; return 8 * (i >> 2) + 4 * n + (i & 3); }

struct Unit { int pm, pn, arow0, aux, gbase, gcnt, acolb; const char* b; };

struct DenseOrder {
    int nM, nN, nwg, G, c; const char* Bt; size_t tstepB;
    __device__ void init(int M, int N, int K, int G_, int c_, const bf16* Bt_) { nM = M / BM; nN = N / BM; nwg = nM * nN; G = G_; c = c_; Bt = (const char*)Bt_; tstepB = (size_t)BM * K * 2; }
    __device__ bool next(int i, Unit& u) const {
        int wgid;
        if (G % NXCD == 0) { const int L = i * G + c; if (L >= nwg) return false;
            const int q = nwg / NXCD, r = nwg % NXCD, xcd = L % NXCD, off = L / NXCD; wgid = (xcd < r ? xcd * (q + 1) : r * (q + 1) + (xcd - r) * q) + off; }
        else {
            const int R = (nwg + G - 1) / G, x = c % NXCD, slot = c / NXCD, gq = G / NXCD, gr = G % NXCD, nx = gq + (x < gr ? 1 : 0), pre = x * gq + (x < gr ? x : gr);
            if (i >= R) return false;
            wgid = R * pre + i * nx + slot; if (wgid >= nwg) return false; }
        const int nig = WGM * nN, gid = wgid / nig, fm = gid * WGM, gsz = (nM - fm) < WGM ? (nM - fm) : WGM;
        u.pm = fm + ((wgid % nig) % gsz); u.pn = (wgid % nig) / gsz; u.arow0 = u.pm * BM; u.aux = 0; u.gbase = 0; u.gcnt = 0; u.acolb = 0; u.b = Bt + (size_t)u.pn * tstepB; return true;
    }
};
template <int NPN> struct GroupOrder {
    int G, c; const LAS int* tb; const LAS int* cn; const char* W; size_t estride, tstepB;
    __device__ bool next(int i, Unit& u) const {
        const int cc = (G % NXCD == 0) ? (c % NXCD) * (G / NXCD) + c / NXCD : c;
        const long L = (long)i * G + cc; if (L >= (long)tb[256] * NPN) return false;
        const int tile = (int)(L / NPN), pn = (int)(L % NPN);
        int e = 0;
#pragma unroll
        for (int s2 = 128; s2 >= 1; s2 >>= 1) if (tb[e + s2] <= tile) e += s2;
        const int j = tile - tb[e];
        u.pm = tile; u.pn = pn; u.arow0 = tile * BM; u.aux = e; u.gbase = e * 16384 + j * BM; u.gcnt = cn[e] - j * BM; u.acolb = 0; u.b = W + (size_t)e * estride + (size_t)pn * tstepB; return true;
    }
};

struct SplitK2Order {
    static constexpr bool HALF_TILES = false;
    int nM, G, c; const char* Bt;
    int khalfB;
    __device__ bool next(int i, Unit& u) const {
        const int L = i * G + c; if (L >= 2 * nM) return false;
        u.pm = L >> 1; u.pn = L & 1; u.arow0 = u.pm * BM; u.aux = 0; u.gbase = 0; u.gcnt = 0; u.acolb = (L & 1) * khalfB; u.b = Bt + (size_t)(L & 1) * 256 * khalfB; return true;
    }
};

typedef __bf16 bf16v2_t __attribute__((ext_vector_type(2)));
__device__ __forceinline__ unsigned cvt_pk_bf16(float lo, float hi) { bf16v2_t v; v[0] = (__bf16)lo; v[1] = (__bf16)hi; return __builtin_bit_cast(unsigned, v); }

template <class Epi, class Sched, bool GATHER, int F8S = -1, int F8A = 0>
__device__ __forceinline__ void gemm_phase(LAS unsigned char* lds, const void* Abase, const int* rowmap, const int K, const Sched& S, const Epi& E, const unsigned strideA = 0u) {
    const int tid = threadIdx.x, wid = __builtin_amdgcn_readfirstlane(tid >> 6), lane = tid & 63, wr = wid >> 2, wc = wid & 3, fr = lane & 15, fq = lane >> 4;
    const int nt = K / BK;
    const unsigned rowB = (unsigned)K * 2u;
    const unsigned rowA = strideA ? strideA : rowB;
    int RA[2]; unsigned vA[2], voffB[2];
#pragma unroll
    for (int i = 0; i < 2; ++i) { int R, C; stage_rc(tid * 16 + i * 8192, R, C); const int Rb = Epi::PERM ? ((R & ~31) + perm32(R & 31)) : R;
        RA[i] = R; vA[i] = (unsigned)C * 2u; voffB[i] = (unsigned)(Rb * K + C) * 2u; }
    const size_t kstep = (size_t)(BK * 2);
    const size_t hstep = (size_t)HALF * K * 2;
    const unsigned ldsw = (unsigned)wid * 1024u;
    const int aoff0 = lds_byte(wr * 64 + fr, 8 * fq), boff0 = lds_byte(wc * 32 + fr, 8 * fq);
    constexpr int KOFF = 1024;
    const char* A0 = (const char*)Abase;
    unsigned VA[2][2];
#define PG8_SA(b, h) (((b) * 2 + (h)) * HTB)
#define PG8_SB(b, h) ((4 + (b) * 2 + (h)) * HTB)
#define PG8_STAGE_B(bufoff, gbase) do { _Pragma("unroll") for (int _i = 0; _i < 2; ++_i) \
        __builtin_amdgcn_global_load_lds((const unsigned*)((const char*)(gbase) + voffB[_i]), (LAS unsigned*)(lds + (bufoff) + ldsw + _i * 8192), 16, 0, 0); } while (0)
#define PG8_STAGE_A(bufoff, gbase, h) do { _Pragma("unroll") for (int _i = 0; _i < 2; ++_i) \
        __builtin_amdgcn_global_load_lds((const unsigned*)((const char*)(gbase) + VA[h][_i]), (LAS unsigned*)(lds + (bufoff) + ldsw + _i * 8192), 16, 0, 0); } while (0)
#define PG8_CAT(lo, hi) __builtin_shufflevector(__builtin_bit_cast(v4i, lo), __builtin_bit_cast(v4i, hi), 0, 1, 2, 3, 4, 5, 6, 7)
#define PG8_LO(x) __builtin_bit_cast(bf16x8, __builtin_shufflevector(x, x, 0, 1, 2, 3))
#define PG8_HI(x) __builtin_bit_cast(bf16x8, __builtin_shufflevector(x, x, 4, 5, 6, 7))
#define PG8_LDA(dst, b, h) do { _Pragma("unroll") for (int m = 0; m < 4; ++m) dst[m] = PG8_CAT(*(const LAS bf16x8*)(lds + PG8_SA(b, h) + aoff0 + m * 2048), *(const LAS bf16x8*)(lds + PG8_SA(b, h) + aoff0 + KOFF + m * 2048)); } while (0)
#define PG8_LDB(dst, b, h) do { _Pragma("unroll") for (int n = 0; n < 2; ++n) dst[n] = PG8_CAT(*(const LAS bf16x8*)(lds + PG8_SB(b, h) + boff0 + n * 2048), *(const LAS bf16x8*)(lds + PG8_SB(b, h) + boff0 + KOFF + n * 2048)); } while (0)
#define PG8_MMA(ai, bj, At, Bt) do { __builtin_amdgcn_s_setprio(1); _Pragma("unroll") for (int m = 0; m < 4; ++m) _Pragma("unroll") for (int n = 0; n < 2; ++n) { \
        if (F8S >= 0) acc[ai][bj][m][n] = __builtin_amdgcn_mfma_scale_f32_16x16x128_f8f6f4(Bt[n], At[m], acc[ai][bj][m][n], 0, 0, 0, (127 - (F8S >= 0 ? F8S : 0)) * 0x01010101, 0, (127 - F8A) * 0x01010101); \
        else { acc[ai][bj][m][n] = __builtin_amdgcn_mfma_f32_16x16x32_bf16(PG8_LO(Bt[n]), PG8_LO(At[m]), acc[ai][bj][m][n], 0, 0, 0); \
               acc[ai][bj][m][n] = __builtin_amdgcn_mfma_f32_16x16x32_bf16(PG8_HI(Bt[n]), PG8_HI(At[m]), acc[ai][bj][m][n], 0, 0, 0); } } \
        __builtin_amdgcn_s_setprio(0); } while (0)
#define PG8_WAIT_V(n) asm volatile("s_waitcnt vmcnt(" #n ")" ::: "memory")
#define PG8_WAIT_L(n) asm volatile("s_waitcnt lgkmcnt(" #n ")" ::: "memory")
#define PG8_BAR __builtin_amdgcn_s_barrier()
#define PG8_SCHED __builtin_amdgcn_sched_barrier(0)
#define PG8_AOFFS(u) do { _Pragma("unroll") for (int _h = 0; _h < 2; ++_h) _Pragma("unroll") for (int _i = 0; _i < 2; ++_i) \
        { const int _r = _h * HALF + RA[_i]; unsigned _row; if (GATHER) { const int _rc = _r < (u).gcnt ? _r : ((u).gcnt > 0 ? (u).gcnt - 1 : 0); const unsigned _m = (unsigned)rowmap[(u).gbase + _rc]; _row = (_r < (u).gcnt) ? _m : 16384u; } else _row = (unsigned)((u).arow0 + _r); VA[_h][_i] = _row * rowA + (unsigned)(u).acolb + vA[_i]; } } while (0)
    Unit cur, nxt; int ui = 0;
    if (!S.next(0, cur)) return;
    f32x4 acc[2][2][4][2];
#pragma unroll
    for (int a = 0; a < 2; ++a)
#pragma unroll
        for (int b = 0; b < 2; ++b)
#pragma unroll
            for (int m = 0; m < 4; ++m)
#pragma unroll
                for (int n = 0; n < 2; ++n) acc[a][b][m][n] = (f32x4){0.f, 0.f, 0.f, 0.f};
    v8i At[4], B0[2], B1[2];
    PG8_AOFFS(cur);
    const char* cA = A0;
    const char* cB = cur.b;
    PG8_STAGE_B(PG8_SB(0, 0), cB); PG8_STAGE_A(PG8_SA(0, 0), cA, 0); PG8_STAGE_B(PG8_SB(0, 1), cB + hstep); PG8_STAGE_A(PG8_SA(0, 1), cA, 1);
    if (wr == 1) PG8_BAR;
    PG8_WAIT_V(4); PG8_BAR;
    PG8_STAGE_B(PG8_SB(1, 0), cB + kstep); PG8_STAGE_A(PG8_SA(1, 0), cA + kstep, 0); PG8_STAGE_B(PG8_SB(1, 1), cB + hstep + kstep);
    PG8_WAIT_V(6); PG8_BAR;
    for (;;) {
        bool has_next = false; const char* nA = cA; const char* nB = cB;
#pragma unroll 1
        for (int t = 0; t < nt; t += 2) {
            const bool last = (t == nt - 2);
            if (last) { has_next = S.next(ui + 1, nxt); if (has_next) { nB = nxt.b; } }
            const char* a1 = cA + (size_t)(t + 1) * kstep;
            const char* a2 = last ? nA : cA + (size_t)(t + 2) * kstep; const char* b2 = last ? nB : cB + (size_t)(t + 2) * kstep;
            const char* a3 = a2 + kstep; const char* b3 = b2 + kstep;
            PG8_LDB(B0, 0, 0); PG8_SCHED; PG8_LDA(At, 0, 0); PG8_STAGE_A(PG8_SA(1, 1), a1, 1);
            PG8_WAIT_L(8); PG8_BAR; PG8_WAIT_L(0); PG8_MMA(0, 0, At, B0); PG8_BAR; PG8_SCHED;
            if (last && has_next) { PG8_AOFFS(nxt); }
            PG8_LDB(B1, 0, 1); PG8_STAGE_B(PG8_SB(0, 0), b2);
            PG8_BAR; PG8_WAIT_L(0); PG8_MMA(0, 1, At, B1); PG8_BAR;
            PG8_LDA(At, 0, 1); PG8_STAGE_A(PG8_SA(0, 0), a2, 0);
            PG8_BAR; PG8_WAIT_L(0); PG8_MMA(1, 0, At, B0); PG8_BAR; PG8_SCHED;
            PG8_STAGE_B(PG8_SB(0, 1), b2 + hstep);
            PG8_WAIT_V(6); PG8_BAR; PG8_MMA(1, 1, At, B1); PG8_BAR;
            PG8_LDB(B0, 1, 0); PG8_SCHED; PG8_LDA(At, 1, 0); PG8_STAGE_A(PG8_SA(0, 1), a2, 1);
            PG8_WAIT_L(8); PG8_BAR; PG8_WAIT_L(0); PG8_MMA(0, 0, At, B0); PG8_BAR; PG8_SCHED;
            PG8_LDB(B1, 1, 1); PG8_STAGE_B(PG8_SB(1, 0), b3);
            PG8_BAR; PG8_WAIT_L(0); PG8_MMA(0, 1, At, B1); PG8_BAR;
            PG8_LDA(At, 1, 1); PG8_STAGE_A(PG8_SA(1, 0), a3, 0);
            PG8_BAR; PG8_WAIT_L(0); PG8_MMA(1, 0, At, B0); PG8_BAR; PG8_SCHED;
            PG8_STAGE_B(PG8_SB(1, 1), b3 + hstep);
            PG8_WAIT_V(6); PG8_BAR; PG8_MMA(1, 1, At, B1); PG8_BAR;
        }
        E(acc, cur, wr, wc, fr, fq);
        if (!has_next) break;
#pragma unroll
        for (int a = 0; a < 2; ++a)
#pragma unroll
            for (int b = 0; b < 2; ++b)
#pragma unroll
                for (int m = 0; m < 4; ++m)
#pragma unroll
                    for (int n = 0; n < 2; ++n) acc[a][b][m][n] = (f32x4){0.f, 0.f, 0.f, 0.f};
        cur = nxt; cA = nA; cB = nB; ++ui;
    }
    PG8_WAIT_V(0);
    if (wr == 0) PG8_BAR;
    PG8_BAR;
#undef PG8_SA
#undef PG8_SB
#undef PG8_STAGE_A
#undef PG8_STAGE_B
#undef PG8_LDA
#undef PG8_CAT
#undef PG8_LO
#undef PG8_HI
#undef PG8_LDB
#undef PG8_MMA
#undef PG8_WAIT_V
#undef PG8_WAIT_L
#undef PG8_BAR
#undef PG8_SCHED
#undef PG8_AOFFS
}
}

struct EpiF32Res {
    static constexpr bool PERM = false;
    float* C; int ldc; const float* res; float alpha;
    __device__ __forceinline__ void operator()(const f32x4 (&acc)[2][2][4][2], const pg8::Unit& u, int wr, int wc, int fr, int fq) const {
        const int row0 = u.pm * 256 + wr * 64 + fr, col0 = u.pn * 256 + wc * 32 + 4 * fq;
#pragma unroll
        for (int ai = 0; ai < 2; ++ai)
#pragma unroll
            for (int m = 0; m < 4; ++m) { const size_t ro = (size_t)(row0 + ai * 128 + m * 16) * ldc + col0;
#pragma unroll
                for (int bj = 0; bj < 2; ++bj)
#pragma unroll
                    for (int n = 0; n < 2; ++n) { f32x4 v = acc[ai][bj][m][n];
                        if (res) { const f32x4 r = *(const f32x4*)(res + ro + bj * 128 + n * 16); v = v + r * alpha; }
                        *(f32x4*)(C + ro + bj * 128 + n * 16) = v; } }
    }
};
struct EpiBf16Res {
    static constexpr bool PERM = true;
    bf16* O; int ldc; const float* res; float alpha;
    __device__ __forceinline__ void operator()(const f32x4 (&acc)[2][2][4][2], const pg8::Unit& u, int wr, int wc, int fr, int fq) const {
        const int row0 = u.pm * 256 + wr * 64 + fr, col0 = u.pn * 256 + wc * 32 + 8 * fq;
        f32x4 r[2][4][2];
#define EB_RO(st, g) ((size_t)(row0 + ((st) >> 1) * 128 + (2 * ((st) & 1) + ((g) >> 1)) * 16) * ldc + col0 + ((g) & 1) * 128)
#define EB_LOAD(st) do { _Pragma("unroll") for (int _g = 0; _g < 4; ++_g) { const float* _p = res + EB_RO(st, _g); r[(st) & 1][_g][0] = *(const f32x4*)_p; r[(st) & 1][_g][1] = *(const f32x4*)(_p + 4); } } while (0)
#define EB_STORE(st) do { _Pragma("unroll") for (int _g = 0; _g < 4; ++_g) { const int _ai = (st) >> 1, _m = 2 * ((st) & 1) + (_g >> 1), _bj = _g & 1; \
            const f32x4 v0 = acc[_ai][_bj][_m][0] + r[(st) & 1][_g][0] * alpha, v1 = acc[_ai][_bj][_m][1] + r[(st) & 1][_g][1] * alpha; \
            v4u o; o.x = pg8::cvt_pk_bf16(v0[0], v0[1]); o.y = pg8::cvt_pk_bf16(v0[2], v0[3]); o.z = pg8::cvt_pk_bf16(v1[0], v1[1]); o.w = pg8::cvt_pk_bf16(v1[2], v1[3]); \
            *(v4u*)(O + EB_RO(st, _g)) = o; } } while (0)
        EB_LOAD(0); EB_LOAD(1);
        EB_STORE(0); EB_LOAD(2);
        EB_STORE(1); EB_LOAD(3);
        EB_STORE(2); EB_STORE(3);
#undef EB_RO
#undef EB_LOAD
#undef EB_STORE
    }
};
struct EpiBf16Plain {
    static constexpr bool PERM = true;
    bf16* O; int ldc;
    __device__ __forceinline__ void operator()(const f32x4 (&acc)[2][2][4][2], const pg8::Unit& u, int wr, int wc, int fr, int fq) const {
        const int row0 = u.pm * 256 + wr * 64 + fr, col0 = u.pn * 256 + wc * 32 + 8 * fq;
#pragma unroll
        for (int ai = 0; ai < 2; ++ai)
#pragma unroll
            for (int m = 0; m < 4; ++m) { bf16* rowp = O + (size_t)(row0 + ai * 128 + m * 16) * ldc + col0;
#pragma unroll
                for (int bj = 0; bj < 2; ++bj) { const f32x4 v0 = acc[ai][bj][m][0], v1 = acc[ai][bj][m][1];
                    v4u o; o.x = pg8::cvt_pk_bf16(v0[0], v0[1]); o.y = pg8::cvt_pk_bf16(v0[2], v0[3]); o.z = pg8::cvt_pk_bf16(v1[0], v1[1]); o.w = pg8::cvt_pk_bf16(v1[2], v1[3]);
                    *(v4u*)(rowp + bj * 128) = o; } }
    }
};
struct EpiSwiGLU {
    static constexpr bool PERM = true;
    bf16* H;
    __device__ __forceinline__ void operator()(const f32x4 (&acc)[2][2][4][2], const pg8::Unit& u, int wr, int wc, int fr, int fq) const {
        const int row0 = u.pm * 256 + wr * 64 + fr, col0 = u.pn * 128 + wc * 32 + 8 * fq;
#pragma unroll
        for (int ai = 0; ai < 2; ++ai)
#pragma unroll
            for (int m = 0; m < 4; ++m) { bf16* rowp = H + (size_t)(row0 + ai * 128 + m * 16) * 256 + col0;
                const f32x4 g0 = acc[ai][0][m][0], g1 = acc[ai][0][m][1], u0 = acc[ai][1][m][0], u1 = acc[ai][1][m][1];
                float h[8];
#pragma unroll
                for (int e = 0; e < 4; ++e) { h[e] = siluf_(g0[e]) * u0[e]; h[4 + e] = siluf_(g1[e]) * u1[e]; }
                v4u o; o.x = pg8::cvt_pk_bf16(h[0], h[1]); o.y = pg8::cvt_pk_bf16(h[2], h[3]); o.z = pg8::cvt_pk_bf16(h[4], h[5]); o.w = pg8::cvt_pk_bf16(h[6], h[7]);
                *(v4u*)rowp = o; }
    }
};
struct EpiSwiGLU8 {
    static constexpr bool PERM = true;
    unsigned char* H;
    __device__ __forceinline__ void operator()(const f32x4 (&acc)[2][2][4][2], const pg8::Unit& u, int wr, int wc, int fr, int fq) const {
        const int row0 = u.pm * 256 + wr * 64 + fr, col0 = u.pn * 128 + wc * 32 + 8 * fq;
#pragma unroll
        for (int ai = 0; ai < 2; ++ai)
#pragma unroll
            for (int m = 0; m < 4; ++m) { unsigned char* rowp = H + (size_t)(row0 + ai * 128 + m * 16) * 256 + col0;
                const f32x4 g0 = acc[ai][0][m][0], g1 = acc[ai][0][m][1], u0 = acc[ai][1][m][0], u1 = acc[ai][1][m][1];
                float h[8];
#pragma unroll
                for (int e = 0; e < 4; ++e) { h[e] = 4.f * siluf_(g0[e]) * u0[e]; h[4 + e] = 4.f * siluf_(g1[e]) * u1[e]; }
                v2u o; o.x = pk4_fp8(h[0], h[1], h[2], h[3]); o.y = pk4_fp8(h[4], h[5], h[6], h[7]);
                *(v2u*)rowp = o; }
    }
};
struct EpiScatter8 {
    static constexpr bool PERM = true;
    unsigned char* Y; const int* rowdst;
    __device__ __forceinline__ void operator()(const f32x4 (&acc)[2][2][4][2], const pg8::Unit& u, int wr, int wc, int fr, int fq) const {
        const int r0 = wr * 64 + fr, col0 = u.pn * 256 + wc * 32 + 8 * fq;
        unsigned dst[8];
#pragma unroll
        for (int i = 0; i < 8; ++i) { const int rr = r0 + (i >> 2) * 128 + (i & 3) * 16; const int rc = rr < u.gcnt ? rr : (u.gcnt > 0 ? u.gcnt - 1 : 0); const unsigned dd = (unsigned)rowdst[u.gbase + rc]; dst[i] = (rr < u.gcnt) ? dd : 131072u; }
#pragma unroll
        for (int ai = 0; ai < 2; ++ai)
#pragma unroll
            for (int m = 0; m < 4; ++m) { unsigned char* rowp = Y + (size_t)dst[ai * 4 + m] * 1024 + col0;
#pragma unroll
                for (int bj = 0; bj < 2; ++bj) { const f32x4 v0 = acc[ai][bj][m][0] * 16.f, v1 = acc[ai][bj][m][1] * 16.f;
                    v2u o; o.x = pk4_fp8(v0[0], v0[1], v0[2], v0[3]); o.y = pk4_fp8(v1[0], v1[1], v1[2], v1[3]);
                    *(v2u*)(rowp + bj * 128) = o; } }
    }
};
struct EpiScatter {
    static constexpr bool PERM = true;
    bf16* Y; const int* rowdst;
    __device__ __forceinline__ void operator()(const f32x4 (&acc)[2][2][4][2], const pg8::Unit& u, int wr, int wc, int fr, int fq) const {
        const int r0 = wr * 64 + fr, col0 = u.pn * 256 + wc * 32 + 8 * fq;
        unsigned dst[8];
#pragma unroll
        for (int i = 0; i < 8; ++i) { const int rr = r0 + (i >> 2) * 128 + (i & 3) * 16; const int rc = rr < u.gcnt ? rr : (u.gcnt > 0 ? u.gcnt - 1 : 0); const unsigned dd = (unsigned)rowdst[u.gbase + rc]; dst[i] = (rr < u.gcnt) ? dd : 131072u; }
#pragma unroll
        for (int ai = 0; ai < 2; ++ai)
#pragma unroll
            for (int m = 0; m < 4; ++m) { bf16* rowp = Y + (size_t)dst[ai * 4 + m] * 1024 + col0;
#pragma unroll
                for (int bj = 0; bj < 2; ++bj) { const f32x4 v0 = acc[ai][bj][m][0], v1 = acc[ai][bj][m][1];
                    v4u o; o.x = pg8::cvt_pk_bf16(v0[0], v0[1]); o.y = pg8::cvt_pk_bf16(v0[2], v0[3]); o.z = pg8::cvt_pk_bf16(v1[0], v1[1]); o.w = pg8::cvt_pk_bf16(v1[2], v1[3]);
                    *(v4u*)(rowp + bj * 128) = o; } }
    }
};

struct Args { const float* in[21]; float* out; unsigned char* ws; float rope_inv[16]; int ph_lo, ph_hi; };
struct Frame {
    LAS unsigned char* lds; volatile LAS unsigned* MISC; unsigned* ctl; unsigned char* ws;
    int wave, G, bid;
};

__device__ __forceinline__ void transpose_item(const float* src, int ld, int k0, int n0, int nvalid, bf16* dst, int lddst, int dst_row0, LAS float* scr, int lane) {
    const int n4 = 4 * (lane & 15), kq = lane >> 4;
    f32x4 v[16];
#pragma unroll
    for (int i = 0; i < 16; ++i) v[i] = (n4 < nvalid) ? *(const f32x4*)(src + (size_t)(k0 + kq + 4 * i) * ld + n0 + n4) : (f32x4){0.f, 0.f, 0.f, 0.f};
#pragma unroll
    for (int i = 0; i < 16; ++i) { LAS float* p = scr + (kq + 4 * i) * 65 + n4; p[0] = v[i][0]; p[1] = v[i][1]; p[2] = v[i][2]; p[3] = v[i][3]; }
    LDS_WAIT(); asm volatile("" ::: "memory");
    const int c = lane & 7;
#pragma unroll
    for (int j = 0; j < 8; ++j) { const int nn = (lane >> 3) + 8 * j; const LAS float* s = scr + (8 * c) * 65 + nn;
        v4u o; o.x = pk2(s[0 * 65], s[1 * 65]); o.y = pk2(s[2 * 65], s[3 * 65]); o.z = pk2(s[4 * 65], s[5 * 65]); o.w = pk2(s[6 * 65], s[7 * 65]);
        *(v4u*)(dst + (size_t)(dst_row0 + nn) * lddst + k0 + 8 * c) = o; }
    LDS_WAIT(); asm volatile("" ::: "memory");
}
__device__ __forceinline__ void transpose_item8(const float* src, int ld, int k0, int n0, int nvalid, unsigned char* dst, int lddst, int dst_row0, float scale, LAS float* scr, int lane) {
    const int n4 = 4 * (lane & 15), kq = lane >> 4;
    f32x4 v[16];
#pragma unroll
    for (int i = 0; i < 16; ++i) v[i] = (n4 < nvalid) ? *(const f32x4*)(src + (size_t)(k0 + kq + 4 * i) * ld + n0 + n4) : (f32x4){0.f, 0.f, 0.f, 0.f};
#pragma unroll
    for (int i = 0; i < 16; ++i) { LAS float* p = scr + (kq + 4 * i) * 65 + n4; p[0] = v[i][0] * scale; p[1] = v[i][1] * scale; p[2] = v[i][2] * scale; p[3] = v[i][3] * scale; }
    LDS_WAIT(); asm volatile("" ::: "memory");
    const int c = lane & 7;
#pragma unroll
    for (int j = 0; j < 8; ++j) { const int nn = (lane >> 3) + 8 * j; const LAS float* s = scr + (8 * c) * 65 + nn;
        v2u o; o.x = pk4_fp8(s[0 * 65], s[1 * 65], s[2 * 65], s[3 * 65]); o.y = pk4_fp8(s[4 * 65], s[5 * 65], s[6 * 65], s[7 * 65]);
        *(v2u*)(dst + (size_t)(dst_row0 + nn) * lddst + k0 + 8 * c) = o; }
    LDS_WAIT(); asm volatile("" ::: "memory");
}
__device__ __forceinline__ int gu_row(int n, int is_up) { return (n >> 7) * 256 + is_up * 128 + (n & 127); }

__device__ __forceinline__ void p0_prologue(Frame& F, const Args& a, const bool experts, const int wg0) {
    LAS float* scr = (LAS float*)(F.lds + F.wave * 16896);
    const int gw = (F.bid - wg0) * NWAVES + F.wave, NGW = (F.G - wg0) * NWAVES;
    unsigned char* ws = F.ws;
    constexpr int I_IN = 16 * (NIN / 64), I_SQ = 16 * 16, I_RT = 16 * 4, I_SH = 16 * 4, I_SD = 4 * 16, I_EX = 64;
    constexpr int NSMALL = I_IN + 3 * I_SQ + I_RT + 2 * I_SH + I_SD;
    const int ln = (int)(threadIdx.x & 63);
    const int it0 = experts ? NSMALL : 0, it1 = experts ? NSMALL + NEXP * 3 * I_EX : NSMALL;
    for (int it = it0 + gw; it < it1; it += NGW) {
        int r = it;
        if (r < I_IN) { const int nblk = NIN / 64, kb = r / nblk, nb = r % nblk, j0 = nb * 64;
            int n0, nv; if (j0 < 4096) { n0 = j0; nv = 64; } else if (j0 < 7680) { n0 = j0 + 16; nv = 64; } else if (j0 == 7680) { n0 = 4096; nv = 16; } else { n0 = 0; nv = 0; }
            transpose_item8(a.in[1], 7696, kb * 64, n0, nv, ws + WS_WIN, 1024, j0, 32.f, scr, ln); continue; } r -= I_IN;
        if (r < 3 * I_SQ) { const int w = r / I_SQ, q = r % I_SQ, kb = q / 16, nb = q % 16;
            transpose_item8(a.in[6 + w], 1024, kb * 64, nb * 64, 64, ws + (w == 0 ? WS_WGP : (w == 1 ? WS_WMP : WS_WOUT)), 1024, nb * 64, 64.f, scr, ln); continue; } r -= 3 * I_SQ;
        if (r < I_RT) { const int kb = r / 4, nb = r % 4, hf = kb >> 3;
            transpose_item(a.in[11], 256, kb * 64, nb * 64, 64, (bf16*)(ws + WS_ROUTER), 512, hf * 256 + nb * 64 - hf, scr, ln); continue; } r -= I_RT;
        if (r < 2 * I_SH) { const int up = r / I_SH, q = r % I_SH, kb = q / 4, nb = q % 4;
            transpose_item8(a.in[16 + up], 256, kb * 64, nb * 64, 64, ws + WS_SHGU, 1024, gu_row(nb * 64, up), 32.f, scr, ln); continue; } r -= 2 * I_SH;
        if (r < I_SD) { const int kb = r / 16, nb = r % 16; transpose_item(a.in[18], 1024, kb * 64, nb * 64, 64, (bf16*)(ws + WS_SHD), 256, nb * 64, scr, ln); continue; } r -= I_SD;
        { const int e = r / (3 * I_EX), q = r % (3 * I_EX), w = q / I_EX, p = q % I_EX;
            if (w < 2) { const int kb = p / 4, nb = p % 4;
                transpose_item8(a.in[13 + w] + (size_t)e * 1024 * 256, 256, kb * 64, nb * 64, 64, ws + WS_EXPGU + (size_t)e * 512 * 1024, 1024, gu_row(nb * 64, w), 32.f, scr, ln); }
            else { const int kb = p / 16, nb = p % 16;
                transpose_item8(a.in[15] + (size_t)e * 256 * 1024, 1024, kb * 64, nb * 64, 64, ws + WS_EXPD + (size_t)e * 1024 * 256, 256, nb * 64, 32.f, scr, ln); } }
    }
    if (experts) return;
    { const f32x4* x4 = (const f32x4*)a.in[0]; v2u* xb = (v2u*)(ws + WS_XB); const size_t n8 = (size_t)T * D / 8;
        for (size_t i = (size_t)F.bid * 512 + threadIdx.x; i < n8; i += (size_t)F.G * 512) { const f32x4 p = x4[2 * i], q = x4[2 * i + 1];
            v2u o; o.x = pk4_fp8(p[0], p[1], p[2], p[3]); o.y = pk4_fp8(q[0], q[1], q[2], q[3]); xb[i] = o; } }
    { _Float16* rope = (_Float16*)(ws + WS_ROPE);
        for (int idx = F.bid * 512 + ((int)threadIdx.x); idx < T * 16; idx += F.G * 512) { const int t = idx >> 4, i = idx & 15;
            const float angf = (float)t * a.rope_inv[i]; double ang = (double)angf;
            const double TWO_PI = 6.283185307179586476925, PI = 3.14159265358979323846;
            const double kq = __builtin_rint(ang / TWO_PI); double rr = ang - kq * TWO_PI; double cs = 1.0;
            if (rr > 0.5 * PI) { rr = PI - rr; cs = -1.0; } else if (rr < -0.5 * PI) { rr = -PI - rr; cs = -1.0; }
            const double r2 = rr * rr;
            double s = 1.0 / 355687428096000.0;
            s = s * (-r2) + 1.0 / 1307674368000.0; s = s * (-r2) + 1.0 / 6227020800.0; s = s * (-r2) + 1.0 / 39916800.0; s = s * (-r2) + 1.0 / 362880.0;
            s = s * (-r2) + 1.0 / 5040.0; s = s * (-r2) + 1.0 / 120.0; s = s * (-r2) + 1.0 / 6.0; s = s * (-r2) + 1.0; s *= rr;
            double c = 1.0 / 20922789888000.0;
            c = c * (-r2) + 1.0 / 87178291200.0; c = c * (-r2) + 1.0 / 479001600.0; c = c * (-r2) + 1.0 / 3628800.0; c = c * (-r2) + 1.0 / 40320.0;
            c = c * (-r2) + 1.0 / 720.0; c = c * (-r2) + 1.0 / 24.0; c = c * (-r2) + 0.5; c = c * (-r2) + 1.0; c *= cs;
            rope[t * 32 + i] = (_Float16)c; rope[t * 32 + 16 + i] = (_Float16)s; } }
    if (F.bid == 0 && ((int)threadIdx.x) < 128) ((v4u*)(ws + WS_HB + (size_t)T * D * 2))[((int)threadIdx.x)] = (v4u){0u, 0u, 0u, 0u};
}

__device__ __forceinline__ void expert_convert_queue(Frame& F, const Args& a) {
    LAS float* scr = (LAS float*)(F.lds + F.wave * 16896);
    const int lane = (int)(threadIdx.x & 63); unsigned char* ws = F.ws;
    constexpr int I_EX = 64, NIT = NEXP * 3 * I_EX, CH = 8;
    const int n4 = 4 * (lane & 15), kq = lane >> 4, c8 = lane & 7;
#define EX_LOAD(V, r_) do { const int _e = (r_) / (3 * I_EX), _q = (r_) % (3 * I_EX), _w = _q / I_EX, _p = _q % I_EX; const float* _s; int _ld, _k0, _n0; \
        if (_w < 2) { _s = a.in[13 + _w] + (size_t)_e * 1024 * 256; _ld = 256; _k0 = (_p / 4) * 64; _n0 = (_p % 4) * 64; } \
        else { _s = a.in[15] + (size_t)_e * 256 * 1024; _ld = 1024; _k0 = (_p / 16) * 64; _n0 = (_p % 16) * 64; } \
        _Pragma("unroll") for (int _i = 0; _i < 16; ++_i) V[_i] = __builtin_nontemporal_load((const f32x4*)(_s + (size_t)(_k0 + kq + 4 * _i) * _ld + _n0 + n4)); } while (0)
#define EX_PROC(V, r_) do { const int _e = (r_) / (3 * I_EX), _q = (r_) % (3 * I_EX), _w = _q / I_EX, _p = _q % I_EX; unsigned char* _dst; int _lddst, _row0, _k0; \
        if (_w < 2) { _dst = ws + WS_EXPGU + (size_t)_e * 512 * 1024; _lddst = 1024; _row0 = gu_row((_p % 4) * 64, _w); _k0 = (_p / 4) * 64; } \
        else { _dst = ws + WS_EXPD + (size_t)_e * 1024 * 256; _lddst = 256; _row0 = (_p % 16) * 64; _k0 = (_p / 16) * 64; } \
        _Pragma("unroll") for (int _i = 0; _i < 16; ++_i) { LAS float* _pp = scr + (kq + 4 * _i) * 65 + n4; _pp[0] = V[_i][0] * 32.f; _pp[1] = V[_i][1] * 32.f; _pp[2] = V[_i][2] * 32.f; _pp[3] = V[_i][3] * 32.f; } \
        LDS_WAIT(); asm volatile("" ::: "memory"); \
        _Pragma("unroll") for (int _j = 0; _j < 8; ++_j) { const int _nn = (lane >> 3) + 8 * _j; const LAS float* _sp = scr + (8 * c8) * 65 + _nn; \
            v2u _o; _o.x = pk4_fp8(_sp[0 * 65], _sp[1 * 65], _sp[2 * 65], _sp[3 * 65]); _o.y = pk4_fp8(_sp[4 * 65], _sp[5 * 65], _sp[6 * 65], _sp[7 * 65]); \
            __builtin_nontemporal_store(_o, (v2u*)(_dst + (size_t)(_row0 + _nn) * _lddst + _k0 + 8 * c8)); } \
        LDS_WAIT(); asm volatile("" ::: "memory"); } while (0)
    for (;;) {
        unsigned nxt = 0u;
        if (lane == 0) nxt = atomicAdd(&F.ctl[CW_CONVQ], (unsigned)CH);
        const int r0 = __builtin_amdgcn_readfirstlane((int)nxt);
        if (r0 >= NIT) break;
#pragma unroll 1
        for (int r = r0; r < r0 + CH; r += 2) {
            f32x4 va[16], vb[16];
            EX_LOAD(va, r); EX_LOAD(vb, r + 1);
            EX_PROC(va, r); EX_PROC(vb, r + 1);
        }
    }
#undef EX_LOAD
#undef EX_PROC
}

__device__ __forceinline__ void ln_rows(Frame& F, bf16* XB_, unsigned char* X8, const float* g, const float* b) {
    const int gw = F.bid * NWAVES + F.wave, NGW = F.G * NWAVES, lane = (int)(threadIdx.x & 63);
    f32x4 gv[4], bv[4];
#pragma unroll
    for (int j = 0; j < 4; ++j) { gv[j] = ((const f32x4*)g)[lane + 64 * j]; bv[j] = ((const f32x4*)b)[lane + 64 * j]; }
    for (int m0 = gw; m0 < T; m0 += 4 * NGW) {
        v2u x[4][4];
#pragma unroll
        for (int k = 0; k < 4; ++k) { const int mk = (m0 + k * NGW < T) ? m0 + k * NGW : T - 1; const v2u* xr = (const v2u*)(XB_ + (size_t)mk * D) + lane;
#pragma unroll
            for (int j = 0; j < 4; ++j) x[k][j] = xr[64 * j]; }
#pragma unroll
        for (int k = 0; k < 4; ++k) { const int m = m0 + k * NGW;
            f32x4 v[4]; float s = 0.f;
#pragma unroll
            for (int j = 0; j < 4; ++j) { v[j] = (f32x4){bflo(x[k][j].x), bfhi(x[k][j].x), bflo(x[k][j].y), bfhi(x[k][j].y)}; s += (v[j][0] + v[j][1]) + (v[j][2] + v[j][3]); }
            const float mean = wave_sum(s) * (1.f / D); float s2 = 0.f;
#pragma unroll
            for (int j = 0; j < 4; ++j) { v[j] = v[j] - mean; s2 += (v[j][0] * v[j][0] + v[j][1] * v[j][1]) + (v[j][2] * v[j][2] + v[j][3] * v[j][3]); }
            const float rstd = 1.f / sqrtf(wave_sum(s2) * (1.f / D) + LN_EPS);
            if (k == 0) __builtin_amdgcn_s_waitcnt(0x0F70);
            if (m < T) { v2u* xw = (v2u*)(XB_ + (size_t)m * D) + lane;
#pragma unroll
                for (int j = 0; j < 4; ++j) { const f32x4 y = v[j] * rstd * gv[j] + bv[j];
                    v2u o; o.x = pk2(y[0], y[1]); o.y = pk2(y[2], y[3]); xw[64 * j] = o;
                    ((unsigned*)(X8 + (size_t)m * D))[lane + 64 * j] = pk4_fp8(y[0], y[1], y[2], y[3]); } }
        }
    }
}

__device__ __forceinline__ bf16x8 pack8(const f32x4 a, const f32x4 b) {
    v4u o; o.x = pg8::cvt_pk_bf16(a[0], a[1]); o.y = pg8::cvt_pk_bf16(a[2], a[3]); o.z = pg8::cvt_pk_bf16(b[0], b[1]); o.w = pg8::cvt_pk_bf16(b[2], b[3]);
    return __builtin_bit_cast(bf16x8, o);
}
__device__ __forceinline__ f32x4 mfma16(const bf16x8 a, const bf16x8 b, const f32x4 c) { return __builtin_amdgcn_mfma_f32_16x16x32_bf16(a, b, c, 0, 0, 0); }
__device__ __forceinline__ float softplusf_(float x) { return fmaxf(x, 0.f) + log1pf(expf(-fabsf(x))); }

constexpr float MB_QSCALE = 0.08838834764831845f * 1.4426950408889634f;
struct EpiInProj {
    static constexpr bool PERM = true;
    unsigned char* ws; const float* a_log; const float* dt_bias;
    __device__ __forceinline__ void operator()(const f32x4 (&acc)[2][2][4][2], const pg8::Unit& u, int wr, int wc, int fr, int fq) const {
        const int pn = u.pn, row0 = u.pm * 256 + wr * 64 + fr, colt = wc * 32 + 8 * fq;
        if (pn == 30) {
            if (wc == 0 && fq < 2) {
                float al[8], db[8];
#pragma unroll
                for (int j = 0; j < 8; ++j) { al[j] = -expf(a_log[j]); db[j] = dt_bias[j]; }
#pragma unroll
                for (int ai = 0; ai < 2; ++ai)
#pragma unroll
                    for (int m = 0; m < 4; ++m) { const int row = row0 + ai * 128 + m * 16; const f32x4 v0 = acc[ai][0][m][0], v1 = acc[ai][0][m][1];
                        f32x4 o0, o1;
                        if (fq == 0) {
#pragma unroll
                            for (int e = 0; e < 4; ++e) { o0[e] = 1.f / (1.f + expf(-v0[e])); o1[e] = 1.f / (1.f + expf(-v1[e])); }
                            float* p = (float*)(ws + WS_BETA) + (size_t)row * 8; *(f32x4*)p = o0; *(f32x4*)(p + 4) = o1;
                        } else {
#pragma unroll
                            for (int e = 0; e < 4; ++e) { o0[e] = al[e] * softplusf_(v0[e] + db[e]); o1[e] = al[4 + e] * softplusf_(v1[e] + db[4 + e]); }
                            float* p = (float*)(ws + WS_GLOG) + (size_t)row * 8; *(f32x4*)p = o0; *(f32x4*)(p + 4) = o1;
                        } }
            }
            return;
        }
        int kind, ld, cbase; bf16* dst;
        if (pn < 12) { kind = 0; dst = (bf16*)(ws + WS_CONVIN); ld = 3072; cbase = pn * 256; }
        else if (pn < 16) { kind = 1; dst = (bf16*)(ws + WS_GG); ld = 1024; cbase = (pn - 12) * 256; }
        else if (pn < 20) { kind = 3; dst = (bf16*)(ws + WS_MQ); ld = 1024; cbase = (pn - 16) * 256; }
        else if (pn == 20) { kind = 3; dst = (bf16*)(ws + WS_MK); ld = 256; cbase = 0; }
        else if (pn == 21) { kind = 0; dst = (bf16*)(ws + WS_MV); ld = 256; cbase = 0; }
        else if (pn < 26) { kind = 2; dst = (bf16*)(ws + WS_SGG); ld = 1024; cbase = (pn - 22) * 256; }
        else { kind = 2; dst = (bf16*)(ws + WS_SGM); ld = 1024; cbase = (pn - 26) * 256; }
        const bool rope = (kind == 3) && (wc == 0);
        const int i0 = 8 * (fq & 1);
        float ksum[2][8];
#pragma unroll
        for (int bj = 0; bj < 2; ++bj)
#pragma unroll
            for (int e = 0; e < 8; ++e) ksum[bj][e] = 0.f;
        typedef _Float16 f16x8 __attribute__((ext_vector_type(8)));
        f16x8 cq[4], sq[4];
#pragma unroll
        for (int ai = 0; ai < 2; ++ai) {
            if (rope) {
#pragma unroll
                for (int k = 0; k < 4; ++k) { const _Float16* rp = (const _Float16*)(ws + WS_ROPE) + (size_t)(row0 + ai * 128 + k * 16) * 32 + i0; cq[k] = *(const f16x8*)rp; sq[k] = *(const f16x8*)(rp + 16); }
            }
#pragma unroll
            for (int m = 0; m < 4; ++m) { const int row = row0 + ai * 128 + m * 16; bf16* rowp = dst + (size_t)row * ld + cbase + colt;
                f32x4 c0, c1, s0, s1;
                if (rope) { const f16x8 cc = cq[m], ss = sq[m];
#pragma unroll
                    for (int e = 0; e < 4; ++e) { c0[e] = (float)cc[e]; c1[e] = (float)cc[4 + e]; s0[e] = (float)ss[e]; s1[e] = (float)ss[4 + e]; } }
#pragma unroll
                for (int bj = 0; bj < 2; ++bj) { f32x4 v0 = acc[ai][bj][m][0], v1 = acc[ai][bj][m][1];
                    if (kind == 1) {
#pragma unroll
                        for (int e = 0; e < 4; ++e) { v0[e] = siluf_(v0[e]); v1[e] = siluf_(v1[e]); }
                    } else if (kind == 2) {
#pragma unroll
                        for (int e = 0; e < 4; ++e) { v0[e] = sigmoidf_(v0[e]); v1[e] = sigmoidf_(v1[e]); }
                    } else if (rope) {
                        const float sg = fq < 2 ? -1.f : 1.f;
#pragma unroll
                        for (int e = 0; e < 4; ++e) { const float p0 = __shfl_xor(v0[e], 32), p1 = __shfl_xor(v1[e], 32);
                            v0[e] = v0[e] * c0[e] + sg * p0 * s0[e]; v1[e] = v1[e] * c1[e] + sg * p1 * s1[e]; }
                    }
                    if (pn == 20) {
#pragma unroll
                        for (int e = 0; e < 4; ++e) { ksum[bj][e] += v0[e]; ksum[bj][4 + e] += v1[e]; }
                    }
                    if (pn >= 16 && pn < 20) { v0 = v0 * MB_QSCALE; v1 = v1 * MB_QSCALE; }
                    v4u o; o.x = pg8::cvt_pk_bf16(v0[0], v0[1]); o.y = pg8::cvt_pk_bf16(v0[2], v0[3]); o.z = pg8::cvt_pk_bf16(v1[0], v1[1]); o.w = pg8::cvt_pk_bf16(v1[2], v1[3]);
                    *(v4u*)(rowp + bj * 128) = o; } }
        }
        if (pn == 20) {
            float* km = (float*)(ws + WS_CTL) + CW_KMEAN;
#pragma unroll
            for (int bj = 0; bj < 2; ++bj)
#pragma unroll
                for (int e = 0; e < 8; ++e) { float s = ksum[bj][e];
#pragma unroll
                    for (int o = 1; o < 16; o <<= 1) s += __shfl_xor(s, o);
                    if (fr == 0) atomicAdd(km + ((size_t)bj * 64 + u.pm) * 128 + colt + e, s * (1.f / 256.f)); }
        }
    }
};
template <bool ACCUM, bool F8OUT = false> struct EpiGate {
    static constexpr bool PERM = true;
    bf16* M; const bf16* gate; unsigned char* M8;
    __device__ __forceinline__ void operator()(const f32x4 (&acc)[2][2][4][2], const pg8::Unit& u, int wr, int wc, int fr, int fq) const {
        const int row0 = u.pm * 256 + wr * 64 + fr, col0 = u.pn * 256 + wc * 32 + 8 * fq;
        v4u gq[2][4], pq[2][4];
#define EG_RO(st, g) ((size_t)(row0 + ((st) >> 1) * 128 + (2 * ((st) & 1) + ((g) >> 1)) * 16) * 1024 + col0 + ((g) & 1) * 128)
#define EG_LOAD(st) do { _Pragma("unroll") for (int _g = 0; _g < 4; ++_g) { gq[(st) & 1][_g] = *(const v4u*)(gate + EG_RO(st, _g)); if (ACCUM) pq[(st) & 1][_g] = *(const v4u*)(M + EG_RO(st, _g)); } } while (0)
#define EG_STORE(st) do { _Pragma("unroll") for (int _g = 0; _g < 4; ++_g) { const int _ai = (st) >> 1, _m = 2 * ((st) & 1) + (_g >> 1), _bj = _g & 1; \
            const f32x4 v0 = acc[_ai][_bj][_m][0], v1 = acc[_ai][_bj][_m][1]; const v4u g = gq[(st) & 1][_g]; \
            float r[8] = {v0[0] * bflo(g.x), v0[1] * bfhi(g.x), v0[2] * bflo(g.y), v0[3] * bfhi(g.y), v1[0] * bflo(g.z), v1[1] * bfhi(g.z), v1[2] * bflo(g.w), v1[3] * bfhi(g.w)}; \
            if (ACCUM) { const v4u p = pq[(st) & 1][_g]; \
                r[0] += bflo(p.x); r[1] += bfhi(p.x); r[2] += bflo(p.y); r[3] += bfhi(p.y); r[4] += bflo(p.z); r[5] += bfhi(p.z); r[6] += bflo(p.w); r[7] += bfhi(p.w); } \
            if (F8OUT) { v2u o8; o8.x = pk4_fp8(4.f * r[0], 4.f * r[1], 4.f * r[2], 4.f * r[3]); o8.y = pk4_fp8(4.f * r[4], 4.f * r[5], 4.f * r[6], 4.f * r[7]); *(v2u*)(M8 + EG_RO(st, _g)) = o8; } \
            else { v4u o; o.x = pg8::cvt_pk_bf16(r[0], r[1]); o.y = pg8::cvt_pk_bf16(r[2], r[3]); o.z = pg8::cvt_pk_bf16(r[4], r[5]); o.w = pg8::cvt_pk_bf16(r[6], r[7]); \
                *(v4u*)(M + EG_RO(st, _g)) = o; } } } while (0)
        EG_LOAD(0); EG_LOAD(1);
        EG_STORE(0); EG_LOAD(2);
        EG_STORE(1); EG_LOAD(3);
        EG_STORE(2); EG_STORE(3);
#undef EG_RO
#undef EG_LOAD
#undef EG_STORE
    }
};

constexpr int GP_WF = 0, GP_QGF = 16384, GP_KDF = 32768, GP_AQF = 49152, GP_UT = 57344, GP_UNIT = 73728;
constexpr int PL_KB = 0, PL_QB = 17408, PL_RH = 34816, PL_X = 71680, PL_XT = 80896, PL_P = 99328, PL_SC = 108544;
__device__ __forceinline__ bf16x8 ldsfrag(const LAS unsigned char* base, int row, int stride, int ks, int q) { return *(const LAS bf16x8*)(base + row * stride + ks * 64 + q * 16); }

constexpr int PL_STG = 109056;
__device__ __forceinline__ void gdn_prep_all(Frame& F, const Args& a) {
    LAS unsigned char* L = F.lds; unsigned char* ws = F.ws;
    const int tid = threadIdx.x, lane = tid & 63, w = F.wave, l15 = lane & 15, q = lane >> 4;
    LAS float* sc_gc = (LAS float*)(L + PL_SC); LAS float* sc_beta = sc_gc + 64;
    const bf16* cin = (const bf16*)(ws + WS_CONVIN);
    float gpre = 0.f, bpre = 0.f;
#define GP_PREFETCH(uu_) do { const int _h = (uu_) & 7, _t0 = 64 * ((uu_) >> 3); \
        if (w == 0) { gpre = ((const float*)(ws + WS_GLOG))[(size_t)(_t0 + lane) * 8 + _h]; bpre = ((const float*)(ws + WS_BETA))[(size_t)(_t0 + lane) * 8 + _h]; } \
        _Pragma("unroll") for (int _i = 0; _i < 5; ++_i) { const int _pc = w + 8 * _i;     \
            if (_pc < 34) { const int _p = _pc / 17, _r0 = 4 * (_pc % 17); int _row = _r0 + (lane >> 4); if (_row > 66) _row = 66; int _t = _t0 - 3 + _row; if (_t < 0) _t = 0; \
                __builtin_amdgcn_global_load_lds((const unsigned*)(cin + (size_t)_t * 3072 + _p * 1024 + _h * 128 + (lane & 15) * 8), (LAS unsigned*)(L + PL_STG + _p * 17408 + _r0 * 256), 16, 0, 0); } } } while (0)
    unsigned uvn[11];
#define UV_PREFETCH(uu_) do { const int _h = (uu_) & 7, _t0 = 64 * ((uu_) >> 3); \
        _Pragma("unroll") for (int _jj = 0; _jj < 11; ++_jj) { int _t = _t0 + 8 * w - 3 + _jj; if (_t < 0) _t = 0; uvn[_jj] = *(const unsigned*)(cin + (size_t)_t * 3072 + 2048 + _h * 128 + 2 * lane); } } while (0)
    { const int u0 = F.bid < 2048 ? F.bid : 2047; UV_PREFETCH(u0); }
    if (F.bid < 2048) GP_PREFETCH(F.bid);
    int hcw = -1;
    constexpr int PL_CW = 144384;
  for (int u = F.bid; u < 2048; u += F.G) {
    const int h = u & 7, n = u >> 3, t0 = 64 * n;
    unsigned char* gp = ws + WS_GDNP + (size_t)(h * 256 + n) * GP_UNIT;
    if (h != hcw) { hcw = h;
        if (w == 0) {
#pragma unroll
            for (int p = 0; p < 3; ++p) { f32x2 tmpc[4];
#pragma unroll
                for (int j = 0; j < 4; ++j) tmpc[j] = *(const f32x2*)(a.in[2] + (size_t)j * 3072 + p * 1024 + h * 128 + 2 * lane);
                __builtin_amdgcn_sched_barrier(0);
#pragma unroll
                for (int j = 0; j < 4; ++j) *(LAS f32x2*)(L + PL_CW + ((p * 4 + j) * 64 + lane) * 8) = tmpc[j];
                __builtin_amdgcn_sched_barrier(0); }
        } }
    if (w == 0) { float g = gpre; const float b = bpre;
#pragma unroll
        for (int o = 1; o < 64; o <<= 1) { const float t = __shfl_up(g, o); if (lane >= o) g += t; }
        sc_gc[lane] = g; sc_beta[lane] = b; if (lane == 63) ((float*)(ws + WS_GL))[h * 256 + n] = expf(g); }
    __syncthreads();
    {
        unsigned uv[11];
#pragma unroll
        for (int jj = 0; jj < 11; ++jj) { const int t = t0 + 8 * w - 3 + jj; uv[jj] = (t >= 0) ? uvn[jj] : 0u; }
#pragma unroll
        for (int p = 0; p < 3; ++p) {
            f32x2 cw[4]; unsigned uu[11];
#pragma unroll
            for (int j = 0; j < 4; ++j) cw[j] = *(const LAS f32x2*)(L + PL_CW + ((p * 4 + j) * 64 + lane) * 8);
#pragma unroll
            for (int jj = 0; jj < 11; ++jj) { const int t = t0 + 8 * w - 3 + jj; uu[jj] = (p == 2) ? uv[jj] : ((t >= 0) ? *(const LAS unsigned*)(L + PL_STG + p * 17408 + (8 * w + jj) * 256 + lane * 4) : 0u); }
            float y0[8], y1[8], ss[8];
#pragma unroll
            for (int i = 0; i < 8; ++i) { float a0 = 0.f, a1 = 0.f;
#pragma unroll
                for (int j = 0; j < 4; ++j) { a0 += cw[j][0] * bflo(uu[i + j]); a1 += cw[j][1] * bfhi(uu[i + j]); }
                y0[i] = siluf_(a0); y1[i] = siluf_(a1); ss[i] = y0[i] * y0[i] + y1[i] * y1[i]; }
            if (p < 2) {
#pragma unroll
                for (int o = 1; o < 64; o <<= 1)
#pragma unroll
                    for (int i = 0; i < 8; ++i) ss[i] += __shfl_xor(ss[i], o);
#pragma unroll
                for (int i = 0; i < 8; ++i) { const float r = __builtin_amdgcn_rsqf(ss[i] + 1e-6f) * (p == 0 ? 0.08838834764831845f : 1.f); y0[i] *= r; y1[i] *= r; }
            }
            if (p < 2) {
#pragma unroll
                for (int i = 0; i < 8; ++i) *(LAS unsigned*)(L + (p == 0 ? PL_QB : PL_KB) + (8 * w + i) * 272 + lane * 4) = pg8::cvt_pk_bf16(y0[i], y1[i]);
            }
            if (p >= 1) {
                float f[8];
#pragma unroll
                for (int i = 0; i < 8; ++i) { const int c = 8 * w + i; f[i] = (p == 1) ? sc_beta[c] * __expf(sc_gc[c]) : sc_beta[c]; }
                v4u r0, r1;
                r0.x = pg8::cvt_pk_bf16(y0[0] * f[0], y0[1] * f[1]); r0.y = pg8::cvt_pk_bf16(y0[2] * f[2], y0[3] * f[3]); r0.z = pg8::cvt_pk_bf16(y0[4] * f[4], y0[5] * f[5]); r0.w = pg8::cvt_pk_bf16(y0[6] * f[6], y0[7] * f[7]);
                r1.x = pg8::cvt_pk_bf16(y1[0] * f[0], y1[1] * f[1]); r1.y = pg8::cvt_pk_bf16(y1[2] * f[2], y1[3] * f[3]); r1.z = pg8::cvt_pk_bf16(y1[4] * f[4], y1[5] * f[5]); r1.w = pg8::cvt_pk_bf16(y1[6] * f[6], y1[7] * f[7]);
                const int rb = (p == 1) ? 128 : 0;
                *(LAS v4u*)(L + PL_RH + (rb + 2 * lane) * 144 + 16 * w) = r0; *(LAS v4u*)(L + PL_RH + (rb + 2 * lane + 1) * 144 + 16 * w) = r1;
            }
        }
    }
    __syncthreads();
    if (u + F.G < 2048) GP_PREFETCH(u + F.G);
    { const int un = u + F.G < 2048 ? u + F.G : 2047; UV_PREFETCH(un); }
    const int mt = w & 3;
    f32x4 Pacc[4];
    {
        bf16x8 af[4];
#pragma unroll
        for (int ks = 0; ks < 4; ++ks) af[ks] = ldsfrag(L + PL_KB, 16 * mt + l15, 272, ks, q);
#pragma unroll
        for (int nt = 0; nt < 4; ++nt) { f32x4 acc = {0.f, 0.f, 0.f, 0.f};
#pragma unroll
            for (int ks = 0; ks < 4; ++ks) acc = mfma16(af[ks], ldsfrag(L + PL_KB, 16 * nt + l15, 272, ks, q), acc);
            const int s = 16 * nt + l15; const float gs = sc_gc[s]; f32x4 val;
#pragma unroll
            for (int r = 0; r < 4; ++r) { const int c = 16 * mt + 4 * q + r; val[r] = (s < c) ? sc_beta[c] * acc[r] * __expf(sc_gc[c] - gs) : 0.f; }
            if (w < 4) {
#pragma unroll
                for (int r = 0; r < 4; ++r) *(LAS bf16*)(L + PL_X + (16 * mt + 4 * q + r) * 144 + s * 2) = (bf16)f2bf(val[r]);
                v2u o; o.x = pg8::cvt_pk_bf16(val[0], val[1]); o.y = pg8::cvt_pk_bf16(val[2], val[3]);
                *(LAS v2u*)(L + PL_XT + s * 144 + (16 * mt + 4 * q) * 2) = o;
            } else {
#pragma unroll
                for (int r = 0; r < 4; ++r) { const int c = 16 * mt + 4 * q + r; Pacc[nt][r] = ((c == s) ? 1.f : 0.f) - val[r]; *(LAS bf16*)(L + PL_P + c * 144 + s * 2) = (bf16)f2bf(Pacc[nt][r]); }
            }
        }
        if (w >= 4) {
            bf16x8 qf[4];
#pragma unroll
            for (int ks = 0; ks < 4; ++ks) qf[ks] = ldsfrag(L + PL_QB, 16 * mt + l15, 272, ks, q);
            const int c = 16 * mt + l15; const float gcq = sc_gc[c];
            f32x4 aq[4];
#pragma unroll
            for (int m2 = 0; m2 < 4; ++m2) { f32x4 acc = {0.f, 0.f, 0.f, 0.f};
#pragma unroll
                for (int ks = 0; ks < 4; ++ks) acc = mfma16(ldsfrag(L + PL_KB, 16 * m2 + l15, 272, ks, q), qf[ks], acc);
#pragma unroll
                for (int r = 0; r < 4; ++r) { const int cp = 16 * m2 + 4 * q + r; aq[m2][r] = (cp <= c) ? acc[r] * __expf(gcq - sc_gc[cp]) : 0.f; } }
#pragma unroll
            for (int k2 = 0; k2 < 2; ++k2) *(bf16x8*)(gp + GP_AQF + (mt * 2 + k2) * 1024 + lane * 16) = pack8(aq[2 * k2], aq[2 * k2 + 1]);
        }
    }
    do { asm volatile("s_waitcnt lgkmcnt(0)" ::: "memory"); __builtin_amdgcn_s_barrier(); asm volatile("" ::: "memory"); } while (0);
#pragma unroll
    for (int lev = 0; lev < 6; ++lev) {
        const int cur = lev & 1;
        const LAS unsigned char* xt = L + PL_XT + cur * 9216;
        if (w < 4) {
            if (lev < 5) {
                bf16x8 af[2]; f32x4 xa[4];
#pragma unroll
                for (int ks = 0; ks < 2; ++ks) af[ks] = ldsfrag(L + PL_X, 16 * mt + l15, 144, ks, q);
#pragma unroll
                for (int nt = 0; nt < 4; ++nt) { xa[nt] = (f32x4){0.f, 0.f, 0.f, 0.f};
#pragma unroll
                    for (int ks = 0; ks < 2; ++ks) xa[nt] = mfma16(af[ks], ldsfrag(xt, 16 * nt + l15, 144, ks, q), xa[nt]); }
                LAS unsigned char* xtn = L + PL_XT + (cur ^ 1) * 9216;
#pragma unroll
                for (int nt = 0; nt < 4; ++nt) { const int s = 16 * nt + l15;
#pragma unroll
                    for (int r = 0; r < 4; ++r) *(LAS bf16*)(L + PL_X + (16 * mt + 4 * q + r) * 144 + s * 2) = (bf16)f2bf(xa[nt][r]);
                    v2u o; o.x = pg8::cvt_pk_bf16(xa[nt][0], xa[nt][1]); o.y = pg8::cvt_pk_bf16(xa[nt][2], xa[nt][3]);
                    *(LAS v2u*)(xtn + s * 144 + (16 * mt + 4 * q) * 2) = o; }
            }
        } else if (lev >= 1) {
            bf16x8 af[2];
#pragma unroll
            for (int ks = 0; ks < 2; ++ks) af[ks] = ldsfrag(L + PL_P, 16 * mt + l15, 144, ks, q);
#pragma unroll
            for (int nt = 0; nt < 4; ++nt)
#pragma unroll
                for (int ks = 0; ks < 2; ++ks) Pacc[nt] = mfma16(af[ks], ldsfrag(xt, 16 * nt + l15, 144, ks, q), Pacc[nt]);
#pragma unroll
            for (int nt = 0; nt < 4; ++nt)
#pragma unroll
                for (int r = 0; r < 4; ++r) *(LAS bf16*)(L + PL_P + (16 * mt + 4 * q + r) * 144 + (16 * nt + l15) * 2) = (bf16)f2bf(Pacc[nt][r]);
        }
        do { asm volatile("s_waitcnt lgkmcnt(0)" ::: "memory"); __builtin_amdgcn_s_barrier(); asm volatile("" ::: "memory"); } while (0);
    }
    __builtin_amdgcn_s_waitcnt(0x0F70);
    if (w < 4) {
#pragma unroll
        for (int i = 0; i < 2; ++i) { const int nt = 2 * w + i; f32x4 uu[4];
            const bf16x8 b0 = ldsfrag(L + PL_RH, 16 * nt + l15, 144, 0, q), b1 = ldsfrag(L + PL_RH, 16 * nt + l15, 144, 1, q);
#pragma unroll
            for (int m2 = 0; m2 < 4; ++m2) { uu[m2] = mfma16(ldsfrag(L + PL_P, 16 * m2 + l15, 144, 0, q), b0, (f32x4){0.f, 0.f, 0.f, 0.f}); uu[m2] = mfma16(ldsfrag(L + PL_P, 16 * m2 + l15, 144, 1, q), b1, uu[m2]); }
            unsigned char* up = gp + GP_UT + (16 * nt + l15) * 128 + q * 32;
            *(bf16x8*)up = pack8(uu[0], uu[1]); *(bf16x8*)(up + 16) = pack8(uu[2], uu[3]); }
    } else {
        const bf16x8 b0 = ldsfrag(L + PL_P, 16 * mt + l15, 144, 0, q), b1 = ldsfrag(L + PL_P, 16 * mt + l15, 144, 1, q);
        f32x4 wa[8];
#pragma unroll
        for (int md = 0; md < 8; ++md) { wa[md] = mfma16(ldsfrag(L + PL_RH, 128 + 16 * md + l15, 144, 0, q), b0, (f32x4){0.f, 0.f, 0.f, 0.f}); wa[md] = mfma16(ldsfrag(L + PL_RH, 128 + 16 * md + l15, 144, 1, q), b1, wa[md]); wa[md] = -wa[md]; }
#pragma unroll
        for (int ks = 0; ks < 4; ++ks) { const f32x4 a0 = wa[2 * ks] * 32.f, a1 = wa[2 * ks + 1] * 32.f; v2u o8; o8.x = pk4_fp8(a0[0], a0[1], a0[2], a0[3]); o8.y = pk4_fp8(a1[0], a1[1], a1[2], a1[3]);
            *(v2u*)(gp + GP_WF + (mt * 4 + ks) * 512 + lane * 8) = o8; }
    }
    {
        const float gl = sc_gc[63];
#pragma unroll
        for (int i = 0; i < 2; ++i) { const int f = 2 * w + i;
            { const int m2 = f >> 2, ks = f & 3, c = 16 * m2 + l15; const float eg = __expf(sc_gc[c]);
              const v2u x0 = *(const LAS v2u*)(L + PL_QB + c * 272 + (32 * ks + 4 * q) * 2), x1 = *(const LAS v2u*)(L + PL_QB + c * 272 + (32 * ks + 16 + 4 * q) * 2);
              const f32x4 v0 = {bflo(x0.x) * eg, bfhi(x0.x) * eg, bflo(x0.y) * eg, bfhi(x0.y) * eg}, v1 = {bflo(x1.x) * eg, bfhi(x1.x) * eg, bflo(x1.y) * eg, bfhi(x1.y) * eg};
              *(bf16x8*)(gp + GP_QGF + f * 1024 + lane * 16) = pack8(v0, v1); }
            { const int md = f >> 1, ks = f & 1, d = 16 * md + l15; f32x4 v0, v1;
#pragma unroll
              for (int r = 0; r < 4; ++r) { const int c0 = 32 * ks + 4 * q + r, c1 = c0 + 16;
                  v0[r] = bf2f(*(const LAS bf16*)(L + PL_KB + c0 * 272 + d * 2)) * __expf(gl - sc_gc[c0]); v1[r] = bf2f(*(const LAS bf16*)(L + PL_KB + c1 * 272 + d * 2)) * __expf(gl - sc_gc[c1]); }
              v2u o8; o8.x = pk4_fp8(64.f * v0[0], 64.f * v0[1], 64.f * v0[2], 64.f * v0[3]); o8.y = pk4_fp8(64.f * v1[0], 64.f * v1[1], 64.f * v1[2], 64.f * v1[3]);
              *(v2u*)(gp + GP_KDF + f * 512 + lane * 8) = o8; }
        }
    }
    do { asm volatile("s_waitcnt lgkmcnt(0)" ::: "memory"); __builtin_amdgcn_s_barrier(); asm volatile("" ::: "memory"); } while (0);
  }
#undef GP_PREFETCH
#undef UV_PREFETCH
}

__device__ __forceinline__ void gdn_scan(Frame& F, const int h) {
    LAS unsigned char* L = F.lds; unsigned char* ws = F.ws;
    const int lane = threadIdx.x & 63, w = F.wave, l15 = lane & 15, q = lane >> 4;
    const unsigned char* gph = ws + WS_GDNP + (size_t)h * 256 * GP_UNIT;
    const float* GLp = (const float*)(ws + WS_GL) + h * 256;
    float* Op = (float*)(ws + WS_O) + h * 128 + 16 * w + l15;
    f32x4 Sf[8];
#pragma unroll
    for (int md = 0; md < 8; ++md) Sf[md] = (f32x4){0.f, 0.f, 0.f, 0.f};
#define SCAN_ISSUE(nn) do { const unsigned char* _s = gph + (size_t)(nn) * GP_UNIT; LAS unsigned char* _d = L + ((nn) & 1) * 57344; \
        _Pragma("unroll") for (int _p = 0; _p < 7; ++_p) __builtin_amdgcn_global_load_lds((const unsigned*)(_s + (w + 8 * _p) * 1024 + lane * 16), (LAS unsigned*)(_d + (w + 8 * _p) * 1024), 16, 0, 0); } while (0)
    SCAN_ISSUE(0);
    for (int n = 0; n < 256; ++n) {
        VM_WAIT(); __syncthreads();
        if (n + 1 < 256) SCAN_ISSUE(n + 1);
        const LAS unsigned char* sl = L + (n & 1) * 57344;
        const unsigned char* up = gph + (size_t)n * GP_UNIT + GP_UT + (16 * w + l15) * 128 + q * 32;
        const v4u u0 = *(const v4u*)up, u1 = *(const v4u*)(up + 16);
        const float gl = GLp[n];
        bf16x8 sb[4];
#pragma unroll
        for (int ks = 0; ks < 4; ++ks) sb[ks] = pack8(Sf[2 * ks], Sf[2 * ks + 1]);
        f32x4 vn[4], oo[4];
        vn[0] = (f32x4){bflo(u0.x), bfhi(u0.x), bflo(u0.y), bfhi(u0.y)}; vn[1] = (f32x4){bflo(u0.z), bfhi(u0.z), bflo(u0.w), bfhi(u0.w)};
        vn[2] = (f32x4){bflo(u1.x), bfhi(u1.x), bflo(u1.y), bfhi(u1.y)}; vn[3] = (f32x4){bflo(u1.z), bfhi(u1.z), bflo(u1.w), bfhi(u1.w)};
#pragma unroll
        for (int m2 = 0; m2 < 4; ++m2) { oo[m2] = (f32x4){0.f, 0.f, 0.f, 0.f};
#pragma unroll
            for (int ks = 0; ks < 4; ++ks) { vn[m2] = mfma16(*(const LAS bf16x8*)(sl + GP_WF + (m2 * 4 + ks) * 1024 + lane * 16), sb[ks], vn[m2]);
                oo[m2] = mfma16(*(const LAS bf16x8*)(sl + GP_QGF + (m2 * 4 + ks) * 1024 + lane * 16), sb[ks], oo[m2]); } }
        const bf16x8 vb0 = pack8(vn[0], vn[1]), vb1 = pack8(vn[2], vn[3]);
#pragma unroll
        for (int m2 = 0; m2 < 4; ++m2) { oo[m2] = mfma16(*(const LAS bf16x8*)(sl + GP_AQF + (m2 * 2) * 1024 + lane * 16), vb0, oo[m2]);
            oo[m2] = mfma16(*(const LAS bf16x8*)(sl + GP_AQF + (m2 * 2 + 1) * 1024 + lane * 16), vb1, oo[m2]); }
#pragma unroll
        for (int md = 0; md < 8; ++md) { Sf[md] = Sf[md] * gl;
            Sf[md] = mfma16(*(const LAS bf16x8*)(sl + GP_KDF + (md * 2) * 1024 + lane * 16), vb0, Sf[md]);
            Sf[md] = mfma16(*(const LAS bf16x8*)(sl + GP_KDF + (md * 2 + 1) * 1024 + lane * 16), vb1, Sf[md]); }
#pragma unroll
        for (int m2 = 0; m2 < 4; ++m2)
#pragma unroll
            for (int r = 0; r < 4; ++r) Op[(size_t)(64 * n + 16 * m2 + 4 * q + r) * 1024] = oo[m2][r];
    }
#undef SCAN_ISSUE
    VM_WAIT(); __syncthreads();
}

__device__ __forceinline__ v4u fp8x8_bf16(const unsigned a, const unsigned b, const float sc) {
    typedef float f32x2_ __attribute__((ext_vector_type(2)));
    const f32x2_ p0 = __builtin_amdgcn_cvt_pk_f32_fp8(a, false), p1 = __builtin_amdgcn_cvt_pk_f32_fp8(a, true), p2 = __builtin_amdgcn_cvt_pk_f32_fp8(b, false), p3 = __builtin_amdgcn_cvt_pk_f32_fp8(b, true);
    v4u o; o.x = pg8::cvt_pk_bf16(p0[0] * sc, p0[1] * sc); o.y = pg8::cvt_pk_bf16(p1[0] * sc, p1[1] * sc); o.z = pg8::cvt_pk_bf16(p2[0] * sc, p2[1] * sc); o.w = pg8::cvt_pk_bf16(p3[0] * sc, p3[1] * sc);
    return o;
}

constexpr int NSCAN = 32, NWARM = 8;
constexpr int SC_SLOT = 36864;
constexpr int SC_WU = 20480, SC_KD = 16384;
__device__ __forceinline__ void gdn_scan2(Frame& F, const int b) {
    LAS unsigned char* L = F.lds; unsigned char* ws = F.ws;
    const int lane = threadIdx.x & 63, w = F.wave, l15 = lane & 15, q = lane >> 4;
    const int h = b & 7, part = b >> 3;
    unsigned char* gph = ws + WS_GDNP + (size_t)h * 256 * GP_UNIT;
    unsigned char* sbp = ws + WS_O + (size_t)h * 256 * 32768;
    constexpr int KDR = 4 * SC_WU, GLT = KDR + 4 * SC_KD;
#define SC_BAR() do { asm volatile("s_waitcnt lgkmcnt(0)" ::: "memory"); __builtin_amdgcn_s_barrier(); asm volatile("" ::: "memory"); } while (0)
    if (threadIdx.x < 256) ((LAS float*)(L + GLT))[threadIdx.x] = ((const float*)(ws + WS_GL))[h * 256 + threadIdx.x];
#define SC_HSTEP(n, RS) do { SC_PUT(RS, (n) + 2); SC_LOAD(RS, (n) + 10); \
            if (w == 7 && lane == 0) __hip_atomic_store(&F.ctl[CW_PROG + 64 * b], (unsigned)((n) + 1), __ATOMIC_RELAXED, __HIP_MEMORY_SCOPE_AGENT); \
            SC_BAR(); } while (0)
#define SC_LOOP() do { \
        SC_LOAD(r0, 0); SC_LOAD(r1, 1); SC_LOAD(r2, 2); SC_LOAD(r3, 3); SC_LOAD(r4, 4); SC_LOAD(r5, 5); SC_LOAD(r6, 6); SC_LOAD(r7, 7); \
        SC_PUT(r0, 0); SC_LOAD(r0, 8); SC_PUT(r1, 1); SC_LOAD(r1, 9);          \
        SC_BAR(); SC_BAR(); \
          \
        _Pragma("unroll 1") for (int n0 = 0; n0 < 256; n0 += 8) { SC_HSTEP(n0, r2); SC_HSTEP(n0 + 1, r3); SC_HSTEP(n0 + 2, r4); SC_HSTEP(n0 + 3, r5); SC_HSTEP(n0 + 4, r6); SC_HSTEP(n0 + 5, r7); SC_HSTEP(n0 + 6, r0); SC_HSTEP(n0 + 7, r1); } } while (0)
    if (w >= 6) {
        const int sok = GP_KDF + (4 * (w - 6)) * 1024 + lane * 16, dok = KDR + (8 * (w - 6) + (lane >> 5)) * 1024 + (lane & 31) * 32;
#define SC_LOAD(R, nn) do { const int _nn = (nn) < 255 ? (nn) : 255; const unsigned char* _u = gph + (size_t)_nn * GP_UNIT + sok; _Pragma("unroll") for (int _i = 0; _i < 4; ++_i) R[_i] = *(const v4u*)(_u + _i * 1024); } while (0)
#define SC_PUT(R, nn) do { LAS unsigned char* _d = L + dok + ((nn) & 3) * SC_KD; _Pragma("unroll") for (int _i = 0; _i < 4; ++_i) { \
            *(LAS v4u*)(_d + _i * 2048) = fp8x8_bf16(R[_i].x, R[_i].y, 1.f / 64.f); *(LAS v4u*)(_d + _i * 2048 + 16) = fp8x8_bf16(R[_i].z, R[_i].w, 1.f / 64.f); } } while (0)
        v4u r0[4], r1[4], r2[4], r3[4], r4[4], r5[4], r6[4], r7[4];
        SC_LOOP();
#undef SC_LOAD
#undef SC_PUT
    } else if (w >= 2) {
        const int lw = w - 2;
        const int sow = GP_WF + (2 * lw) * 1024 + lane * 16, sou = GP_UT + part * 4096 + lw * 1024 + lane * 16;
        const int dww = (4 * lw + (lane >> 5)) * 1024 + (lane & 31) * 32, dwu = 16384 + lw * 1024 + lane * 16;
#define SC_LOAD(R, nn) do { const int _nn = (nn) < 255 ? (nn) : 255; const unsigned char* _u = gph + (size_t)_nn * GP_UNIT; R[0] = *(const v4u*)(_u + sow); R[1] = *(const v4u*)(_u + sow + 1024); R[2] = *(const v4u*)(_u + sou); } while (0)
#define SC_PUT(R, nn) do { LAS unsigned char* _d = L + ((nn) & 3) * SC_WU; _Pragma("unroll") for (int _i = 0; _i < 2; ++_i) { \
            *(LAS v4u*)(_d + dww + _i * 2048) = fp8x8_bf16(R[_i].x, R[_i].y, 1.f / 32.f); *(LAS v4u*)(_d + dww + _i * 2048 + 16) = fp8x8_bf16(R[_i].z, R[_i].w, 1.f / 32.f); } \
            *(LAS v4u*)(_d + dwu) = R[2]; } while (0)
        v4u r0[3], r1[3], r2[3], r3[3], r4[3], r5[3], r6[3], r7[3];
        SC_LOOP();
#undef SC_LOAD
#undef SC_PUT
#undef SC_LOOP
#undef SC_HSTEP
    } else {
        f32x4 Sf[8];
#pragma unroll
        for (int md = 0; md < 8; ++md) Sf[md] = (f32x4){0.f, 0.f, 0.f, 0.f};
        bf16x8 wf[16], kf[16]; v4u u0, u1;
        SC_BAR();
#pragma unroll
        for (int i = 0; i < 16; ++i) wf[i] = *(const LAS bf16x8*)(L + i * 1024 + lane * 16);
        { const LAS unsigned char* up = L + 16384 + (16 * w + l15) * 128 + q * 32; u0 = *(const LAS v4u*)up; u1 = *(const LAS v4u*)(up + 16); }
#pragma unroll
        for (int i = 0; i < 16; ++i) kf[i] = *(const LAS bf16x8*)(L + KDR + i * 1024 + lane * 16);
        SC_BAR();
        const int slice = 2 * part + w;
#pragma unroll 1
        for (int n = 0; n < 256; ++n) {
            f32x4 vn[4];
            vn[0] = (f32x4){bflo(u0.x), bfhi(u0.x), bflo(u0.y), bfhi(u0.y)}; vn[1] = (f32x4){bflo(u0.z), bfhi(u0.z), bflo(u0.w), bfhi(u0.w)};
            vn[2] = (f32x4){bflo(u1.x), bfhi(u1.x), bflo(u1.y), bfhi(u1.y)}; vn[3] = (f32x4){bflo(u1.z), bfhi(u1.z), bflo(u1.w), bfhi(u1.w)};
            const float gl = ((const LAS float*)(L + GLT))[n];
            bf16x8 sb[4];
#pragma unroll
            for (int ks = 0; ks < 4; ++ks) { sb[ks] = pack8(Sf[2 * ks], Sf[2 * ks + 1]);
                *(bf16x8*)(sbp + ((size_t)n * 32 + slice * 4 + ks) * 1024 + lane * 16) = sb[ks]; }
            asm volatile("s_waitcnt lgkmcnt(0)" ::: "memory");
            __builtin_amdgcn_sched_barrier(0);
#pragma unroll
            for (int ks = 0; ks < 4; ++ks)
#pragma unroll
                for (int m2 = 0; m2 < 4; ++m2) vn[m2] = mfma16(wf[m2 * 4 + ks], sb[ks], vn[m2]);
            __builtin_amdgcn_sched_barrier(0);
#pragma unroll
            for (int md = 0; md < 8; ++md) Sf[md] = Sf[md] * gl;
            if (n + 1 < 256) { const LAS unsigned char* wu = L + ((n + 1) & 3) * SC_WU;
#pragma unroll
                for (int i = 0; i < 16; ++i) wf[i] = *(const LAS bf16x8*)(wu + i * 1024 + lane * 16);
                const LAS unsigned char* up = wu + 16384 + (16 * w + l15) * 128 + q * 32; u0 = *(const LAS v4u*)up; u1 = *(const LAS v4u*)(up + 16); }
            __builtin_amdgcn_sched_barrier(0);
            const bf16x8 vb0 = pack8(vn[0], vn[1]), vb1 = pack8(vn[2], vn[3]);
            unsigned char* vbp = gph + (size_t)n * GP_UNIT + GP_UT + slice * 2048 + lane * 16;
            *(bf16x8*)vbp = vb0; *(bf16x8*)(vbp + 1024) = vb1;
#pragma unroll
            for (int md = 0; md < 8; ++md) Sf[md] = mfma16(kf[md * 2], vb0, Sf[md]);
#pragma unroll
            for (int md = 0; md < 8; ++md) Sf[md] = mfma16(kf[md * 2 + 1], vb1, Sf[md]);
            __builtin_amdgcn_sched_barrier(0);
            if (n + 1 < 256) { const LAS unsigned char* kd = L + KDR + ((n + 1) & 3) * SC_KD;
#pragma unroll
                for (int i = 0; i < 16; ++i) kf[i] = *(const LAS bf16x8*)(kd + i * 1024 + lane * 16); }
            SC_BAR();
        }
    }
#undef SC_BAR
    VM_WAIT(); __syncthreads();
}

__device__ __forceinline__ void gdn_scan_warm(Frame& F, const int h) {
    unsigned char* ws = F.ws; const int tid = threadIdx.x;
    const unsigned char* gph = ws + WS_GDNP + (size_t)h * 256 * GP_UNIT;
    LAS unsigned* pw = (LAS unsigned*)(F.lds + 1024);
    unsigned acc = 0u;
    constexpr int WDIST = 14;
    for (int m = 0; m < 256; ++m) {
        if (m >= WDIST) {
            if (tid == 0) { unsigned sp = 0; while (__hip_atomic_load(&F.ctl[CW_PROG + 64 * h], __ATOMIC_RELAXED, __HIP_MEMORY_SCOPE_AGENT) + WDIST < (unsigned)m + 1u) { __builtin_amdgcn_s_sleep(4); if (++sp > (1u << 22)) break; } }
            __syncthreads();
        }
        const unsigned char* u = gph + (size_t)m * GP_UNIT;
#pragma unroll
        for (int i = 0; i < 2; ++i) { const int x = tid + 512 * i, p = x >> 6, o = (x & 63) * 16;
            const unsigned char* src = u + (p < 8 ? GP_WF + p * 1024 : GP_KDF + (p - 8) * 1024) + o;
            const v4u v = *(const v4u*)src; acc ^= v.x ^ v.y ^ v.z ^ v.w; }
    }
    if (acc == 0x12345u) *pw = acc;
    __syncthreads();
}

__device__ __forceinline__ void gdn_ophase(Frame& F, const float* norm_w) {
    unsigned char* ws = F.ws; const int lane = threadIdx.x & 63, w = F.wave, l15 = lane & 15, q = lane >> 4, mt = w & 3, us = w >> 2;
    LAS unsigned char* LB = F.lds + us * 49152;
    LAS unsigned char* tl = F.lds + 98304 + w * 4352;
    float nwv[8];
#pragma unroll
    for (int sl = 0; sl < 8; ++sl) nwv[sl] = norm_w[16 * sl + l15];
    v4u gq[4], gqn[4]; bf16x8 aq[4], aa[2], aqn[4], aan[2]; v4u bsh[12];
#define OP_REQ(u_, GQ, AQ, AA) do { const int _u = (u_) < 2048 ? (u_) : 2047, _h = _u >> 8, _n = _u & 255; \
        const unsigned char* _gp = ws + WS_GDNP + (size_t)_u * GP_UNIT; const unsigned char* _sbp = ws + WS_O + (size_t)_u * 32768; \
        const size_t _gidx = (size_t)(64 * _n + 16 * mt + (lane >> 2)) * 1024 + _h * 128 + (lane & 3) * 32; \
        _Pragma("unroll") for (int _c = 0; _c < 4; ++_c) GQ[_c] = *(const v4u*)((const bf16*)(ws + WS_GG) + _gidx + _c * 8); \
        _Pragma("unroll") for (int _k = 0; _k < 4; ++_k) AQ[_k] = *(const bf16x8*)(_gp + GP_QGF + (mt * 4 + _k) * 1024 + lane * 16); \
        _Pragma("unroll") for (int _k = 0; _k < 2; ++_k) AA[_k] = *(const bf16x8*)(_gp + GP_AQF + (mt * 2 + _k) * 1024 + lane * 16); \
        _Pragma("unroll") for (int _i = 0; _i < 8; ++_i) bsh[_i] = *(const v4u*)(_sbp + (8 * mt + _i) * 1024 + lane * 16); \
        _Pragma("unroll") for (int _i = 0; _i < 4; ++_i) bsh[8 + _i] = *(const v4u*)(_gp + GP_UT + (4 * mt + _i) * 1024 + lane * 16); } while (0)
    int u = 2 * F.bid + us;
    OP_REQ(u, gqn, aqn, aan);
    for (; u < 2048; u += 2 * F.G) {
        const int h = u >> 8, n = u & 255;
        __syncthreads();
#pragma unroll
        for (int i = 0; i < 8; ++i) *(LAS v4u*)(LB + (8 * mt + i) * 1024 + lane * 16) = bsh[i];
#pragma unroll
        for (int i = 0; i < 4; ++i) *(LAS v4u*)(LB + 32768 + (4 * mt + i) * 1024 + lane * 16) = bsh[8 + i];
#pragma unroll
        for (int c = 0; c < 4; ++c) { gq[c] = gqn[c]; aq[c] = aqn[c]; }
        aa[0] = aan[0]; aa[1] = aan[1];
        __syncthreads();
        OP_REQ(u + 2 * F.G, gqn, aqn, aan);
        f32x4 o[8]; float ss[4] = {0.f, 0.f, 0.f, 0.f};
#pragma unroll
        for (int sl = 0; sl < 8; ++sl) { o[sl] = (f32x4){0.f, 0.f, 0.f, 0.f};
#pragma unroll
            for (int ks = 0; ks < 4; ++ks) o[sl] = mfma16(aq[ks], *(const LAS bf16x8*)(LB + (sl * 4 + ks) * 1024 + lane * 16), o[sl]);
#pragma unroll
            for (int k2 = 0; k2 < 2; ++k2) o[sl] = mfma16(aa[k2], *(const LAS bf16x8*)(LB + 32768 + (sl * 2 + k2) * 1024 + lane * 16), o[sl]);
#pragma unroll
            for (int r = 0; r < 4; ++r) ss[r] += o[sl][r] * o[sl][r]; }
#pragma unroll
        for (int r = 0; r < 4; ++r) { float s = ss[r]; s += __shfl_xor(s, 1); s += __shfl_xor(s, 2); s += __shfl_xor(s, 4); s += __shfl_xor(s, 8); ss[r] = 1.f / sqrtf(s * (1.f / 128.f) + 1e-6f); }
#pragma unroll
        for (int sl = 0; sl < 8; ++sl) { const float nw = nwv[sl];
#pragma unroll
            for (int r = 0; r < 4; ++r) *(LAS bf16*)(tl + (4 * q + r) * 272 + (16 * sl + l15) * 2) = (bf16)f2bf(o[sl][r] * ss[r] * nw); }
        LDS_WAIT(); asm volatile("" ::: "memory");
        __builtin_amdgcn_s_waitcnt(0x0F70);
        { const int row = lane >> 2, seg = lane & 3; const size_t idx = (size_t)(64 * n + 16 * mt + row) * 1024 + h * 128 + seg * 32;
          bf16* OG = (bf16*)(ws + WS_OG);
#pragma unroll
          for (int c4 = 0; c4 < 4; ++c4) { const v4u y = *(const LAS v4u*)(tl + row * 272 + seg * 64 + c4 * 16), g = gq[c4];
              v2u d; d.x = pk4_fp8(bflo(y.x) * bflo(g.x), bfhi(y.x) * bfhi(g.x), bflo(y.y) * bflo(g.y), bfhi(y.y) * bfhi(g.y)); d.y = pk4_fp8(bflo(y.z) * bflo(g.z), bfhi(y.z) * bfhi(g.z), bflo(y.w) * bflo(g.w), bfhi(y.w) * bfhi(g.w));
              *(v2u*)((unsigned char*)OG + idx + c4 * 8) = d; } }
        LDS_WAIT(); asm volatile("" ::: "memory");
    }
#undef OP_REQ
    __syncthreads();
}

__device__ __forceinline__ void gdn_post(Frame& F, const float* norm_w) {
    unsigned char* ws = F.ws; const int lane = threadIdx.x & 63;
    const int gw = F.bid * NWAVES + F.wave, NGW = F.G * NWAVES;
    f32x4 nw[4];
#pragma unroll
    for (int j = 0; j < 4; ++j) nw[j] = *(const f32x4*)(norm_w + (lane & 7) * 16 + 4 * j);
    for (int t = gw; t < T; t += NGW) {
        const f32x4* op = (const f32x4*)((const float*)(ws + WS_O) + (size_t)t * 1024 + lane * 16);
        f32x4 o[4]; float ss = 0.f;
#pragma unroll
        for (int j = 0; j < 4; ++j) { o[j] = op[j]; ss += (o[j][0] * o[j][0] + o[j][1] * o[j][1]) + (o[j][2] * o[j][2] + o[j][3] * o[j][3]); }
        ss += __shfl_xor(ss, 1); ss += __shfl_xor(ss, 2); ss += __shfl_xor(ss, 4);
        const float r = 1.f / sqrtf(ss * (1.f / 128.f) + 1e-6f);
        const v4u* gpn = (const v4u*)((const bf16*)(ws + WS_GG) + (size_t)t * 1024 + lane * 16);
        const v4u g0 = gpn[0], g1 = gpn[1];
        const float gg[16] = {bflo(g0.x), bfhi(g0.x), bflo(g0.y), bfhi(g0.y), bflo(g0.z), bfhi(g0.z), bflo(g0.w), bfhi(g0.w), bflo(g1.x), bfhi(g1.x), bflo(g1.y), bfhi(g1.y), bflo(g1.z), bfhi(g1.z), bflo(g1.w), bfhi(g1.w)};
        float y[16];
#pragma unroll
        for (int j = 0; j < 4; ++j)
#pragma unroll
            for (int e = 0; e < 4; ++e) y[4 * j + e] = o[j][e] * r * nw[j][e] * gg[4 * j + e];
        v4u* dp = (v4u*)((bf16*)(ws + WS_OG) + (size_t)t * 1024 + lane * 16);
        v4u d0, d1; d0.x = pk2(y[0], y[1]); d0.y = pk2(y[2], y[3]); d0.z = pk2(y[4], y[5]); d0.w = pk2(y[6], y[7]); d1.x = pk2(y[8], y[9]); d1.y = pk2(y[10], y[11]); d1.z = pk2(y[12], y[13]); d1.w = pk2(y[14], y[15]);
        dp[0] = d0; dp[1] = d1;
    }
}

constexpr int ML_LTOT = 2064384;
__device__ __forceinline__ int moba_listoff(int g, int n) { return g * ML_LTOT + 4 * (n * T - 128 * n * (n + 1)); }
typedef short s16x4 __attribute__((ext_vector_type(4)));

__device__ __forceinline__ void moba_select_unit(Frame& F, const int g, const int b) {
    if (b == 0) return;
    LAS unsigned char* L = F.lds; unsigned char* ws = F.ws;
    const int tid = threadIdx.x, lane = tid & 63, w = F.wave, l15 = lane & 15, q = lane >> 4;
    constexpr int KH = 0, KL = 17408, GS = 34816, SEL = 68096, LC = 80384, LB = 80640;
    const float* km = (const float*)(ws + WS_CTL) + CW_KMEAN + (size_t)g * 64 * 128;
    for (int i = tid; i < 64 * 128; i += 512) { const int n = i >> 7, d = i & 127; const float x = (n < b) ? km[i] : 0.f; const unsigned hi = f2bf(x); const float lo = x - bf2f(hi);
        *(LAS bf16*)(L + KH + n * 272 + d * 2) = (bf16)hi; *(LAS bf16*)(L + KL + n * 272 + d * 2) = (bf16)f2bf(lo); }
    if (tid < 64) *(LAS unsigned*)(L + LC + tid * 4) = 0u;
    __syncthreads();
    const bf16* MQ = (const bf16*)(ws + WS_MQ);
    LAS float* gs = (LAS float*)(L + GS + w * 4160);
    const int nsel = b < 3 ? b : 3;
#define MS_LOADQ(dst, mt_) do { const int _r0 = (mt_) * 16 + l15; const bf16* _qp = MQ + (size_t)(256 * b + (_r0 >> 2)) * 1024 + (4 * g + (_r0 & 3)) * 128 + 8 * q; \
        _Pragma("unroll") for (int _ks = 0; _ks < 4; ++_ks) dst[_ks] = *(const bf16x8*)(_qp + 32 * _ks); } while (0)
    bf16x8 af[4], af1[4], af2[4];
    MS_LOADQ(af, w); MS_LOADQ(af1, w + 8); MS_LOADQ(af2, w + 16);
    for (int mtile = w; mtile < 64; mtile += 8) {
#pragma unroll
        for (int nt = 0; nt < 4; ++nt) { f32x4 acc = {0.f, 0.f, 0.f, 0.f};
#pragma unroll
            for (int ks = 0; ks < 4; ++ks) { acc = mfma16(af[ks], ldsfrag(L + KH, 16 * nt + l15, 272, ks, q), acc); acc = mfma16(af[ks], ldsfrag(L + KL, 16 * nt + l15, 272, ks, q), acc); }
#pragma unroll
            for (int r = 0; r < 4; ++r) gs[(4 * q + r) * 65 + 16 * nt + l15] = acc[r]; }
        LDS_WAIT(); asm volatile("" ::: "memory");
        {
            const int row = lane >> 2, part = lane & 3;
            float v0 = -INFINITY, v1 = -INFINITY, v2 = -INFINITY; int i0 = 0, i1 = 0, i2 = 0;
            const int nlo = part * 16, nhi = (nlo + 16 < b) ? nlo + 16 : b;
            for (int n = nlo; n < nhi; ++n) { const float x = gs[row * 65 + n];
                if (x > v0) { v2 = v1; i2 = i1; v1 = v0; i1 = i0; v0 = x; i0 = n; } else if (x > v1) { v2 = v1; i2 = i1; v1 = x; i1 = n; } else if (x > v2) { v2 = x; i2 = n; } }
#pragma unroll
            for (int o = 1; o < 4; o <<= 1) {
                const float w0 = __shfl_xor(v0, o), w1 = __shfl_xor(v1, o), w2 = __shfl_xor(v2, o); const int j0 = __shfl_xor(i0, o), j1 = __shfl_xor(i1, o), j2 = __shfl_xor(i2, o);
                const bool lower = (lane & o) == 0;
                const float a0 = lower ? v0 : w0, a1 = lower ? v1 : w1, a2 = lower ? v2 : w2, b0 = lower ? w0 : v0, b1 = lower ? w1 : v1, b2 = lower ? w2 : v2;
                const int ia0 = lower ? i0 : j0, ia1 = lower ? i1 : j1, ia2 = lower ? i2 : j2, ib0 = lower ? j0 : i0, ib1 = lower ? j1 : i1, ib2 = lower ? j2 : i2;
                float r0, r1, r2; int k0, k1, k2;
                if (b0 > a0) { r0 = b0; k0 = ib0;
                    if (b1 > a0) { r1 = b1; k1 = ib1; if (b2 > a0) { r2 = b2; k2 = ib2; } else { r2 = a0; k2 = ia0; } }
                    else { r1 = a0; k1 = ia0; if (b1 > a1) { r2 = b1; k2 = ib1; } else { r2 = a1; k2 = ia1; } } }
                else { r0 = a0; k0 = ia0;
                    if (b0 > a1) { r1 = b0; k1 = ib0; if (b1 > a1) { r2 = b1; k2 = ib1; } else { r2 = a1; k2 = ia1; } }
                    else { r1 = a1; k1 = ia1; if (b0 > a2) { r2 = b0; k2 = ib0; } else { r2 = a2; k2 = ia2; } } }
                v0 = r0; v1 = r1; v2 = r2; i0 = k0; i1 = k1; i2 = k2;
            }
            if (part == 0) { const int rr = mtile * 16 + row;
#pragma unroll
                for (int j = 0; j < 3; ++j) if (j < nsel) { const int blk = j == 0 ? i0 : (j == 1 ? i1 : i2);
                    const unsigned lp = __hip_atomic_fetch_add((LAS unsigned*)(L + LC + blk * 4), 1u, __ATOMIC_RELAXED, __HIP_MEMORY_SCOPE_WORKGROUP);
                    *(LAS unsigned short*)(L + SEL + (rr * 3 + j) * 2) = (unsigned short)blk; *(LAS unsigned short*)(L + SEL + 6144 + (rr * 3 + j) * 2) = (unsigned short)lp; } }
        }
        LDS_WAIT(); asm volatile("" ::: "memory");
#pragma unroll
        for (int ks = 0; ks < 4; ++ks) { af[ks] = af1[ks]; af1[ks] = af2[ks]; }
        if (mtile + 24 < 64) MS_LOADQ(af2, mtile + 24);
    }
#undef MS_LOADQ
    __syncthreads();
    if (tid < b) { const unsigned c = *(LAS unsigned*)(L + LC + tid * 4); *(LAS unsigned*)(L + LB + tid * 4) = c ? atomicAdd(&F.ctl[CW_MOBA_CNT + g * 64 + tid], c) : 0u; }
    __syncthreads();
    unsigned* lists = (unsigned*)(ws + WS_LISTS);
    for (int rr = tid; rr < 1024; rr += 512) { const int t = 256 * b + (rr >> 2), hr = rr & 3;
        for (int j = 0; j < nsel; ++j) { const int blk = *(LAS unsigned short*)(L + SEL + (rr * 3 + j) * 2); const unsigned lp = *(LAS unsigned short*)(L + SEL + 6144 + (rr * 3 + j) * 2);
            lists[moba_listoff(g, blk) + *(LAS unsigned*)(L + LB + blk * 4) + lp] = (unsigned)t | ((unsigned)hr << 14) | ((unsigned)j << 16); } }
    __syncthreads();
}

__device__ __forceinline__ void moba_attn_unit(Frame& F, const int g, const int n, const unsigned* list, const int count, const bool own) {
    LAS unsigned char* L = F.lds; unsigned char* ws = F.ws;
    const int tid = threadIdx.x, lane = tid & 63, w = F.wave, l15 = lane & 15, q = lane >> 4;
    constexpr int KS = 0, VS = 73728;
    { const bf16* MK = (const bf16*)(ws + WS_MK) + (size_t)(256 * n) * 256 + g * 128; const bf16* MV = (const bf16*)(ws + WS_MV) + (size_t)(256 * n) * 256 + g * 128;
        v4u kv[8], vv[8];
#pragma unroll
        for (int i = 0; i < 8; ++i) { const int p = tid + 512 * i, row = p >> 4, ch = p & 15; kv[i] = *(const v4u*)(MK + (size_t)row * 256 + ch * 8); vv[i] = *(const v4u*)(MV + (size_t)row * 256 + ch * 8); }
#pragma unroll
        for (int i = 0; i < 8; ++i) { const int p = tid + 512 * i, row = p >> 4, ch = p & 15; *(LAS v4u*)(L + KS + row * 288 + ch * 16) = kv[i]; *(LAS v4u*)(L + VS + row * 288 + ch * 16) = vv[i]; } }
    __syncthreads();
    const bf16* MQ = (const bf16*)(ws + WS_MQ); bf16* PO = (bf16*)(ws + WS_PO); float* LSE = (float*)(ws + WS_LSE);
    const int ntile = (count + 15) >> 4;
#define MB_ENTRY(tl) ({ int _i = (tl) * 16 + l15; if (_i >= count) _i = count - 1; own ? ((unsigned)(256 * n + (_i >> 2)) | ((unsigned)(_i & 3) << 14) | (3u << 16)) : list[_i]; })
#define MB_LOADQ(dst, e) do { const bf16* _qp = MQ + (size_t)((e) & 16383u) * 1024 + (4 * g + (int)(((e) >> 14) & 3u)) * 128 + 8 * q; \
        _Pragma("unroll") for (int _ks = 0; _ks < 4; ++_ks) dst[_ks] = *(const bf16x8*)(_qp + 32 * _ks); } while (0)
    unsigned e_cur = 0u, e_nxt = 0u; bf16x8 qf[4], qn[4];
    if (w < ntile) { e_cur = MB_ENTRY(w); MB_LOADQ(qf, e_cur); }
    if (w + 8 < ntile) e_nxt = MB_ENTRY(w + 8);
    __builtin_amdgcn_s_waitcnt(0x0F70);
    for (int tile = w; tile < ntile; tile += 8) {
        unsigned e_nn = 0u;
        if (tile + 16 < ntile) e_nn = MB_ENTRY(tile + 16);
        if (tile + 8 < ntile) MB_LOADQ(qn, e_nxt);
        const bool live = tile * 16 + l15 < count;
        const int t = (int)(e_cur & 16383u), hr = (int)((e_cur >> 14) & 3u), j = (int)((e_cur >> 16) & 3u), h = 4 * g + hr;
        f32x4 s[16];
        {
            bf16x8 ka[8], kb[8];
#define MB_LDK(dst, g) do { _Pragma("unroll") for (int _i = 0; _i < 8; ++_i) dst[_i] = ldsfrag(L + KS, 16 * (2 * (g) + (_i >> 2)) + l15, 288, _i & 3, q); } while (0)
#define MB_MMK(src, g) do { _Pragma("unroll") for (int _h = 0; _h < 2; ++_h) { _Pragma("unroll") for (int _ks = 0; _ks < 4; ++_ks) s[2 * (g) + _h] = mfma16(src[_h * 4 + _ks], qf[_ks], s[2 * (g) + _h]); } } while (0)
            const int gmax = own ? ((tile >> 2) >> 1) : 7;
#pragma unroll
            for (int kt = 0; kt < 16; ++kt) s[kt] = (f32x4){0.f, 0.f, 0.f, 0.f};
            MB_LDK(ka, 0);
#pragma unroll
            for (int g = 0; g < 8; g += 2) {
                if (g + 1 <= gmax) MB_LDK(kb, g + 1);
                __builtin_amdgcn_sched_barrier(0); if (g <= gmax) MB_MMK(ka, g); __builtin_amdgcn_sched_barrier(0);
                if (g + 2 < 8 && g + 2 <= gmax) MB_LDK(ka, g + 2);
                __builtin_amdgcn_sched_barrier(0); if (g + 1 <= gmax) MB_MMK(kb, g + 1); __builtin_amdgcn_sched_barrier(0);
            }
#undef MB_LDK
#undef MB_MMK
        }
        const int tq = own ? (t - 256 * n) : 255;
        float m = -1e30f;
#pragma unroll
        for (int kt = 0; kt < 16; ++kt)
#pragma unroll
            for (int r = 0; r < 4; ++r) { const int key = 16 * kt + 4 * q + r; const float x = (!own || key <= tq) ? s[kt][r] : -1e30f; s[kt][r] = x; m = fmaxf(m, x); }
        m = fmaxf(m, __shfl_xor(m, 16)); m = fmaxf(m, __shfl_xor(m, 32));
        float l = 0.f;
#pragma unroll
        for (int kt = 0; kt < 16; ++kt)
#pragma unroll
            for (int r = 0; r < 4; ++r) { const float p = __builtin_amdgcn_exp2f(s[kt][r] - m); s[kt][r] = p; l += p; }
        l += __shfl_xor(l, 16); l += __shfl_xor(l, 32);
        f32x4 oa[8];
#pragma unroll
        for (int md = 0; md < 8; ++md) oa[md] = (f32x4){0.f, 0.f, 0.f, 0.f};
        {
            bf16x8 va[4], vb2[4];
            const LAS unsigned char* vbase = L + VS + (4 * q + (l15 >> 2)) * 288 + (l15 & 3) * 8;
#define MB_LDV(dst, x) do { _Pragma("unroll") for (int _m = 0; _m < 4; ++_m) { const int _md = 4 * ((x) & 1) + _m, _k2 = (x) >> 1; \
                const s16x4 _a0 = __builtin_amdgcn_ds_read_tr16_b64_v4i16((LAS s16x4*)(vbase + (32 * _k2) * 288 + _md * 32)), _a1 = __builtin_amdgcn_ds_read_tr16_b64_v4i16((LAS s16x4*)(vbase + (32 * _k2 + 16) * 288 + _md * 32)); \
                dst[_m] = (bf16x8){_a0[0], _a0[1], _a0[2], _a0[3], _a1[0], _a1[1], _a1[2], _a1[3]}; } } while (0)
#define MB_MMV(src, x) do { const bf16x8 _pb = pack8(s[2 * ((x) >> 1)], s[2 * ((x) >> 1) + 1]); _Pragma("unroll") for (int _m = 0; _m < 4; ++_m) oa[4 * ((x) & 1) + _m] = mfma16(src[_m], _pb, oa[4 * ((x) & 1) + _m]); } while (0)
            const int xmax = own ? (2 * (tile >> 3) + 1) : 15;
            MB_LDV(va, 0);
#pragma unroll
            for (int x = 0; x < 16; x += 2) {
                if (x + 1 <= xmax) MB_LDV(vb2, x + 1);
                __builtin_amdgcn_sched_barrier(0); if (x <= xmax) MB_MMV(va, x); __builtin_amdgcn_sched_barrier(0);
                if (x + 2 < 16 && x + 2 <= xmax) MB_LDV(va, x + 2);
                __builtin_amdgcn_sched_barrier(0); if (x + 1 <= xmax) MB_MMV(vb2, x + 1); __builtin_amdgcn_sched_barrier(0);
            }
#undef MB_LDV
#undef MB_MMV
        }
        __builtin_amdgcn_s_waitcnt(0x0F70);
        if (live) { const float inv = 1.f / l; bf16* op = PO + (((size_t)t * 8 + h) * 4 + j) * 128 + 4 * q;
#pragma unroll
            for (int md = 0; md < 8; ++md) { v2u o; o.x = pg8::cvt_pk_bf16(oa[md][0] * inv, oa[md][1] * inv); o.y = pg8::cvt_pk_bf16(oa[md][2] * inv, oa[md][3] * inv); __builtin_nontemporal_store(o, (v2u*)(op + 16 * md)); }
            if (q == 0) __builtin_nontemporal_store((m + __builtin_amdgcn_logf(l)) * 0.6931471805599453f, &LSE[((size_t)t * 8 + h) * 4 + j]); }
        e_cur = e_nxt; e_nxt = e_nn;
#pragma unroll
        for (int ks = 0; ks < 4; ++ks) qf[ks] = qn[ks];
    }
#undef MB_ENTRY
#undef MB_LOADQ
    __syncthreads();
}

__device__ __forceinline__ void moba_own_queue(Frame& F) {
    LAS int* bc = (LAS int*)(F.lds + 148480) + 132; const int tid = threadIdx.x;
    for (;;) {
        if (tid == 0) *bc = (int)atomicAdd(&F.ctl[CW_QHEAD], 1u);
        __syncthreads();
        const int it = *bc;
        __syncthreads();
        if (it >= 128) break;
        moba_attn_unit(F, it & 1, it >> 1, nullptr, 1024, true);
    }
}
__device__ __forceinline__ void moba_attn_queue(Frame& F) {
    LAS unsigned char* L = F.lds; unsigned char* ws = F.ws; const int tid = threadIdx.x;
    LAS int* pre = (LAS int*)(L + 148480); LAS int* bc = pre + 132;
    moba_own_queue(F);
    if (tid < 128) { const int c = (int)__hip_atomic_load(&F.ctl[CW_MOBA_CNT + tid], __ATOMIC_RELAXED, __HIP_MEMORY_SCOPE_AGENT); const int nch = (c + 1023) >> 10; int v = nch;
#pragma unroll
        for (int o = 1; o < 64; o <<= 1) { const int t2 = __shfl_up(v, o); if ((tid & 63) >= o) v += t2; }
        pre[tid] = v - nch; if ((tid & 63) == 63) pre[129 + (tid >> 6)] = v; }
    __syncthreads();
    if (tid >= 64 && tid < 128) pre[tid] += pre[129];
    if (tid == 0) pre[128] = pre[129] + pre[130];
    __syncthreads();
    const int total = pre[128];
    for (;;) {
        if (tid == 0) *bc = (int)atomicAdd(&F.ctl[CW_QHEAD + 1], 1u);
        __syncthreads();
        const int x = *bc;
        __syncthreads();
        if (x >= total) break;
        int idx = 0; while (pre[idx + 1] <= x) ++idx;
        const int g = idx >> 6, n = idx & 63, ch = x - pre[idx]; const int cnt = (int)__hip_atomic_load(&F.ctl[CW_MOBA_CNT + idx], __ATOMIC_RELAXED, __HIP_MEMORY_SCOPE_AGENT);
        const int c0 = ch * 1024, cc = (cnt - c0) < 1024 ? (cnt - c0) : 1024;
        moba_attn_unit(F, g, n, (const unsigned*)(ws + WS_LISTS) + moba_listoff(g, n) + c0, cc, false);
    }
}

__device__ __forceinline__ void moba_combine(Frame& F, const int wg0) {
    unsigned char* ws = F.ws; const int lane = threadIdx.x & 63;
    const int gw = (F.bid - wg0) * NWAVES + F.wave, NGW = (F.G - wg0) * NWAVES;
    const bf16* PO = (const bf16*)(ws + WS_PO); const float* LSE = (const float*)(ws + WS_LSE);
    const int h = lane >> 3;
#define MC_LOAD(t_, L_, A_, C_) do { L_ = __builtin_nontemporal_load((const f32x4*)(LSE + ((size_t)(t_) * 8 + h) * 4)); \
        _Pragma("unroll") for (int _j = 0; _j < 4; ++_j) { const v4u* _pp = (const v4u*)(PO + (((size_t)(t_) * 8 + h) * 4 + _j) * 128 + (lane & 7) * 16); A_[_j] = __builtin_nontemporal_load(_pp); C_[_j] = __builtin_nontemporal_load(_pp + 1); } } while (0)
    f32x4 ls, lsn; v4u pa[4], pc[4], na[4], nc[4];
    int t = gw;
    if (t < T) MC_LOAD(t, ls, pa, pc);
    for (; t < T; t += NGW) {
        const int tn = t + NGW;
        if (tn < T) MC_LOAD(tn, lsn, na, nc);
        const int b = t >> 8, nsel = b < 3 ? b : 3;
        float lj[4] = {nsel > 0 ? ls[0] : -INFINITY, nsel > 1 ? ls[1] : -INFINITY, nsel > 2 ? ls[2] : -INFINITY, ls[3]};
        const float M = fmaxf(fmaxf(lj[0], lj[1]), fmaxf(lj[2], lj[3]));
        float wj[4], ws_ = 0.f;
#pragma unroll
        for (int j = 0; j < 4; ++j) { wj[j] = __expf(lj[j] - M); ws_ += wj[j]; }
        const float inv = 1.f / ws_;
        float acc[16];
#pragma unroll
        for (int e = 0; e < 16; ++e) acc[e] = 0.f;
#pragma unroll
        for (int j = 0; j < 4; ++j) { const bool on = (j == 3) || (j < nsel);
            const v4u a = pa[j], c = pc[j]; const float wv = wj[j] * inv;
#define MC_ACC(i_, x_) acc[i_] += on ? wv * (x_) : 0.f
            MC_ACC(0, bflo(a.x)); MC_ACC(1, bfhi(a.x)); MC_ACC(2, bflo(a.y)); MC_ACC(3, bfhi(a.y)); MC_ACC(4, bflo(a.z)); MC_ACC(5, bfhi(a.z)); MC_ACC(6, bflo(a.w)); MC_ACC(7, bfhi(a.w));
            MC_ACC(8, bflo(c.x)); MC_ACC(9, bfhi(c.x)); MC_ACC(10, bflo(c.y)); MC_ACC(11, bfhi(c.y)); MC_ACC(12, bflo(c.z)); MC_ACC(13, bfhi(c.z)); MC_ACC(14, bflo(c.w)); MC_ACC(15, bfhi(c.w));
#undef MC_ACC
        }
        v4u d8; d8.x = pk4_fp8(16.f * acc[0], 16.f * acc[1], 16.f * acc[2], 16.f * acc[3]); d8.y = pk4_fp8(16.f * acc[4], 16.f * acc[5], 16.f * acc[6], 16.f * acc[7]);
        d8.z = pk4_fp8(16.f * acc[8], 16.f * acc[9], 16.f * acc[10], 16.f * acc[11]); d8.w = pk4_fp8(16.f * acc[12], 16.f * acc[13], 16.f * acc[14], 16.f * acc[15]);
        __builtin_amdgcn_s_waitcnt(0x0F70);
        *(v4u*)(ws + WS_A2 + (size_t)t * 1024 + lane * 16) = d8;
        ls = lsn;
#pragma unroll
        for (int j = 0; j < 4; ++j) { pa[j] = na[j]; pc[j] = nc[j]; }
    }
#undef MC_LOAD
}

constexpr size_t WS_ELIST = 944 * MiB, WS_EDST = 960 * MiB;
constexpr size_t WS_HB8 = 976 * MiB;
__device__ __forceinline__ void moe_route(Frame& F, const float* logits, const float* bias, float* wts, unsigned* cnt, int* elist, int* edst) {
    const int lane = threadIdx.x & 63, tid = threadIdx.x;
    LAS unsigned* lcnt = (LAS unsigned*)F.lds; LAS unsigned* gb = lcnt + 256; LAS unsigned* pk = gb + 256;
    const f32x4 bz = ((const f32x4*)bias)[lane];
    for (int t0 = F.bid * 64; t0 < T; t0 += F.G * 64) {
        if (tid < 256) lcnt[tid] = 0u;
        __syncthreads();
        f32x4 lgs[8];
#pragma unroll
        for (int i = 0; i < 8; ++i) { const f32x4* lp = (const f32x4*)(logits + (size_t)(t0 + 8 * F.wave + i) * 512); lgs[i] = lp[lane] + lp[64 + lane]; }
#pragma unroll 1
        for (int i = 0; i < 8; ++i) {
            const int t = t0 + 8 * F.wave + i;
            f32x4 lg = lgs[0];
#pragma unroll
            for (int k = 1; k < 8; ++k) if (i == k) lg = lgs[k];
            float sc[4], ch[4];
#pragma unroll
            for (int e = 0; e < 4; ++e) { sc[e] = 1.f / (1.f + expf(-lg[e])); ch[e] = sc[e] + bz[e]; }
            float a = fmaxf(ch[0], ch[1]), b = fminf(ch[0], ch[1]);
            { const float a2 = fmaxf(ch[2], ch[3]), b2 = fminf(ch[2], ch[3]); const float na = fmaxf(a, a2); b = fmaxf(fminf(a, a2), fmaxf(b, b2)); a = na; }
#pragma unroll
            for (int o = 1; o < 8; o <<= 1) { const float a2 = __shfl_xor(a, o), b2 = __shfl_xor(b, o); const float na = fmaxf(a, a2); b = fmaxf(fminf(a, a2), fmaxf(b, b2)); a = na; }
            const float gs = a + b; const int g = lane >> 3;
            int rank = 0;
#pragma unroll
            for (int g2 = 0; g2 < 8; ++g2) { const float o = __shfl(gs, g2 * 8); rank += (o > gs || (o == gs && g2 < g)) ? 1 : 0; }
            const bool sel = rank < 4;
            unsigned key[4];
#pragma unroll
            for (int e = 0; e < 4; ++e) { const unsigned bb = __builtin_bit_cast(unsigned, ch[e]); key[e] = sel ? ((bb & 0x80000000u) ? ~bb : (bb | 0x80000000u)) : 0u; }
            unsigned thr = 0u;
            for (int bit = 31; bit >= 0; --bit) { const unsigned cand = thr | (1u << bit); int c = 0;
#pragma unroll
                for (int e = 0; e < 4; ++e) c += __builtin_popcountll(__ballot(key[e] >= cand));
                if (c >= 8) thr = cand;
                if (c == 8) break; }
            int G8 = 0; unsigned long long beq[4]; bool gt[4], eq[4];
#pragma unroll
            for (int e = 0; e < 4; ++e) { gt[e] = key[e] > thr; eq[e] = key[e] == thr; G8 += __builtin_popcountll(__ballot(gt[e])); beq[e] = __ballot(eq[e]); }
            const int need = 8 - G8;
            int tb_ = 0;
#pragma unroll
            for (int e = 0; e < 4; ++e) tb_ += (int)__builtin_amdgcn_mbcnt_hi((unsigned)(beq[e] >> 32), __builtin_amdgcn_mbcnt_lo((unsigned)beq[e], 0u));
            bool pick[4]; int run = tb_;
#pragma unroll
            for (int e = 0; e < 4; ++e) { pick[e] = gt[e] || (eq[e] && run < need); run += eq[e] ? 1 : 0; }
            int sb = 0; float ls = 0.f;
#pragma unroll
            for (int e = 0; e < 4; ++e) { const unsigned long long bp = __ballot(pick[e]); sb += (int)__builtin_amdgcn_mbcnt_hi((unsigned)(bp >> 32), __builtin_amdgcn_mbcnt_lo((unsigned)bp, 0u)); ls += pick[e] ? sc[e] : 0.f; }
            const float ssum = wave_sum(ls);
            int slot = sb;
#pragma unroll
            for (int e = 0; e < 4; ++e) if (pick[e]) { const int ex = 4 * lane + e;
                wts[t * 8 + slot] = sc[e] / (ssum + 1e-20f) * 2.5f;
                const unsigned lp = __hip_atomic_fetch_add(&lcnt[ex], 1u, __ATOMIC_RELAXED, __HIP_MEMORY_SCOPE_WORKGROUP);
                const int pi = ((8 * F.wave + i) * 8 + slot) * 2; pk[pi] = (unsigned)ex | (lp << 8); pk[pi + 1] = (unsigned)(t * 8 + slot); ++slot; }
        }
        __syncthreads();
        if (tid < 256) { const unsigned c = lcnt[tid]; gb[tid] = c ? atomicAdd(&cnt[tid], c) : 0u; }
        __syncthreads();
        { const unsigned x = pk[2 * tid], d = pk[2 * tid + 1]; const unsigned ex = x & 255u, p = gb[ex] + (x >> 8);
          elist[(size_t)ex * T + p] = (int)(d >> 3); edst[(size_t)ex * T + p] = (int)d; }
        __syncthreads();
    }
}
constexpr int MOE_TB_OFF = 148480;
__device__ __forceinline__ void moe_tiles(Frame& F, const unsigned* cnt) {
    LAS int* tb = (LAS int*)(F.lds + MOE_TB_OFF); LAS int* cn = tb + 260;
    if (F.wave == 0) { const int lane = threadIdx.x & 63; int c[4], nt[4], s_ = 0;
#pragma unroll
        for (int e = 0; e < 4; ++e) { c[e] = (int)__hip_atomic_load(&cnt[4 * lane + e], __ATOMIC_RELAXED, __HIP_MEMORY_SCOPE_AGENT); nt[e] = (c[e] + 255) >> 8; s_ += nt[e]; }
        int inc = s_;
#pragma unroll
        for (int o = 1; o < 64; o <<= 1) { const int v = __shfl_up(inc, o); if (lane >= o) inc += v; }
        int ex = inc - s_;
#pragma unroll
        for (int e = 0; e < 4; ++e) { tb[4 * lane + e] = ex; cn[4 * lane + e] = c[e]; ex += nt[e]; }
        if (lane == 63) tb[256] = inc; }
    __syncthreads();
}
__device__ __forceinline__ void final_rows(Frame& F, const bf16* HBp, const bf16* SHY, const unsigned char* YR, const float* wts, const float* g, const float* b, float* out, bool use_moe) {
    const int gw = F.bid * NWAVES + F.wave, NGW = F.G * NWAVES, lane = ((int)(threadIdx.x & 63));
    f32x4 gv[4], bv[4];
#pragma unroll
    for (int j = 0; j < 4; ++j) { gv[j] = ((const f32x4*)g)[lane + 64 * j]; bv[j] = ((const f32x4*)b)[lane + 64 * j]; }
#define FR_LOAD(m_, H_, S_, W_, Y_) do { const int _m = (m_) < T ? (m_) : T - 1; const v2u* _xr = (const v2u*)(HBp + (size_t)_m * D) + lane; \
        _Pragma("unroll") for (int _j = 0; _j < 4; ++_j) H_[_j] = _xr[64 * _j]; \
        if (use_moe) { const v2u* _sr = (const v2u*)(SHY + (size_t)_m * D) + lane; _Pragma("unroll") for (int _j = 0; _j < 4; ++_j) S_[_j] = _sr[64 * _j]; \
            W_ = wts[_m * 8 + (lane & 7)]; \
            _Pragma("unroll") for (int _k = 0; _k < 8; ++_k) { const unsigned* _yr = (const unsigned*)(YR + ((size_t)_m * 8 + _k) * D) + lane; \
                _Pragma("unroll") for (int _j = 0; _j < 4; ++_j) Y_[_k * 4 + _j] = _yr[64 * _j]; } } } while (0)
    v2u hA[4], sA[4], hB[4], sB[4]; float wA = 0.f, wB = 0.f; unsigned yA[32], yB[32];
    if (gw < T) FR_LOAD(gw, hA, sA, wA, yA);
    for (int m = gw; m < T; m += NGW) {
        FR_LOAD(m + NGW, hB, sB, wB, yB);
        f32x4 v[4];
#pragma unroll
        for (int j = 0; j < 4; ++j) { const v2u x = hA[j]; v[j] = (f32x4){bflo(x.x), bfhi(x.x), bflo(x.y), bfhi(x.y)} * DN_ALPHA; }
        if (use_moe) {
#pragma unroll
            for (int j = 0; j < 4; ++j) { const v2u s = sA[j]; v[j][0] += bflo(s.x); v[j][1] += bfhi(s.x); v[j][2] += bflo(s.y); v[j][3] += bfhi(s.y); }
#pragma unroll
            for (int k = 0; k < 8; ++k) { const float w = __shfl(wA, k) * 0.0625f;
#pragma unroll
                for (int j = 0; j < 4; ++j) { const unsigned x = yA[k * 4 + j];
                    v[j][0] += w * __builtin_amdgcn_cvt_f32_fp8(x, 0); v[j][1] += w * __builtin_amdgcn_cvt_f32_fp8(x, 1); v[j][2] += w * __builtin_amdgcn_cvt_f32_fp8(x, 2); v[j][3] += w * __builtin_amdgcn_cvt_f32_fp8(x, 3); } }
        }
        float s = 0.f;
#pragma unroll
        for (int j = 0; j < 4; ++j) s += (v[j][0] + v[j][1]) + (v[j][2] + v[j][3]);
        const float mean = wave_sum(s) * (1.f / D); float s2 = 0.f;
#pragma unroll
        for (int j = 0; j < 4; ++j) { v[j] = v[j] - mean; s2 += (v[j][0] * v[j][0] + v[j][1] * v[j][1]) + (v[j][2] * v[j][2] + v[j][3] * v[j][3]); }
        const float rstd = 1.f / sqrtf(wave_sum(s2) * (1.f / D) + LN_EPS);
        __builtin_amdgcn_s_waitcnt(0x0F70);
        f32x4* o = (f32x4*)(out + (size_t)m * D) + lane;
#pragma unroll
        for (int j = 0; j < 4; ++j) o[64 * j] = v[j] * rstd * gv[j] + bv[j];
#pragma unroll
        for (int j = 0; j < 4; ++j) { hA[j] = hB[j]; sA[j] = sB[j]; }
        wA = wB;
#pragma unroll
        for (int i = 0; i < 32; ++i) yA[i] = yB[i];
    }
#undef FR_LOAD
}

enum Phase { PH_PROLOGUE = 0, PH_INPROJ, PH_PREP, PH_SCAN, PH_POST, PH_PROJ, PH_WOUT, PH_LN1, PH_ROUTER, PH_ROUTE, PH_EXP1, PH_EXP2, PH_FINAL, PH_COUNT };

__global__ void __launch_bounds__(NWAVES * 64, 2) mega_fwd(Args args) {
    extern __shared__ __attribute__((aligned(16))) unsigned char lds_raw[];
    Frame F;
    F.lds = (LAS unsigned char*)lds_raw;
    F.MISC = (volatile LAS unsigned*)(F.lds + MISC_OFF);
    F.wave = __builtin_amdgcn_readfirstlane(threadIdx.x >> 6);
    F.G = gridDim.x; F.bid = blockIdx.x; F.ws = args.ws; F.ctl = (unsigned*)(args.ws + WS_CTL);
    unsigned char* ws = args.ws;
    if (((int)threadIdx.x) < 64) F.MISC[((int)threadIdx.x)] = 0u;
    __syncthreads();
    XcdBarrier bar; bar.bar = F.ctl + CW_BAR; bar.x = 0; bar.st = nullptr; bar.gtot = 0;
    if (!N_LAUNCH_SPLIT) bar = xcd_barrier_post(F.ctl + CW_BAR, F.MISC + 8);
    XcdBarrier bar2; bar2.bar = F.ctl + CW_BAR2; bar2.x = 0; bar2.st = nullptr; bar2.gtot = 0;
    if (!N_LAUNCH_SPLIT && F.bid >= NSCAN + NWARM) { bar2 = xcd_barrier_post(F.ctl + CW_BAR2, F.MISC + 10); bar2.gtot = F.G - (NSCAN + NWARM); }
    const int lo = args.ph_lo, hi = args.ph_hi;
#define IN(k) (lo <= (k) && (k) < hi)
#define SEAM(k) do { if (IN(k) && IN((k) + 1)) xcd_barrier(bar); } while (0)

    if (IN(PH_PROLOGUE)) { p0_prologue(F, args, false, 0); }
    SEAM(PH_PROLOGUE);

#if STAGE >= 3
    if (IN(PH_INPROJ)) {
        constexpr int NGEMM = 153;
        if (F.bid < NGEMM) {
            pg8::DenseOrder S; S.init(T, NIN, D / 2, NGEMM, F.bid, (const bf16*)(ws + WS_WIN));
            EpiInProj E{ws, args.in[3], args.in[4]};
            pg8::gemm_phase<EpiInProj, pg8::DenseOrder, false, 5>(F.lds, ws + WS_XB, nullptr, D / 2, S, E);
        }
        expert_convert_queue(F, args);
    }
    SEAM(PH_INPROJ);
    if (IN(PH_PREP)) {
        gdn_prep_all(F, args);
    }
    SEAM(PH_PREP);
    if (IN(PH_SCAN)) {
        if (F.bid < NSCAN) gdn_scan2(F, F.bid);
        else if (F.bid < NSCAN + NWARM) gdn_scan_warm(F, F.bid - NSCAN);
#if STAGE >= 4
        else {
            {
                const int su = F.bid - (NSCAN + NWARM);
                if (su < 126 && F.G - (NSCAN + NWARM) >= 126) moba_select_unit(F, su & 1, 63 - (su >> 1));
                else if (F.G - (NSCAN + NWARM) >= 126) moba_own_queue(F);
                else for (int u = su; u < 128; u += F.G - (NSCAN + NWARM)) moba_select_unit(F, u & 1, 63 - (u >> 1));
            }
            xcd_barrier(bar2);
            moba_attn_queue(F);
            xcd_barrier(bar2);
            moba_combine(F, NSCAN + NWARM);
        }
#endif
    }
    SEAM(PH_SCAN);
    if (IN(PH_POST)) { gdn_ophase(F, args.in[5]); }
    SEAM(PH_POST);
    if (IN(PH_PROJ)) {
#if STAGE >= 4
        {
            pg8::DenseOrder S2; S2.init(T, D, D / 2, F.G, F.bid, (const bf16*)(ws + WS_WMP));
            EpiGate<false> E2{(bf16*)(ws + WS_MBUF), (const bf16*)(ws + WS_SGM), nullptr};
            pg8::gemm_phase<EpiGate<false>, pg8::DenseOrder, false, 6, 4>(F.lds, ws + WS_A2, nullptr, D / 2, S2, E2);
        }
#endif
        pg8::DenseOrder S; S.init(T, D, D / 2, F.G, F.bid, (const bf16*)(ws + WS_WGP));
#if STAGE >= 4
        EpiGate<true, true> E{(bf16*)(ws + WS_MBUF), (const bf16*)(ws + WS_SGG), ws + WS_OG + 16 * MiB};
        pg8::gemm_phase<EpiGate<true, true>, pg8::DenseOrder, false, 6, 0>(F.lds, ws + WS_OG, nullptr, D / 2, S, E);
#else
        EpiGate<false, true> E{(bf16*)(ws + WS_MBUF), (const bf16*)(ws + WS_SGG), ws + WS_OG + 16 * MiB};
        pg8::gemm_phase<EpiGate<false, true>, pg8::DenseOrder, false, 6, 0>(F.lds, ws + WS_OG, nullptr, D / 2, S, E);
#endif
    }
    SEAM(PH_PROJ);
    if (IN(PH_WOUT)) {
        pg8::DenseOrder S; S.init(T, D, D / 2, F.G, F.bid, (const bf16*)(ws + WS_WOUT));
        EpiBf16Res E{(bf16*)(ws + WS_HB), 1024, args.in[0], DN_ALPHA};
        pg8::gemm_phase<EpiBf16Res, pg8::DenseOrder, false, 6, 2>(F.lds, ws + WS_OG + 16 * MiB, nullptr, D / 2, S, E);
    }
#else
    SEAM(PH_INPROJ); SEAM(PH_PREP); SEAM(PH_SCAN); SEAM(PH_POST); SEAM(PH_PROJ);
    if (IN(PH_WOUT)) {
        const f32x4* x4 = (const f32x4*)args.in[0]; v2u* p4 = (v2u*)(ws + WS_HB); const size_t n4 = (size_t)T * D / 4;
        for (size_t i = (size_t)F.bid * 512 + threadIdx.x; i < n4; i += (size_t)F.G * 512) { const f32x4 x = x4[i] * DN_ALPHA; v2u o; o.x = pk2(x[0], x[1]); o.y = pk2(x[2], x[3]); p4[i] = o; }
    }
#endif
    SEAM(PH_WOUT);
    if (IN(PH_LN1)) { ln_rows(F, (bf16*)(ws + WS_HB), ws + WS_HB8, args.in[9], args.in[10]);
        if (F.bid == 0 && threadIdx.x < 64) ((v4u*)(ws + WS_HB8 + (size_t)T * D))[threadIdx.x] = (v4u){0u, 0u, 0u, 0u}; }
    SEAM(PH_LN1);
#if STAGE >= 2
    if (IN(PH_ROUTER)) {
        { pg8::SplitK2Order S; S.nM = T / 256; S.G = F.G; S.c = F.bid; S.Bt = (const char*)(ws + WS_ROUTER); S.khalfB = 1024;
          EpiF32Res E{(float*)(ws + WS_LOGITS2), 512, nullptr, 0.f};
          pg8::gemm_phase<EpiF32Res, pg8::SplitK2Order, false>(F.lds, (const bf16*)(ws + WS_HB), nullptr, D / 2, S, E, 2048u); }
        { pg8::DenseOrder S; S.init(T, 512, D / 2, F.G, (F.bid + 128) % F.G, (const bf16*)(ws + WS_SHGU));
          EpiSwiGLU E{(bf16*)(ws + WS_HS)};
          pg8::gemm_phase<EpiSwiGLU, pg8::DenseOrder, false, 5>(F.lds, ws + WS_HB8, nullptr, D / 2, S, E); }
    }
    SEAM(PH_ROUTER);
    if (IN(PH_ROUTE)) { moe_route(F, (const float*)(ws + WS_LOGITS2), args.in[12], (float*)(ws + WS_WTS), F.ctl + CW_MOE_CNT, (int*)(ws + WS_ELIST), (int*)(ws + WS_EDST)); }
    SEAM(PH_ROUTE);
    if (IN(PH_EXP1)) {
        moe_tiles(F, F.ctl + CW_MOE_CNT);
        { pg8::GroupOrder<2> S; S.G = F.G; S.c = F.bid; S.tb = (const LAS int*)(F.lds + MOE_TB_OFF); S.cn = S.tb + 260; S.W = (const char*)(ws + WS_EXPGU); S.estride = (size_t)512 * 1024; S.tstepB = (size_t)256 * 1024;
          EpiSwiGLU8 E{ws + WS_HEXP};
          pg8::gemm_phase<EpiSwiGLU8, pg8::GroupOrder<2>, true, 5>(F.lds, ws + WS_HB8, (const int*)(ws + WS_ELIST), D / 2, S, E); }
        { pg8::DenseOrder S; S.init(T, 1024, 256, F.G, F.bid, (const bf16*)(ws + WS_SHD));
          EpiBf16Plain E{(bf16*)(ws + WS_SHY), 1024};
          pg8::gemm_phase<EpiBf16Plain, pg8::DenseOrder, false>(F.lds, (const bf16*)(ws + WS_HS), nullptr, 256, S, E); }
    }
    SEAM(PH_EXP1);
    if (IN(PH_EXP2)) {
        moe_tiles(F, F.ctl + CW_MOE_CNT);
        pg8::GroupOrder<4> S; S.G = F.G; S.c = F.bid; S.tb = (const LAS int*)(F.lds + MOE_TB_OFF); S.cn = S.tb + 260; S.W = (const char*)(ws + WS_EXPD); S.estride = (size_t)1024 * 256; S.tstepB = (size_t)256 * 256;
        EpiScatter8 E{ws + WS_YR, (const int*)(ws + WS_EDST)};
        pg8::gemm_phase<EpiScatter8, pg8::GroupOrder<4>, false, 5, 2>(F.lds, ws + WS_HEXP, nullptr, 128 | (args.ph_lo >> 30), S, E);
    }
    SEAM(PH_EXP2);
#else
    SEAM(PH_ROUTER); SEAM(PH_ROUTE); SEAM(PH_EXP1); SEAM(PH_EXP2);
#endif
    if (IN(PH_FINAL)) {
        final_rows(F, (const bf16*)(ws + WS_HB), (const bf16*)(ws + WS_SHY), ws + WS_YR, (const float*)(ws + WS_WTS), args.in[19], args.in[20], args.out, STAGE >= 2);
    }
#undef IN
#undef SEAM
}

extern "C" void kernel_launch(void* const* d_in, const int* in_sizes, int n_in, void* d_out, int out_size, void* d_ws, size_t ws_size, hipStream_t stream) {
    static int grid = 0;
    if (grid == 0) {
        if (n_in != 21 || out_size != T * D || ws_size < WS_END) { fprintf(stderr, "kernel_launch: unexpected shapes (n_in %d out %d ws %zu)\n", n_in, out_size, ws_size); grid = -1; return; }
        int dev = 0, cus = 0, per_cu = 0;
        if (hipGetDevice(&dev) != hipSuccess || hipDeviceGetAttribute(&cus, hipDeviceAttributeMultiprocessorCount, dev) != hipSuccess) { grid = -1; return; }
        if (hipFuncSetAttribute((const void*)mega_fwd, hipFuncAttributeMaxDynamicSharedMemorySize, LDS_BYTES) != hipSuccess) { fprintf(stderr, "kernel_launch: hipFuncSetAttribute failed\n"); grid = -1; return; }
        if (hipOccupancyMaxActiveBlocksPerMultiprocessor(&per_cu, (const void*)mega_fwd, NWAVES * 64, LDS_BYTES) != hipSuccess || per_cu < 1) { fprintf(stderr, "kernel_launch: occupancy query says %d\n", per_cu); }
        (void)hipGetLastError();
        grid = cus;
    }
    if (grid < 0) return;
    (void)hipMemsetAsync((char*)d_ws + WS_CTL, 0, CTL_ZERO_BYTES, stream);
    Args a{};
    for (int i = 0; i < 21; ++i) a.in[i] = (const float*)d_in[i];
    a.out = (float*)d_out; a.ws = (unsigned char*)d_ws;
    for (int i = 0; i < 16; ++i) a.rope_inv[i] = powf(500000.0f, -(float)i / 16.0f);
#if N_LAUNCH_SPLIT
    for (int p = 0; p < PH_COUNT; ++p) { a.ph_lo = p; a.ph_hi = p + 1; hipLaunchKernelGGL(mega_fwd, dim3(grid), dim3(NWAVES * 64), LDS_BYTES, stream, a); }
#else
    a.ph_lo = 0; a.ph_hi = PH_COUNT;
    hipLaunchKernelGGL(mega_fwd, dim3(grid), dim3(NWAVES * 64), LDS_BYTES, stream, a);
#endif
}
```

```cpp
#include <hip/hip_runtime.h>
#include <cstdio>
#include <cstdint>
#include <cmath>

#ifndef STAGE
#define STAGE 4
#endif
#ifndef N_LAUNCH_SPLIT
#define N_LAUNCH_SPLIT 0
#endif

#define GAS __attribute__((address_space(1)))
#define LAS __attribute__((address_space(3)))
typedef unsigned short bf16;
typedef unsigned v4u __attribute__((ext_vector_type(4)));
typedef unsigned v2u __attribute__((ext_vector_type(2)));
typedef float f32x4 __attribute__((ext_vector_type(4)));
typedef float f32x2 __attribute__((ext_vector_type(2)));
typedef short bf16x8 __attribute__((ext_vector_type(8)));
typedef short bf16x4 __attribute__((ext_vector_type(4)));
#define LDS_WAIT() asm volatile("s_waitcnt lgkmcnt(0)" ::: "memory")
#define VM_WAIT() asm volatile("s_waitcnt vmcnt(0)" ::: "memory")

__device__ __forceinline__ unsigned f2bf(float f) { unsigned u = __builtin_bit_cast(unsigned, f); return (u + 0x7fffu + ((u >> 16) & 1u)) >> 16; }
__device__ __forceinline__ unsigned pk2(float lo, float hi) { return f2bf(lo) | (f2bf(hi) << 16); }
__device__ __forceinline__ float bf2f(unsigned b) { return __builtin_bit_cast(float, b << 16); }
__device__ __forceinline__ float bflo(unsigned w) { return __builtin_bit_cast(float, w << 16); }
__device__ __forceinline__ float bfhi(unsigned w) { return __builtin_bit_cast(float, w & 0xffff0000u); }
__device__ __forceinline__ unsigned pk4_fp8(float a, float b, float c, float d) { unsigned w = 0u; w = __builtin_amdgcn_cvt_pk_fp8_f32(a, b, w, false); w = __builtin_amdgcn_cvt_pk_fp8_f32(c, d, w, true); return w; }
__device__ __forceinline__ float sigmoidf_(float x) { return __builtin_amdgcn_rcpf(1.f + __builtin_amdgcn_exp2f(-1.4426950408889634f * x)); }
__device__ __forceinline__ float siluf_(float x) { return x * __builtin_amdgcn_rcpf(1.f + __builtin_amdgcn_exp2f(-1.4426950408889634f * x)); }
__device__ __forceinline__ float wave_sum(float v) {
#pragma unroll
    for (int o = 1; o < 64; o <<= 1) v += __shfl_xor(v, o);
    return v;
}

#define DPP_STEP(v, ctrl, rmask) ((v) + __builtin_bit_cast(float, __builtin_amdgcn_update_dpp(0, __builtin_bit_cast(int, (v)), (ctrl), (rmask), 0xf, false)))
__device__ __forceinline__ float wave_sum_dpp(float v) {
    v = DPP_STEP(v, 0x111, 0xf); v = DPP_STEP(v, 0x112, 0xf); v = DPP_STEP(v, 0x114, 0xf); v = DPP_STEP(v, 0x118, 0xf);
    v = DPP_STEP(v, 0x142, 0xa);
    v = DPP_STEP(v, 0x143, 0xc);
    return __builtin_bit_cast(float, __builtin_amdgcn_readlane(__builtin_bit_cast(int, v), 63));
}

constexpr int T = 16384, D = 1024;
constexpr int NIN = 7936;
constexpr int NEXP = 256, TOPK = 8, EDIM = 256;
constexpr int RMAX = T * TOPK + NEXP * 256;
constexpr float LN_EPS = 1e-5f;
constexpr float DN_ALPHA = 1.189207115002721f;

constexpr size_t MiB = 1u << 20;
constexpr size_t WS_CTL = 0, CTL_ZERO_BYTES = 1 * MiB;
constexpr size_t WS_ROPE = 1 * MiB;
constexpr size_t WS_GL = 3 * MiB;
constexpr size_t WS_EIDX = 4 * MiB;
constexpr size_t WS_WTS = 4 * MiB + 512 * 1024;
constexpr size_t WS_ROWTOK = 5 * MiB;
constexpr size_t WS_ROWDST = 6 * MiB;
constexpr size_t WS_TILEE = 7 * MiB;
constexpr size_t WS_WIN = 8 * MiB;
constexpr size_t WS_WGP = 24 * MiB, WS_WMP = 26 * MiB, WS_WOUT = 28 * MiB;
constexpr size_t WS_ROUTER = 30 * MiB;
constexpr size_t WS_SHGU = 30 * MiB + 512 * 1024;
constexpr size_t WS_SHD = 31 * MiB + 512 * 1024;
constexpr size_t WS_EXPGU = 32 * MiB;
constexpr size_t WS_EXPD = 288 * MiB;
constexpr size_t WS_XB = 416 * MiB;
constexpr size_t WS_CONVIN = 448 * MiB;
constexpr size_t WS_PO = 416 * MiB;
constexpr size_t WS_GG = 544 * MiB, WS_MQ = 576 * MiB, WS_MK = 608 * MiB, WS_MV = 616 * MiB, WS_SGG = 624 * MiB, WS_SGM = 656 * MiB;
constexpr size_t WS_BETA = 688 * MiB, WS_GLOG = 688 * MiB + 512 * 1024;
constexpr size_t WS_GDNP = 690 * MiB;
constexpr size_t WS_O = 834 * MiB;
constexpr size_t WS_LISTS = 898 * MiB, WS_LSE = 914 * MiB, WS_OG = 916 * MiB, WS_A2 = 948 * MiB, WS_MBUF = 980 * MiB;
constexpr size_t WS_HF = 690 * MiB;
constexpr size_t WS_HB = 754 * MiB;
constexpr size_t WS_LOGITS = 787 * MiB;
constexpr size_t WS_LOGITS2 = 544 * MiB;
constexpr size_t WS_HS = 808 * MiB;
constexpr size_t WS_SHY = 816 * MiB;
constexpr size_t WS_HEXP = 848 * MiB;
constexpr size_t WS_YR = 416 * MiB;
constexpr size_t WS_END = 1024 * MiB;
constexpr int CW_BAR = 4096;
constexpr int CW_MOBA_CNT = 8192, CW_QHEAD = 8448, CW_MOE_CNT = 8704, CW_MOE_FILL = 8960;
constexpr int CW_CONVQ = 9300;
constexpr int CW_BAR2 = 40960;
constexpr int CW_PROG = 32768;
constexpr int CW_KMEAN = 16384;

constexpr int LDS_BYTES = 155648;
constexpr int MISC_OFF = 153600;
constexpr int NWAVES = 8;

#define XB_TMO      128
#define XB_XCNT(j)  (256  + 64 * (j))
#define XB_XSUB(j)  (1280 + 64 * (j))
#define XB_XGEN(j)  (2304 + 64 * (j))
#define XB_TOP      3328
#define XB_TOPGEN   3392
#define XCD_BAR_WORDS 3456
#define XB_SPIN_CAP (1u << 18)
__device__ __forceinline__ unsigned xb_ld(unsigned* p)              { return __hip_atomic_load(p, __ATOMIC_RELAXED, __HIP_MEMORY_SCOPE_AGENT); }
__device__ __forceinline__ unsigned xb_add(unsigned* p, unsigned v) { return __hip_atomic_fetch_add(p, v, __ATOMIC_RELAXED, __HIP_MEMORY_SCOPE_AGENT); }
__device__ __forceinline__ unsigned xb_xcc_id() { return (unsigned)__builtin_amdgcn_s_getreg((3 << 11) | 20) & 0xFu; }
#define XB_SPIN(cond, bar) do { unsigned _sp = 0; while (cond) { __builtin_amdgcn_s_sleep(1); \
    if ((++_sp & 255u) == 0u) { if (xb_ld(&(bar)[XB_TMO])) break; if (_sp > XB_SPIN_CAP) { atomicAdd(&(bar)[XB_TMO], 1u); break; } } } } while (0)
struct XcdBarrier { unsigned* bar; unsigned x; volatile LAS unsigned* st; unsigned gtot; };
__device__ __forceinline__ XcdBarrier xcd_barrier_post(unsigned* bar, volatile LAS unsigned* st) {
    XcdBarrier b; b.bar = bar; b.x = xb_xcc_id(); b.st = st; b.gtot = gridDim.x * gridDim.y * gridDim.z;
    if (threadIdx.x == 0) (void)xb_add(&bar[XB_XCNT(b.x)], 1u);
    return b;
}
__device__ __forceinline__ void xcd_barrier_complete(unsigned* bar, unsigned x, unsigned& nloc, unsigned& nx, const unsigned G) {
    unsigned sum, cnt, mine, sp = 0u;
    for (;;) {
        sum = 0u; cnt = 0u; mine = 0u;
#pragma unroll
        for (unsigned j = 0; j < 16; ++j) { const unsigned c = xb_ld(&bar[XB_XCNT(j)]); sum += c; cnt += (c > 0u) ? 1u : 0u; mine = (j == x) ? c : mine; }
        if (sum == G) break;
        __builtin_amdgcn_s_sleep(1);
        if ((++sp & 255u) == 0u) { if (xb_ld(&bar[XB_TMO])) break; if (sp > XB_SPIN_CAP) { atomicAdd(&bar[XB_TMO], 1u); break; } }
    }
    nloc = mine > 0u ? mine : 1u; nx = cnt > 0u ? cnt : 1u;
}
__device__ __forceinline__ void xcd_barrier(const XcdBarrier& b) {
    asm volatile("s_waitcnt vmcnt(0)" ::: "memory");
    __syncthreads();
    if (threadIdx.x == 0) {
        unsigned* bar = b.bar;
        __builtin_amdgcn_s_waitcnt(0);
        unsigned nloc = b.st[0], nx = b.st[1];
        if (nloc == 0u) { xcd_barrier_complete(bar, b.x, nloc, nx, b.gtot); b.st[0] = nloc; b.st[1] = nx; }
        const unsigned old = xb_add(&bar[XB_XSUB(b.x)], 1u);
        const unsigned gen = old / nloc;
        if (old + 1u == (gen + 1u) * nloc) {
            __builtin_amdgcn_fence(__ATOMIC_RELEASE, "agent");
            asm volatile("s_waitcnt vmcnt(0)" ::: "memory");
            const unsigned og = xb_add(&bar[XB_TOP], 1u);
            const unsigned tg = og / nx;
            if (og + 1u == (tg + 1u) * nx) xb_add(&bar[XB_TOPGEN], 1u);
            else XB_SPIN(xb_ld(&bar[XB_TOPGEN]) == tg, bar);
            __builtin_amdgcn_fence(__ATOMIC_ACQUIRE, "agent");
            xb_add(&bar[XB_XGEN(b.x)], 1u);
            asm volatile("s_waitcnt vmcnt(0)" ::: "memory");
        } else {
            XB_SPIN(xb_ld(&bar[XB_XGEN(b.x)]) == gen, bar);
            __builtin_amdgcn_fence(__ATOMIC_ACQUIRE, "agent");
            asm volatile("s_waitcnt vmcnt(0)" ::: "memory");
        }
    }
    __syncthreads();
}

namespace pg8 {
typedef int v4i __attribute__((ext_vector_type(4)));
typedef int v8i __attribute__((ext_vector_type(8)));
constexpr int BM = 256, BK = 64, HALF = 128, HTB = HALF * BK * 2, STAGE_BYTES = 8 * HTB, NXCD = 8, WGM = 8;
__host__ __device__ __forceinline__ int lds_byte(int r, int c) { const int st = (r >> 4) * 2 + (c >> 5), rr = r & 15, cc = c & 31, ob = rr * 64 + cc * 2; return st * 1024 + (ob ^ (((ob >> 9) & 1) << 5)); }
__host__ __device__ __forceinline__ void stage_rc(int b, int& R, int& C) { const int st = b / 1024, sb = b % 1024, swz = sb ^ (((sb >> 9) & 1) << 5); R = (st >> 1) * 16 + swz / 64; C = (st & 1) * 32 + (swz % 64) / 2; }
__host__ __device__ __forceinline__ int perm32(int rho) { const int n = rho >> 4, i = rho & 15; return 8 * (i >> 2) + 4 * n + (i & 3); }

struct Unit { int pm, pn, arow0, aux, gbase, gcnt, acolb; const char* b; };

struct DenseOrder {
    int nM, nN, nwg, G, c; const char* Bt; size_t tstepB;
    __device__ void init(int M, int N, int K, int G_, int c_, const bf16* Bt_) { nM = M / BM; nN = N / BM; nwg = nM * nN; G = G_; c = c_; Bt = (const char*)Bt_; tstepB = (size_t)BM * K * 2; }
    __device__ bool next(int i, Unit& u) const {
        int wgid;
        if (G % NXCD == 0) { const int L = i * G + c; if (L >= nwg) return false;
            const int q = nwg / NXCD, r = nwg % NXCD, xcd = L % NXCD, off = L / NXCD; wgid = (xcd < r ? xcd * (q + 1) : r * (q + 1) + (xcd - r) * q) + off; }
        else {
            const int R = (nwg + G - 1) / G, x = c % NXCD, slot = c / NXCD, gq = G / NXCD, gr = G % NXCD, nx = gq + (x < gr ? 1 : 0), pre = x * gq + (x < gr ? x : gr);
            if (i >= R) return false;
            wgid = R * pre + i * nx + slot; if (wgid >= nwg) return false; }
        const int nig = WGM * nN, gid = wgid / nig, fm = gid * WGM, gsz = (nM - fm) < WGM ? (nM - fm) : WGM;
        u.pm = fm + ((wgid % nig) % gsz); u.pn = (wgid % nig) / gsz; u.arow0 = u.pm * BM; u.aux = 0; u.gbase = 0; u.gcnt = 0; u.acolb = 0; u.b = Bt + (size_t)u.pn * tstepB; return true;
    }
};
template <int NPN> struct GroupOrder {
    int G, c; const LAS int* tb; const LAS int* cn; const char* W; size_t estride, tstepB;
    __device__ bool next(int i, Unit& u) const {
        const int cc = (G % NXCD == 0) ? (c % NXCD) * (G / NXCD) + c / NXCD : c;
        const long L = (long)i * G + cc; if (L >= (long)tb[256] * NPN) return false;
        const int tile = (int)(L / NPN), pn = (int)(L % NPN);
        int e = 0;
#pragma unroll
        for (int s2 = 128; s2 >= 1; s2 >>= 1) if (tb[e + s2] <= tile) e += s2;
        const int j = tile - tb[e];
        u.pm = tile; u.pn = pn; u.arow0 = tile * BM; u.aux = e; u.gbase = e * 16384 + j * BM; u.gcnt = cn[e] - j * BM; u.acolb = 0; u.b = W + (size_t)e * estride + (size_t)pn * tstepB; return true;
    }
};

struct SplitK2Order {
    static constexpr bool HALF_TILES = false;
    int nM, G, c; const char* Bt;
    int khalfB;
    __device__ bool next(int i, Unit& u) const {
        const int L = i * G + c; if (L >= 2 * nM) return false;
        u.pm = L >> 1; u.pn = L & 1; u.arow0 = u.pm * BM; u.aux = 0; u.gbase = 0; u.gcnt = 0; u.acolb = (L & 1) * khalfB; u.b = Bt + (size_t)(L & 1) * 256 * khalfB; return true;
    }
};

typedef __bf16 bf16v2_t __attribute__((ext_vector_type(2)));
__device__ __forceinline__ unsigned cvt_pk_bf16(float lo, float hi) { bf16v2_t v; v[0] = (__bf16)lo; v[1] = (__bf16)hi; return __builtin_bit_cast(unsigned, v); }

template <class Epi, class Sched, bool GATHER, int F8S = -1, int F8A = 0>
__device__ __forceinline__ void gemm_phase(LAS unsigned char* lds, const void* Abase, const int* rowmap, const int K, const Sched& S, const Epi& E, const unsigned strideA = 0u) {
    const int tid = threadIdx.x, wid = __builtin_amdgcn_readfirstlane(tid >> 6), lane = tid & 63, wr = wid >> 2, wc = wid & 3, fr = lane & 15, fq = lane >> 4;
    const int nt = K / BK;
    const unsigned rowB = (unsigned)K * 2u;
    const unsigned rowA = strideA ? strideA : rowB;
    int RA[2]; unsigned vA[2], voffB[2];
#pragma unroll
    for (int i = 0; i < 2; ++i) { int R, C; stage_rc(tid * 16 + i * 8192, R, C); const int Rb = Epi::PERM ? ((R & ~31) + perm32(R & 31)) : R;
        RA[i] = R; vA[i] = (unsigned)C * 2u; voffB[i] = (unsigned)(Rb * K + C) * 2u; }
    const size_t kstep = (size_t)(BK * 2);
    const size_t hstep = (size_t)HALF * K * 2;
    const unsigned ldsw = (unsigned)wid * 1024u;
    const int aoff0 = lds_byte(wr * 64 + fr, 8 * fq), boff0 = lds_byte(wc * 32 + fr, 8 * fq);
    constexpr int KOFF = 1024;
    const char* A0 = (const char*)Abase;
    unsigned VA[2][2];
#define PG8_SA(b, h) (((b) * 2 + (h)) * HTB)
#define PG8_SB(b, h) ((4 + (b) * 2 + (h)) * HTB)
#define PG8_STAGE_B(bufoff, gbase) do { _Pragma("unroll") for (int _i = 0; _i < 2; ++_i) \
        __builtin_amdgcn_global_load_lds((const unsigned*)((const char*)(gbase) + voffB[_i]), (LAS unsigned*)(lds + (bufoff) + ldsw + _i * 8192), 16, 0, 0); } while (0)
#define PG8_STAGE_A(bufoff, gbase, h) do { _Pragma("unroll") for (int _i = 0; _i < 2; ++_i) \
        __builtin_amdgcn_global_load_lds((const unsigned*)((const char*)(gbase) + VA[h][_i]), (LAS unsigned*)(lds + (bufoff) + ldsw + _i * 8192), 16, 0, 0); } while (0)
#define PG8_CAT(lo, hi) __builtin_shufflevector(__builtin_bit_cast(v4i, lo), __builtin_bit_cast(v4i, hi), 0, 1, 2, 3, 4, 5, 6, 7)
#define PG8_LO(x) __builtin_bit_cast(bf16x8, __builtin_shufflevector(x, x, 0, 1, 2, 3))
#define PG8_HI(x) __builtin_bit_cast(bf16x8, __builtin_shufflevector(x, x, 4, 5, 6, 7))
#define PG8_LDA(dst, b, h) do { _Pragma("unroll") for (int m = 0; m < 4; ++m) dst[m] = PG8_CAT(*(const LAS bf16x8*)(lds + PG8_SA(b, h) + aoff0 + m * 2048), *(const LAS bf16x8*)(lds + PG8_SA(b, h) + aoff0 + KOFF + m * 2048)); } while (0)
#define PG8_LDB(dst, b, h) do { _Pragma("unroll") for (int n = 0; n < 2; ++n) dst[n] = PG8_CAT(*(const LAS bf16x8*)(lds + PG8_SB(b, h) + boff0 + n * 2048), *(const LAS bf16x8*)(lds + PG8_SB(b, h) + boff0 + KOFF + n * 2048)); } while (0)
#define PG8_MMA(ai, bj, At, Bt) do { __builtin_amdgcn_s_setprio(1); _Pragma("unroll") for (int m = 0; m < 4; ++m) _Pragma("unroll") for (int n = 0; n < 2; ++n) { \
        if (F8S >= 0) acc[ai][bj][m][n] = __builtin_amdgcn_mfma_scale_f32_16x16x128_f8f6f4(Bt[n], At[m], acc[ai][bj][m][n], 0, 0, 0, (127 - (F8S >= 0 ? F8S : 0)) * 0x01010101, 0, (127 - F8A) * 0x01010101); \
        else { acc[ai][bj][m][n] = __builtin_amdgcn_mfma_f32_16x16x32_bf16(PG8_LO(Bt[n]), PG8_LO(At[m]), acc[ai][bj][m][n], 0, 0, 0); \
               acc[ai][bj][m][n] = __builtin_amdgcn_mfma_f32_16x16x32_bf16(PG8_HI(Bt[n]), PG8_HI(At[m]), acc[ai][bj][m][n], 0, 0, 0); } } \
        __builtin_amdgcn_s_setprio(0); } while (0)
#define PG8_WAIT_V(n) asm volatile("s_waitcnt vmcnt(" #n ")" ::: "memory")
#define PG8_WAIT_L(n) asm volatile("s_waitcnt lgkmcnt(" #n ")" ::: "memory")
#define PG8_BAR __builtin_amdgcn_s_barrier()
#define PG8_SCHED __builtin_amdgcn_sched_barrier(0)
#define PG8_AOFFS(u) do { _Pragma("unroll") for (int _h = 0; _h < 2; ++_h) _Pragma("unroll") for (int _i = 0; _i < 2; ++_i) \
        { const int _r = _h * HALF + RA[_i]; unsigned _row; if (GATHER) { const int _rc = _r < (u).gcnt ? _r : ((u).gcnt > 0 ? (u).gcnt - 1 : 0); const unsigned _m = (unsigned)rowmap[(u).gbase + _rc]; _row = (_r < (u).gcnt) ? _m : 16384u; } else _row = (unsigned)((u).arow0 + _r); VA[_h][_i] = _row * rowA + (unsigned)(u).acolb + vA[_i]; } } while (0)
    Unit cur, nxt; int ui = 0;
    if (!S.next(0, cur)) return;
    f32x4 acc[2][2][4][2];
#pragma unroll
    for (int a = 0; a < 2; ++a)
#pragma unroll
        for (int b = 0; b < 2; ++b)
#pragma unroll
            for (int m = 0; m < 4; ++m)
#pragma unroll
                for (int n = 0; n < 2; ++n) acc[a][b][m][n] = (f32x4){0.f, 0.f, 0.f, 0.f};
    v8i At[4], B0[2], B1[2];
    PG8_AOFFS(cur);
    const char* cA = A0;
    const char* cB = cur.b;
    PG8_STAGE_B(PG8_SB(0, 0), cB); PG8_STAGE_A(PG8_SA(0, 0), cA, 0); PG8_STAGE_B(PG8_SB(0, 1), cB + hstep); PG8_STAGE_A(PG8_SA(0, 1), cA, 1);
    if (wr == 1) PG8_BAR;
    PG8_WAIT_V(4); PG8_BAR;
    PG8_STAGE_B(PG8_SB(1, 0), cB + kstep); PG8_STAGE_A(PG8_SA(1, 0), cA + kstep, 0); PG8_STAGE_B(PG8_SB(1, 1), cB + hstep + kstep);
    PG8_WAIT_V(6); PG8_BAR;
    for (;;) {
        bool has_next = false; const char* nA = cA; const char* nB = cB;
#pragma unroll 1
        for (int t = 0; t < nt; t += 2) {
            const bool last = (t == nt - 2);
            if (last) { has_next = S.next(ui + 1, nxt); if (has_next) { nB = nxt.b; } }
            const char* a1 = cA + (size_t)(t + 1) * kstep;
            const char* a2 = last ? nA : cA + (size_t)(t + 2) * kstep; const char* b2 = last ? nB : cB + (size_t)(t + 2) * kstep;
            const char* a3 = a2 + kstep; const char* b3 = b2 + kstep;
            PG8_LDB(B0, 0, 0); PG8_SCHED; PG8_LDA(At, 0, 0); PG8_STAGE_A(PG8_SA(1, 1), a1, 1);
            PG8_WAIT_L(8); PG8_BAR; PG8_WAIT_L(0); PG8_MMA(0, 0, At, B0); PG8_BAR; PG8_SCHED;
            if (last && has_next) { PG8_AOFFS(nxt); }
            PG8_LDB(B1, 0, 1); PG8_STAGE_B(PG8_SB(0, 0), b2);
            PG8_BAR; PG8_WAIT_L(0); PG8_MMA(0, 1, At, B1); PG8_BAR;
            PG8_LDA(At, 0, 1); PG8_STAGE_A(PG8_SA(0, 0), a2, 0);
            PG8_BAR; PG8_WAIT_L(0); PG8_MMA(1, 0, At, B0); PG8_BAR; PG8_SCHED;
            PG8_STAGE_B(PG8_SB(0, 1), b2 + hstep);
            PG8_WAIT_V(6); PG8_BAR; PG8_MMA(1, 1, At, B1); PG8_BAR;
            PG8_LDB(B0, 1, 0); PG8_SCHED; PG8_LDA(At, 1, 0); PG8_STAGE_A(PG8_SA(0, 1), a2, 1);
            PG8_WAIT_L(8); PG8_BAR; PG8_WAIT_L(0); PG8_MMA(0, 0, At, B0); PG8_BAR; PG8_SCHED;
            PG8_LDB(B1, 1, 1); PG8_STAGE_B(PG8_SB(1, 0), b3);
            PG8_BAR; PG8_WAIT_L(0); PG8_MMA(0, 1, At, B1); PG8_BAR;
            PG8_LDA(At, 1, 1); PG8_STAGE_A(PG8_SA(1, 0), a3, 0);
            PG8_BAR; PG8_WAIT_L(0); PG8_MMA(1, 0, At, B0); PG8_BAR; PG8_SCHED;
            PG8_STAGE_B(PG8_SB(1, 1), b3 + hstep);
            PG8_WAIT_V(6); PG8_BAR; PG8_MMA(1, 1, At, B1); PG8_BAR;
        }
        E(acc, cur, wr, wc, fr, fq);
        if (!has_next) break;
#pragma unroll
        for (int a = 0; a < 2; ++a)
#pragma unroll
            for (int b = 0; b < 2; ++b)
#pragma unroll
                for (int m = 0; m < 4; ++m)
#pragma unroll
                    for (int n = 0; n < 2; ++n) acc[a][b][m][n] = (f32x4){0.f, 0.f, 0.f, 0.f};
        cur = nxt; cA = nA; cB = nB; ++ui;
    }
    PG8_WAIT_V(0);
    if (wr == 0) PG8_BAR;
    PG8_BAR;
#undef PG8_SA
#undef PG8_SB
#undef PG8_STAGE_A
#undef PG8_STAGE_B
#undef PG8_LDA
#undef PG8_CAT
#undef PG8_LO
#undef PG8_HI
#undef PG8_LDB
#undef PG8_MMA
#undef PG8_WAIT_V
#undef PG8_WAIT_L
#undef PG8_BAR
#undef PG8_SCHED
#undef PG8_AOFFS
}
}

struct EpiF32Res {
    static constexpr bool PERM = false;
    float* C; int ldc; const float* res; float alpha;
    __device__ __forceinline__ void operator()(const f32x4 (&acc)[2][2][4][2], const pg8::Unit& u, int wr, int wc, int fr, int fq) const {
        const int row0 = u.pm * 256 + wr * 64 + fr, col0 = u.pn * 256 + wc * 32 + 4 * fq;
#pragma unroll
        for (int ai = 0; ai < 2; ++ai)
#pragma unroll
            for (int m = 0; m < 4; ++m) { const size_t ro = (size_t)(row0 + ai * 128 + m * 16) * ldc + col0;
#pragma unroll
                for (int bj = 0; bj < 2; ++bj)
#pragma unroll
                    for (int n = 0; n < 2; ++n) { f32x4 v = acc[ai][bj][m][n];
                        if (res) { const f32x4 r = *(const f32x4*)(res + ro + bj * 128 + n * 16); v = v + r * alpha; }
                        *(f32x4*)(C + ro + bj * 128 + n * 16) = v; } }
    }
};
struct EpiBf16Res {
    static constexpr bool PERM = true;
    bf16* O; int ldc; const float* res; float alpha;
    __device__ __forceinline__ void operator()(const f32x4 (&acc)[2][2][4][2], const pg8::Unit& u, int wr, int wc, int fr, int fq) const {
        const int row0 = u.pm * 256 + wr * 64 + fr, col0 = u.pn * 256 + wc * 32 + 8 * fq;
        f32x4 r[2][4][2];
#define EB_RO(st, g) ((size_t)(row0 + ((st) >> 1) * 128 + (2 * ((st) & 1) + ((g) >> 1)) * 16) * ldc + col0 + ((g) & 1) * 128)
#define EB_LOAD(st) do { _Pragma("unroll") for (int _g = 0; _g < 4; ++_g) { const float* _p = res + EB_RO(st, _g); r[(st) & 1][_g][0] = *(const f32x4*)_p; r[(st) & 1][_g][1] = *(const f32x4*)(_p + 4); } } while (0)
#define EB_STORE(st) do { _Pragma("unroll") for (int _g = 0; _g < 4; ++_g) { const int _ai = (st) >> 1, _m = 2 * ((st) & 1) + (_g >> 1), _bj = _g & 1; \
            const f32x4 v0 = acc[_ai][_bj][_m][0] + r[(st) & 1][_g][0] * alpha, v1 = acc[_ai][_bj][_m][1] + r[(st) & 1][_g][1] * alpha; \
            v4u o; o.x = pg8::cvt_pk_bf16(v0[0], v0[1]); o.y = pg8::cvt_pk_bf16(v0[2], v0[3]); o.z = pg8::cvt_pk_bf16(v1[0], v1[1]); o.w = pg8::cvt_pk_bf16(v1[2], v1[3]); \
            *(v4u*)(O + EB_RO(st, _g)) = o; } } while (0)
        EB_LOAD(0); EB_LOAD(1);
        EB_STORE(0); EB_LOAD(2);
        EB_STORE(1); EB_LOAD(3);
        EB_STORE(2); EB_STORE(3);
#undef EB_RO
#undef EB_LOAD
#undef EB_STORE
    }
};
struct EpiBf16Plain {
    static constexpr bool PERM = true;
    bf16* O; int ldc;
    __device__ __forceinline__ void operator()(const f32x4 (&acc)[2][2][4][2], const pg8::Unit& u, int wr, int wc, int fr, int fq) const {
        const int row0 = u.pm * 256 + wr * 64 + fr, col0 = u.pn * 256 + wc * 32 + 8 * fq;
#pragma unroll
        for (int ai = 0; ai < 2; ++ai)
#pragma unroll
            for (int m = 0; m < 4; ++m) { bf16* rowp = O + (size_t)(row0 + ai * 128 + m * 16) * ldc + col0;
#pragma unroll
                for (int bj = 0; bj < 2; ++bj) { const f32x4 v0 = acc[ai][bj][m][0], v1 = acc[ai][bj][m][1];
                    v4u o; o.x = pg8::cvt_pk_bf16(v0[0], v0[1]); o.y = pg8::cvt_pk_bf16(v0[2], v0[3]); o.z = pg8::cvt_pk_bf16(v1[0], v1[1]); o.w = pg8::cvt_pk_bf16(v1[2], v1[3]);
                    *(v4u*)(rowp + bj * 128) = o; } }
    }
};
struct EpiSwiGLU {
    static constexpr bool PERM = true;
    bf16* H;
    __device__ __forceinline__ void operator()(const f32x4 (&acc)[2][2][4][2], const pg8::Unit& u, int wr, int wc, int fr, int fq) const {
        const int row0 = u.pm * 256 + wr * 64 + fr, col0 = u.pn * 128 + wc * 32 + 8 * fq;
#pragma unroll
        for (int ai = 0; ai < 2; ++ai)
#pragma unroll
            for (int m = 0; m < 4; ++m) { bf16* rowp = H + (size_t)(row0 + ai * 128 + m * 16) * 256 + col0;
                const f32x4 g0 = acc[ai][0][m][0], g1 = acc[ai][0][m][1], u0 = acc[ai][1][m][0], u1 = acc[ai][1][m][1];
                float h[8];
#pragma unroll
                for (int e = 0; e < 4; ++e) { h[e] = siluf_(g0[e]) * u0[e]; h[4 + e] = siluf_(g1[e]) * u1[e]; }
                v4u o; o.x = pg8::cvt_pk_bf16(h[0], h[1]); o.y = pg8::cvt_pk_bf16(h[2], h[3]); o.z = pg8::cvt_pk_bf16(h[4], h[5]); o.w = pg8::cvt_pk_bf16(h[6], h[7]);
                *(v4u*)rowp = o; }
    }
};
struct EpiSwiGLU8 {
    static constexpr bool PERM = true;
    unsigned char* H;
    __device__ __forceinline__ void operator()(const f32x4 (&acc)[2][2][4][2], const pg8::Unit& u, int wr, int wc, int fr, int fq) const {
        const int row0 = u.pm * 256 + wr * 64 + fr, col0 = u.pn * 128 + wc * 32 + 8 * fq;
#pragma unroll
        for (int ai = 0; ai < 2; ++ai)
#pragma unroll
            for (int m = 0; m < 4; ++m) { unsigned char* rowp = H + (size_t)(row0 + ai * 128 + m * 16) * 256 + col0;
                const f32x4 g0 = acc[ai][0][m][0], g1 = acc[ai][0][m][1], u0 = acc[ai][1][m][0], u1 = acc[ai][1][m][1];
                float h[8];
#pragma unroll
                for (int e = 0; e < 4; ++e) { h[e] = 4.f * siluf_(g0[e]) * u0[e]; h[4 + e] = 4.f * siluf_(g1[e]) * u1[e]; }
                v2u o; o.x = pk4_fp8(h[0], h[1], h[2], h[3]); o.y = pk4_fp8(h[4], h[5], h[6], h[7]);
                *(v2u*)rowp = o; }
    }
};
struct EpiScatter8 {
    static constexpr bool PERM = true;
    unsigned char* Y; const int* rowdst;
    __device__ __forceinline__ void operator()(const f32x4 (&acc)[2][2][4][2], const pg8::Unit& u, int wr, int wc, int fr, int fq) const {
        const int r0 = wr * 64 + fr, col0 = u.pn * 256 + wc * 32 + 8 * fq;
        unsigned dst[8];
#pragma unroll
        for (int i = 0; i < 8; ++i) { const int rr = r0 + (i >> 2) * 128 + (i & 3) * 16; const int rc = rr < u.gcnt ? rr : (u.gcnt > 0 ? u.gcnt - 1 : 0); const unsigned dd = (unsigned)rowdst[u.gbase + rc]; dst[i] = (rr < u.gcnt) ? dd : 131072u; }
#pragma unroll
        for (int ai = 0; ai < 2; ++ai)
#pragma unroll
            for (int m = 0; m < 4; ++m) { unsigned char* rowp = Y + (size_t)dst[ai * 4 + m] * 1024 + col0;
#pragma unroll
                for (int bj = 0; bj < 2; ++bj) { const f32x4 v0 = acc[ai][bj][m][0] * 16.f, v1 = acc[ai][bj][m][1] * 16.f;
                    v2u o; o.x = pk4_fp8(v0[0], v0[1], v0[2], v0[3]); o.y = pk4_fp8(v1[0], v1[1], v1[2], v1[3]);
                    *(v2u*)(rowp + bj * 128) = o; } }
    }
};
struct EpiScatter {
    static constexpr bool PERM = true;
    bf16* Y; const int* rowdst;
    __device__ __forceinline__ void operator()(const f32x4 (&acc)[2][2][4][2], const pg8::Unit& u, int wr, int wc, int fr, int fq) const {
        const int r0 = wr * 64 + fr, col0 = u.pn * 256 + wc * 32 + 8 * fq;
        unsigned dst[8];
#pragma unroll
        for (int i = 0; i < 8; ++i) { const int rr = r0 + (i >> 2) * 128 + (i & 3) * 16; const int rc = rr < u.gcnt ? rr : (u.gcnt > 0 ? u.gcnt - 1 : 0); const unsigned dd = (unsigned)rowdst[u.gbase + rc]; dst[i] = (rr < u.gcnt) ? dd : 131072u; }
#pragma unroll
        for (int ai = 0; ai < 2; ++ai)
#pragma unroll
            for (int m = 0; m < 4; ++m) { bf16* rowp = Y + (size_t)dst[ai * 4 + m] * 1024 + col0;
#pragma unroll
                for (int bj = 0; bj < 2; ++bj) { const f32x4 v0 = acc[ai][bj][m][0], v1 = acc[ai][bj][m][1];
                    v4u o; o.x = pg8::cvt_pk_bf16(v0[0], v0[1]); o.y = pg8::cvt_pk_bf16(v0[2], v0[3]); o.z = pg8::cvt_pk_bf16(v1[0], v1[1]); o.w = pg8::cvt_pk_bf16(v1[2], v1[3]);
                    *(v4u*)(rowp + bj * 128) = o; } }
    }
};

struct Args { const float* in[21]; float* out; unsigned char* ws; float rope_inv[16]; int ph_lo, ph_hi; };
struct Frame {
    LAS unsigned char* lds; volatile LAS unsigned* MISC; unsigned* ctl; unsigned char* ws;
    int wave, G, bid;
};

__device__ __forceinline__ void transpose_item(const float* src, int ld, int k0, int n0, int nvalid, bf16* dst, int lddst, int dst_row0, LAS float* scr, int lane) {
    const int n4 = 4 * (lane & 15), kq = lane >> 4;
    f32x4 v[16];
#pragma unroll
    for (int i = 0; i < 16; ++i) v[i] = (n4 < nvalid) ? *(const f32x4*)(src + (size_t)(k0 + kq + 4 * i) * ld + n0 + n4) : (f32x4){0.f, 0.f, 0.f, 0.f};
#pragma unroll
    for (int i = 0; i < 16; ++i) { LAS float* p = scr + (kq + 4 * i) * 65 + n4; p[0] = v[i][0]; p[1] = v[i][1]; p[2] = v[i][2]; p[3] = v[i][3]; }
    LDS_WAIT(); asm volatile("" ::: "memory");
    const int c = lane & 7;
#pragma unroll
    for (int j = 0; j < 8; ++j) { const int nn = (lane >> 3) + 8 * j; const LAS float* s = scr + (8 * c) * 65 + nn;
        v4u o; o.x = pk2(s[0 * 65], s[1 * 65]); o.y = pk2(s[2 * 65], s[3 * 65]); o.z = pk2(s[4 * 65], s[5 * 65]); o.w = pk2(s[6 * 65], s[7 * 65]);
        *(v4u*)(dst + (size_t)(dst_row0 + nn) * lddst + k0 + 8 * c) = o; }
    LDS_WAIT(); asm volatile("" ::: "memory");
}
__device__ __forceinline__ void transpose_item8(const float* src, int ld, int k0, int n0, int nvalid, unsigned char* dst, int lddst, int dst_row0, float scale, LAS float* scr, int lane) {
    const int n4 = 4 * (lane & 15), kq = lane >> 4;
    f32x4 v[16];
#pragma unroll
    for (int i = 0; i < 16; ++i) v[i] = (n4 < nvalid) ? *(const f32x4*)(src + (size_t)(k0 + kq + 4 * i) * ld + n0 + n4) : (f32x4){0.f, 0.f, 0.f, 0.f};
#pragma unroll
    for (int i = 0; i < 16; ++i) { LAS float* p = scr + (kq + 4 * i) * 65 + n4; p[0] = v[i][0] * scale; p[1] = v[i][1] * scale; p[2] = v[i][2] * scale; p[3] = v[i][3] * scale; }
    LDS_WAIT(); asm volatile("" ::: "memory");
    const int c = lane & 7;
#pragma unroll
    for (int j = 0; j < 8; ++j) { const int nn = (lane >> 3) + 8 * j; const LAS float* s = scr + (8 * c) * 65 + nn;
        v2u o; o.x = pk4_fp8(s[0 * 65], s[1 * 65], s[2 * 65], s[3 * 65]); o.y = pk4_fp8(s[4 * 65], s[5 * 65], s[6 * 65], s[7 * 65]);
        *(v2u*)(dst + (size_t)(dst_row0 + nn) * lddst + k0 + 8 * c) = o; }
    LDS_WAIT(); asm volatile("" ::: "memory");
}
__device__ __forceinline__ int gu_row(int n, int is_up) { return (n >> 7) * 256 + is_up * 128 + (n & 127); }

__device__ __forceinline__ void p0_prologue(Frame& F, const Args& a, const bool experts, const int wg0) {
    LAS float* scr = (LAS float*)(F.lds + F.wave * 16896);
    const int gw = (F.bid - wg0) * NWAVES + F.wave, NGW = (F.G - wg0) * NWAVES;
    unsigned char* ws = F.ws;
    constexpr int I_IN = 16 * (NIN / 64), I_SQ = 16 * 16, I_RT = 16 * 4, I_SH = 16 * 4, I_SD = 4 * 16, I_EX = 64;
    constexpr int NSMALL = I_IN + 3 * I_SQ + I_RT + 2 * I_SH + I_SD;
    const int ln = (int)(threadIdx.x & 63);
    const int it0 = experts ? NSMALL : 0, it1 = experts ? NSMALL + NEXP * 3 * I_EX : NSMALL;
    for (int it = it0 + gw; it < it1; it += NGW) {
        int r = it;
        if (r < I_IN) { const int nblk = NIN / 64, kb = r / nblk, nb = r % nblk, j0 = nb * 64;
            int n0, nv; if (j0 < 4096) { n0 = j0; nv = 64; } else if (j0 < 7680) { n0 = j0 + 16; nv = 64; } else if (j0 == 7680) { n0 = 4096; nv = 16; } else { n0 = 0; nv = 0; }
            transpose_item8(a.in[1], 7696, kb * 64, n0, nv, ws + WS_WIN, 1024, j0, 32.f, scr, ln); continue; } r -= I_IN;
        if (r < 3 * I_SQ) { const int w = r / I_SQ, q = r % I_SQ, kb = q / 16, nb = q % 16;
            transpose_item8(a.in[6 + w], 1024, kb * 64, nb * 64, 64, ws + (w == 0 ? WS_WGP : (w == 1 ? WS_WMP : WS_WOUT)), 1024, nb * 64, 64.f, scr, ln); continue; } r -= 3 * I_SQ;
        if (r < I_RT) { const int kb = r / 4, nb = r % 4, hf = kb >> 3;
            transpose_item(a.in[11], 256, kb * 64, nb * 64, 64, (bf16*)(ws + WS_ROUTER), 512, hf * 256 + nb * 64 - hf, scr, ln); continue; } r -= I_RT;
        if (r < 2 * I_SH) { const int up = r / I_SH, q = r % I_SH, kb = q / 4, nb = q % 4;
            transpose_item8(a.in[16 + up], 256, kb * 64, nb * 64, 64, ws + WS_SHGU, 1024, gu_row(nb * 64, up), 32.f, scr, ln); continue; } r -= 2 * I_SH;
        if (r < I_SD) { const int kb = r / 16, nb = r % 16; transpose_item(a.in[18], 1024, kb * 64, nb * 64, 64, (bf16*)(ws + WS_SHD), 256, nb * 64, scr, ln); continue; } r -= I_SD;
        { const int e = r / (3 * I_EX), q = r % (3 * I_EX), w = q / I_EX, p = q % I_EX;
            if (w < 2) { const int kb = p / 4, nb = p % 4;
                transpose_item8(a.in[13 + w] + (size_t)e * 1024 * 256, 256, kb * 64, nb * 64, 64, ws + WS_EXPGU + (size_t)e * 512 * 1024, 1024, gu_row(nb * 64, w), 32.f, scr, ln); }
            else { const int kb = p / 16, nb = p % 16;
                transpose_item8(a.in[15] + (size_t)e * 256 * 1024, 1024, kb * 64, nb * 64, 64, ws + WS_EXPD + (size_t)e * 1024 * 256, 256, nb * 64, 32.f, scr, ln); } }
    }
    if (experts) return;
    { const f32x4* x4 = (const f32x4*)a.in[0]; v2u* xb = (v2u*)(ws + WS_XB); const size_t n8 = (size_t)T * D / 8;
        for (size_t i = (size_t)F.bid * 512 + threadIdx.x; i < n8; i += (size_t)F.G * 512) { const f32x4 p = x4[2 * i], q = x4[2 * i + 1];
            v2u o; o.x = pk4_fp8(p[0], p[1], p[2], p[3]); o.y = pk4_fp8(q[0], q[1], q[2], q[3]); xb[i] = o; } }
    { _Float16* rope = (_Float16*)(ws + WS_ROPE);
        for (int idx = F.bid * 512 + ((int)threadIdx.x); idx < T * 16; idx += F.G * 512) { const int t = idx >> 4, i = idx & 15;
            const float angf = (float)t * a.rope_inv[i]; double ang = (double)angf;
            const double TWO_PI = 6.283185307179586476925, PI = 3.14159265358979323846;
            const double kq = __builtin_rint(ang / TWO_PI); double rr = ang - kq * TWO_PI; double cs = 1.0;
            if (rr > 0.5 * PI) { rr = PI - rr; cs = -1.0; } else if (rr < -0.5 * PI) { rr = -PI - rr; cs = -1.0; }
            const double r2 = rr * rr;
            double s = 1.0 / 355687428096000.0;
            s = s * (-r2) + 1.0 / 1307674368000.0; s = s * (-r2) + 1.0 / 6227020800.0; s = s * (-r2) + 1.0 / 39916800.0; s = s * (-r2) + 1.0 / 362880.0;
            s = s * (-r2) + 1.0 / 5040.0; s = s * (-r2) + 1.0 / 120.0; s = s * (-r2) + 1.0 / 6.0; s = s * (-r2) + 1.0; s *= rr;
            double c = 1.0 / 20922789888000.0;
            c = c * (-r2) + 1.0 / 87178291200.0; c = c * (-r2) + 1.0 / 479001600.0; c = c * (-r2) + 1.0 / 3628800.0; c = c * (-r2) + 1.0 / 40320.0;
            c = c * (-r2) + 1.0 / 720.0; c = c * (-r2) + 1.0 / 24.0; c = c * (-r2) + 0.5; c = c * (-r2) + 1.0; c *= cs;
            rope[t * 32 + i] = (_Float16)c; rope[t * 32 + 16 + i] = (_Float16)s; } }
    if (F.bid == 0 && ((int)threadIdx.x) < 128) ((v4u*)(ws + WS_HB + (size_t)T * D * 2))[((int)threadIdx.x)] = (v4u){0u, 0u, 0u, 0u};
}

__device__ __forceinline__ void expert_convert_queue(Frame& F, const Args& a) {
    LAS float* scr = (LAS float*)(F.lds + F.wave * 16896);
    const int lane = (int)(threadIdx.x & 63); unsigned char* ws = F.ws;
    constexpr int I_EX = 64, NIT = NEXP * 3 * I_EX, CH = 8;
    const int n4 = 4 * (lane & 15), kq = lane >> 4, c8 = lane & 7;
#define EX_LOAD(V, r_) do { const int _e = (r_) / (3 * I_EX), _q = (r_) % (3 * I_EX), _w = _q / I_EX, _p = _q % I_EX; const float* _s; int _ld, _k0, _n0; \
        if (_w < 2) { _s = a.in[13 + _w] + (size_t)_e * 1024 * 256; _ld = 256; _k0 = (_p / 4) * 64; _n0 = (_p % 4) * 64; } \
        else { _s = a.in[15] + (size_t)_e * 256 * 1024; _ld = 1024; _k0 = (_p / 16) * 64; _n0 = (_p % 16) * 64; } \
        _Pragma("unroll") for (int _i = 0; _i < 16; ++_i) V[_i] = __builtin_nontemporal_load((const f32x4*)(_s + (size_t)(_k0 + kq + 4 * _i) * _ld + _n0 + n4)); } while (0)
#define EX_PROC(V, r_) do { const int _e = (r_) / (3 * I_EX), _q = (r_) % (3 * I_EX), _w = _q / I_EX, _p = _q % I_EX; unsigned char* _dst; int _lddst, _row0, _k0; \
        if (_w < 2) { _dst = ws + WS_EXPGU + (size_t)_e * 512 * 1024; _lddst = 1024; _row0 = gu_row((_p % 4) * 64, _w); _k0 = (_p / 4) * 64; } \
        else { _dst = ws + WS_EXPD + (size_t)_e * 1024 * 256; _lddst = 256; _row0 = (_p % 16) * 64; _k0 = (_p / 16) * 64; } \
        _Pragma("unroll") for (int _i = 0; _i < 16; ++_i) { LAS float* _pp = scr + (kq + 4 * _i) * 65 + n4; _pp[0] = V[_i][0] * 32.f; _pp[1] = V[_i][1] * 32.f; _pp[2] = V[_i][2] * 32.f; _pp[3] = V[_i][3] * 32.f; } \
        LDS_WAIT(); asm volatile("" ::: "memory"); \
        _Pragma("unroll") for (int _j = 0; _j < 8; ++_j) { const int _nn = (lane >> 3) + 8 * _j; const LAS float* _sp = scr + (8 * c8) * 65 + _nn; \
            v2u _o; _o.x = pk4_fp8(_sp[0 * 65], _sp[1 * 65], _sp[2 * 65], _sp[3 * 65]); _o.y = pk4_fp8(_sp[4 * 65], _sp[5 * 65], _sp[6 * 65], _sp[7 * 65]); \
            __builtin_nontemporal_store(_o, (v2u*)(_dst + (size_t)(_row0 + _nn) * _lddst + _k0 + 8 * c8)); } \
        LDS_WAIT(); asm volatile("" ::: "memory"); } while (0)
    for (;;) {
        unsigned nxt = 0u;
        if (lane == 0) nxt = atomicAdd(&F.ctl[CW_CONVQ], (unsigned)CH);
        const int r0 = __builtin_amdgcn_readfirstlane((int)nxt);
        if (r0 >= NIT) break;
#pragma unroll 1
        for (int r = r0; r < r0 + CH; r += 2) {
            f32x4 va[16], vb[16];
            EX_LOAD(va, r); EX_LOAD(vb, r + 1);
            EX_PROC(va, r); EX_PROC(vb, r + 1);
        }
    }
#undef EX_LOAD
#undef EX_PROC
}

__device__ __forceinline__ void ln_rows(Frame& F, bf16* XB_, unsigned char* X8, const float* g, const float* b) {
    const int gw = F.bid * NWAVES + F.wave, NGW = F.G * NWAVES, lane = (int)(threadIdx.x & 63);
    f32x4 gv[4], bv[4];
#pragma unroll
    for (int j = 0; j < 4; ++j) { gv[j] = ((const f32x4*)g)[lane + 64 * j]; bv[j] = ((const f32x4*)b)[lane + 64 * j]; }
    for (int m0 = gw; m0 < T; m0 += 4 * NGW) {
        v2u x[4][4];
#pragma unroll
        for (int k = 0; k < 4; ++k) { const int mk = (m0 + k * NGW < T) ? m0 + k * NGW : T - 1; const v2u* xr = (const v2u*)(XB_ + (size_t)mk * D) + lane;
#pragma unroll
            for (int j = 0; j < 4; ++j) x[k][j] = xr[64 * j]; }
#pragma unroll
        for (int k = 0; k < 4; ++k) { const int m = m0 + k * NGW;
            f32x4 v[4]; float s = 0.f;
#pragma unroll
            for (int j = 0; j < 4; ++j) { v[j] = (f32x4){bflo(x[k][j].x), bfhi(x[k][j].x), bflo(x[k][j].y), bfhi(x[k][j].y)}; s += (v[j][0] + v[j][1]) + (v[j][2] + v[j][3]); }
            const float mean = wave_sum(s) * (1.f / D); float s2 = 0.f;
#pragma unroll
            for (int j = 0; j < 4; ++j) { v[j] = v[j] - mean; s2 += (v[j][0] * v[j][0] + v[j][1] * v[j][1]) + (v[j][2] * v[j][2] + v[j][3] * v[j][3]); }
            const float rstd = 1.f / sqrtf(wave_sum(s2) * (1.f / D) + LN_EPS);
            if (k == 0) __builtin_amdgcn_s_waitcnt(0x0F70);
            if (m < T) { v2u* xw = (v2u*)(XB_ + (size_t)m * D) + lane;
#pragma unroll
                for (int j = 0; j < 4; ++j) { const f32x4 y = v[j] * rstd * gv[j] + bv[j];
                    v2u o; o.x = pk2(y[0], y[1]); o.y = pk2(y[2], y[3]); xw[64 * j] = o;
                    ((unsigned*)(X8 + (size_t)m * D))[lane + 64 * j] = pk4_fp8(y[0], y[1], y[2], y[3]); } }
        }
    }
}

__device__ __forceinline__ bf16x8 pack8(const f32x4 a, const f32x4 b) {
    v4u o; o.x = pg8::cvt_pk_bf16(a[0], a[1]); o.y = pg8::cvt_pk_bf16(a[2], a[3]); o.z = pg8::cvt_pk_bf16(b[0], b[1]); o.w = pg8::cvt_pk_bf16(b[2], b[3]);
    return __builtin_bit_cast(bf16x8, o);
}
__device__ __forceinline__ f32x4 mfma16(const bf16x8 a, const bf16x8 b, const f32x4 c) { return __builtin_amdgcn_mfma_f32_16x16x32_bf16(a, b, c, 0, 0, 0); }
__device__ __forceinline__ float softplusf_(float x) { return fmaxf(x, 0.f) + log1pf(expf(-fabsf(x))); }

constexpr float MB_QSCALE = 0.08838834764831845f * 1.4426950408889634f;
struct EpiInProj {
    static constexpr bool PERM = true;
    unsigned char* ws; const float* a_log; const float* dt_bias;
    __device__ __forceinline__ void operator()(const f32x4 (&acc)[2][2][4][2], const pg8::Unit& u, int wr, int wc, int fr, int fq) const {
        const int pn = u.pn, row0 = u.pm * 256 + wr * 64 + fr, colt = wc * 32 + 8 * fq;
        if (pn == 30) {
            if (wc == 0 && fq < 2) {
                float al[8], db[8];
#pragma unroll
                for (int j = 0; j < 8; ++j) { al[j] = -expf(a_log[j]); db[j] = dt_bias[j]; }
#pragma unroll
                for (int ai = 0; ai < 2; ++ai)
#pragma unroll
                    for (int m = 0; m < 4; ++m) { const int row = row0 + ai * 128 + m * 16; const f32x4 v0 = acc[ai][0][m][0], v1 = acc[ai][0][m][1];
                        f32x4 o0, o1;
                        if (fq == 0) {
#pragma unroll
                            for (int e = 0; e < 4; ++e) { o0[e] = 1.f / (1.f + expf(-v0[e])); o1[e] = 1.f / (1.f + expf(-v1[e])); }
                            float* p = (float*)(ws + WS_BETA) + (size_t)row * 8; *(f32x4*)p = o0; *(f32x4*)(p + 4) = o1;
                        } else {
#pragma unroll
                            for (int e = 0; e < 4; ++e) { o0[e] = al[e] * softplusf_(v0[e] + db[e]); o1[e] = al[4 + e] * softplusf_(v1[e] + db[4 + e]); }
                            float* p = (float*)(ws + WS_GLOG) + (size_t)row * 8; *(f32x4*)p = o0; *(f32x4*)(p + 4) = o1;
                        } }
            }
            return;
        }
        int kind, ld, cbase; bf16* dst;
        if (pn < 12) { kind = 0; dst = (bf16*)(ws + WS_CONVIN); ld = 3072; cbase = pn * 256; }
        else if (pn < 16) { kind = 1; dst = (bf16*)(ws + WS_GG); ld = 1024; cbase = (pn - 12) * 256; }
        else if (pn < 20) { kind = 3; dst = (bf16*)(ws + WS_MQ); ld = 1024; cbase = (pn - 16) * 256; }
        else if (pn == 20) { kind = 3; dst = (bf16*)(ws + WS_MK); ld = 256; cbase = 0; }
        else if (pn == 21) { kind = 0; dst = (bf16*)(ws + WS_MV); ld = 256; cbase = 0; }
        else if (pn < 26) { kind = 2; dst = (bf16*)(ws + WS_SGG); ld = 1024; cbase = (pn - 22) * 256; }
        else { kind = 2; dst = (bf16*)(ws + WS_SGM); ld = 1024; cbase = (pn - 26) * 256; }
        const bool rope = (kind == 3) && (wc == 0);
        const int i0 = 8 * (fq & 1);
        float ksum[2][8];
#pragma unroll
        for (int bj = 0; bj < 2; ++bj)
#pragma unroll
            for (int e = 0; e < 8; ++e) ksum[bj][e] = 0.f;
        typedef _Float16 f16x8 __attribute__((ext_vector_type(8)));
        f16x8 cq[4], sq[4];
#pragma unroll
        for (int ai = 0; ai < 2; ++ai) {
            if (rope) {
#pragma unroll
                for (int k = 0; k < 4; ++k) { const _Float16* rp = (const _Float16*)(ws + WS_ROPE) + (size_t)(row0 + ai * 128 + k * 16) * 32 + i0; cq[k] = *(const f16x8*)rp; sq[k] = *(const f16x8*)(rp + 16); }
            }
#pragma unroll
            for (int m = 0; m < 4; ++m) { const int row = row0 + ai * 128 + m * 16; bf16* rowp = dst + (size_t)row * ld + cbase + colt;
                f32x4 c0, c1, s0, s1;
                if (rope) { const f16x8 cc = cq[m], ss = sq[m];
#pragma unroll
                    for (int e = 0; e < 4; ++e) { c0[e] = (float)cc[e]; c1[e] = (float)cc[4 + e]; s0[e] = (float)ss[e]; s1[e] = (float)ss[4 + e]; } }
#pragma unroll
                for (int bj = 0; bj < 2; ++bj) { f32x4 v0 = acc[ai][bj][m][0], v1 = acc[ai][bj][m][1];
                    if (kind == 1) {
#pragma unroll
                        for (int e = 0; e < 4; ++e) { v0[e] = siluf_(v0[e]); v1[e] = siluf_(v1[e]); }
                    } else if (kind == 2) {
#pragma unroll
                        for (int e = 0; e < 4; ++e) { v0[e] = sigmoidf_(v0[e]); v1[e] = sigmoidf_(v1[e]); }
                    } else if (rope) {
                        const float sg = fq < 2 ? -1.f : 1.f;
#pragma unroll
                        for (int e = 0; e < 4; ++e) { const float p0 = __shfl_xor(v0[e], 32), p1 = __shfl_xor(v1[e], 32);
                            v0[e] = v0[e] * c0[e] + sg * p0 * s0[e]; v1[e] = v1[e] * c1[e] + sg * p1 * s1[e]; }
                    }
                    if (pn == 20) {
#pragma unroll
                        for (int e = 0; e < 4; ++e) { ksum[bj][e] += v0[e]; ksum[bj][4 + e] += v1[e]; }
                    }
                    if (pn >= 16 && pn < 20) { v0 = v0 * MB_QSCALE; v1 = v1 * MB_QSCALE; }
                    v4u o; o.x = pg8::cvt_pk_bf16(v0[0], v0[1]); o.y = pg8::cvt_pk_bf16(v0[2], v0[3]); o.z = pg8::cvt_pk_bf16(v1[0], v1[1]); o.w = pg8::cvt_pk_bf16(v1[2], v1[3]);
                    *(v4u*)(rowp + bj * 128) = o; } }
        }
        if (pn == 20) {
            float* km = (float*)(ws + WS_CTL) + CW_KMEAN;
#pragma unroll
            for (int bj = 0; bj < 2; ++bj)
#pragma unroll
                for (int e = 0; e < 8; ++e) { float s = ksum[bj][e];
#pragma unroll
                    for (int o = 1; o < 16; o <<= 1) s += __shfl_xor(s, o);
                    if (fr == 0) atomicAdd(km + ((size_t)bj * 64 + u.pm) * 128 + colt + e, s * (1.f / 256.f)); }
        }
    }
};
template <bool ACCUM, bool F8OUT = false> struct EpiGate {
    static constexpr bool PERM = true;
    bf16* M; const bf16* gate; unsigned char* M8;
    __device__ __forceinline__ void operator()(const f32x4 (&acc)[2][2][4][2], const pg8::Unit& u, int wr, int wc, int fr, int fq) const {
        const int row0 = u.pm * 256 + wr * 64 + fr, col0 = u.pn * 256 + wc * 32 + 8 * fq;
        v4u gq[2][4], pq[2][4];
#define EG_RO(st, g) ((size_t)(row0 + ((st) >> 1) * 128 + (2 * ((st) & 1) + ((g) >> 1)) * 16) * 1024 + col0 + ((g) & 1) * 128)
#define EG_LOAD(st) do { _Pragma("unroll") for (int _g = 0; _g < 4; ++_g) { gq[(st) & 1][_g] = *(const v4u*)(gate + EG_RO(st, _g)); if (ACCUM) pq[(st) & 1][_g] = *(const v4u*)(M + EG_RO(st, _g)); } } while (0)
#define EG_STORE(st) do { _Pragma("unroll") for (int _g = 0; _g < 4; ++_g) { const int _ai = (st) >> 1, _m = 2 * ((st) & 1) + (_g >> 1), _bj = _g & 1; \
            const f32x4 v0 = acc[_ai][_bj][_m][0], v1 = acc[_ai][_bj][_m][1]; const v4u g = gq[(st) & 1][_g]; \
            float r[8] = {v0[0] * bflo(g.x), v0[1] * bfhi(g.x), v0[2] * bflo(g.y), v0[3] * bfhi(g.y), v1[0] * bflo(g.z), v1[1] * bfhi(g.z), v1[2] * bflo(g.w), v1[3] * bfhi(g.w)}; \
            if (ACCUM) { const v4u p = pq[(st) & 1][_g]; \
                r[0] += bflo(p.x); r[1] += bfhi(p.x); r[2] += bflo(p.y); r[3] += bfhi(p.y); r[4] += bflo(p.z); r[5] += bfhi(p.z); r[6] += bflo(p.w); r[7] += bfhi(p.w); } \
            if (F8OUT) { v2u o8; o8.x = pk4_fp8(4.f * r[0], 4.f * r[1], 4.f * r[2], 4.f * r[3]); o8.y = pk4_fp8(4.f * r[4], 4.f * r[5], 4.f * r[6], 4.f * r[7]); *(v2u*)(M8 + EG_RO(st, _g)) = o8; } \
            else { v4u o; o.x = pg8::cvt_pk_bf16(r[0], r[1]); o.y = pg8::cvt_pk_bf16(r[2], r[3]); o.z = pg8::cvt_pk_bf16(r[4], r[5]); o.w = pg8::cvt_pk_bf16(r[6], r[7]); \
                *(v4u*)(M + EG_RO(st, _g)) = o; } } } while (0)
        EG_LOAD(0); EG_LOAD(1);
        EG_STORE(0); EG_LOAD(2);
        EG_STORE(1); EG_LOAD(3);
        EG_STORE(2); EG_STORE(3);
#undef EG_RO
#undef EG_LOAD
#undef EG_STORE
    }
};

constexpr int GP_WF = 0, GP_QGF = 16384, GP_KDF = 32768, GP_AQF = 49152, GP_UT = 57344, GP_UNIT = 73728;
constexpr int PL_KB = 0, PL_QB = 17408, PL_RH = 34816, PL_X = 71680, PL_XT = 80896, PL_P = 99328, PL_SC = 108544;
__device__ __forceinline__ bf16x8 ldsfrag(const LAS unsigned char* base, int row, int stride, int ks, int q) { return *(const LAS bf16x8*)(base + row * stride + ks * 64 + q * 16); }

constexpr int PL_STG = 109056;
__device__ __forceinline__ void gdn_prep_all(Frame& F, const Args& a) {
    LAS unsigned char* L = F.lds; unsigned char* ws = F.ws;
    const int tid = threadIdx.x, lane = tid & 63, w = F.wave, l15 = lane & 15, q = lane >> 4;
    LAS float* sc_gc = (LAS float*)(L + PL_SC); LAS float* sc_beta = sc_gc + 64;
    const bf16* cin = (const bf16*)(ws + WS_CONVIN);
    float gpre = 0.f, bpre = 0.f;
#define GP_PREFETCH(uu_) do { const int _h = (uu_) & 7, _t0 = 64 * ((uu_) >> 3); \
        if (w == 0) { gpre = ((const float*)(ws + WS_GLOG))[(size_t)(_t0 + lane) * 8 + _h]; bpre = ((const float*)(ws + WS_BETA))[(size_t)(_t0 + lane) * 8 + _h]; } \
        _Pragma("unroll") for (int _i = 0; _i < 5; ++_i) { const int _pc = w + 8 * _i;     \
            if (_pc < 34) { const int _p = _pc / 17, _r0 = 4 * (_pc % 17); int _row = _r0 + (lane >> 4); if (_row > 66) _row = 66; int _t = _t0 - 3 + _row; if (_t < 0) _t = 0; \
                __builtin_amdgcn_global_load_lds((const unsigned*)(cin + (size_t)_t * 3072 + _p * 1024 + _h * 128 + (lane & 15) * 8), (LAS unsigned*)(L + PL_STG + _p * 17408 + _r0 * 256), 16, 0, 0); } } } while (0)
    unsigned uvn[11];
#define UV_PREFETCH(uu_) do { const int _h = (uu_) & 7, _t0 = 64 * ((uu_) >> 3); \
        _Pragma("unroll") for (int _jj = 0; _jj < 11; ++_jj) { int _t = _t0 + 8 * w - 3 + _jj; if (_t < 0) _t = 0; uvn[_jj] = *(const unsigned*)(cin + (size_t)_t * 3072 + 2048 + _h * 128 + 2 * lane); } } while (0)
    { const int u0 = F.bid < 2048 ? F.bid : 2047; UV_PREFETCH(u0); }
    if (F.bid < 2048) GP_PREFETCH(F.bid);
    int hcw = -1;
    constexpr int PL_CW = 144384;
  for (int u = F.bid; u < 2048; u += F.G) {
    const int h = u & 7, n = u >> 3, t0 = 64 * n;
    unsigned char* gp = ws + WS_GDNP + (size_t)(h * 256 + n) * GP_UNIT;
    if (h != hcw) { hcw = h;
        if (w == 0) {
#pragma unroll
            for (int p = 0; p < 3; ++p) { f32x2 tmpc[4];
#pragma unroll
                for (int j = 0; j < 4; ++j) tmpc[j] = *(const f32x2*)(a.in[2] + (size_t)j * 3072 + p * 1024 + h * 128 + 2 * lane);
                __builtin_amdgcn_sched_barrier(0);
#pragma unroll
                for (int j = 0; j < 4; ++j) *(LAS f32x2*)(L + PL_CW + ((p * 4 + j) * 64 + lane) * 8) = tmpc[j];
                __builtin_amdgcn_sched_barrier(0); }
        } }
    if (w == 0) { float g = gpre; const float b = bpre;
#pragma unroll
        for (int o = 1; o < 64; o <<= 1) { const float t = __shfl_up(g, o); if (lane >= o) g += t; }
        sc_gc[lane] = g; sc_beta[lane] = b; if (lane == 63) ((float*)(ws + WS_GL))[h * 256 + n] = expf(g); }
    __syncthreads();
    {
        unsigned uv[11];
#pragma unroll
        for (int jj = 0; jj < 11; ++jj) { const int t = t0 + 8 * w - 3 + jj; uv[jj] = (t >= 0) ? uvn[jj] : 0u; }
#pragma unroll
        for (int p = 0; p < 3; ++p) {
            f32x2 cw[4]; unsigned uu[11];
#pragma unroll
            for (int j = 0; j < 4; ++j) cw[j] = *(const LAS f32x2*)(L + PL_CW + ((p * 4 + j) * 64 + lane) * 8);
#pragma unroll
            for (int jj = 0; jj < 11; ++jj) { const int t = t0 + 8 * w - 3 + jj; uu[jj] = (p == 2) ? uv[jj] : ((t >= 0) ? *(const LAS unsigned*)(L + PL_STG + p * 17408 + (8 * w + jj) * 256 + lane * 4) : 0u); }
            float y0[8], y1[8], ss[8];
#pragma unroll
            for (int i = 0; i < 8; ++i) { float a0 = 0.f, a1 = 0.f;
#pragma unroll
                for (int j = 0; j < 4; ++j) { a0 += cw[j][0] * bflo(uu[i + j]); a1 += cw[j][1] * bfhi(uu[i + j]); }
                y0[i] = siluf_(a0); y1[i] = siluf_(a1); ss[i] = y0[i] * y0[i] + y1[i] * y1[i]; }
            if (p < 2) {
#pragma unroll
                for (int i = 0; i < 8; ++i) ss[i] = wave_sum_dpp(ss[i]);
#pragma unroll
                for (int i = 0; i < 8; ++i) { const float r = __builtin_amdgcn_rsqf(ss[i] + 1e-6f) * (p == 0 ? 0.08838834764831845f : 1.f); y0[i] *= r; y1[i] *= r; }
            }
            if (p < 2) {
#pragma unroll
                for (int i = 0; i < 8; ++i) *(LAS unsigned*)(L + (p == 0 ? PL_QB : PL_KB) + (8 * w + i) * 272 + lane * 4) = pg8::cvt_pk_bf16(y0[i], y1[i]);
            }
            if (p >= 1) {
                float f[8];
#pragma unroll
                for (int i = 0; i < 8; ++i) { const int c = 8 * w + i; f[i] = (p == 1) ? sc_beta[c] * __expf(sc_gc[c]) : sc_beta[c]; }
                v4u r0, r1;
                r0.x = pg8::cvt_pk_bf16(y0[0] * f[0], y0[1] * f[1]); r0.y = pg8::cvt_pk_bf16(y0[2] * f[2], y0[3] * f[3]); r0.z = pg8::cvt_pk_bf16(y0[4] * f[4], y0[5] * f[5]); r0.w = pg8::cvt_pk_bf16(y0[6] * f[6], y0[7] * f[7]);
                r1.x = pg8::cvt_pk_bf16(y1[0] * f[0], y1[1] * f[1]); r1.y = pg8::cvt_pk_bf16(y1[2] * f[2], y1[3] * f[3]); r1.z = pg8::cvt_pk_bf16(y1[4] * f[4], y1[5] * f[5]); r1.w = pg8::cvt_pk_bf16(y1[6] * f[6], y1[7] * f[7]);
                const int rb = (p == 1) ? 128 : 0;
                *(LAS v4u*)(L + PL_RH + (rb + 2 * lane) * 144 + 16 * w) = r0; *(LAS v4u*)(L + PL_RH + (rb + 2 * lane + 1) * 144 + 16 * w) = r1;
            }
        }
    }
    __syncthreads();
    if (u + F.G < 2048) GP_PREFETCH(u + F.G);
    { const int un = u + F.G < 2048 ? u + F.G : 2047; UV_PREFETCH(un); }
    const int mt = w & 3;
    f32x4 Pacc[4];
    {
        bf16x8 af[4];
#pragma unroll
        for (int ks = 0; ks < 4; ++ks) af[ks] = ldsfrag(L + PL_KB, 16 * mt + l15, 272, ks, q);
#pragma unroll
        for (int nt = 0; nt < 4; ++nt) { f32x4 acc = {0.f, 0.f, 0.f, 0.f};
#pragma unroll
            for (int ks = 0; ks < 4; ++ks) acc = mfma16(af[ks], ldsfrag(L + PL_KB, 16 * nt + l15, 272, ks, q), acc);
            const int s = 16 * nt + l15; const float gs = sc_gc[s]; f32x4 val;
#pragma unroll
            for (int r = 0; r < 4; ++r) { const int c = 16 * mt + 4 * q + r; val[r] = (s < c) ? sc_beta[c] * acc[r] * __expf(sc_gc[c] - gs) : 0.f; }
            if (w < 4) {
#pragma unroll
                for (int r = 0; r < 4; ++r) *(LAS bf16*)(L + PL_X + (16 * mt + 4 * q + r) * 144 + s * 2) = (bf16)f2bf(val[r]);
                v2u o; o.x = pg8::cvt_pk_bf16(val[0], val[1]); o.y = pg8::cvt_pk_bf16(val[2], val[3]);
                *(LAS v2u*)(L + PL_XT + s * 144 + (16 * mt + 4 * q) * 2) = o;
            } else {
#pragma unroll
                for (int r = 0; r < 4; ++r) { const int c = 16 * mt + 4 * q + r; Pacc[nt][r] = ((c == s) ? 1.f : 0.f) - val[r]; *(LAS bf16*)(L + PL_P + c * 144 + s * 2) = (bf16)f2bf(Pacc[nt][r]); }
            }
        }
        if (w >= 4) {
            bf16x8 qf[4];
#pragma unroll
            for (int ks = 0; ks < 4; ++ks) qf[ks] = ldsfrag(L + PL_QB, 16 * mt + l15, 272, ks, q);
            const int c = 16 * mt + l15; const float gcq = sc_gc[c];
            f32x4 aq[4];
#pragma unroll
            for (int m2 = 0; m2 < 4; ++m2) { f32x4 acc = {0.f, 0.f, 0.f, 0.f};
#pragma unroll
                for (int ks = 0; ks < 4; ++ks) acc = mfma16(ldsfrag(L + PL_KB, 16 * m2 + l15, 272, ks, q), qf[ks], acc);
#pragma unroll
                for (int r = 0; r < 4; ++r) { const int cp = 16 * m2 + 4 * q + r; aq[m2][r] = (cp <= c) ? acc[r] * __expf(gcq - sc_gc[cp]) : 0.f; } }
#pragma unroll
            for (int k2 = 0; k2 < 2; ++k2) *(bf16x8*)(gp + GP_AQF + (mt * 2 + k2) * 1024 + lane * 16) = pack8(aq[2 * k2], aq[2 * k2 + 1]);
        }
    }
    do { asm volatile("s_waitcnt lgkmcnt(0)" ::: "memory"); __builtin_amdgcn_s_barrier(); asm volatile("" ::: "memory"); } while (0);
#pragma unroll
    for (int lev = 0; lev < 6; ++lev) {
        const int cur = lev & 1;
        const LAS unsigned char* xt = L + PL_XT + cur * 9216;
        if (w < 4) {
            if (lev < 5) {
                bf16x8 af[2]; f32x4 xa[4];
#pragma unroll
                for (int ks = 0; ks < 2; ++ks) af[ks] = ldsfrag(L + PL_X, 16 * mt + l15, 144, ks, q);
#pragma unroll
                for (int nt = 0; nt < 4; ++nt) { xa[nt] = (f32x4){0.f, 0.f, 0.f, 0.f};
#pragma unroll
                    for (int ks = 0; ks < 2; ++ks) xa[nt] = mfma16(af[ks], ldsfrag(xt, 16 * nt + l15, 144, ks, q), xa[nt]); }
                LAS unsigned char* xtn = L + PL_XT + (cur ^ 1) * 9216;
#pragma unroll
                for (int nt = 0; nt < 4; ++nt) { const int s = 16 * nt + l15;
#pragma unroll
                    for (int r = 0; r < 4; ++r) *(LAS bf16*)(L + PL_X + (16 * mt + 4 * q + r) * 144 + s * 2) = (bf16)f2bf(xa[nt][r]);
                    v2u o; o.x = pg8::cvt_pk_bf16(xa[nt][0], xa[nt][1]); o.y = pg8::cvt_pk_bf16(xa[nt][2], xa[nt][3]);
                    *(LAS v2u*)(xtn + s * 144 + (16 * mt + 4 * q) * 2) = o; }
            }
        } else if (lev >= 1) {
            bf16x8 af[2];
#pragma unroll
            for (int ks = 0; ks < 2; ++ks) af[ks] = ldsfrag(L + PL_P, 16 * mt + l15, 144, ks, q);
#pragma unroll
            for (int nt = 0; nt < 4; ++nt)
#pragma unroll
                for (int ks = 0; ks < 2; ++ks) Pacc[nt] = mfma16(af[ks], ldsfrag(xt, 16 * nt + l15, 144, ks, q), Pacc[nt]);
#pragma unroll
            for (int nt = 0; nt < 4; ++nt)
#pragma unroll
                for (int r = 0; r < 4; ++r) *(LAS bf16*)(L + PL_P + (16 * mt + 4 * q + r) * 144 + (16 * nt + l15) * 2) = (bf16)f2bf(Pacc[nt][r]);
        }
        do { asm volatile("s_waitcnt lgkmcnt(0)" ::: "memory"); __builtin_amdgcn_s_barrier(); asm volatile("" ::: "memory"); } while (0);
    }
    __builtin_amdgcn_s_waitcnt(0x0F70);
    if (w < 4) {
#pragma unroll
        for (int i = 0; i < 2; ++i) { const int nt = 2 * w + i; f32x4 uu[4];
            const bf16x8 b0 = ldsfrag(L + PL_RH, 16 * nt + l15, 144, 0, q), b1 = ldsfrag(L + PL_RH, 16 * nt + l15, 144, 1, q);
#pragma unroll
            for (int m2 = 0; m2 < 4; ++m2) { uu[m2] = mfma16(ldsfrag(L + PL_P, 16 * m2 + l15, 144, 0, q), b0, (f32x4){0.f, 0.f, 0.f, 0.f}); uu[m2] = mfma16(ldsfrag(L + PL_P, 16 * m2 + l15, 144, 1, q), b1, uu[m2]); }
            unsigned char* up = gp + GP_UT + (16 * nt + l15) * 128 + q * 32;
            *(bf16x8*)up = pack8(uu[0], uu[1]); *(bf16x8*)(up + 16) = pack8(uu[2], uu[3]); }
    } else {
        const bf16x8 b0 = ldsfrag(L + PL_P, 16 * mt + l15, 144, 0, q), b1 = ldsfrag(L + PL_P, 16 * mt + l15, 144, 1, q);
        f32x4 wa[8];
#pragma unroll
        for (int md = 0; md < 8; ++md) { wa[md] = mfma16(ldsfrag(L + PL_RH, 128 + 16 * md + l15, 144, 0, q), b0, (f32x4){0.f, 0.f, 0.f, 0.f}); wa[md] = mfma16(ldsfrag(L + PL_RH, 128 + 16 * md + l15, 144, 1, q), b1, wa[md]); wa[md] = -wa[md]; }
#pragma unroll
        for (int ks = 0; ks < 4; ++ks) { const f32x4 a0 = wa[2 * ks] * 32.f, a1 = wa[2 * ks + 1] * 32.f; v2u o8; o8.x = pk4_fp8(a0[0], a0[1], a0[2], a0[3]); o8.y = pk4_fp8(a1[0], a1[1], a1[2], a1[3]);
            *(v2u*)(gp + GP_WF + (mt * 4 + ks) * 512 + lane * 8) = o8; }
    }
    {
        const float gl = sc_gc[63];
#pragma unroll
        for (int i = 0; i < 2; ++i) { const int f = 2 * w + i;
            { const int m2 = f >> 2, ks = f & 3, c = 16 * m2 + l15; const float eg = __expf(sc_gc[c]);
              const v2u x0 = *(const LAS v2u*)(L + PL_QB + c * 272 + (32 * ks + 4 * q) * 2), x1 = *(const LAS v2u*)(L + PL_QB + c * 272 + (32 * ks + 16 + 4 * q) * 2);
              const f32x4 v0 = {bflo(x0.x) * eg, bfhi(x0.x) * eg, bflo(x0.y) * eg, bfhi(x0.y) * eg}, v1 = {bflo(x1.x) * eg, bfhi(x1.x) * eg, bflo(x1.y) * eg, bfhi(x1.y) * eg};
              *(bf16x8*)(gp + GP_QGF + f * 1024 + lane * 16) = pack8(v0, v1); }
            { const int md = f >> 1, ks = f & 1, d = 16 * md + l15; f32x4 v0, v1;
#pragma unroll
              for (int r = 0; r < 4; ++r) { const int c0 = 32 * ks + 4 * q + r, c1 = c0 + 16;
                  v0[r] = bf2f(*(const LAS bf16*)(L + PL_KB + c0 * 272 + d * 2)) * __expf(gl - sc_gc[c0]); v1[r] = bf2f(*(const LAS bf16*)(L + PL_KB + c1 * 272 + d * 2)) * __expf(gl - sc_gc[c1]); }
              v2u o8; o8.x = pk4_fp8(64.f * v0[0], 64.f * v0[1], 64.f * v0[2], 64.f * v0[3]); o8.y = pk4_fp8(64.f * v1[0], 64.f * v1[1], 64.f * v1[2], 64.f * v1[3]);
              *(v2u*)(gp + GP_KDF + f * 512 + lane * 8) = o8; }
        }
    }
    do { asm volatile("s_waitcnt lgkmcnt(0)" ::: "memory"); __builtin_amdgcn_s_barrier(); asm volatile("" ::: "memory"); } while (0);
  }
#undef GP_PREFETCH
#undef UV_PREFETCH
}

__device__ __forceinline__ void gdn_scan(Frame& F, const int h) {
    LAS unsigned char* L = F.lds; unsigned char* ws = F.ws;
    const int lane = threadIdx.x & 63, w = F.wave, l15 = lane & 15, q = lane >> 4;
    const unsigned char* gph = ws + WS_GDNP + (size_t)h * 256 * GP_UNIT;
    const float* GLp = (const float*)(ws + WS_GL) + h * 256;
    float* Op = (float*)(ws + WS_O) + h * 128 + 16 * w + l15;
    f32x4 Sf[8];
#pragma unroll
    for (int md = 0; md < 8; ++md) Sf[md] = (f32x4){0.f, 0.f, 0.f, 0.f};
#define SCAN_ISSUE(nn) do { const unsigned char* _s = gph + (size_t)(nn) * GP_UNIT; LAS unsigned char* _d = L + ((nn) & 1) * 57344; \
        _Pragma("unroll") for (int _p = 0; _p < 7; ++_p) __builtin_amdgcn_global_load_lds((const unsigned*)(_s + (w + 8 * _p) * 1024 + lane * 16), (LAS unsigned*)(_d + (w + 8 * _p) * 1024), 16, 0, 0); } while (0)
    SCAN_ISSUE(0);
    for (int n = 0; n < 256; ++n) {
        VM_WAIT(); __syncthreads();
        if (n + 1 < 256) SCAN_ISSUE(n + 1);
        const LAS unsigned char* sl = L + (n & 1) * 57344;
        const unsigned char* up = gph + (size_t)n * GP_UNIT + GP_UT + (16 * w + l15) * 128 + q * 32;
        const v4u u0 = *(const v4u*)up, u1 = *(const v4u*)(up + 16);
        const float gl = GLp[n];
        bf16x8 sb[4];
#pragma unroll
        for (int ks = 0; ks < 4; ++ks) sb[ks] = pack8(Sf[2 * ks], Sf[2 * ks + 1]);
        f32x4 vn[4], oo[4];
        vn[0] = (f32x4){bflo(u0.x), bfhi(u0.x), bflo(u0.y), bfhi(u0.y)}; vn[1] = (f32x4){bflo(u0.z), bfhi(u0.z), bflo(u0.w), bfhi(u0.w)};
        vn[2] = (f32x4){bflo(u1.x), bfhi(u1.x), bflo(u1.y), bfhi(u1.y)}; vn[3] = (f32x4){bflo(u1.z), bfhi(u1.z), bflo(u1.w), bfhi(u1.w)};
#pragma unroll
        for (int m2 = 0; m2 < 4; ++m2) { oo[m2] = (f32x4){0.f, 0.f, 0.f, 0.f};
#pragma unroll
            for (int ks = 0; ks < 4; ++ks) { vn[m2] = mfma16(*(const LAS bf16x8*)(sl + GP_WF + (m2 * 4 + ks) * 1024 + lane * 16), sb[ks], vn[m2]);
                oo[m2] = mfma16(*(const LAS bf16x8*)(sl + GP_QGF + (m2 * 4 + ks) * 1024 + lane * 16), sb[ks], oo[m2]); } }
        const bf16x8 vb0 = pack8(vn[0], vn[1]), vb1 = pack8(vn[2], vn[3]);
#pragma unroll
        for (int m2 = 0; m2 < 4; ++m2) { oo[m2] = mfma16(*(const LAS bf16x8*)(sl + GP_AQF + (m2 * 2) * 1024 + lane * 16), vb0, oo[m2]);
            oo[m2] = mfma16(*(const LAS bf16x8*)(sl + GP_AQF + (m2 * 2 + 1) * 1024 + lane * 16), vb1, oo[m2]); }
#pragma unroll
        for (int md = 0; md < 8; ++md) { Sf[md] = Sf[md] * gl;
            Sf[md] = mfma16(*(const LAS bf16x8*)(sl + GP_KDF + (md * 2) * 1024 + lane * 16), vb0, Sf[md]);
            Sf[md] = mfma16(*(const LAS bf16x8*)(sl + GP_KDF + (md * 2 + 1) * 1024 + lane * 16), vb1, Sf[md]); }
#pragma unroll
        for (int m2 = 0; m2 < 4; ++m2)
#pragma unroll
            for (int r = 0; r < 4; ++r) Op[(size_t)(64 * n + 16 * m2 + 4 * q + r) * 1024] = oo[m2][r];
    }
#undef SCAN_ISSUE
    VM_WAIT(); __syncthreads();
}

__device__ __forceinline__ v4u fp8x8_bf16(const unsigned a, const unsigned b, const float sc) {
    typedef float f32x2_ __attribute__((ext_vector_type(2)));
    const f32x2_ p0 = __builtin_amdgcn_cvt_pk_f32_fp8(a, false), p1 = __builtin_amdgcn_cvt_pk_f32_fp8(a, true), p2 = __builtin_amdgcn_cvt_pk_f32_fp8(b, false), p3 = __builtin_amdgcn_cvt_pk_f32_fp8(b, true);
    v4u o; o.x = pg8::cvt_pk_bf16(p0[0] * sc, p0[1] * sc); o.y = pg8::cvt_pk_bf16(p1[0] * sc, p1[1] * sc); o.z = pg8::cvt_pk_bf16(p2[0] * sc, p2[1] * sc); o.w = pg8::cvt_pk_bf16(p3[0] * sc, p3[1] * sc);
    return o;
}

constexpr int NSCAN = 32, NWARM = 8;
constexpr int SC_SLOT = 36864;
constexpr int SC_WU = 20480, SC_KD = 16384;
__device__ __forceinline__ void gdn_scan2(Frame& F, const int b) {
    LAS unsigned char* L = F.lds; unsigned char* ws = F.ws;
    const int lane = threadIdx.x & 63, w = F.wave, l15 = lane & 15, q = lane >> 4;
    const int h = b & 7, part = b >> 3;
    unsigned char* gph = ws + WS_GDNP + (size_t)h * 256 * GP_UNIT;
    unsigned char* sbp = ws + WS_O + (size_t)h * 256 * 32768;
    constexpr int KDR = 4 * SC_WU, GLT = KDR + 4 * SC_KD;
#define SC_BAR() do { asm volatile("s_waitcnt lgkmcnt(0)" ::: "memory"); __builtin_amdgcn_s_barrier(); asm volatile("" ::: "memory"); } while (0)
    if (threadIdx.x < 256) ((LAS float*)(L + GLT))[threadIdx.x] = ((const float*)(ws + WS_GL))[h * 256 + threadIdx.x];
#define SC_HSTEP(n, RS) do { SC_PUT(RS, (n) + 2); SC_LOAD(RS, (n) + 10); \
            if (w == 7 && lane == 0) __hip_atomic_store(&F.ctl[CW_PROG + 64 * b], (unsigned)((n) + 1), __ATOMIC_RELAXED, __HIP_MEMORY_SCOPE_AGENT); \
            SC_BAR(); } while (0)
#define SC_LOOP() do { \
        SC_LOAD(r0, 0); SC_LOAD(r1, 1); SC_LOAD(r2, 2); SC_LOAD(r3, 3); SC_LOAD(r4, 4); SC_LOAD(r5, 5); SC_LOAD(r6, 6); SC_LOAD(r7, 7); \
        SC_PUT(r0, 0); SC_LOAD(r0, 8); SC_PUT(r1, 1); SC_LOAD(r1, 9);          \
        SC_BAR(); SC_BAR(); \
          \
        _Pragma("unroll 1") for (int n0 = 0; n0 < 256; n0 += 8) { SC_HSTEP(n0, r2); SC_HSTEP(n0 + 1, r3); SC_HSTEP(n0 + 2, r4); SC_HSTEP(n0 + 3, r5); SC_HSTEP(n0 + 4, r6); SC_HSTEP(n0 + 5, r7); SC_HSTEP(n0 + 6, r0); SC_HSTEP(n0 + 7, r1); } } while (0)
    if (w >= 6) {
        const int sok = GP_KDF + (4 * (w - 6)) * 1024 + lane * 16, dok = KDR + (8 * (w - 6) + (lane >> 5)) * 1024 + (lane & 31) * 32;
#define SC_LOAD(R, nn) do { const int _nn = (nn) < 255 ? (nn) : 255; const unsigned char* _u = gph + (size_t)_nn * GP_UNIT + sok; _Pragma("unroll") for (int _i = 0; _i < 4; ++_i) R[_i] = *(const v4u*)(_u + _i * 1024); } while (0)
#define SC_PUT(R, nn) do { LAS unsigned char* _d = L + dok + ((nn) & 3) * SC_KD; _Pragma("unroll") for (int _i = 0; _i < 4; ++_i) { \
            *(LAS v4u*)(_d + _i * 2048) = fp8x8_bf16(R[_i].x, R[_i].y, 1.f / 64.f); *(LAS v4u*)(_d + _i * 2048 + 16) = fp8x8_bf16(R[_i].z, R[_i].w, 1.f / 64.f); } } while (0)
        v4u r0[4], r1[4], r2[4], r3[4], r4[4], r5[4], r6[4], r7[4];
        SC_LOOP();
#undef SC_LOAD
#undef SC_PUT
    } else if (w >= 2) {
        const int lw = w - 2;
        const int sow = GP_WF + (2 * lw) * 1024 + lane * 16, sou = GP_UT + part * 4096 + lw * 1024 + lane * 16;
        const int dww = (4 * lw + (lane >> 5)) * 1024 + (lane & 31) * 32, dwu = 16384 + lw * 1024 + lane * 16;
#define SC_LOAD(R, nn) do { const int _nn = (nn) < 255 ? (nn) : 255; const unsigned char* _u = gph + (size_t)_nn * GP_UNIT; R[0] = *(const v4u*)(_u + sow); R[1] = *(const v4u*)(_u + sow + 1024); R[2] = *(const v4u*)(_u + sou); } while (0)
#define SC_PUT(R, nn) do { LAS unsigned char* _d = L + ((nn) & 3) * SC_WU; _Pragma("unroll") for (int _i = 0; _i < 2; ++_i) { \
            *(LAS v4u*)(_d + dww + _i * 2048) = fp8x8_bf16(R[_i].x, R[_i].y, 1.f / 32.f); *(LAS v4u*)(_d + dww + _i * 2048 + 16) = fp8x8_bf16(R[_i].z, R[_i].w, 1.f / 32.f); } \
            *(LAS v4u*)(_d + dwu) = R[2]; } while (0)
        v4u r0[3], r1[3], r2[3], r3[3], r4[3], r5[3], r6[3], r7[3];
        SC_LOOP();
#undef SC_LOAD
#undef SC_PUT
#undef SC_LOOP
#undef SC_HSTEP
    } else {
        f32x4 Sf[8];
#pragma unroll
        for (int md = 0; md < 8; ++md) Sf[md] = (f32x4){0.f, 0.f, 0.f, 0.f};
        bf16x8 wf[16], kf[16]; v4u u0, u1;
        SC_BAR();
#pragma unroll
        for (int i = 0; i < 16; ++i) wf[i] = *(const LAS bf16x8*)(L + i * 1024 + lane * 16);
        { const LAS unsigned char* up = L + 16384 + (16 * w + l15) * 128 + q * 32; u0 = *(const LAS v4u*)up; u1 = *(const LAS v4u*)(up + 16); }
#pragma unroll
        for (int i = 0; i < 16; ++i) kf[i] = *(const LAS bf16x8*)(L + KDR + i * 1024 + lane * 16);
        SC_BAR();
        const int slice = 2 * part + w;
#pragma unroll 1
        for (int n = 0; n < 256; ++n) {
            f32x4 vn[4];
            vn[0] = (f32x4){bflo(u0.x), bfhi(u0.x), bflo(u0.y), bfhi(u0.y)}; vn[1] = (f32x4){bflo(u0.z), bfhi(u0.z), bflo(u0.w), bfhi(u0.w)};
            vn[2] = (f32x4){bflo(u1.x), bfhi(u1.x), bflo(u1.y), bfhi(u1.y)}; vn[3] = (f32x4){bflo(u1.z), bfhi(u1.z), bflo(u1.w), bfhi(u1.w)};
            const float gl = ((const LAS float*)(L + GLT))[n];
            bf16x8 sb[4];
#pragma unroll
            for (int ks = 0; ks < 4; ++ks) { sb[ks] = pack8(Sf[2 * ks], Sf[2 * ks + 1]);
                *(bf16x8*)(sbp + ((size_t)n * 32 + slice * 4 + ks) * 1024 + lane * 16) = sb[ks]; }
            asm volatile("s_waitcnt lgkmcnt(0)" ::: "memory");
            __builtin_amdgcn_sched_barrier(0);
#pragma unroll
            for (int ks = 0; ks < 4; ++ks)
#pragma unroll
                for (int m2 = 0; m2 < 4; ++m2) vn[m2] = mfma16(wf[m2 * 4 + ks], sb[ks], vn[m2]);
            __builtin_amdgcn_sched_barrier(0);
#pragma unroll
            for (int md = 0; md < 8; ++md) Sf[md] = Sf[md] * gl;
            if (n + 1 < 256) { const LAS unsigned char* wu = L + ((n + 1) & 3) * SC_WU;
#pragma unroll
                for (int i = 0; i < 16; ++i) wf[i] = *(const LAS bf16x8*)(wu + i * 1024 + lane * 16);
                const LAS unsigned char* up = wu + 16384 + (16 * w + l15) * 128 + q * 32; u0 = *(const LAS v4u*)up; u1 = *(const LAS v4u*)(up + 16); }
            __builtin_amdgcn_sched_barrier(0);
            const bf16x8 vb0 = pack8(vn[0], vn[1]), vb1 = pack8(vn[2], vn[3]);
            unsigned char* vbp = gph + (size_t)n * GP_UNIT + GP_UT + slice * 2048 + lane * 16;
            *(bf16x8*)vbp = vb0; *(bf16x8*)(vbp + 1024) = vb1;
#pragma unroll
            for (int md = 0; md < 8; ++md) Sf[md] = mfma16(kf[md * 2], vb0, Sf[md]);
#pragma unroll
            for (int md = 0; md < 8; ++md) Sf[md] = mfma16(kf[md * 2 + 1], vb1, Sf[md]);
            __builtin_amdgcn_sched_barrier(0);
            if (n + 1 < 256) { const LAS unsigned char* kd = L + KDR + ((n + 1) & 3) * SC_KD;
#pragma unroll
                for (int i = 0; i < 16; ++i) kf[i] = *(const LAS bf16x8*)(kd + i * 1024 + lane * 16); }
            SC_BAR();
        }
    }
#undef SC_BAR
    VM_WAIT(); __syncthreads();
}

__device__ __forceinline__ void gdn_scan_warm(Frame& F, const int h) {
    unsigned char* ws = F.ws; const int tid = threadIdx.x;
    const unsigned char* gph = ws + WS_GDNP + (size_t)h * 256 * GP_UNIT;
    LAS unsigned* pw = (LAS unsigned*)(F.lds + 1024);
    unsigned acc = 0u;
    constexpr int WDIST = 14;
    for (int m = 0; m < 256; ++m) {
        if (m >= WDIST) {
            if (tid == 0) { unsigned sp = 0; while (__hip_atomic_load(&F.ctl[CW_PROG + 64 * h], __ATOMIC_RELAXED, __HIP_MEMORY_SCOPE_AGENT) + WDIST < (unsigned)m + 1u) { __builtin_amdgcn_s_sleep(4); if (++sp > (1u << 22)) break; } }
            __syncthreads();
        }
        const unsigned char* u = gph + (size_t)m * GP_UNIT;
#pragma unroll
        for (int i = 0; i < 2; ++i) { const int x = tid + 512 * i, p = x >> 6, o = (x & 63) * 16;
            const unsigned char* src = u + (p < 8 ? GP_WF + p * 1024 : GP_KDF + (p - 8) * 1024) + o;
            const v4u v = *(const v4u*)src; acc ^= v.x ^ v.y ^ v.z ^ v.w; }
    }
    if (acc == 0x12345u) *pw = acc;
    __syncthreads();
}

__device__ __forceinline__ void gdn_ophase(Frame& F, const float* norm_w) {
    unsigned char* ws = F.ws; const int lane = threadIdx.x & 63, w = F.wave, l15 = lane & 15, q = lane >> 4, mt = w & 3, us = w >> 2;
    LAS unsigned char* LB = F.lds + us * 49152;
    LAS unsigned char* tl = F.lds + 98304 + w * 4352;
    float nwv[8];
#pragma unroll
    for (int sl = 0; sl < 8; ++sl) nwv[sl] = norm_w[16 * sl + l15];
    v4u gq[4], gqn[4]; bf16x8 aq[4], aa[2], aqn[4], aan[2]; v4u bsh[12];
#define OP_REQ(u_, GQ, AQ, AA) do { const int _u = (u_) < 2048 ? (u_) : 2047, _h = _u >> 8, _n = _u & 255; \
        const unsigned char* _gp = ws + WS_GDNP + (size_t)_u * GP_UNIT; const unsigned char* _sbp = ws + WS_O + (size_t)_u * 32768; \
        const size_t _gidx = (size_t)(64 * _n + 16 * mt + (lane >> 2)) * 1024 + _h * 128 + (lane & 3) * 32; \
        _Pragma("unroll") for (int _c = 0; _c < 4; ++_c) GQ[_c] = *(const v4u*)((const bf16*)(ws + WS_GG) + _gidx + _c * 8); \
        _Pragma("unroll") for (int _k = 0; _k < 4; ++_k) AQ[_k] = *(const bf16x8*)(_gp + GP_QGF + (mt * 4 + _k) * 1024 + lane * 16); \
        _Pragma("unroll") for (int _k = 0; _k < 2; ++_k) AA[_k] = *(const bf16x8*)(_gp + GP_AQF + (mt * 2 + _k) * 1024 + lane * 16); \
        _Pragma("unroll") for (int _i = 0; _i < 8; ++_i) bsh[_i] = *(const v4u*)(_sbp + (8 * mt + _i) * 1024 + lane * 16); \
        _Pragma("unroll") for (int _i = 0; _i < 4; ++_i) bsh[8 + _i] = *(const v4u*)(_gp + GP_UT + (4 * mt + _i) * 1024 + lane * 16); } while (0)
    int u = 2 * F.bid + us;
    OP_REQ(u, gqn, aqn, aan);
    for (; u < 2048; u += 2 * F.G) {
        const int h = u >> 8, n = u & 255;
        __syncthreads();
#pragma unroll
        for (int i = 0; i < 8; ++i) *(LAS v4u*)(LB + (8 * mt + i) * 1024 + lane * 16) = bsh[i];
#pragma unroll
        for (int i = 0; i < 4; ++i) *(LAS v4u*)(LB + 32768 + (4 * mt + i) * 1024 + lane * 16) = bsh[8 + i];
#pragma unroll
        for (int c = 0; c < 4; ++c) { gq[c] = gqn[c]; aq[c] = aqn[c]; }
        aa[0] = aan[0]; aa[1] = aan[1];
        __syncthreads();
        OP_REQ(u + 2 * F.G, gqn, aqn, aan);
        f32x4 o[8]; float ss[4] = {0.f, 0.f, 0.f, 0.f};
#pragma unroll
        for (int sl = 0; sl < 8; ++sl) { o[sl] = (f32x4){0.f, 0.f, 0.f, 0.f};
#pragma unroll
            for (int ks = 0; ks < 4; ++ks) o[sl] = mfma16(aq[ks], *(const LAS bf16x8*)(LB + (sl * 4 + ks) * 1024 + lane * 16), o[sl]);
#pragma unroll
            for (int k2 = 0; k2 < 2; ++k2) o[sl] = mfma16(aa[k2], *(const LAS bf16x8*)(LB + 32768 + (sl * 2 + k2) * 1024 + lane * 16), o[sl]);
#pragma unroll
            for (int r = 0; r < 4; ++r) ss[r] += o[sl][r] * o[sl][r]; }
#pragma unroll
        for (int r = 0; r < 4; ++r) { float s = ss[r]; s += __shfl_xor(s, 1); s += __shfl_xor(s, 2); s += __shfl_xor(s, 4); s += __shfl_xor(s, 8); ss[r] = 1.f / sqrtf(s * (1.f / 128.f) + 1e-6f); }
#pragma unroll
        for (int sl = 0; sl < 8; ++sl) { const float nw = nwv[sl];
#pragma unroll
            for (int r = 0; r < 4; ++r) *(LAS bf16*)(tl + (4 * q + r) * 272 + (16 * sl + l15) * 2) = (bf16)f2bf(o[sl][r] * ss[r] * nw); }
        LDS_WAIT(); asm volatile("" ::: "memory");
        __builtin_amdgcn_s_waitcnt(0x0F70);
        { const int row = lane >> 2, seg = lane & 3; const size_t idx = (size_t)(64 * n + 16 * mt + row) * 1024 + h * 128 + seg * 32;
          bf16* OG = (bf16*)(ws + WS_OG);
#pragma unroll
          for (int c4 = 0; c4 < 4; ++c4) { const v4u y = *(const LAS v4u*)(tl + row * 272 + seg * 64 + c4 * 16), g = gq[c4];
              v2u d; d.x = pk4_fp8(bflo(y.x) * bflo(g.x), bfhi(y.x) * bfhi(g.x), bflo(y.y) * bflo(g.y), bfhi(y.y) * bfhi(g.y)); d.y = pk4_fp8(bflo(y.z) * bflo(g.z), bfhi(y.z) * bfhi(g.z), bflo(y.w) * bflo(g.w), bfhi(y.w) * bfhi(g.w));
              *(v2u*)((unsigned char*)OG + idx + c4 * 8) = d; } }
        LDS_WAIT(); asm volatile("" ::: "memory");
    }
#undef OP_REQ
    __syncthreads();
}

__device__ __forceinline__ void gdn_post(Frame& F, const float* norm_w) {
    unsigned char* ws = F.ws; const int lane = threadIdx.x & 63;
    const int gw = F.bid * NWAVES + F.wave, NGW = F.G * NWAVES;
    f32x4 nw[4];
#pragma unroll
    for (int j = 0; j < 4; ++j) nw[j] = *(const f32x4*)(norm_w + (lane & 7) * 16 + 4 * j);
    for (int t = gw; t < T; t += NGW) {
        const f32x4* op = (const f32x4*)((const float*)(ws + WS_O) + (size_t)t * 1024 + lane * 16);
        f32x4 o[4]; float ss = 0.f;
#pragma unroll
        for (int j = 0; j < 4; ++j) { o[j] = op[j]; ss += (o[j][0] * o[j][0] + o[j][1] * o[j][1]) + (o[j][2] * o[j][2] + o[j][3] * o[j][3]); }
        ss += __shfl_xor(ss, 1); ss += __shfl_xor(ss, 2); ss += __shfl_xor(ss, 4);
        const float r = 1.f / sqrtf(ss * (1.f / 128.f) + 1e-6f);
        const v4u* gpn = (const v4u*)((const bf16*)(ws + WS_GG) + (size_t)t * 1024 + lane * 16);
        const v4u g0 = gpn[0], g1 = gpn[1];
        const float gg[16] = {bflo(g0.x), bfhi(g0.x), bflo(g0.y), bfhi(g0.y), bflo(g0.z), bfhi(g0.z), bflo(g0.w), bfhi(g0.w), bflo(g1.x), bfhi(g1.x), bflo(g1.y), bfhi(g1.y), bflo(g1.z), bfhi(g1.z), bflo(g1.w), bfhi(g1.w)};
        float y[16];
#pragma unroll
        for (int j = 0; j < 4; ++j)
#pragma unroll
            for (int e = 0; e < 4; ++e) y[4 * j + e] = o[j][e] * r * nw[j][e] * gg[4 * j + e];
        v4u* dp = (v4u*)((bf16*)(ws + WS_OG) + (size_t)t * 1024 + lane * 16);
        v4u d0, d1; d0.x = pk2(y[0], y[1]); d0.y = pk2(y[2], y[3]); d0.z = pk2(y[4], y[5]); d0.w = pk2(y[6], y[7]); d1.x = pk2(y[8], y[9]); d1.y = pk2(y[10], y[11]); d1.z = pk2(y[12], y[13]); d1.w = pk2(y[14], y[15]);
        dp[0] = d0; dp[1] = d1;
    }
}

constexpr int ML_LTOT = 2064384;
__device__ __forceinline__ int moba_listoff(int g, int n) { return g * ML_LTOT + 4 * (n * T - 128 * n * (n + 1)); }
typedef short s16x4 __attribute__((ext_vector_type(4)));

__device__ __forceinline__ void moba_select_unit(Frame& F, const int g, const int b) {
    if (b == 0) return;
    LAS unsigned char* L = F.lds; unsigned char* ws = F.ws;
    const int tid = threadIdx.x, lane = tid & 63, w = F.wave, l15 = lane & 15, q = lane >> 4;
    constexpr int KH = 0, KL = 17408, GS = 34816, SEL = 68096, LC = 80384, LB = 80640;
    const float* km = (const float*)(ws + WS_CTL) + CW_KMEAN + (size_t)g * 64 * 128;
    for (int i = tid; i < 64 * 128; i += 512) { const int n = i >> 7, d = i & 127; const float x = (n < b) ? km[i] : 0.f; const unsigned hi = f2bf(x); const float lo = x - bf2f(hi);
        *(LAS bf16*)(L + KH + n * 272 + d * 2) = (bf16)hi; *(LAS bf16*)(L + KL + n * 272 + d * 2) = (bf16)f2bf(lo); }
    if (tid < 64) *(LAS unsigned*)(L + LC + tid * 4) = 0u;
    __syncthreads();
    const bf16* MQ = (const bf16*)(ws + WS_MQ);
    LAS float* gs = (LAS float*)(L + GS + w * 4160);
    const int nsel = b < 3 ? b : 3;
#define MS_LOADQ(dst, mt_) do { const int _r0 = (mt_) * 16 + l15; const bf16* _qp = MQ + (size_t)(256 * b + (_r0 >> 2)) * 1024 + (4 * g + (_r0 & 3)) * 128 + 8 * q; \
        _Pragma("unroll") for (int _ks = 0; _ks < 4; ++_ks) dst[_ks] = *(const bf16x8*)(_qp + 32 * _ks); } while (0)
    bf16x8 af[4], af1[4], af2[4];
    MS_LOADQ(af, w); MS_LOADQ(af1, w + 8); MS_LOADQ(af2, w + 16);
    for (int mtile = w; mtile < 64; mtile += 8) {
#pragma unroll
        for (int nt = 0; nt < 4; ++nt) { f32x4 acc = {0.f, 0.f, 0.f, 0.f};
#pragma unroll
            for (int ks = 0; ks < 4; ++ks) { acc = mfma16(af[ks], ldsfrag(L + KH, 16 * nt + l15, 272, ks, q), acc); acc = mfma16(af[ks], ldsfrag(L + KL, 16 * nt + l15, 272, ks, q), acc); }
#pragma unroll
            for (int r = 0; r < 4; ++r) gs[(4 * q + r) * 65 + 16 * nt + l15] = acc[r]; }
        LDS_WAIT(); asm volatile("" ::: "memory");
        {
            const int row = lane >> 2, part = lane & 3;
            float v0 = -INFINITY, v1 = -INFINITY, v2 = -INFINITY; int i0 = 0, i1 = 0, i2 = 0;
            const int nlo = part * 16, nhi = (nlo + 16 < b) ? nlo + 16 : b;
            for (int n = nlo; n < nhi; ++n) { const float x = gs[row * 65 + n];
                if (x > v0) { v2 = v1; i2 = i1; v1 = v0; i1 = i0; v0 = x; i0 = n; } else if (x > v1) { v2 = v1; i2 = i1; v1 = x; i1 = n; } else if (x > v2) { v2 = x; i2 = n; } }
#pragma unroll
            for (int o = 1; o < 4; o <<= 1) {
                const float w0 = __shfl_xor(v0, o), w1 = __shfl_xor(v1, o), w2 = __shfl_xor(v2, o); const int j0 = __shfl_xor(i0, o), j1 = __shfl_xor(i1, o), j2 = __shfl_xor(i2, o);
                const bool lower = (lane & o) == 0;
                const float a0 = lower ? v0 : w0, a1 = lower ? v1 : w1, a2 = lower ? v2 : w2, b0 = lower ? w0 : v0, b1 = lower ? w1 : v1, b2 = lower ? w2 : v2;
                const int ia0 = lower ? i0 : j0, ia1 = lower ? i1 : j1, ia2 = lower ? i2 : j2, ib0 = lower ? j0 : i0, ib1 = lower ? j1 : i1, ib2 = lower ? j2 : i2;
                float r0, r1, r2; int k0, k1, k2;
                if (b0 > a0) { r0 = b0; k0 = ib0;
                    if (b1 > a0) { r1 = b1; k1 = ib1; if (b2 > a0) { r2 = b2; k2 = ib2; } else { r2 = a0; k2 = ia0; } }
                    else { r1 = a0; k1 = ia0; if (b1 > a1) { r2 = b1; k2 = ib1; } else { r2 = a1; k2 = ia1; } } }
                else { r0 = a0; k0 = ia0;
                    if (b0 > a1) { r1 = b0; k1 = ib0; if (b1 > a1) { r2 = b1; k2 = ib1; } else { r2 = a1; k2 = ia1; } }
                    else { r1 = a1; k1 = ia1; if (b0 > a2) { r2 = b0; k2 = ib0; } else { r2 = a2; k2 = ia2; } } }
                v0 = r0; v1 = r1; v2 = r2; i0 = k0; i1 = k1; i2 = k2;
            }
            if (part == 0) { const int rr = mtile * 16 + row;
#pragma unroll
                for (int j = 0; j < 3; ++j) if (j < nsel) { const int blk = j == 0 ? i0 : (j == 1 ? i1 : i2);
                    const unsigned lp = __hip_atomic_fetch_add((LAS unsigned*)(L + LC + blk * 4), 1u, __ATOMIC_RELAXED, __HIP_MEMORY_SCOPE_WORKGROUP);
                    *(LAS unsigned short*)(L + SEL + (rr * 3 + j) * 2) = (unsigned short)blk; *(LAS unsigned short*)(L + SEL + 6144 + (rr * 3 + j) * 2) = (unsigned short)lp; } }
        }
        LDS_WAIT(); asm volatile("" ::: "memory");
#pragma unroll
        for (int ks = 0; ks < 4; ++ks) { af[ks] = af1[ks]; af1[ks] = af2[ks]; }
        if (mtile + 24 < 64) MS_LOADQ(af2, mtile + 24);
    }
#undef MS_LOADQ
    __syncthreads();
    if (tid < b) { const unsigned c = *(LAS unsigned*)(L + LC + tid * 4); *(LAS unsigned*)(L + LB + tid * 4) = c ? atomicAdd(&F.ctl[CW_MOBA_CNT + g * 64 + tid], c) : 0u; }
    __syncthreads();
    unsigned* lists = (unsigned*)(ws + WS_LISTS);
    for (int rr = tid; rr < 1024; rr += 512) { const int t = 256 * b + (rr >> 2), hr = rr & 3;
        for (int j = 0; j < nsel; ++j) { const int blk = *(LAS unsigned short*)(L + SEL + (rr * 3 + j) * 2); const unsigned lp = *(LAS unsigned short*)(L + SEL + 6144 + (rr * 3 + j) * 2);
            lists[moba_listoff(g, blk) + *(LAS unsigned*)(L + LB + blk * 4) + lp] = (unsigned)t | ((unsigned)hr << 14) | ((unsigned)j << 16); } }
    __syncthreads();
}

__device__ __forceinline__ void moba_attn_unit(Frame& F, const int g, const int n, const unsigned* list, const int count, const bool own) {
    LAS unsigned char* L = F.lds; unsigned char* ws = F.ws;
    const int tid = threadIdx.x, lane = tid & 63, w = F.wave, l15 = lane & 15, q = lane >> 4;
    constexpr int KS = 0, VS = 73728;
    { const bf16* MK = (const bf16*)(ws + WS_MK) + (size_t)(256 * n) * 256 + g * 128; const bf16* MV = (const bf16*)(ws + WS_MV) + (size_t)(256 * n) * 256 + g * 128;
        v4u kv[8], vv[8];
#pragma unroll
        for (int i = 0; i < 8; ++i) { const int p = tid + 512 * i, row = p >> 4, ch = p & 15; kv[i] = *(const v4u*)(MK + (size_t)row * 256 + ch * 8); vv[i] = *(const v4u*)(MV + (size_t)row * 256 + ch * 8); }
#pragma unroll
        for (int i = 0; i < 8; ++i) { const int p = tid + 512 * i, row = p >> 4, ch = p & 15; *(LAS v4u*)(L + KS + row * 288 + ch * 16) = kv[i]; *(LAS v4u*)(L + VS + row * 288 + ch * 16) = vv[i]; } }
    __syncthreads();
    const bf16* MQ = (const bf16*)(ws + WS_MQ); bf16* PO = (bf16*)(ws + WS_PO); float* LSE = (float*)(ws + WS_LSE);
    const int ntile = (count + 15) >> 4;
#define MB_ENTRY(tl) ({ int _i = (tl) * 16 + l15; if (_i >= count) _i = count - 1; own ? ((unsigned)(256 * n + (_i >> 2)) | ((unsigned)(_i & 3) << 14) | (3u << 16)) : list[_i]; })
#define MB_LOADQ(dst, e) do { const bf16* _qp = MQ + (size_t)((e) & 16383u) * 1024 + (4 * g + (int)(((e) >> 14) & 3u)) * 128 + 8 * q; \
        _Pragma("unroll") for (int _ks = 0; _ks < 4; ++_ks) dst[_ks] = *(const bf16x8*)(_qp + 32 * _ks); } while (0)
    unsigned e_cur = 0u, e_nxt = 0u; bf16x8 qf[4], qn[4];
    if (w < ntile) { e_cur = MB_ENTRY(w); MB_LOADQ(qf, e_cur); }
    if (w + 8 < ntile) e_nxt = MB_ENTRY(w + 8);
    __builtin_amdgcn_s_waitcnt(0x0F70);
    for (int tile = w; tile < ntile; tile += 8) {
        unsigned e_nn = 0u;
        if (tile + 16 < ntile) e_nn = MB_ENTRY(tile + 16);
        if (tile + 8 < ntile) MB_LOADQ(qn, e_nxt);
        const bool live = tile * 16 + l15 < count;
        const int t = (int)(e_cur & 16383u), hr = (int)((e_cur >> 14) & 3u), j = (int)((e_cur >> 16) & 3u), h = 4 * g + hr;
        f32x4 s[16];
        {
            bf16x8 ka[8], kb[8];
#define MB_LDK(dst, g) do { _Pragma("unroll") for (int _i = 0; _i < 8; ++_i) dst[_i] = ldsfrag(L + KS, 16 * (2 * (g) + (_i >> 2)) + l15, 288, _i & 3, q); } while (0)
#define MB_MMK(src, g) do { _Pragma("unroll") for (int _h = 0; _h < 2; ++_h) { _Pragma("unroll") for (int _ks = 0; _ks < 4; ++_ks) s[2 * (g) + _h] = mfma16(src[_h * 4 + _ks], qf[_ks], s[2 * (g) + _h]); } } while (0)
            const int gmax = own ? ((tile >> 2) >> 1) : 7;
#pragma unroll
            for (int kt = 0; kt < 16; ++kt) s[kt] = (f32x4){0.f, 0.f, 0.f, 0.f};
            MB_LDK(ka, 0);
#pragma unroll
            for (int g = 0; g < 8; g += 2) {
                if (g + 1 <= gmax) MB_LDK(kb, g + 1);
                __builtin_amdgcn_sched_barrier(0); if (g <= gmax) MB_MMK(ka, g); __builtin_amdgcn_sched_barrier(0);
                if (g + 2 < 8 && g + 2 <= gmax) MB_LDK(ka, g + 2);
                __builtin_amdgcn_sched_barrier(0); if (g + 1 <= gmax) MB_MMK(kb, g + 1); __builtin_amdgcn_sched_barrier(0);
            }
#undef MB_LDK
#undef MB_MMK
        }
        const int tq = own ? (t - 256 * n) : 255;
        float m = -1e30f;
#pragma unroll
        for (int kt = 0; kt < 16; ++kt)
#pragma unroll
            for (int r = 0; r < 4; ++r) { const int key = 16 * kt + 4 * q + r; const float x = (!own || key <= tq) ? s[kt][r] : -1e30f; s[kt][r] = x; m = fmaxf(m, x); }
        m = fmaxf(m, __shfl_xor(m, 16)); m = fmaxf(m, __shfl_xor(m, 32));
        float l = 0.f;
#pragma unroll
        for (int kt = 0; kt < 16; ++kt)
#pragma unroll
            for (int r = 0; r < 4; ++r) { const float p = __builtin_amdgcn_exp2f(s[kt][r] - m); s[kt][r] = p; l += p; }
        l += __shfl_xor(l, 16); l += __shfl_xor(l, 32);
        f32x4 oa[8];
#pragma unroll
        for (int md = 0; md < 8; ++md) oa[md] = (f32x4){0.f, 0.f, 0.f, 0.f};
        {
            bf16x8 va[4], vb2[4];
            const LAS unsigned char* vbase = L + VS + (4 * q + (l15 >> 2)) * 288 + (l15 & 3) * 8;
#define MB_LDV(dst, x) do { _Pragma("unroll") for (int _m = 0; _m < 4; ++_m) { const int _md = 4 * ((x) & 1) + _m, _k2 = (x) >> 1; \
                const s16x4 _a0 = __builtin_amdgcn_ds_read_tr16_b64_v4i16((LAS s16x4*)(vbase + (32 * _k2) * 288 + _md * 32)), _a1 = __builtin_amdgcn_ds_read_tr16_b64_v4i16((LAS s16x4*)(vbase + (32 * _k2 + 16) * 288 + _md * 32)); \
                dst[_m] = (bf16x8){_a0[0], _a0[1], _a0[2], _a0[3], _a1[0], _a1[1], _a1[2], _a1[3]}; } } while (0)
#define MB_MMV(src, x) do { const bf16x8 _pb = pack8(s[2 * ((x) >> 1)], s[2 * ((x) >> 1) + 1]); _Pragma("unroll") for (int _m = 0; _m < 4; ++_m) oa[4 * ((x) & 1) + _m] = mfma16(src[_m], _pb, oa[4 * ((x) & 1) + _m]); } while (0)
            const int xmax = own ? (2 * (tile >> 3) + 1) : 15;
            MB_LDV(va, 0);
#pragma unroll
            for (int x = 0; x < 16; x += 2) {
                if (x + 1 <= xmax) MB_LDV(vb2, x + 1);
                __builtin_amdgcn_sched_barrier(0); if (x <= xmax) MB_MMV(va, x); __builtin_amdgcn_sched_barrier(0);
                if (x + 2 < 16 && x + 2 <= xmax) MB_LDV(va, x + 2);
                __builtin_amdgcn_sched_barrier(0); if (x + 1 <= xmax) MB_MMV(vb2, x + 1); __builtin_amdgcn_sched_barrier(0);
            }
#undef MB_LDV
#undef MB_MMV
        }
        __builtin_amdgcn_s_waitcnt(0x0F70);
        if (live) { const float inv = 1.f / l; bf16* op = PO + (((size_t)t * 8 + h) * 4 + j) * 128 + 4 * q;
#pragma unroll
            for (int md = 0; md < 8; ++md) { v2u o; o.x = pg8::cvt_pk_bf16(oa[md][0] * inv, oa[md][1] * inv); o.y = pg8::cvt_pk_bf16(oa[md][2] * inv, oa[md][3] * inv); __builtin_nontemporal_store(o, (v2u*)(op + 16 * md)); }
            if (q == 0) __builtin_nontemporal_store((m + __builtin_amdgcn_logf(l)) * 0.6931471805599453f, &LSE[((size_t)t * 8 + h) * 4 + j]); }
        e_cur = e_nxt; e_nxt = e_nn;
#pragma unroll
        for (int ks = 0; ks < 4; ++ks) qf[ks] = qn[ks];
    }
#undef MB_ENTRY
#undef MB_LOADQ
    __syncthreads();
}

__device__ __forceinline__ void moba_own_queue(Frame& F) {
    LAS int* bc = (LAS int*)(F.lds + 148480) + 132; const int tid = threadIdx.x;
    for (;;) {
        if (tid == 0) *bc = (int)atomicAdd(&F.ctl[CW_QHEAD], 1u);
        __syncthreads();
        const int it = *bc;
        __syncthreads();
        if (it >= 128) break;
        moba_attn_unit(F, it & 1, it >> 1, nullptr, 1024, true);
    }
}
__device__ __forceinline__ void moba_attn_queue(Frame& F) {
    LAS unsigned char* L = F.lds; unsigned char* ws = F.ws; const int tid = threadIdx.x;
    LAS int* pre = (LAS int*)(L + 148480); LAS int* bc = pre + 132;
    moba_own_queue(F);
    if (tid < 128) { const int c = (int)__hip_atomic_load(&F.ctl[CW_MOBA_CNT + tid], __ATOMIC_RELAXED, __HIP_MEMORY_SCOPE_AGENT); const int nch = (c + 1023) >> 10; int v = nch;
#pragma unroll
        for (int o = 1; o < 64; o <<= 1) { const int t2 = __shfl_up(v, o); if ((tid & 63) >= o) v += t2; }
        pre[tid] = v - nch; if ((tid & 63) == 63) pre[129 + (tid >> 6)] = v; }
    __syncthreads();
    if (tid >= 64 && tid < 128) pre[tid] += pre[129];
    if (tid == 0) pre[128] = pre[129] + pre[130];
    __syncthreads();
    const int total = pre[128];
    for (;;) {
        if (tid == 0) *bc = (int)atomicAdd(&F.ctl[CW_QHEAD + 1], 1u);
        __syncthreads();
        const int x = *bc;
        __syncthreads();
        if (x >= total) break;
        int idx = 0; while (pre[idx + 1] <= x) ++idx;
        const int g = idx >> 6, n = idx & 63, ch = x - pre[idx]; const int cnt = (int)__hip_atomic_load(&F.ctl[CW_MOBA_CNT + idx], __ATOMIC_RELAXED, __HIP_MEMORY_SCOPE_AGENT);
        const int c0 = ch * 1024, cc = (cnt - c0) < 1024 ? (cnt - c0) : 1024;
        moba_attn_unit(F, g, n, (const unsigned*)(ws + WS_LISTS) + moba_listoff(g, n) + c0, cc, false);
    }
}

__device__ __forceinline__ void moba_combine(Frame& F, const int wg0) {
    unsigned char* ws = F.ws; const int lane = threadIdx.x & 63;
    const int gw = (F.bid - wg0) * NWAVES + F.wave, NGW = (F.G - wg0) * NWAVES;
    const bf16* PO = (const bf16*)(ws + WS_PO); const float* LSE = (const float*)(ws + WS_LSE);
    const int h = lane >> 3;
#define MC_LOAD(t_, L_, A_, C_) do { L_ = __builtin_nontemporal_load((const f32x4*)(LSE + ((size_t)(t_) * 8 + h) * 4)); \
        _Pragma("unroll") for (int _j = 0; _j < 4; ++_j) { const v4u* _pp = (const v4u*)(PO + (((size_t)(t_) * 8 + h) * 4 + _j) * 128 + (lane & 7) * 16); A_[_j] = __builtin_nontemporal_load(_pp); C_[_j] = __builtin_nontemporal_load(_pp + 1); } } while (0)
    f32x4 ls, lsn; v4u pa[4], pc[4], na[4], nc[4];
    int t = gw;
    if (t < T) MC_LOAD(t, ls, pa, pc);
    for (; t < T; t += NGW) {
        const int tn = t + NGW;
        if (tn < T) MC_LOAD(tn, lsn, na, nc);
        const int b = t >> 8, nsel = b < 3 ? b : 3;
        float lj[4] = {nsel > 0 ? ls[0] : -INFINITY, nsel > 1 ? ls[1] : -INFINITY, nsel > 2 ? ls[2] : -INFINITY, ls[3]};
        const float M = fmaxf(fmaxf(lj[0], lj[1]), fmaxf(lj[2], lj[3]));
        float wj[4], ws_ = 0.f;
#pragma unroll
        for (int j = 0; j < 4; ++j) { wj[j] = __expf(lj[j] - M); ws_ += wj[j]; }
        const float inv = 1.f / ws_;
        float acc[16];
#pragma unroll
        for (int e = 0; e < 16; ++e) acc[e] = 0.f;
#pragma unroll
        for (int j = 0; j < 4; ++j) { const bool on = (j == 3) || (j < nsel);
            const v4u a = pa[j], c = pc[j]; const float wv = wj[j] * inv;
#define MC_ACC(i_, x_) acc[i_] += on ? wv * (x_) : 0.f
            MC_ACC(0, bflo(a.x)); MC_ACC(1, bfhi(a.x)); MC_ACC(2, bflo(a.y)); MC_ACC(3, bfhi(a.y)); MC_ACC(4, bflo(a.z)); MC_ACC(5, bfhi(a.z)); MC_ACC(6, bflo(a.w)); MC_ACC(7, bfhi(a.w));
            MC_ACC(8, bflo(c.x)); MC_ACC(9, bfhi(c.x)); MC_ACC(10, bflo(c.y)); MC_ACC(11, bfhi(c.y)); MC_ACC(12, bflo(c.z)); MC_ACC(13, bfhi(c.z)); MC_ACC(14, bflo(c.w)); MC_ACC(15, bfhi(c.w));
#undef MC_ACC
        }
        v4u d8; d8.x = pk4_fp8(16.f * acc[0], 16.f * acc[1], 16.f * acc[2], 16.f * acc[3]); d8.y = pk4_fp8(16.f * acc[4], 16.f * acc[5], 16.f * acc[6], 16.f * acc[7]);
        d8.z = pk4_fp8(16.f * acc[8], 16.f * acc[9], 16.f * acc[10], 16.f * acc[11]); d8.w = pk4_fp8(16.f * acc[12], 16.f * acc[13], 16.f * acc[14], 16.f * acc[15]);
        __builtin_amdgcn_s_waitcnt(0x0F70);
        *(v4u*)(ws + WS_A2 + (size_t)t * 1024 + lane * 16) = d8;
        ls = lsn;
#pragma unroll
        for (int j = 0; j < 4; ++j) { pa[j] = na[j]; pc[j] = nc[j]; }
    }
#undef MC_LOAD
}

constexpr size_t WS_ELIST = 944 * MiB, WS_EDST = 960 * MiB;
constexpr size_t WS_HB8 = 976 * MiB;
__device__ __forceinline__ void moe_route(Frame& F, const float* logits, const float* bias, float* wts, unsigned* cnt, int* elist, int* edst) {
    const int lane = threadIdx.x & 63, tid = threadIdx.x;
    LAS unsigned* lcnt = (LAS unsigned*)F.lds; LAS unsigned* gb = lcnt + 256; LAS unsigned* pk = gb + 256;
    const f32x4 bz = ((const f32x4*)bias)[lane];
    for (int t0 = F.bid * 64; t0 < T; t0 += F.G * 64) {
        if (tid < 256) lcnt[tid] = 0u;
        __syncthreads();
        f32x4 lgs[8];
#pragma unroll
        for (int i = 0; i < 8; ++i) { const f32x4* lp = (const f32x4*)(logits + (size_t)(t0 + 8 * F.wave + i) * 512); lgs[i] = lp[lane] + lp[64 + lane]; }
#pragma unroll 1
        for (int i = 0; i < 8; ++i) {
            const int t = t0 + 8 * F.wave + i;
            f32x4 lg = lgs[0];
#pragma unroll
            for (int k = 1; k < 8; ++k) if (i == k) lg = lgs[k];
            float sc[4], ch[4];
#pragma unroll
            for (int e = 0; e < 4; ++e) { sc[e] = 1.f / (1.f + expf(-lg[e])); ch[e] = sc[e] + bz[e]; }
            float a = fmaxf(ch[0], ch[1]), b = fminf(ch[0], ch[1]);
            { const float a2 = fmaxf(ch[2], ch[3]), b2 = fminf(ch[2], ch[3]); const float na = fmaxf(a, a2); b = fmaxf(fminf(a, a2), fmaxf(b, b2)); a = na; }
#pragma unroll
            for (int o = 1; o < 8; o <<= 1) { const float a2 = __shfl_xor(a, o), b2 = __shfl_xor(b, o); const float na = fmaxf(a, a2); b = fmaxf(fminf(a, a2), fmaxf(b, b2)); a = na; }
            const float gs = a + b; const int g = lane >> 3;
            int rank = 0;
#pragma unroll
            for (int g2 = 0; g2 < 8; ++g2) { const float o = __shfl(gs, g2 * 8); rank += (o > gs || (o == gs && g2 < g)) ? 1 : 0; }
            const bool sel = rank < 4;
            unsigned key[4];
#pragma unroll
            for (int e = 0; e < 4; ++e) { const unsigned bb = __builtin_bit_cast(unsigned, ch[e]); key[e] = sel ? ((bb & 0x80000000u) ? ~bb : (bb | 0x80000000u)) : 0u; }
            unsigned thr = 0u;
            for (int bit = 31; bit >= 0; --bit) { const unsigned cand = thr | (1u << bit); int c = 0;
#pragma unroll
                for (int e = 0; e < 4; ++e) c += __builtin_popcountll(__ballot(key[e] >= cand));
                if (c >= 8) thr = cand;
                if (c == 8) break; }
            int G8 = 0; unsigned long long beq[4]; bool gt[4], eq[4];
#pragma unroll
            for (int e = 0; e < 4; ++e) { gt[e] = key[e] > thr; eq[e] = key[e] == thr; G8 += __builtin_popcountll(__ballot(gt[e])); beq[e] = __ballot(eq[e]); }
            const int need = 8 - G8;
            int tb_ = 0;
#pragma unroll
            for (int e = 0; e < 4; ++e) tb_ += (int)__builtin_amdgcn_mbcnt_hi((unsigned)(beq[e] >> 32), __builtin_amdgcn_mbcnt_lo((unsigned)beq[e], 0u));
            bool pick[4]; int run = tb_;
#pragma unroll
            for (int e = 0; e < 4; ++e) { pick[e] = gt[e] || (eq[e] && run < need); run += eq[e] ? 1 : 0; }
            int sb = 0; float ls = 0.f;
#pragma unroll
            for (int e = 0; e < 4; ++e) { const unsigned long long bp = __ballot(pick[e]); sb += (int)__builtin_amdgcn_mbcnt_hi((unsigned)(bp >> 32), __builtin_amdgcn_mbcnt_lo((unsigned)bp, 0u)); ls += pick[e] ? sc[e] : 0.f; }
            const float ssum = wave_sum(ls);
            int slot = sb;
#pragma unroll
            for (int e = 0; e < 4; ++e) if (pick[e]) { const int ex = 4 * lane + e;
                wts[t * 8 + slot] = sc[e] / (ssum + 1e-20f) * 2.5f;
                const unsigned lp = __hip_atomic_fetch_add(&lcnt[ex], 1u, __ATOMIC_RELAXED, __HIP_MEMORY_SCOPE_WORKGROUP);
                const int pi = ((8 * F.wave + i) * 8 + slot) * 2; pk[pi] = (unsigned)ex | (lp << 8); pk[pi + 1] = (unsigned)(t * 8 + slot); ++slot; }
        }
        __syncthreads();
        if (tid < 256) { const unsigned c = lcnt[tid]; gb[tid] = c ? atomicAdd(&cnt[tid], c) : 0u; }
        __syncthreads();
        { const unsigned x = pk[2 * tid], d = pk[2 * tid + 1]; const unsigned ex = x & 255u, p = gb[ex] + (x >> 8);
          elist[(size_t)ex * T + p] = (int)(d >> 3); edst[(size_t)ex * T + p] = (int)d; }
        __syncthreads();
    }
}
constexpr int MOE_TB_OFF = 148480;
__device__ __forceinline__ void moe_tiles(Frame& F, const unsigned* cnt) {
    LAS int* tb = (LAS int*)(F.lds + MOE_TB_OFF); LAS int* cn = tb + 260;
    if (F.wave == 0) { const int lane = threadIdx.x & 63; int c[4], nt[4], s_ = 0;
#pragma unroll
        for (int e = 0; e < 4; ++e) { c[e] = (int)__hip_atomic_load(&cnt[4 * lane + e], __ATOMIC_RELAXED, __HIP_MEMORY_SCOPE_AGENT); nt[e] = (c[e] + 255) >> 8; s_ += nt[e]; }
        int inc = s_;
#pragma unroll
        for (int o = 1; o < 64; o <<= 1) { const int v = __shfl_up(inc, o); if (lane >= o) inc += v; }
        int ex = inc - s_;
#pragma unroll
        for (int e = 0; e < 4; ++e) { tb[4 * lane + e] = ex; cn[4 * lane + e] = c[e]; ex += nt[e]; }
        if (lane == 63) tb[256] = inc; }
    __syncthreads();
}
__device__ __forceinline__ void final_rows(Frame& F, const bf16* HBp, const bf16* SHY, const unsigned char* YR, const float* wts, const float* g, const float* b, float* out, bool use_moe) {
    const int gw = F.bid * NWAVES + F.wave, NGW = F.G * NWAVES, lane = ((int)(threadIdx.x & 63));
    f32x4 gv[4], bv[4];
#pragma unroll
    for (int j = 0; j < 4; ++j) { gv[j] = ((const f32x4*)g)[lane + 64 * j]; bv[j] = ((const f32x4*)b)[lane + 64 * j]; }
#define FR_LOAD(m_, H_, S_, W_, Y_) do { const int _m = (m_) < T ? (m_) : T - 1; const v2u* _xr = (const v2u*)(HBp + (size_t)_m * D) + lane; \
        _Pragma("unroll") for (int _j = 0; _j < 4; ++_j) H_[_j] = _xr[64 * _j]; \
        if (use_moe) { const v2u* _sr = (const v2u*)(SHY + (size_t)_m * D) + lane; _Pragma("unroll") for (int _j = 0; _j < 4; ++_j) S_[_j] = _sr[64 * _j]; \
            W_ = wts[_m * 8 + (lane & 7)]; \
            _Pragma("unroll") for (int _k = 0; _k < 8; ++_k) { const unsigned* _yr = (const unsigned*)(YR + ((size_t)_m * 8 + _k) * D) + lane; \
                _Pragma("unroll") for (int _j = 0; _j < 4; ++_j) Y_[_k * 4 + _j] = _yr[64 * _j]; } } } while (0)
    v2u hA[4], sA[4], hB[4], sB[4]; float wA = 0.f, wB = 0.f; unsigned yA[32], yB[32];
    if (gw < T) FR_LOAD(gw, hA, sA, wA, yA);
    for (int m = gw; m < T; m += NGW) {
        FR_LOAD(m + NGW, hB, sB, wB, yB);
        f32x4 v[4];
#pragma unroll
        for (int j = 0; j < 4; ++j) { const v2u x = hA[j]; v[j] = (f32x4){bflo(x.x), bfhi(x.x), bflo(x.y), bfhi(x.y)} * DN_ALPHA; }
        if (use_moe) {
#pragma unroll
            for (int j = 0; j < 4; ++j) { const v2u s = sA[j]; v[j][0] += bflo(s.x); v[j][1] += bfhi(s.x); v[j][2] += bflo(s.y); v[j][3] += bfhi(s.y); }
#pragma unroll
            for (int k = 0; k < 8; ++k) { const float w = __shfl(wA, k) * 0.0625f;
#pragma unroll
                for (int j = 0; j < 4; ++j) { const unsigned x = yA[k * 4 + j];
                    v[j][0] += w * __builtin_amdgcn_cvt_f32_fp8(x, 0); v[j][1] += w * __builtin_amdgcn_cvt_f32_fp8(x, 1); v[j][2] += w * __builtin_amdgcn_cvt_f32_fp8(x, 2); v[j][3] += w * __builtin_amdgcn_cvt_f32_fp8(x, 3); } }
        }
        float s = 0.f;
#pragma unroll
        for (int j = 0; j < 4; ++j) s += (v[j][0] + v[j][1]) + (v[j][2] + v[j][3]);
        const float mean = wave_sum(s) * (1.f / D); float s2 = 0.f;
#pragma unroll
        for (int j = 0; j < 4; ++j) { v[j] = v[j] - mean; s2 += (v[j][0] * v[j][0] + v[j][1] * v[j][1]) + (v[j][2] * v[j][2] + v[j][3] * v[j][3]); }
        const float rstd = 1.f / sqrtf(wave_sum(s2) * (1.f / D) + LN_EPS);
        __builtin_amdgcn_s_waitcnt(0x0F70);
        f32x4* o = (f32x4*)(out + (size_t)m * D) + lane;
#pragma unroll
        for (int j = 0; j < 4; ++j) o[64 * j] = v[j] * rstd * gv[j] + bv[j];
#pragma unroll
        for (int j = 0; j < 4; ++j) { hA[j] = hB[j]; sA[j] = sB[j]; }
        wA = wB;
#pragma unroll
        for (int i = 0; i < 32; ++i) yA[i] = yB[i];
    }
#undef FR_LOAD
}

enum Phase { PH_PROLOGUE = 0, PH_INPROJ, PH_PREP, PH_SCAN, PH_POST, PH_PROJ, PH_WOUT, PH_LN1, PH_ROUTER, PH_ROUTE, PH_EXP1, PH_EXP2, PH_FINAL, PH_COUNT };

__global__ void __launch_bounds__(NWAVES * 64, 2) mega_fwd(Args args) {
    extern __shared__ __attribute__((aligned(16))) unsigned char lds_raw[];
    Frame F;
    F.lds = (LAS unsigned char*)lds_raw;
    F.MISC = (volatile LAS unsigned*)(F.lds + MISC_OFF);
    F.wave = __builtin_amdgcn_readfirstlane(threadIdx.x >> 6);
    F.G = gridDim.x; F.bid = blockIdx.x; F.ws = args.ws; F.ctl = (unsigned*)(args.ws + WS_CTL);
    unsigned char* ws = args.ws;
    if (((int)threadIdx.x) < 64) F.MISC[((int)threadIdx.x)] = 0u;
    __syncthreads();
    XcdBarrier bar; bar.bar = F.ctl + CW_BAR; bar.x = 0; bar.st = nullptr; bar.gtot = 0;
    if (!N_LAUNCH_SPLIT) bar = xcd_barrier_post(F.ctl + CW_BAR, F.MISC + 8);
    XcdBarrier bar2; bar2.bar = F.ctl + CW_BAR2; bar2.x = 0; bar2.st = nullptr; bar2.gtot = 0;
    if (!N_LAUNCH_SPLIT && F.bid >= NSCAN + NWARM) { bar2 = xcd_barrier_post(F.ctl + CW_BAR2, F.MISC + 10); bar2.gtot = F.G - (NSCAN + NWARM); }
    const int lo = args.ph_lo, hi = args.ph_hi;
#define IN(k) (lo <= (k) && (k) < hi)
#define SEAM(k) do { if (IN(k) && IN((k) + 1)) xcd_barrier(bar); } while (0)

    if (IN(PH_PROLOGUE)) { p0_prologue(F, args, false, 0); }
    SEAM(PH_PROLOGUE);

#if STAGE >= 3
    if (IN(PH_INPROJ)) {
        constexpr int NGEMM = 153;
        if (F.bid < NGEMM) {
            pg8::DenseOrder S; S.init(T, NIN, D / 2, NGEMM, F.bid, (const bf16*)(ws + WS_WIN));
            EpiInProj E{ws, args.in[3], args.in[4]};
            pg8::gemm_phase<EpiInProj, pg8::DenseOrder, false, 5>(F.lds, ws + WS_XB, nullptr, D / 2, S, E);
        }
        expert_convert_queue(F, args);
    }
    SEAM(PH_INPROJ);
    if (IN(PH_PREP)) {
        gdn_prep_all(F, args);
    }
    SEAM(PH_PREP);
    if (IN(PH_SCAN)) {
        if (F.bid < NSCAN) gdn_scan2(F, F.bid);
        else if (F.bid < NSCAN + NWARM) gdn_scan_warm(F, F.bid - NSCAN);
#if STAGE >= 4
        else {
            {
                const int su = F.bid - (NSCAN + NWARM);
                if (su < 126 && F.G - (NSCAN + NWARM) >= 126) moba_select_unit(F, su & 1, 63 - (su >> 1));
                else if (F.G - (NSCAN + NWARM) >= 126) moba_own_queue(F);
                else for (int u = su; u < 128; u += F.G - (NSCAN + NWARM)) moba_select_unit(F, u & 1, 63 - (u >> 1));
            }
            xcd_barrier(bar2);
            moba_attn_queue(F);
            xcd_barrier(bar2);
            moba_combine(F, NSCAN + NWARM);
        }
#endif
    }
    SEAM(PH_SCAN);
    if (IN(PH_POST)) { gdn_ophase(F, args.in[5]); }
    SEAM(PH_POST);
    if (IN(PH_PROJ)) {
#if STAGE >= 4
        {
            pg8::DenseOrder S2; S2.init(T, D, D / 2, F.G, F.bid, (const bf16*)(ws + WS_WMP));
            EpiGate<false> E2{(bf16*)(ws + WS_MBUF), (const bf16*)(ws + WS_SGM), nullptr};
            pg8::gemm_phase<EpiGate<false>, pg8::DenseOrder, false, 6, 4>(F.lds, ws + WS_A2, nullptr, D / 2, S2, E2);
        }
#endif
        pg8::DenseOrder S; S.init(T, D, D / 2, F.G, F.bid, (const bf16*)(ws + WS_WGP));
#if STAGE >= 4
        EpiGate<true, true> E{(bf16*)(ws + WS_MBUF), (const bf16*)(ws + WS_SGG), ws + WS_OG + 16 * MiB};
        pg8::gemm_phase<EpiGate<true, true>, pg8::DenseOrder, false, 6, 0>(F.lds, ws + WS_OG, nullptr, D / 2, S, E);
#else
        EpiGate<false, true> E{(bf16*)(ws + WS_MBUF), (const bf16*)(ws + WS_SGG), ws + WS_OG + 16 * MiB};
        pg8::gemm_phase<EpiGate<false, true>, pg8::DenseOrder, false, 6, 0>(F.lds, ws + WS_OG, nullptr, D / 2, S, E);
#endif
    }
    SEAM(PH_PROJ);
    if (IN(PH_WOUT)) {
        pg8::DenseOrder S; S.init(T, D, D / 2, F.G, F.bid, (const bf16*)(ws + WS_WOUT));
        EpiBf16Res E{(bf16*)(ws + WS_HB), 1024, args.in[0], DN_ALPHA};
        pg8::gemm_phase<EpiBf16Res, pg8::DenseOrder, false, 6, 2>(F.lds, ws + WS_OG + 16 * MiB, nullptr, D / 2, S, E);
    }
#else
    SEAM(PH_INPROJ); SEAM(PH_PREP); SEAM(PH_SCAN); SEAM(PH_POST); SEAM(PH_PROJ);
    if (IN(PH_WOUT)) {
        const f32x4* x4 = (const f32x4*)args.in[0]; v2u* p4 = (v2u*)(ws + WS_HB); const size_t n4 = (size_t)T * D / 4;
        for (size_t i = (size_t)F.bid * 512 + threadIdx.x; i < n4; i += (size_t)F.G * 512) { const f32x4 x = x4[i] * DN_ALPHA; v2u o; o.x = pk2(x[0], x[1]); o.y = pk2(x[2], x[3]); p4[i] = o; }
    }
#endif
    SEAM(PH_WOUT);
    if (IN(PH_LN1)) { ln_rows(F, (bf16*)(ws + WS_HB), ws + WS_HB8, args.in[9], args.in[10]);
        if (F.bid == 0 && threadIdx.x < 64) ((v4u*)(ws + WS_HB8 + (size_t)T * D))[threadIdx.x] = (v4u){0u, 0u, 0u, 0u}; }
    SEAM(PH_LN1);
#if STAGE >= 2
    if (IN(PH_ROUTER)) {
        { pg8::SplitK2Order S; S.nM = T / 256; S.G = F.G; S.c = F.bid; S.Bt = (const char*)(ws + WS_ROUTER); S.khalfB = 1024;
          EpiF32Res E{(float*)(ws + WS_LOGITS2), 512, nullptr, 0.f};
          pg8::gemm_phase<EpiF32Res, pg8::SplitK2Order, false>(F.lds, (const bf16*)(ws + WS_HB), nullptr, D / 2, S, E, 2048u); }
        { pg8::DenseOrder S; S.init(T, 512, D / 2, F.G, (F.bid + 128) % F.G, (const bf16*)(ws + WS_SHGU));
          EpiSwiGLU E{(bf16*)(ws + WS_HS)};
          pg8::gemm_phase<EpiSwiGLU, pg8::DenseOrder, false, 5>(F.lds, ws + WS_HB8, nullptr, D / 2, S, E); }
    }
    SEAM(PH_ROUTER);
    if (IN(PH_ROUTE)) { moe_route(F, (const float*)(ws + WS_LOGITS2), args.in[12], (float*)(ws + WS_WTS), F.ctl + CW_MOE_CNT, (int*)(ws + WS_ELIST), (int*)(ws + WS_EDST)); }
    SEAM(PH_ROUTE);
    if (IN(PH_EXP1)) {
        moe_tiles(F, F.ctl + CW_MOE_CNT);
        { pg8::GroupOrder<2> S; S.G = F.G; S.c = F.bid; S.tb = (const LAS int*)(F.lds + MOE_TB_OFF); S.cn = S.tb + 260; S.W = (const char*)(ws + WS_EXPGU); S.estride = (size_t)512 * 1024; S.tstepB = (size_t)256 * 1024;
          EpiSwiGLU8 E{ws + WS_HEXP};
          pg8::gemm_phase<EpiSwiGLU8, pg8::GroupOrder<2>, true, 5>(F.lds, ws + WS_HB8, (const int*)(ws + WS_ELIST), D / 2, S, E); }
        { pg8::DenseOrder S; S.init(T, 1024, 256, F.G, F.bid, (const bf16*)(ws + WS_SHD));
          EpiBf16Plain E{(bf16*)(ws + WS_SHY), 1024};
          pg8::gemm_phase<EpiBf16Plain, pg8::DenseOrder, false>(F.lds, (const bf16*)(ws + WS_HS), nullptr, 256, S, E); }
    }
    SEAM(PH_EXP1);
    if (IN(PH_EXP2)) {
        moe_tiles(F, F.ctl + CW_MOE_CNT);
        pg8::GroupOrder<4> S; S.G = F.G; S.c = F.bid; S.tb = (const LAS int*)(F.lds + MOE_TB_OFF); S.cn = S.tb + 260; S.W = (const char*)(ws + WS_EXPD); S.estride = (size_t)1024 * 256; S.tstepB = (size_t)256 * 256;
        EpiScatter8 E{ws + WS_YR, (const int*)(ws + WS_EDST)};
        pg8::gemm_phase<EpiScatter8, pg8::GroupOrder<4>, false, 5, 2>(F.lds, ws + WS_HEXP, nullptr, 128 | (args.ph_lo >> 30), S, E);
    }
    SEAM(PH_EXP2);
#else
    SEAM(PH_ROUTER); SEAM(PH_ROUTE); SEAM(PH_EXP1); SEAM(PH_EXP2);
#endif
    if (IN(PH_FINAL)) {
        final_rows(F, (const bf16*)(ws + WS_HB), (const bf16*)(ws + WS_SHY), ws + WS_YR, (const float*)(ws + WS_WTS), args.in[19], args.in[20], args.out, STAGE >= 2);
    }
#undef IN
#undef SEAM
}

extern "C" void kernel_launch(void* const* d_in, const int* in_sizes, int n_in, void* d_out, int out_size, void* d_ws, size_t ws_size, hipStream_t stream) {
    static int grid = 0;
    if (grid == 0) {
        if (n_in != 21 || out_size != T * D || ws_size < WS_END) { fprintf(stderr, "kernel_launch: unexpected shapes (n_in %d out %d ws %zu)\n", n_in, out_size, ws_size); grid = -1; return; }
        int dev = 0, cus = 0, per_cu = 0;
        if (hipGetDevice(&dev) != hipSuccess || hipDeviceGetAttribute(&cus, hipDeviceAttributeMultiprocessorCount, dev) != hipSuccess) { grid = -1; return; }
        if (hipFuncSetAttribute((const void*)mega_fwd, hipFuncAttributeMaxDynamicSharedMemorySize, LDS_BYTES) != hipSuccess) { fprintf(stderr, "kernel_launch: hipFuncSetAttribute failed\n"); grid = -1; return; }
        if (hipOccupancyMaxActiveBlocksPerMultiprocessor(&per_cu, (const void*)mega_fwd, NWAVES * 64, LDS_BYTES) != hipSuccess || per_cu < 1) { fprintf(stderr, "kernel_launch: occupancy query says %d\n", per_cu); }
        (void)hipGetLastError();
        grid = cus;
    }
    if (grid < 0) return;
    (void)hipMemsetAsync((char*)d_ws + WS_CTL, 0, CTL_ZERO_BYTES, stream);
    Args a{};
    for (int i = 0; i < 21; ++i) a.in[i] = (const float*)d_in[i];
    a.out = (float*)d_out; a.ws = (unsigned char*)d_ws;
    for (int i = 0; i < 16; ++i) a.rope_inv[i] = powf(500000.0f, -(float)i / 16.0f);
#if N_LAUNCH_SPLIT
    for (int p = 0; p < PH_COUNT; ++p) { a.ph_lo = p; a.ph_hi = p + 1; hipLaunchKernelGGL(mega_fwd, dim3(grid), dim3(NWAVES * 64), LDS_BYTES, stream, a); }
#else
    a.ph_lo = 0; a.ph_hi = PH_COUNT;
    hipLaunchKernelGGL(mega_fwd, dim3(grid), dim3(NWAVES * 64), LDS_BYTES, stream, a);
#endif
}
```

```cpp
#include <hip/hip_runtime.h>
#include <cstdio>
#include <cstdint>
#include <cmath>

#ifndef STAGE
#define STAGE 4
#endif
#ifndef N_LAUNCH_SPLIT
#define N_LAUNCH_SPLIT 0
#endif

#define GAS __attribute__((address_space(1)))
#define LAS __attribute__((address_space(3)))
typedef unsigned short bf16;
typedef unsigned v4u __attribute__((ext_vector_type(4)));
typedef unsigned v2u __attribute__((ext_vector_type(2)));
typedef float f32x4 __attribute__((ext_vector_type(4)));
typedef float f32x2 __attribute__((ext_vector_type(2)));
typedef short bf16x8 __attribute__((ext_vector_type(8)));
typedef short bf16x4 __attribute__((ext_vector_type(4)));
#define LDS_WAIT() asm volatile("s_waitcnt lgkmcnt(0)" ::: "memory")
#define VM_WAIT() asm volatile("s_waitcnt vmcnt(0)" ::: "memory")

__device__ __forceinline__ unsigned f2bf(float f) { unsigned u = __builtin_bit_cast(unsigned, f); return (u + 0x7fffu + ((u >> 16) & 1u)) >> 16; }
__device__ __forceinline__ unsigned pk2(float lo, float hi) { return f2bf(lo) | (f2bf(hi) << 16); }
__device__ __forceinline__ float bf2f(unsigned b) { return __builtin_bit_cast(float, b << 16); }
__device__ __forceinline__ float bflo(unsigned w) { return __builtin_bit_cast(float, w << 16); }
__device__ __forceinline__ float bfhi(unsigned w) { return __builtin_bit_cast(float, w & 0xffff0000u); }
__device__ __forceinline__ unsigned pk4_fp8(float a, float b, float c, float d) { unsigned w = 0u; w = __builtin_amdgcn_cvt_pk_fp8_f32(a, b, w, false); w = __builtin_amdgcn_cvt_pk_fp8_f32(c, d, w, true); return w; }
__device__ __forceinline__ float sigmoidf_(float x) { return __builtin_amdgcn_rcpf(1.f + __builtin_amdgcn_exp2f(-1.4426950408889634f * x)); }
__device__ __forceinline__ float siluf_(float x) { return x * __builtin_amdgcn_rcpf(1.f + __builtin_amdgcn_exp2f(-1.4426950408889634f * x)); }
#define DPP_STEP(v, ctrl, rmask) ((v) + __builtin_bit_cast(float, __builtin_amdgcn_update_dpp(0, __builtin_bit_cast(int, (v)), (ctrl), (rmask), 0xf, false)))
__device__ __forceinline__ float wave_sum_dpp(float v) {
    v = DPP_STEP(v, 0x111, 0xf); v = DPP_STEP(v, 0x112, 0xf); v = DPP_STEP(v, 0x114, 0xf); v = DPP_STEP(v, 0x118, 0xf);
    v = DPP_STEP(v, 0x142, 0xa);
    v = DPP_STEP(v, 0x143, 0xc);
    return __builtin_bit_cast(float, __builtin_amdgcn_readlane(__builtin_bit_cast(int, v), 63));
}

__device__ __forceinline__ float wave_sum(float v) { return wave_sum_dpp(v); }

constexpr int T = 16384, D = 1024;
constexpr int NIN = 7936;
constexpr int NEXP = 256, TOPK = 8, EDIM = 256;
constexpr int RMAX = T * TOPK + NEXP * 256;
constexpr float LN_EPS = 1e-5f;
constexpr float DN_ALPHA = 1.189207115002721f;

constexpr size_t MiB = 1u << 20;
constexpr size_t WS_CTL = 0, CTL_ZERO_BYTES = 1 * MiB;
constexpr size_t WS_ROPE = 1 * MiB;
constexpr size_t WS_GL = 3 * MiB;
constexpr size_t WS_EIDX = 4 * MiB;
constexpr size_t WS_WTS = 4 * MiB + 512 * 1024;
constexpr size_t WS_ROWTOK = 5 * MiB;
constexpr size_t WS_ROWDST = 6 * MiB;
constexpr size_t WS_TILEE = 7 * MiB;
constexpr size_t WS_WIN = 8 * MiB;
constexpr size_t WS_WGP = 24 * MiB, WS_WMP = 26 * MiB, WS_WOUT = 28 * MiB;
constexpr size_t WS_ROUTER = 30 * MiB;
constexpr size_t WS_SHGU = 30 * MiB + 512 * 1024;
constexpr size_t WS_SHD = 31 * MiB + 512 * 1024;
constexpr size_t WS_EXPGU = 32 * MiB;
constexpr size_t WS_EXPD = 288 * MiB;
constexpr size_t WS_XB = 416 * MiB;
constexpr size_t WS_CONVIN = 448 * MiB;
constexpr size_t WS_PO = 416 * MiB;
constexpr size_t WS_GG = 544 * MiB, WS_MQ = 576 * MiB, WS_MK = 608 * MiB, WS_MV = 616 * MiB, WS_SGG = 624 * MiB, WS_SGM = 656 * MiB;
constexpr size_t WS_BETA = 688 * MiB, WS_GLOG = 688 * MiB + 512 * 1024;
constexpr size_t WS_GDNP = 690 * MiB;
constexpr size_t WS_O = 834 * MiB;
constexpr size_t WS_LISTS = 898 * MiB, WS_LSE = 914 * MiB, WS_OG = 916 * MiB, WS_A2 = 948 * MiB, WS_MBUF = 980 * MiB;
constexpr size_t WS_HF = 690 * MiB;
constexpr size_t WS_HB = 754 * MiB;
constexpr size_t WS_LOGITS = 787 * MiB;
constexpr size_t WS_LOGITS2 = 544 * MiB;
constexpr size_t WS_HS = 808 * MiB;
constexpr size_t WS_SHY = 816 * MiB;
constexpr size_t WS_HEXP = 848 * MiB;
constexpr size_t WS_YR = 416 * MiB;
constexpr size_t WS_END = 1024 * MiB;
constexpr int CW_BAR = 4096;
constexpr int CW_MOBA_CNT = 8192, CW_QHEAD = 8448, CW_MOE_CNT = 8704, CW_MOE_FILL = 8960;
constexpr int CW_CONVQ = 9300;
constexpr int CW_BAR2 = 40960;
constexpr int CW_PROG = 32768;
constexpr int CW_KMEAN = 16384;

constexpr int LDS_BYTES = 155648;
constexpr int MISC_OFF = 153600;
constexpr int NWAVES = 8;

#define XB_TMO      128
#define XB_XCNT(j)  (256  + 64 * (j))
#define XB_XSUB(j)  (1280 + 64 * (j))
#define XB_XGEN(j)  (2304 + 64 * (j))
#define XB_TOP      3328
#define XB_TOPGEN   3392
#define XCD_BAR_WORDS 3456
#define XB_SPIN_CAP (1u << 18)
__device__ __forceinline__ unsigned xb_ld(unsigned* p)              { return __hip_atomic_load(p, __ATOMIC_RELAXED, __HIP_MEMORY_SCOPE_AGENT); }
__device__ __forceinline__ unsigned xb_add(unsigned* p, unsigned v) { return __hip_atomic_fetch_add(p, v, __ATOMIC_RELAXED, __HIP_MEMORY_SCOPE_AGENT); }
__device__ __forceinline__ unsigned xb_xcc_id() { return (unsigned)__builtin_amdgcn_s_getreg((3 << 11) | 20) & 0xFu; }
#define XB_SPIN(cond, bar) do { unsigned _sp = 0; while (cond) { __builtin_amdgcn_s_sleep(1); \
    if ((++_sp & 255u) == 0u) { if (xb_ld(&(bar)[XB_TMO])) break; if (_sp > XB_SPIN_CAP) { atomicAdd(&(bar)[XB_TMO], 1u); break; } } } } while (0)
struct XcdBarrier { unsigned* bar; unsigned x; volatile LAS unsigned* st; unsigned gtot; };
__device__ __forceinline__ XcdBarrier xcd_barrier_post(unsigned* bar, volatile LAS unsigned* st) {
    XcdBarrier b; b.bar = bar; b.x = xb_xcc_id(); b.st = st; b.gtot = gridDim.x * gridDim.y * gridDim.z;
    if (threadIdx.x == 0) (void)xb_add(&bar[XB_XCNT(b.x)], 1u);
    return b;
}
__device__ __forceinline__ void xcd_barrier_complete(unsigned* bar, unsigned x, unsigned& nloc, unsigned& nx, const unsigned G) {
    unsigned sum, cnt, mine, sp = 0u;
    for (;;) {
        sum = 0u; cnt = 0u; mine = 0u;
#pragma unroll
        for (unsigned j = 0; j < 16; ++j) { const unsigned c = xb_ld(&bar[XB_XCNT(j)]); sum += c; cnt += (c > 0u) ? 1u : 0u; mine = (j == x) ? c : mine; }
        if (sum == G) break;
        __builtin_amdgcn_s_sleep(1);
        if ((++sp & 255u) == 0u) { if (xb_ld(&bar[XB_TMO])) break; if (sp > XB_SPIN_CAP) { atomicAdd(&bar[XB_TMO], 1u); break; } }
    }
    nloc = mine > 0u ? mine : 1u; nx = cnt > 0u ? cnt : 1u;
}
__device__ __forceinline__ void xcd_barrier(const XcdBarrier& b) {
    asm volatile("s_waitcnt vmcnt(0)" ::: "memory");
    __syncthreads();
    if (threadIdx.x == 0) {
        unsigned* bar = b.bar;
        __builtin_amdgcn_s_waitcnt(0);
        unsigned nloc = b.st[0], nx = b.st[1];
        if (nloc == 0u) { xcd_barrier_complete(bar, b.x, nloc, nx, b.gtot); b.st[0] = nloc; b.st[1] = nx; }
        const unsigned old = xb_add(&bar[XB_XSUB(b.x)], 1u);
        const unsigned gen = old / nloc;
        if (old + 1u == (gen + 1u) * nloc) {
            __builtin_amdgcn_fence(__ATOMIC_RELEASE, "agent");
            asm volatile("s_waitcnt vmcnt(0)" ::: "memory");
            const unsigned og = xb_add(&bar[XB_TOP], 1u);
            const unsigned tg = og / nx;
            if (og + 1u == (tg + 1u) * nx) xb_add(&bar[XB_TOPGEN], 1u);
            else XB_SPIN(xb_ld(&bar[XB_TOPGEN]) == tg, bar);
            __builtin_amdgcn_fence(__ATOMIC_ACQUIRE, "agent");
            xb_add(&bar[XB_XGEN(b.x)], 1u);
            asm volatile("s_waitcnt vmcnt(0)" ::: "memory");
        } else {
            XB_SPIN(xb_ld(&bar[XB_XGEN(b.x)]) == gen, bar);
            __builtin_amdgcn_fence(__ATOMIC_ACQUIRE, "agent");
            asm volatile("s_waitcnt vmcnt(0)" ::: "memory");
        }
    }
    __syncthreads();
}

namespace pg8 {
typedef int v4i __attribute__((ext_vector_type(4)));
typedef int v8i __attribute__((ext_vector_type(8)));
constexpr int BM = 256, BK = 64, HALF = 128, HTB = HALF * BK * 2, STAGE_BYTES = 8 * HTB, NXCD = 8, WGM = 8;
__host__ __device__ __forceinline__ int lds_byte(int r, int c) { const int st = (r >> 4) * 2 + (c >> 5), rr = r & 15, cc = c & 31, ob = rr * 64 + cc * 2; return st * 1024 + (ob ^ (((ob >> 9) & 1) << 5)); }
__host__ __device__ __forceinline__ void stage_rc(int b, int& R, int& C) { const int st = b / 1024, sb = b % 1024, swz = sb ^ (((sb >> 9) & 1) << 5); R = (st >> 1) * 16 + swz / 64; C = (st & 1) * 32 + (swz % 64) / 2; }
__host__ __device__ __forceinline__ int perm32(int rho) { const int n = rho >> 4, i = rho & 15; return 8 * (i >> 2) + 4 * n + (i & 3); }

struct Unit { int pm, pn, arow0, aux, gbase, gcnt, acolb; const char* b; };

struct DenseOrder {
    int nM, nN, nwg, G, c; const char* Bt; size_t tstepB;
    __device__ void init(int M, int N, int K, int G_, int c_, const bf16* Bt_) { nM = M / BM; nN = N / BM; nwg = nM * nN; G = G_; c = c_; Bt = (const char*)Bt_; tstepB = (size_t)BM * K * 2; }
    __device__ bool next(int i, Unit& u) const {
        int wgid;
        if (G % NXCD == 0) { const int L = i * G + c; if (L >= nwg) return false;
            const int q = nwg / NXCD, r = nwg % NXCD, xcd = L % NXCD, off = L / NXCD; wgid = (xcd < r ? xcd * (q + 1) : r * (q + 1) + (xcd - r) * q) + off; }
        else {
            const int R = (nwg + G - 1) / G, x = c % NXCD, slot = c / NXCD, gq = G / NXCD, gr = G % NXCD, nx = gq + (x < gr ? 1 : 0), pre = x * gq + (x < gr ? x : gr);
            if (i >= R) return false;
            wgid = R * pre + i * nx + slot; if (wgid >= nwg) return false; }
        const int nig = WGM * nN, gid = wgid / nig, fm = gid * WGM, gsz = (nM - fm) < WGM ? (nM - fm) : WGM;
        u.pm = fm + ((wgid % nig) % gsz); u.pn = (wgid % nig) / gsz; u.arow0 = u.pm * BM; u.aux = 0; u.gbase = 0; u.gcnt = 0; u.acolb = 0; u.b = Bt + (size_t)u.pn * tstepB; return true;
    }
};
template <int NPN> struct GroupOrder {
    int G, c; const LAS int* tb; const LAS int* cn; const char* W; size_t estride, tstepB;
    __device__ bool next(int i, Unit& u) const {
        const int cc = (G % NXCD == 0) ? (c % NXCD) * (G / NXCD) + c / NXCD : c;
        const long L = (long)i * G + cc; if (L >= (long)tb[256] * NPN) return false;
        const int tile = (int)(L / NPN), pn = (int)(L % NPN);
        int e = 0;
#pragma unroll
        for (int s2 = 128; s2 >= 1; s2 >>= 1) if (tb[e + s2] <= tile) e += s2;
        const int j = tile - tb[e];
        u.pm = tile; u.pn = pn; u.arow0 = tile * BM; u.aux = e; u.gbase = e * 16384 + j * BM; u.gcnt = cn[e] - j * BM; u.acolb = 0; u.b = W + (size_t)e * estride + (size_t)pn * tstepB; return true;
    }
};

struct SplitK2Order {
    static constexpr bool HALF_TILES = false;
    int nM, G, c; const char* Bt;
    int khalfB;
    __device__ bool next(int i, Unit& u) const {
        const int L = i * G + c; if (L >= 2 * nM) return false;
        u.pm = L >> 1; u.pn = L & 1; u.arow0 = u.pm * BM; u.aux = 0; u.gbase = 0; u.gcnt = 0; u.acolb = (L & 1) * khalfB; u.b = Bt + (size_t)(L & 1) * 256 * khalfB; return true;
    }
};

typedef __bf16 bf16v2_t __attribute__((ext_vector_type(2)));
__device__ __forceinline__ unsigned cvt_pk_bf16(float lo, float hi) { bf16v2_t v; v[0] = (__bf16)lo; v[1] = (__bf16)hi; return __builtin_bit_cast(unsigned, v); }

template <class Epi, class Sched, bool GATHER, int F8S = -1, int F8A = 0>
__device__ __forceinline__ void gemm_phase(LAS unsigned char* lds, const void* Abase, const int* rowmap, const int K, const Sched& S, const Epi& E, const unsigned strideA = 0u) {
    const int tid = threadIdx.x, wid = __builtin_amdgcn_readfirstlane(tid >> 6), lane = tid & 63, wr = wid >> 2, wc = wid & 3, fr = lane & 15, fq = lane >> 4;
    const int nt = K / BK;
    const unsigned rowB = (unsigned)K * 2u;
    const unsigned rowA = strideA ? strideA : rowB;
    int RA[2]; unsigned vA[2], voffB[2];
#pragma unroll
    for (int i = 0; i < 2; ++i) { int R, C; stage_rc(tid * 16 + i * 8192, R, C); const int Rb = Epi::PERM ? ((R & ~31) + perm32(R & 31)) : R;
        RA[i] = R; vA[i] = (unsigned)C * 2u; voffB[i] = (unsigned)(Rb * K + C) * 2u; }
    const size_t kstep = (size_t)(BK * 2);
    const size_t hstep = (size_t)HALF * K * 2;
    const unsigned ldsw = (unsigned)wid * 1024u;
    const int aoff0 = lds_byte(wr * 64 + fr, 8 * fq), boff0 = lds_byte(wc * 32 + fr, 8 * fq);
    constexpr int KOFF = 1024;
    const char* A0 = (const char*)Abase;
    unsigned VA[2][2];
#define PG8_SA(b, h) (((b) * 2 + (h)) * HTB)
#define PG8_SB(b, h) ((4 + (b) * 2 + (h)) * HTB)
#define PG8_STAGE_B(bufoff, gbase) do { _Pragma("unroll") for (int _i = 0; _i < 2; ++_i) \
        __builtin_amdgcn_global_load_lds((const unsigned*)((const char*)(gbase) + voffB[_i]), (LAS unsigned*)(lds + (bufoff) + ldsw + _i * 8192), 16, 0, 0); } while (0)
#define PG8_STAGE_A(bufoff, gbase, h) do { _Pragma("unroll") for (int _i = 0; _i < 2; ++_i) \
        __builtin_amdgcn_global_load_lds((const unsigned*)((const char*)(gbase) + VA[h][_i]), (LAS unsigned*)(lds + (bufoff) + ldsw + _i * 8192), 16, 0, 0); } while (0)
#define PG8_CAT(lo, hi) __builtin_shufflevector(__builtin_bit_cast(v4i, lo), __builtin_bit_cast(v4i, hi), 0, 1, 2, 3, 4, 5, 6, 7)
#define PG8_LO(x) __builtin_bit_cast(bf16x8, __builtin_shufflevector(x, x, 0, 1, 2, 3))
#define PG8_HI(x) __builtin_bit_cast(bf16x8, __builtin_shufflevector(x, x, 4, 5, 6, 7))
#define PG8_LDA(dst, b, h) do { _Pragma("unroll") for (int m = 0; m < 4; ++m) dst[m] = PG8_CAT(*(const LAS bf16x8*)(lds + PG8_SA(b, h) + aoff0 + m * 2048), *(const LAS bf16x8*)(lds + PG8_SA(b, h) + aoff0 + KOFF + m * 2048)); } while (0)
#define PG8_LDB(dst, b, h) do { _Pragma("unroll") for (int n = 0; n < 2; ++n) dst[n] = PG8_CAT(*(const LAS bf16x8*)(lds + PG8_SB(b, h) + boff0 + n * 2048), *(const LAS bf16x8*)(lds + PG8_SB(b, h) + boff0 + KOFF + n * 2048)); } while (0)
#define PG8_MMA(ai, bj, At, Bt) do { __builtin_amdgcn_s_setprio(1); _Pragma("unroll") for (int m = 0; m < 4; ++m) _Pragma("unroll") for (int n = 0; n < 2; ++n) { \
        if (F8S >= 0) acc[ai][bj][m][n] = __builtin_amdgcn_mfma_scale_f32_16x16x128_f8f6f4(Bt[n], At[m], acc[ai][bj][m][n], 0, 0, 0, (127 - (F8S >= 0 ? F8S : 0)) * 0x01010101, 0, (127 - F8A) * 0x01010101); \
        else { acc[ai][bj][m][n] = __builtin_amdgcn_mfma_f32_16x16x32_bf16(PG8_LO(Bt[n]), PG8_LO(At[m]), acc[ai][bj][m][n], 0, 0, 0); \
               acc[ai][bj][m][n] = __builtin_amdgcn_mfma_f32_16x16x32_bf16(PG8_HI(Bt[n]), PG8_HI(At[m]), acc[ai][bj][m][n], 0, 0, 0); } } \
        __builtin_amdgcn_s_setprio(0); } while (0)
#define PG8_WAIT_V(n) asm volatile("s_waitcnt vmcnt(" #n ")" ::: "memory")
#define PG8_WAIT_L(n) asm volatile("s_waitcnt lgkmcnt(" #n ")" ::: "memory")
#define PG8_BAR __builtin_amdgcn_s_barrier()
#define PG8_SCHED __builtin_amdgcn_sched_barrier(0)
#define PG8_AOFFS(u) do { _Pragma("unroll") for (int _h = 0; _h < 2; ++_h) _Pragma("unroll") for (int _i = 0; _i < 2; ++_i) \
        { const int _r = _h * HALF + RA[_i]; unsigned _row; if (GATHER) { const int _rc = _r < (u).gcnt ? _r : ((u).gcnt > 0 ? (u).gcnt - 1 : 0); const unsigned _m = (unsigned)rowmap[(u).gbase + _rc]; _row = (_r < (u).gcnt) ? _m : 16384u; } else _row = (unsigned)((u).arow0 + _r); VA[_h][_i] = _row * rowA + (unsigned)(u).acolb + vA[_i]; } } while (0)
    Unit cur, nxt; int ui = 0;
    if (!S.next(0, cur)) return;
    f32x4 acc[2][2][4][2];
#pragma unroll
    for (int a = 0; a < 2; ++a)
#pragma unroll
        for (int b = 0; b < 2; ++b)
#pragma unroll
            for (int m = 0; m < 4; ++m)
#pragma unroll
                for (int n = 0; n < 2; ++n) acc[a][b][m][n] = (f32x4){0.f, 0.f, 0.f, 0.f};
    v8i At[4], B0[2], B1[2];
    PG8_AOFFS(cur);
    const char* cA = A0;
    const char* cB = cur.b;
    PG8_STAGE_B(PG8_SB(0, 0), cB); PG8_STAGE_A(PG8_SA(0, 0), cA, 0); PG8_STAGE_B(PG8_SB(0, 1), cB + hstep); PG8_STAGE_A(PG8_SA(0, 1), cA, 1);
    if (wr == 1) PG8_BAR;
    PG8_WAIT_V(4); PG8_BAR;
    PG8_STAGE_B(PG8_SB(1, 0), cB + kstep); PG8_STAGE_A(PG8_SA(1, 0), cA + kstep, 0); PG8_STAGE_B(PG8_SB(1, 1), cB + hstep + kstep);
    PG8_WAIT_V(6); PG8_BAR;
    for (;;) {
        bool has_next = false; const char* nA = cA; const char* nB = cB;
#pragma unroll 1
        for (int t = 0; t < nt; t += 2) {
            const bool last = (t == nt - 2);
            if (last) { has_next = S.next(ui + 1, nxt); if (has_next) { nB = nxt.b; } }
            const char* a1 = cA + (size_t)(t + 1) * kstep;
            const char* a2 = last ? nA : cA + (size_t)(t + 2) * kstep; const char* b2 = last ? nB : cB + (size_t)(t + 2) * kstep;
            const char* a3 = a2 + kstep; const char* b3 = b2 + kstep;
            PG8_LDB(B0, 0, 0); PG8_SCHED; PG8_LDA(At, 0, 0); PG8_STAGE_A(PG8_SA(1, 1), a1, 1);
            PG8_WAIT_L(8); PG8_BAR; PG8_WAIT_L(0); PG8_MMA(0, 0, At, B0); PG8_BAR; PG8_SCHED;
            if (last && has_next) { PG8_AOFFS(nxt); }
            PG8_LDB(B1, 0, 1); PG8_STAGE_B(PG8_SB(0, 0), b2);
            PG8_BAR; PG8_WAIT_L(0); PG8_MMA(0, 1, At, B1); PG8_BAR;
            PG8_LDA(At, 0, 1); PG8_STAGE_A(PG8_SA(0, 0), a2, 0);
            PG8_BAR; PG8_WAIT_L(0); PG8_MMA(1, 0, At, B0); PG8_BAR; PG8_SCHED;
            PG8_STAGE_B(PG8_SB(0, 1), b2 + hstep);
            PG8_WAIT_V(6); PG8_BAR; PG8_MMA(1, 1, At, B1); PG8_BAR;
            PG8_LDB(B0, 1, 0); PG8_SCHED; PG8_LDA(At, 1, 0); PG8_STAGE_A(PG8_SA(0, 1), a2, 1);
            PG8_WAIT_L(8); PG8_BAR; PG8_WAIT_L(0); PG8_MMA(0, 0, At, B0); PG8_BAR; PG8_SCHED;
            PG8_LDB(B1, 1, 1); PG8_STAGE_B(PG8_SB(1, 0), b3);
            PG8_BAR; PG8_WAIT_L(0); PG8_MMA(0, 1, At, B1); PG8_BAR;
            PG8_LDA(At, 1, 1); PG8_STAGE_A(PG8_SA(1, 0), a3, 0);
            PG8_BAR; PG8_WAIT_L(0); PG8_MMA(1, 0, At, B0); PG8_BAR; PG8_SCHED;
            PG8_STAGE_B(PG8_SB(1, 1), b3 + hstep);
            PG8_WAIT_V(6); PG8_BAR; PG8_MMA(1, 1, At, B1); PG8_BAR;
        }
        E(acc, cur, wr, wc, fr, fq);
        if (!has_next) break;
#pragma unroll
        for (int a = 0; a < 2; ++a)
#pragma unroll
            for (int b = 0; b < 2; ++b)
#pragma unroll
                for (int m = 0; m < 4; ++m)
#pragma unroll
                    for (int n = 0; n < 2; ++n) acc[a][b][m][n] = (f32x4){0.f, 0.f, 0.f, 0.f};
        cur = nxt; cA = nA; cB = nB; ++ui;
    }
    PG8_WAIT_V(0);
    if (wr == 0) PG8_BAR;
    PG8_BAR;
#undef PG8_SA
#undef PG8_SB
#undef PG8_STAGE_A
#undef PG8_STAGE_B
#undef PG8_LDA
#undef PG8_CAT
#undef PG8_LO
#undef PG8_HI
#undef PG8_LDB
#undef PG8_MMA
#undef PG8_WAIT_V
#undef PG8_WAIT_L
#undef PG8_BAR
#undef PG8_SCHED
#undef PG8_AOFFS
}
}

struct EpiF32Res {
    static constexpr bool PERM = false;
    float* C; int ldc; const float* res; float alpha;
    __device__ __forceinline__ void operator()(const f32x4 (&acc)[2][2][4][2], const pg8::Unit& u, int wr, int wc, int fr, int fq) const {
        const int row0 = u.pm * 256 + wr * 64 + fr, col0 = u.pn * 256 + wc * 32 + 4 * fq;
#pragma unroll
        for (int ai = 0; ai < 2; ++ai)
#pragma unroll
            for (int m = 0; m < 4; ++m) { const size_t ro = (size_t)(row0 + ai * 128 + m * 16) * ldc + col0;
#pragma unroll
                for (int bj = 0; bj < 2; ++bj)
#pragma unroll
                    for (int n = 0; n < 2; ++n) { f32x4 v = acc[ai][bj][m][n];
                        if (res) { const f32x4 r = *(const f32x4*)(res + ro + bj * 128 + n * 16); v = v + r * alpha; }
                        *(f32x4*)(C + ro + bj * 128 + n * 16) = v; } }
    }
};
struct EpiBf16Res {
    static constexpr bool PERM = true;
    bf16* O; int ldc; const float* res; float alpha;
    __device__ __forceinline__ void operator()(const f32x4 (&acc)[2][2][4][2], const pg8::Unit& u, int wr, int wc, int fr, int fq) const {
        const int row0 = u.pm * 256 + wr * 64 + fr, col0 = u.pn * 256 + wc * 32 + 8 * fq;
        f32x4 r[2][4][2];
#define EB_RO(st, g) ((size_t)(row0 + ((st) >> 1) * 128 + (2 * ((st) & 1) + ((g) >> 1)) * 16) * ldc + col0 + ((g) & 1) * 128)
#define EB_LOAD(st) do { _Pragma("unroll") for (int _g = 0; _g < 4; ++_g) { const float* _p = res + EB_RO(st, _g); r[(st) & 1][_g][0] = *(const f32x4*)_p; r[(st) & 1][_g][1] = *(const f32x4*)(_p + 4); } } while (0)
#define EB_STORE(st) do { _Pragma("unroll") for (int _g = 0; _g < 4; ++_g) { const int _ai = (st) >> 1, _m = 2 * ((st) & 1) + (_g >> 1), _bj = _g & 1; \
            const f32x4 v0 = acc[_ai][_bj][_m][0] + r[(st) & 1][_g][0] * alpha, v1 = acc[_ai][_bj][_m][1] + r[(st) & 1][_g][1] * alpha; \
            v4u o; o.x = pg8::cvt_pk_bf16(v0[0], v0[1]); o.y = pg8::cvt_pk_bf16(v0[2], v0[3]); o.z = pg8::cvt_pk_bf16(v1[0], v1[1]); o.w = pg8::cvt_pk_bf16(v1[2], v1[3]); \
            *(v4u*)(O + EB_RO(st, _g)) = o; } } while (0)
        EB_LOAD(0); EB_LOAD(1);
        EB_STORE(0); EB_LOAD(2);
        EB_STORE(1); EB_LOAD(3);
        EB_STORE(2); EB_STORE(3);
#undef EB_RO
#undef EB_LOAD
#undef EB_STORE
    }
};
struct EpiBf16Plain {
    static constexpr bool PERM = true;
    bf16* O; int ldc;
    __device__ __forceinline__ void operator()(const f32x4 (&acc)[2][2][4][2], const pg8::Unit& u, int wr, int wc, int fr, int fq) const {
        const int row0 = u.pm * 256 + wr * 64 + fr, col0 = u.pn * 256 + wc * 32 + 8 * fq;
#pragma unroll
        for (int ai = 0; ai < 2; ++ai)
#pragma unroll
            for (int m = 0; m < 4; ++m) { bf16* rowp = O + (size_t)(row0 + ai * 128 + m * 16) * ldc + col0;
#pragma unroll
                for (int bj = 0; bj < 2; ++bj) { const f32x4 v0 = acc[ai][bj][m][0], v1 = acc[ai][bj][m][1];
                    v4u o; o.x = pg8::cvt_pk_bf16(v0[0], v0[1]); o.y = pg8::cvt_pk_bf16(v0[2], v0[3]); o.z = pg8::cvt_pk_bf16(v1[0], v1[1]); o.w = pg8::cvt_pk_bf16(v1[2], v1[3]);
                    *(v4u*)(rowp + bj * 128) = o; } }
    }
};
struct EpiSwiGLU {
    static constexpr bool PERM = true;
    bf16* H;
    __device__ __forceinline__ void operator()(const f32x4 (&acc)[2][2][4][2], const pg8::Unit& u, int wr, int wc, int fr, int fq) const {
        const int row0 = u.pm * 256 + wr * 64 + fr, col0 = u.pn * 128 + wc * 32 + 8 * fq;
#pragma unroll
        for (int ai = 0; ai < 2; ++ai)
#pragma unroll
            for (int m = 0; m < 4; ++m) { bf16* rowp = H + (size_t)(row0 + ai * 128 + m * 16) * 256 + col0;
                const f32x4 g0 = acc[ai][0][m][0], g1 = acc[ai][0][m][1], u0 = acc[ai][1][m][0], u1 = acc[ai][1][m][1];
                float h[8];
#pragma unroll
                for (int e = 0; e < 4; ++e) { h[e] = siluf_(g0[e]) * u0[e]; h[4 + e] = siluf_(g1[e]) * u1[e]; }
                v4u o; o.x = pg8::cvt_pk_bf16(h[0], h[1]); o.y = pg8::cvt_pk_bf16(h[2], h[3]); o.z = pg8::cvt_pk_bf16(h[4], h[5]); o.w = pg8::cvt_pk_bf16(h[6], h[7]);
                *(v4u*)rowp = o; }
    }
};
struct EpiSwiGLU8 {
    static constexpr bool PERM = true;
    unsigned char* H;
    __device__ __forceinline__ void operator()(const f32x4 (&acc)[2][2][4][2], const pg8::Unit& u, int wr, int wc, int fr, int fq) const {
        const int row0 = u.pm * 256 + wr * 64 + fr, col0 = u.pn * 128 + wc * 32 + 8 * fq;
#pragma unroll
        for (int ai = 0; ai < 2; ++ai)
#pragma unroll
            for (int m = 0; m < 4; ++m) { unsigned char* rowp = H + (size_t)(row0 + ai * 128 + m * 16) * 256 + col0;
                const f32x4 g0 = acc[ai][0][m][0], g1 = acc[ai][0][m][1], u0 = acc[ai][1][m][0], u1 = acc[ai][1][m][1];
                float h[8];
#pragma unroll
                for (int e = 0; e < 4; ++e) { h[e] = 4.f * siluf_(g0[e]) * u0[e]; h[4 + e] = 4.f * siluf_(g1[e]) * u1[e]; }
                v2u o; o.x = pk4_fp8(h[0], h[1], h[2], h[3]); o.y = pk4_fp8(h[4], h[5], h[6], h[7]);
                *(v2u*)rowp = o; }
    }
};
struct EpiScatter8 {
    static constexpr bool PERM = true;
    unsigned char* Y; const int* rowdst;
    __device__ __forceinline__ void operator()(const f32x4 (&acc)[2][2][4][2], const pg8::Unit& u, int wr, int wc, int fr, int fq) const {
        const int r0 = wr * 64 + fr, col0 = u.pn * 256 + wc * 32 + 8 * fq;
        unsigned dst[8];
#pragma unroll
        for (int i = 0; i < 8; ++i) { const int rr = r0 + (i >> 2) * 128 + (i & 3) * 16; const int rc = rr < u.gcnt ? rr : (u.gcnt > 0 ? u.gcnt - 1 : 0); const unsigned dd = (unsigned)rowdst[u.gbase + rc]; dst[i] = (rr < u.gcnt) ? dd : 131072u; }
#pragma unroll
        for (int ai = 0; ai < 2; ++ai)
#pragma unroll
            for (int m = 0; m < 4; ++m) { unsigned char* rowp = Y + (size_t)dst[ai * 4 + m] * 1024 + col0;
#pragma unroll
                for (int bj = 0; bj < 2; ++bj) { const f32x4 v0 = acc[ai][bj][m][0] * 16.f, v1 = acc[ai][bj][m][1] * 16.f;
                    v2u o; o.x = pk4_fp8(v0[0], v0[1], v0[2], v0[3]); o.y = pk4_fp8(v1[0], v1[1], v1[2], v1[3]);
                    *(v2u*)(rowp + bj * 128) = o; } }
    }
};
struct EpiScatter {
    static constexpr bool PERM = true;
    bf16* Y; const int* rowdst;
    __device__ __forceinline__ void operator()(const f32x4 (&acc)[2][2][4][2], const pg8::Unit& u, int wr, int wc, int fr, int fq) const {
        const int r0 = wr * 64 + fr, col0 = u.pn * 256 + wc * 32 + 8 * fq;
        unsigned dst[8];
#pragma unroll
        for (int i = 0; i < 8; ++i) { const int rr = r0 + (i >> 2) * 128 + (i & 3) * 16; const int rc = rr < u.gcnt ? rr : (u.gcnt > 0 ? u.gcnt - 1 : 0); const unsigned dd = (unsigned)rowdst[u.gbase + rc]; dst[i] = (rr < u.gcnt) ? dd : 131072u; }
#pragma unroll
        for (int ai = 0; ai < 2; ++ai)
#pragma unroll
            for (int m = 0; m < 4; ++m) { bf16* rowp = Y + (size_t)dst[ai * 4 + m] * 1024 + col0;
#pragma unroll
                for (int bj = 0; bj < 2; ++bj) { const f32x4 v0 = acc[ai][bj][m][0], v1 = acc[ai][bj][m][1];
                    v4u o; o.x = pg8::cvt_pk_bf16(v0[0], v0[1]); o.y = pg8::cvt_pk_bf16(v0[2], v0[3]); o.z = pg8::cvt_pk_bf16(v1[0], v1[1]); o.w = pg8::cvt_pk_bf16(v1[2], v1[3]);
                    *(v4u*)(rowp + bj * 128) = o; } }
    }
};

struct Args { const float* in[21]; float* out; unsigned char* ws; float rope_inv[16]; int ph_lo, ph_hi; };
struct Frame {
    LAS unsigned char* lds; volatile LAS unsigned* MISC; unsigned* ctl; unsigned char* ws;
    int wave, G, bid;
};

__device__ __forceinline__ void transpose_item(const float* src, int ld, int k0, int n0, int nvalid, bf16* dst, int lddst, int dst_row0, LAS float* scr, int lane) {
    const int n4 = 4 * (lane & 15), kq = lane >> 4;
    f32x4 v[16];
#pragma unroll
    for (int i = 0; i < 16; ++i) v[i] = (n4 < nvalid) ? *(const f32x4*)(src + (size_t)(k0 + kq + 4 * i) * ld + n0 + n4) : (f32x4){0.f, 0.f, 0.f, 0.f};
#pragma unroll
    for (int i = 0; i < 16; ++i) { LAS float* p = scr + (kq + 4 * i) * 65 + n4; p[0] = v[i][0]; p[1] = v[i][1]; p[2] = v[i][2]; p[3] = v[i][3]; }
    LDS_WAIT(); asm volatile("" ::: "memory");
    const int c = lane & 7;
#pragma unroll
    for (int j = 0; j < 8; ++j) { const int nn = (lane >> 3) + 8 * j; const LAS float* s = scr + (8 * c) * 65 + nn;
        v4u o; o.x = pk2(s[0 * 65], s[1 * 65]); o.y = pk2(s[2 * 65], s[3 * 65]); o.z = pk2(s[4 * 65], s[5 * 65]); o.w = pk2(s[6 * 65], s[7 * 65]);
        *(v4u*)(dst + (size_t)(dst_row0 + nn) * lddst + k0 + 8 * c) = o; }
    LDS_WAIT(); asm volatile("" ::: "memory");
}
__device__ __forceinline__ void transpose_item8(const float* src, int ld, int k0, int n0, int nvalid, unsigned char* dst, int lddst, int dst_row0, float scale, LAS float* scr, int lane) {
    const int n4 = 4 * (lane & 15), kq = lane >> 4;
    f32x4 v[16];
#pragma unroll
    for (int i = 0; i < 16; ++i) v[i] = (n4 < nvalid) ? *(const f32x4*)(src + (size_t)(k0 + kq + 4 * i) * ld + n0 + n4) : (f32x4){0.f, 0.f, 0.f, 0.f};
#pragma unroll
    for (int i = 0; i < 16; ++i) { LAS float* p = scr + (kq + 4 * i) * 65 + n4; p[0] = v[i][0] * scale; p[1] = v[i][1] * scale; p[2] = v[i][2] * scale; p[3] = v[i][3] * scale; }
    LDS_WAIT(); asm volatile("" ::: "memory");
    const int c = lane & 7;
#pragma unroll
    for (int j = 0; j < 8; ++j) { const int nn = (lane >> 3) + 8 * j; const LAS float* s = scr + (8 * c) * 65 + nn;
        v2u o; o.x = pk4_fp8(s[0 * 65], s[1 * 65], s[2 * 65], s[3 * 65]); o.y = pk4_fp8(s[4 * 65], s[5 * 65], s[6 * 65], s[7 * 65]);
        *(v2u*)(dst + (size_t)(dst_row0 + nn) * lddst + k0 + 8 * c) = o; }
    LDS_WAIT(); asm volatile("" ::: "memory");
}
__device__ __forceinline__ int gu_row(int n, int is_up) { return (n >> 7) * 256 + is_up * 128 + (n & 127); }

__device__ __forceinline__ void p0_prologue(Frame& F, const Args& a, const bool experts, const int wg0) {
    LAS float* scr = (LAS float*)(F.lds + F.wave * 16896);
    const int gw = (F.bid - wg0) * NWAVES + F.wave, NGW = (F.G - wg0) * NWAVES;
    unsigned char* ws = F.ws;
    constexpr int I_IN = 16 * (NIN / 64), I_SQ = 16 * 16, I_RT = 16 * 4, I_SH = 16 * 4, I_SD = 4 * 16, I_EX = 64;
    constexpr int NSMALL = I_IN + 3 * I_SQ + I_RT + 2 * I_SH + I_SD;
    const int ln = (int)(threadIdx.x & 63);
    const int it0 = experts ? NSMALL : 0, it1 = experts ? NSMALL + NEXP * 3 * I_EX : NSMALL;
    for (int it = it0 + gw; it < it1; it += NGW) {
        int r = it;
        if (r < I_IN) { const int nblk = NIN / 64, kb = r / nblk, nb = r % nblk, j0 = nb * 64;
            int n0, nv; if (j0 < 4096) { n0 = j0; nv = 64; } else if (j0 < 7680) { n0 = j0 + 16; nv = 64; } else if (j0 == 7680) { n0 = 4096; nv = 16; } else { n0 = 0; nv = 0; }
            transpose_item8(a.in[1], 7696, kb * 64, n0, nv, ws + WS_WIN, 1024, j0, 32.f, scr, ln); continue; } r -= I_IN;
        if (r < 3 * I_SQ) { const int w = r / I_SQ, q = r % I_SQ, kb = q / 16, nb = q % 16;
            transpose_item8(a.in[6 + w], 1024, kb * 64, nb * 64, 64, ws + (w == 0 ? WS_WGP : (w == 1 ? WS_WMP : WS_WOUT)), 1024, nb * 64, 64.f, scr, ln); continue; } r -= 3 * I_SQ;
        if (r < I_RT) { const int kb = r / 4, nb = r % 4, hf = kb >> 3;
            transpose_item(a.in[11], 256, kb * 64, nb * 64, 64, (bf16*)(ws + WS_ROUTER), 512, hf * 256 + nb * 64 - hf, scr, ln); continue; } r -= I_RT;
        if (r < 2 * I_SH) { const int up = r / I_SH, q = r % I_SH, kb = q / 4, nb = q % 4;
            transpose_item8(a.in[16 + up], 256, kb * 64, nb * 64, 64, ws + WS_SHGU, 1024, gu_row(nb * 64, up), 32.f, scr, ln); continue; } r -= 2 * I_SH;
        if (r < I_SD) { const int kb = r / 16, nb = r % 16; transpose_item(a.in[18], 1024, kb * 64, nb * 64, 64, (bf16*)(ws + WS_SHD), 256, nb * 64, scr, ln); continue; } r -= I_SD;
        { const int e = r / (3 * I_EX), q = r % (3 * I_EX), w = q / I_EX, p = q % I_EX;
            if (w < 2) { const int kb = p / 4, nb = p % 4;
                transpose_item8(a.in[13 + w] + (size_t)e * 1024 * 256, 256, kb * 64, nb * 64, 64, ws + WS_EXPGU + (size_t)e * 512 * 1024, 1024, gu_row(nb * 64, w), 32.f, scr, ln); }
            else { const int kb = p / 16, nb = p % 16;
                transpose_item8(a.in[15] + (size_t)e * 256 * 1024, 1024, kb * 64, nb * 64, 64, ws + WS_EXPD + (size_t)e * 1024 * 256, 256, nb * 64, 32.f, scr, ln); } }
    }
    if (experts) return;
    { const f32x4* x4 = (const f32x4*)a.in[0]; v2u* xb = (v2u*)(ws + WS_XB); const size_t n8 = (size_t)T * D / 8;
        for (size_t i = (size_t)F.bid * 512 + threadIdx.x; i < n8; i += (size_t)F.G * 512) { const f32x4 p = x4[2 * i], q = x4[2 * i + 1];
            v2u o; o.x = pk4_fp8(p[0], p[1], p[2], p[3]); o.y = pk4_fp8(q[0], q[1], q[2], q[3]); xb[i] = o; } }
    { _Float16* rope = (_Float16*)(ws + WS_ROPE);
        for (int idx = F.bid * 512 + ((int)threadIdx.x); idx < T * 16; idx += F.G * 512) { const int t = idx >> 4, i = idx & 15;
            const float angf = (float)t * a.rope_inv[i]; double ang = (double)angf;
            const double TWO_PI = 6.283185307179586476925, PI = 3.14159265358979323846;
            const double kq = __builtin_rint(ang / TWO_PI); double rr = ang - kq * TWO_PI; double cs = 1.0;
            if (rr > 0.5 * PI) { rr = PI - rr; cs = -1.0; } else if (rr < -0.5 * PI) { rr = -PI - rr; cs = -1.0; }
            const double r2 = rr * rr;
            double s = 1.0 / 355687428096000.0;
            s = s * (-r2) + 1.0 / 1307674368000.0; s = s * (-r2) + 1.0 / 6227020800.0; s = s * (-r2) + 1.0 / 39916800.0; s = s * (-r2) + 1.0 / 362880.0;
            s = s * (-r2) + 1.0 / 5040.0; s = s * (-r2) + 1.0 / 120.0; s = s * (-r2) + 1.0 / 6.0; s = s * (-r2) + 1.0; s *= rr;
            double c = 1.0 / 20922789888000.0;
            c = c * (-r2) + 1.0 / 87178291200.0; c = c * (-r2) + 1.0 / 479001600.0; c = c * (-r2) + 1.0 / 3628800.0; c = c * (-r2) + 1.0 / 40320.0;
            c = c * (-r2) + 1.0 / 720.0; c = c * (-r2) + 1.0 / 24.0; c = c * (-r2) + 0.5; c = c * (-r2) + 1.0; c *= cs;
            rope[t * 32 + i] = (_Float16)c; rope[t * 32 + 16 + i] = (_Float16)s; } }
    if (F.bid == 0 && ((int)threadIdx.x) < 128) ((v4u*)(ws + WS_HB + (size_t)T * D * 2))[((int)threadIdx.x)] = (v4u){0u, 0u, 0u, 0u};
}

__device__ __forceinline__ void expert_convert_queue(Frame& F, const Args& a) {
    LAS float* scr = (LAS float*)(F.lds + F.wave * 16896);
    const int lane = (int)(threadIdx.x & 63); unsigned char* ws = F.ws;
    constexpr int I_EX = 64, NIT = NEXP * 3 * I_EX, CH = 8;
    const int n4 = 4 * (lane & 15), kq = lane >> 4, c8 = lane & 7;
#define EX_LOAD(V, r_) do { const int _e = (r_) / (3 * I_EX), _q = (r_) % (3 * I_EX), _w = _q / I_EX, _p = _q % I_EX; const float* _s; int _ld, _k0, _n0; \
        if (_w < 2) { _s = a.in[13 + _w] + (size_t)_e * 1024 * 256; _ld = 256; _k0 = (_p / 4) * 64; _n0 = (_p % 4) * 64; } \
        else { _s = a.in[15] + (size_t)_e * 256 * 1024; _ld = 1024; _k0 = (_p / 16) * 64; _n0 = (_p % 16) * 64; } \
        _Pragma("unroll") for (int _i = 0; _i < 16; ++_i) V[_i] = __builtin_nontemporal_load((const f32x4*)(_s + (size_t)(_k0 + kq + 4 * _i) * _ld + _n0 + n4)); } while (0)
#define EX_PROC(V, r_) do { const int _e = (r_) / (3 * I_EX), _q = (r_) % (3 * I_EX), _w = _q / I_EX, _p = _q % I_EX; unsigned char* _dst; int _lddst, _row0, _k0; \
        if (_w < 2) { _dst = ws + WS_EXPGU + (size_t)_e * 512 * 1024; _lddst = 1024; _row0 = gu_row((_p % 4) * 64, _w); _k0 = (_p / 4) * 64; } \
        else { _dst = ws + WS_EXPD + (size_t)_e * 1024 * 256; _lddst = 256; _row0 = (_p % 16) * 64; _k0 = (_p / 16) * 64; } \
        _Pragma("unroll") for (int _i = 0; _i < 16; ++_i) { LAS float* _pp = scr + (kq + 4 * _i) * 65 + n4; _pp[0] = V[_i][0] * 32.f; _pp[1] = V[_i][1] * 32.f; _pp[2] = V[_i][2] * 32.f; _pp[3] = V[_i][3] * 32.f; } \
        LDS_WAIT(); asm volatile("" ::: "memory"); \
        _Pragma("unroll") for (int _j = 0; _j < 8; ++_j) { const int _nn = (lane >> 3) + 8 * _j; const LAS float* _sp = scr + (8 * c8) * 65 + _nn; \
            v2u _o; _o.x = pk4_fp8(_sp[0 * 65], _sp[1 * 65], _sp[2 * 65], _sp[3 * 65]); _o.y = pk4_fp8(_sp[4 * 65], _sp[5 * 65], _sp[6 * 65], _sp[7 * 65]); \
            __builtin_nontemporal_store(_o, (v2u*)(_dst + (size_t)(_row0 + _nn) * _lddst + _k0 + 8 * c8)); } \
        LDS_WAIT(); asm volatile("" ::: "memory"); } while (0)
    for (;;) {
        unsigned nxt = 0u;
        if (lane == 0) nxt = atomicAdd(&F.ctl[CW_CONVQ], (unsigned)CH);
        const int r0 = __builtin_amdgcn_readfirstlane((int)nxt);
        if (r0 >= NIT) break;
#pragma unroll 1
        for (int r = r0; r < r0 + CH; r += 2) {
            f32x4 va[16], vb[16];
            EX_LOAD(va, r); EX_LOAD(vb, r + 1);
            EX_PROC(va, r); EX_PROC(vb, r + 1);
        }
    }
#undef EX_LOAD
#undef EX_PROC
}

__device__ __forceinline__ void ln_rows(Frame& F, bf16* XB_, unsigned char* X8, const float* g, const float* b) {
    const int gw = F.bid * NWAVES + F.wave, NGW = F.G * NWAVES, lane = (int)(threadIdx.x & 63);
    f32x4 gv[4], bv[4];
#pragma unroll
    for (int j = 0; j < 4; ++j) { gv[j] = ((const f32x4*)g)[lane + 64 * j]; bv[j] = ((const f32x4*)b)[lane + 64 * j]; }
    for (int m0 = gw; m0 < T; m0 += 4 * NGW) {
        v2u x[4][4];
#pragma unroll
        for (int k = 0; k < 4; ++k) { const int mk = (m0 + k * NGW < T) ? m0 + k * NGW : T - 1; const v2u* xr = (const v2u*)(XB_ + (size_t)mk * D) + lane;
#pragma unroll
            for (int j = 0; j < 4; ++j) x[k][j] = xr[64 * j]; }
#pragma unroll
        for (int k = 0; k < 4; ++k) { const int m = m0 + k * NGW;
            f32x4 v[4]; float s = 0.f;
#pragma unroll
            for (int j = 0; j < 4; ++j) { v[j] = (f32x4){bflo(x[k][j].x), bfhi(x[k][j].x), bflo(x[k][j].y), bfhi(x[k][j].y)}; s += (v[j][0] + v[j][1]) + (v[j][2] + v[j][3]); }
            const float mean = wave_sum(s) * (1.f / D); float s2 = 0.f;
#pragma unroll
            for (int j = 0; j < 4; ++j) { v[j] = v[j] - mean; s2 += (v[j][0] * v[j][0] + v[j][1] * v[j][1]) + (v[j][2] * v[j][2] + v[j][3] * v[j][3]); }
            const float rstd = 1.f / sqrtf(wave_sum(s2) * (1.f / D) + LN_EPS);
            if (k == 0) __builtin_amdgcn_s_waitcnt(0x0F70);
            if (m < T) { v2u* xw = (v2u*)(XB_ + (size_t)m * D) + lane;
#pragma unroll
                for (int j = 0; j < 4; ++j) { const f32x4 y = v[j] * rstd * gv[j] + bv[j];
                    v2u o; o.x = pk2(y[0], y[1]); o.y = pk2(y[2], y[3]); xw[64 * j] = o;
                    ((unsigned*)(X8 + (size_t)m * D))[lane + 64 * j] = pk4_fp8(y[0], y[1], y[2], y[3]); } }
        }
    }
}

__device__ __forceinline__ bf16x8 pack8(const f32x4 a, const f32x4 b) {
    v4u o; o.x = pg8::cvt_pk_bf16(a[0], a[1]); o.y = pg8::cvt_pk_bf16(a[2], a[3]); o.z = pg8::cvt_pk_bf16(b[0], b[1]); o.w = pg8::cvt_pk_bf16(b[2], b[3]);
    return __builtin_bit_cast(bf16x8, o);
}
__device__ __forceinline__ f32x4 mfma16(const bf16x8 a, const bf16x8 b, const f32x4 c) { return __builtin_amdgcn_mfma_f32_16x16x32_bf16(a, b, c, 0, 0, 0); }
__device__ __forceinline__ float softplusf_(float x) { return fmaxf(x, 0.f) + log1pf(expf(-fabsf(x))); }

constexpr float MB_QSCALE = 0.08838834764831845f * 1.4426950408889634f;
struct EpiInProj {
    static constexpr bool PERM = true;
    unsigned char* ws; const float* a_log; const float* dt_bias;
    __device__ __forceinline__ void operator()(const f32x4 (&acc)[2][2][4][2], const pg8::Unit& u, int wr, int wc, int fr, int fq) const {
        const int pn = u.pn, row0 = u.pm * 256 + wr * 64 + fr, colt = wc * 32 + 8 * fq;
        if (pn == 30) {
            if (wc == 0 && fq < 2) {
                float al[8], db[8];
#pragma unroll
                for (int j = 0; j < 8; ++j) { al[j] = -expf(a_log[j]); db[j] = dt_bias[j]; }
#pragma unroll
                for (int ai = 0; ai < 2; ++ai)
#pragma unroll
                    for (int m = 0; m < 4; ++m) { const int row = row0 + ai * 128 + m * 16; const f32x4 v0 = acc[ai][0][m][0], v1 = acc[ai][0][m][1];
                        f32x4 o0, o1;
                        if (fq == 0) {
#pragma unroll
                            for (int e = 0; e < 4; ++e) { o0[e] = 1.f / (1.f + expf(-v0[e])); o1[e] = 1.f / (1.f + expf(-v1[e])); }
                            float* p = (float*)(ws + WS_BETA) + (size_t)row * 8; *(f32x4*)p = o0; *(f32x4*)(p + 4) = o1;
                        } else {
#pragma unroll
                            for (int e = 0; e < 4; ++e) { o0[e] = al[e] * softplusf_(v0[e] + db[e]); o1[e] = al[4 + e] * softplusf_(v1[e] + db[4 + e]); }
                            float* p = (float*)(ws + WS_GLOG) + (size_t)row * 8; *(f32x4*)p = o0; *(f32x4*)(p + 4) = o1;
                        } }
            }
            return;
        }
        int kind, ld, cbase; bf16* dst;
        if (pn < 12) { kind = 0; dst = (bf16*)(ws + WS_CONVIN); ld = 3072; cbase = pn * 256; }
        else if (pn < 16) { kind = 1; dst = (bf16*)(ws + WS_GG); ld = 1024; cbase = (pn - 12) * 256; }
        else if (pn < 20) { kind = 3; dst = (bf16*)(ws + WS_MQ); ld = 1024; cbase = (pn - 16) * 256; }
        else if (pn == 20) { kind = 3; dst = (bf16*)(ws + WS_MK); ld = 256; cbase = 0; }
        else if (pn == 21) { kind = 0; dst = (bf16*)(ws + WS_MV); ld = 256; cbase = 0; }
        else if (pn < 26) { kind = 2; dst = (bf16*)(ws + WS_SGG); ld = 1024; cbase = (pn - 22) * 256; }
        else { kind = 2; dst = (bf16*)(ws + WS_SGM); ld = 1024; cbase = (pn - 26) * 256; }
        const bool rope = (kind == 3) && (wc == 0);
        const int i0 = 8 * (fq & 1);
        float ksum[2][8];
#pragma unroll
        for (int bj = 0; bj < 2; ++bj)
#pragma unroll
            for (int e = 0; e < 8; ++e) ksum[bj][e] = 0.f;
        typedef _Float16 f16x8 __attribute__((ext_vector_type(8)));
        f16x8 cq[4], sq[4];
#pragma unroll
        for (int ai = 0; ai < 2; ++ai) {
            if (rope) {
#pragma unroll
                for (int k = 0; k < 4; ++k) { const _Float16* rp = (const _Float16*)(ws + WS_ROPE) + (size_t)(row0 + ai * 128 + k * 16) * 32 + i0; cq[k] = *(const f16x8*)rp; sq[k] = *(const f16x8*)(rp + 16); }
            }
#pragma unroll
            for (int m = 0; m < 4; ++m) { const int row = row0 + ai * 128 + m * 16; bf16* rowp = dst + (size_t)row * ld + cbase + colt;
                f32x4 c0, c1, s0, s1;
                if (rope) { const f16x8 cc = cq[m], ss = sq[m];
#pragma unroll
                    for (int e = 0; e < 4; ++e) { c0[e] = (float)cc[e]; c1[e] = (float)cc[4 + e]; s0[e] = (float)ss[e]; s1[e] = (float)ss[4 + e]; } }
#pragma unroll
                for (int bj = 0; bj < 2; ++bj) { f32x4 v0 = acc[ai][bj][m][0], v1 = acc[ai][bj][m][1];
                    if (kind == 1) {
#pragma unroll
                        for (int e = 0; e < 4; ++e) { v0[e] = siluf_(v0[e]); v1[e] = siluf_(v1[e]); }
                    } else if (kind == 2) {
#pragma unroll
                        for (int e = 0; e < 4; ++e) { v0[e] = sigmoidf_(v0[e]); v1[e] = sigmoidf_(v1[e]); }
                    } else if (rope) {
                        const float sg = fq < 2 ? -1.f : 1.f;
#pragma unroll
                        for (int e = 0; e < 4; ++e) { const float p0 = __shfl_xor(v0[e], 32), p1 = __shfl_xor(v1[e], 32);
                            v0[e] = v0[e] * c0[e] + sg * p0 * s0[e]; v1[e] = v1[e] * c1[e] + sg * p1 * s1[e]; }
                    }
                    if (pn == 20) {
#pragma unroll
                        for (int e = 0; e < 4; ++e) { ksum[bj][e] += v0[e]; ksum[bj][4 + e] += v1[e]; }
                    }
                    if (pn >= 16 && pn < 20) { v0 = v0 * MB_QSCALE; v1 = v1 * MB_QSCALE; }
                    v4u o; o.x = pg8::cvt_pk_bf16(v0[0], v0[1]); o.y = pg8::cvt_pk_bf16(v0[2], v0[3]); o.z = pg8::cvt_pk_bf16(v1[0], v1[1]); o.w = pg8::cvt_pk_bf16(v1[2], v1[3]);
                    *(v4u*)(rowp + bj * 128) = o; } }
        }
        if (pn == 20) {
            float* km = (float*)(ws + WS_CTL) + CW_KMEAN;
#pragma unroll
            for (int bj = 0; bj < 2; ++bj)
#pragma unroll
                for (int e = 0; e < 8; ++e) { float s = ksum[bj][e];
#pragma unroll
                    for (int o = 1; o < 16; o <<= 1) s += __shfl_xor(s, o);
                    if (fr == 0) atomicAdd(km + ((size_t)bj * 64 + u.pm) * 128 + colt + e, s * (1.f / 256.f)); }
        }
    }
};
template <bool ACCUM, bool F8OUT = false> struct EpiGate {
    static constexpr bool PERM = true;
    bf16* M; const bf16* gate; unsigned char* M8;
    __device__ __forceinline__ void operator()(const f32x4 (&acc)[2][2][4][2], const pg8::Unit& u, int wr, int wc, int fr, int fq) const {
        const int row0 = u.pm * 256 + wr * 64 + fr, col0 = u.pn * 256 + wc * 32 + 8 * fq;
        v4u gq[2][4], pq[2][4];
#define EG_RO(st, g) ((size_t)(row0 + ((st) >> 1) * 128 + (2 * ((st) & 1) + ((g) >> 1)) * 16) * 1024 + col0 + ((g) & 1) * 128)
#define EG_LOAD(st) do { _Pragma("unroll") for (int _g = 0; _g < 4; ++_g) { gq[(st) & 1][_g] = *(const v4u*)(gate + EG_RO(st, _g)); if (ACCUM) pq[(st) & 1][_g] = *(const v4u*)(M + EG_RO(st, _g)); } } while (0)
#define EG_STORE(st) do { _Pragma("unroll") for (int _g = 0; _g < 4; ++_g) { const int _ai = (st) >> 1, _m = 2 * ((st) & 1) + (_g >> 1), _bj = _g & 1; \
            const f32x4 v0 = acc[_ai][_bj][_m][0], v1 = acc[_ai][_bj][_m][1]; const v4u g = gq[(st) & 1][_g]; \
            float r[8] = {v0[0] * bflo(g.x), v0[1] * bfhi(g.x), v0[2] * bflo(g.y), v0[3] * bfhi(g.y), v1[0] * bflo(g.z), v1[1] * bfhi(g.z), v1[2] * bflo(g.w), v1[3] * bfhi(g.w)}; \
            if (ACCUM) { const v4u p = pq[(st) & 1][_g]; \
                r[0] += bflo(p.x); r[1] += bfhi(p.x); r[2] += bflo(p.y); r[3] += bfhi(p.y); r[4] += bflo(p.z); r[5] += bfhi(p.z); r[6] += bflo(p.w); r[7] += bfhi(p.w); } \
            if (F8OUT) { v2u o8; o8.x = pk4_fp8(4.f * r[0], 4.f * r[1], 4.f * r[2], 4.f * r[3]); o8.y = pk4_fp8(4.f * r[4], 4.f * r[5], 4.f * r[6], 4.f * r[7]); *(v2u*)(M8 + EG_RO(st, _g)) = o8; } \
            else { v4u o; o.x = pg8::cvt_pk_bf16(r[0], r[1]); o.y = pg8::cvt_pk_bf16(r[2], r[3]); o.z = pg8::cvt_pk_bf16(r[4], r[5]); o.w = pg8::cvt_pk_bf16(r[6], r[7]); \
                *(v4u*)(M + EG_RO(st, _g)) = o; } } } while (0)
        EG_LOAD(0); EG_LOAD(1);
        EG_STORE(0); EG_LOAD(2);
        EG_STORE(1); EG_LOAD(3);
        EG_STORE(2); EG_STORE(3);
#undef EG_RO
#undef EG_LOAD
#undef EG_STORE
    }
};

constexpr int GP_WF = 0, GP_QGF = 16384, GP_KDF = 32768, GP_AQF = 49152, GP_UT = 57344, GP_UNIT = 73728;
constexpr int PL_KB = 0, PL_QB = 17408, PL_RH = 34816, PL_X = 71680, PL_XT = 80896, PL_P = 99328, PL_SC = 108544;
__device__ __forceinline__ bf16x8 ldsfrag(const LAS unsigned char* base, int row, int stride, int ks, int q) { return *(const LAS bf16x8*)(base + row * stride + ks * 64 + q * 16); }

constexpr int PL_STG = 109056;
__device__ __forceinline__ void gdn_prep_all(Frame& F, const Args& a) {
    LAS unsigned char* L = F.lds; unsigned char* ws = F.ws;
    const int tid = threadIdx.x, lane = tid & 63, w = F.wave, l15 = lane & 15, q = lane >> 4;
    LAS float* sc_gc = (LAS float*)(L + PL_SC); LAS float* sc_beta = sc_gc + 64;
    const bf16* cin = (const bf16*)(ws + WS_CONVIN);
    float gpre = 0.f, bpre = 0.f;
#define GP_PREFETCH(uu_) do { const int _h = (uu_) & 7, _t0 = 64 * ((uu_) >> 3); \
        if (w == 0) { gpre = ((const float*)(ws + WS_GLOG))[(size_t)(_t0 + lane) * 8 + _h]; bpre = ((const float*)(ws + WS_BETA))[(size_t)(_t0 + lane) * 8 + _h]; } \
        _Pragma("unroll") for (int _i = 0; _i < 5; ++_i) { const int _pc = w + 8 * _i;     \
            if (_pc < 34) { const int _p = _pc / 17, _r0 = 4 * (_pc % 17); int _row = _r0 + (lane >> 4); if (_row > 66) _row = 66; int _t = _t0 - 3 + _row; if (_t < 0) _t = 0; \
                __builtin_amdgcn_global_load_lds((const unsigned*)(cin + (size_t)_t * 3072 + _p * 1024 + _h * 128 + (lane & 15) * 8), (LAS unsigned*)(L + PL_STG + _p * 17408 + _r0 * 256), 16, 0, 0); } } } while (0)
    unsigned uvn[11];
#define UV_PREFETCH(uu_) do { const int _h = (uu_) & 7, _t0 = 64 * ((uu_) >> 3); \
        _Pragma("unroll") for (int _jj = 0; _jj < 11; ++_jj) { int _t = _t0 + 8 * w - 3 + _jj; if (_t < 0) _t = 0; uvn[_jj] = *(const unsigned*)(cin + (size_t)_t * 3072 + 2048 + _h * 128 + 2 * lane); } } while (0)
    { const int u0 = F.bid < 2048 ? F.bid : 2047; UV_PREFETCH(u0); }
    if (F.bid < 2048) GP_PREFETCH(F.bid);
    int hcw = -1;
    constexpr int PL_CW = 144384;
  for (int u = F.bid; u < 2048; u += F.G) {
    const int h = u & 7, n = u >> 3, t0 = 64 * n;
    unsigned char* gp = ws + WS_GDNP + (size_t)(h * 256 + n) * GP_UNIT;
    if (h != hcw) { hcw = h;
        if (w == 0) {
#pragma unroll
            for (int p = 0; p < 3; ++p) { f32x2 tmpc[4];
#pragma unroll
                for (int j = 0; j < 4; ++j) tmpc[j] = *(const f32x2*)(a.in[2] + (size_t)j * 3072 + p * 1024 + h * 128 + 2 * lane);
                __builtin_amdgcn_sched_barrier(0);
#pragma unroll
                for (int j = 0; j < 4; ++j) *(LAS f32x2*)(L + PL_CW + ((p * 4 + j) * 64 + lane) * 8) = tmpc[j];
                __builtin_amdgcn_sched_barrier(0); }
        } }
    if (w == 0) { float g = gpre; const float b = bpre;
        g = DPP_STEP(g, 0x111, 0xf); g = DPP_STEP(g, 0x112, 0xf); g = DPP_STEP(g, 0x114, 0xf); g = DPP_STEP(g, 0x118, 0xf); g = DPP_STEP(g, 0x142, 0xa); g = DPP_STEP(g, 0x143, 0xc);
        sc_gc[lane] = g; sc_beta[lane] = b; if (lane == 63) ((float*)(ws + WS_GL))[h * 256 + n] = expf(g); }
    __syncthreads();
    {
        unsigned uv[11];
#pragma unroll
        for (int jj = 0; jj < 11; ++jj) { const int t = t0 + 8 * w - 3 + jj; uv[jj] = (t >= 0) ? uvn[jj] : 0u; }
#pragma unroll
        for (int p = 0; p < 3; ++p) {
            f32x2 cw[4]; unsigned uu[11];
#pragma unroll
            for (int j = 0; j < 4; ++j) cw[j] = *(const LAS f32x2*)(L + PL_CW + ((p * 4 + j) * 64 + lane) * 8);
#pragma unroll
            for (int jj = 0; jj < 11; ++jj) { const int t = t0 + 8 * w - 3 + jj; uu[jj] = (p == 2) ? uv[jj] : ((t >= 0) ? *(const LAS unsigned*)(L + PL_STG + p * 17408 + (8 * w + jj) * 256 + lane * 4) : 0u); }
            float y0[8], y1[8], ss[8];
#pragma unroll
            for (int i = 0; i < 8; ++i) { float a0 = 0.f, a1 = 0.f;
#pragma unroll
                for (int j = 0; j < 4; ++j) { a0 += cw[j][0] * bflo(uu[i + j]); a1 += cw[j][1] * bfhi(uu[i + j]); }
                y0[i] = siluf_(a0); y1[i] = siluf_(a1); ss[i] = y0[i] * y0[i] + y1[i] * y1[i]; }
            if (p < 2) {
#pragma unroll
                for (int i = 0; i < 8; ++i) ss[i] = wave_sum_dpp(ss[i]);
#pragma unroll
                for (int i = 0; i < 8; ++i) { const float r = __builtin_amdgcn_rsqf(ss[i] + 1e-6f) * (p == 0 ? 0.08838834764831845f : 1.f); y0[i] *= r; y1[i] *= r; }
            }
            if (p < 2) {
#pragma unroll
                for (int i = 0; i < 8; ++i) *(LAS unsigned*)(L + (p == 0 ? PL_QB : PL_KB) + (8 * w + i) * 272 + lane * 4) = pg8::cvt_pk_bf16(y0[i], y1[i]);
            }
            if (p >= 1) {
                float f[8];
#pragma unroll
                for (int i = 0; i < 8; ++i) { const int c = 8 * w + i; f[i] = (p == 1) ? sc_beta[c] * __expf(sc_gc[c]) : sc_beta[c]; }
                v4u r0, r1;
                r0.x = pg8::cvt_pk_bf16(y0[0] * f[0], y0[1] * f[1]); r0.y = pg8::cvt_pk_bf16(y0[2] * f[2], y0[3] * f[3]); r0.z = pg8::cvt_pk_bf16(y0[4] * f[4], y0[5] * f[5]); r0.w = pg8::cvt_pk_bf16(y0[6] * f[6], y0[7] * f[7]);
                r1.x = pg8::cvt_pk_bf16(y1[0] * f[0], y1[1] * f[1]); r1.y = pg8::cvt_pk_bf16(y1[2] * f[2], y1[3] * f[3]); r1.z = pg8::cvt_pk_bf16(y1[4] * f[4], y1[5] * f[5]); r1.w = pg8::cvt_pk_bf16(y1[6] * f[6], y1[7] * f[7]);
                const int rb = (p == 1) ? 128 : 0;
                *(LAS v4u*)(L + PL_RH + (rb + 2 * lane) * 144 + 16 * w) = r0; *(LAS v4u*)(L + PL_RH + (rb + 2 * lane + 1) * 144 + 16 * w) = r1;
            }
        }
    }
    __syncthreads();
    if (u + F.G < 2048) GP_PREFETCH(u + F.G);
    { const int un = u + F.G < 2048 ? u + F.G : 2047; UV_PREFETCH(un); }
    const int mt = w & 3;
    f32x4 Pacc[4];
    {
        bf16x8 af[4];
#pragma unroll
        for (int ks = 0; ks < 4; ++ks) af[ks] = ldsfrag(L + PL_KB, 16 * mt + l15, 272, ks, q);
#pragma unroll
        for (int nt = 0; nt < 4; ++nt) { f32x4 acc = {0.f, 0.f, 0.f, 0.f};
#pragma unroll
            for (int ks = 0; ks < 4; ++ks) acc = mfma16(af[ks], ldsfrag(L + PL_KB, 16 * nt + l15, 272, ks, q), acc);
            const int s = 16 * nt + l15; const float gs = sc_gc[s]; f32x4 val;
#pragma unroll
            for (int r = 0; r < 4; ++r) { const int c = 16 * mt + 4 * q + r; val[r] = (s < c) ? sc_beta[c] * acc[r] * __expf(sc_gc[c] - gs) : 0.f; }
            if (w < 4) {
#pragma unroll
                for (int r = 0; r < 4; ++r) *(LAS bf16*)(L + PL_X + (16 * mt + 4 * q + r) * 144 + s * 2) = (bf16)f2bf(val[r]);
                v2u o; o.x = pg8::cvt_pk_bf16(val[0], val[1]); o.y = pg8::cvt_pk_bf16(val[2], val[3]);
                *(LAS v2u*)(L + PL_XT + s * 144 + (16 * mt + 4 * q) * 2) = o;
            } else {
#pragma unroll
                for (int r = 0; r < 4; ++r) { const int c = 16 * mt + 4 * q + r; Pacc[nt][r] = ((c == s) ? 1.f : 0.f) - val[r]; *(LAS bf16*)(L + PL_P + c * 144 + s * 2) = (bf16)f2bf(Pacc[nt][r]); }
            }
        }
        if (w >= 4) {
            bf16x8 qf[4];
#pragma unroll
            for (int ks = 0; ks < 4; ++ks) qf[ks] = ldsfrag(L + PL_QB, 16 * mt + l15, 272, ks, q);
            const int c = 16 * mt + l15; const float gcq = sc_gc[c];
            f32x4 aq[4];
#pragma unroll
            for (int m2 = 0; m2 < 4; ++m2) { f32x4 acc = {0.f, 0.f, 0.f, 0.f};
#pragma unroll
                for (int ks = 0; ks < 4; ++ks) acc = mfma16(ldsfrag(L + PL_KB, 16 * m2 + l15, 272, ks, q), qf[ks], acc);
#pragma unroll
                for (int r = 0; r < 4; ++r) { const int cp = 16 * m2 + 4 * q + r; aq[m2][r] = (cp <= c) ? acc[r] * __expf(gcq - sc_gc[cp]) : 0.f; } }
#pragma unroll
            for (int k2 = 0; k2 < 2; ++k2) *(bf16x8*)(gp + GP_AQF + (mt * 2 + k2) * 1024 + lane * 16) = pack8(aq[2 * k2], aq[2 * k2 + 1]);
        }
    }
    do { asm volatile("s_waitcnt lgkmcnt(0)" ::: "memory"); __builtin_amdgcn_s_barrier(); asm volatile("" ::: "memory"); } while (0);
#pragma unroll
    for (int lev = 0; lev < 6; ++lev) {
        const int cur = lev & 1;
        const LAS unsigned char* xt = L + PL_XT + cur * 9216;
        if (w < 4) {
            if (lev < 5) {
                bf16x8 af[2]; f32x4 xa[4];
#pragma unroll
                for (int ks = 0; ks < 2; ++ks) af[ks] = ldsfrag(L + PL_X, 16 * mt + l15, 144, ks, q);
#pragma unroll
                for (int nt = 0; nt < 4; ++nt) { xa[nt] = (f32x4){0.f, 0.f, 0.f, 0.f};
#pragma unroll
                    for (int ks = 0; ks < 2; ++ks) xa[nt] = mfma16(af[ks], ldsfrag(xt, 16 * nt + l15, 144, ks, q), xa[nt]); }
                LAS unsigned char* xtn = L + PL_XT + (cur ^ 1) * 9216;
#pragma unroll
                for (int nt = 0; nt < 4; ++nt) { const int s = 16 * nt + l15;
#pragma unroll
                    for (int r = 0; r < 4; ++r) *(LAS bf16*)(L + PL_X + (16 * mt + 4 * q + r) * 144 + s * 2) = (bf16)f2bf(xa[nt][r]);
                    v2u o; o.x = pg8::cvt_pk_bf16(xa[nt][0], xa[nt][1]); o.y = pg8::cvt_pk_bf16(xa[nt][2], xa[nt][3]);
                    *(LAS v2u*)(xtn + s * 144 + (16 * mt + 4 * q) * 2) = o; }
            }
        } else if (lev >= 1) {
            bf16x8 af[2];
#pragma unroll
            for (int ks = 0; ks < 2; ++ks) af[ks] = ldsfrag(L + PL_P, 16 * mt + l15, 144, ks, q);
#pragma unroll
            for (int nt = 0; nt < 4; ++nt)
#pragma unroll
                for (int ks = 0; ks < 2; ++ks) Pacc[nt] = mfma16(af[ks], ldsfrag(xt, 16 * nt + l15, 144, ks, q), Pacc[nt]);
#pragma unroll
            for (int nt = 0; nt < 4; ++nt)
#pragma unroll
                for (int r = 0; r < 4; ++r) *(LAS bf16*)(L + PL_P + (16 * mt + 4 * q + r) * 144 + (16 * nt + l15) * 2) = (bf16)f2bf(Pacc[nt][r]);
        }
        do { asm volatile("s_waitcnt lgkmcnt(0)" ::: "memory"); __builtin_amdgcn_s_barrier(); asm volatile("" ::: "memory"); } while (0);
    }
    __builtin_amdgcn_s_waitcnt(0x0F70);
    if (w < 4) {
#pragma unroll
        for (int i = 0; i < 2; ++i) { const int nt = 2 * w + i; f32x4 uu[4];
            const bf16x8 b0 = ldsfrag(L + PL_RH, 16 * nt + l15, 144, 0, q), b1 = ldsfrag(L + PL_RH, 16 * nt + l15, 144, 1, q);
#pragma unroll
            for (int m2 = 0; m2 < 4; ++m2) { uu[m2] = mfma16(ldsfrag(L + PL_P, 16 * m2 + l15, 144, 0, q), b0, (f32x4){0.f, 0.f, 0.f, 0.f}); uu[m2] = mfma16(ldsfrag(L + PL_P, 16 * m2 + l15, 144, 1, q), b1, uu[m2]); }
            unsigned char* up = gp + GP_UT + (16 * nt + l15) * 128 + q * 32;
            *(bf16x8*)up = pack8(uu[0], uu[1]); *(bf16x8*)(up + 16) = pack8(uu[2], uu[3]); }
    } else {
        const bf16x8 b0 = ldsfrag(L + PL_P, 16 * mt + l15, 144, 0, q), b1 = ldsfrag(L + PL_P, 16 * mt + l15, 144, 1, q);
        f32x4 wa[8];
#pragma unroll
        for (int md = 0; md < 8; ++md) { wa[md] = mfma16(ldsfrag(L + PL_RH, 128 + 16 * md + l15, 144, 0, q), b0, (f32x4){0.f, 0.f, 0.f, 0.f}); wa[md] = mfma16(ldsfrag(L + PL_RH, 128 + 16 * md + l15, 144, 1, q), b1, wa[md]); wa[md] = -wa[md]; }
#pragma unroll
        for (int ks = 0; ks < 4; ++ks) { const f32x4 a0 = wa[2 * ks] * 32.f, a1 = wa[2 * ks + 1] * 32.f; v2u o8; o8.x = pk4_fp8(a0[0], a0[1], a0[2], a0[3]); o8.y = pk4_fp8(a1[0], a1[1], a1[2], a1[3]);
            *(v2u*)(gp + GP_WF + (mt * 4 + ks) * 512 + lane * 8) = o8; }
    }
    {
        const float gl = sc_gc[63];
#pragma unroll
        for (int i = 0; i < 2; ++i) { const int f = 2 * w + i;
            { const int m2 = f >> 2, ks = f & 3, c = 16 * m2 + l15; const float eg = __expf(sc_gc[c]);
              const v2u x0 = *(const LAS v2u*)(L + PL_QB + c * 272 + (32 * ks + 4 * q) * 2), x1 = *(const LAS v2u*)(L + PL_QB + c * 272 + (32 * ks + 16 + 4 * q) * 2);
              const f32x4 v0 = {bflo(x0.x) * eg, bfhi(x0.x) * eg, bflo(x0.y) * eg, bfhi(x0.y) * eg}, v1 = {bflo(x1.x) * eg, bfhi(x1.x) * eg, bflo(x1.y) * eg, bfhi(x1.y) * eg};
              *(bf16x8*)(gp + GP_QGF + f * 1024 + lane * 16) = pack8(v0, v1); }
            { const int md = f >> 1, ks = f & 1, d = 16 * md + l15; f32x4 v0, v1;
#pragma unroll
              for (int r = 0; r < 4; ++r) { const int c0 = 32 * ks + 4 * q + r, c1 = c0 + 16;
                  v0[r] = bf2f(*(const LAS bf16*)(L + PL_KB + c0 * 272 + d * 2)) * __expf(gl - sc_gc[c0]); v1[r] = bf2f(*(const LAS bf16*)(L + PL_KB + c1 * 272 + d * 2)) * __expf(gl - sc_gc[c1]); }
              v2u o8; o8.x = pk4_fp8(64.f * v0[0], 64.f * v0[1], 64.f * v0[2], 64.f * v0[3]); o8.y = pk4_fp8(64.f * v1[0], 64.f * v1[1], 64.f * v1[2], 64.f * v1[3]);
              *(v2u*)(gp + GP_KDF + f * 512 + lane * 8) = o8; }
        }
    }
    do { asm volatile("s_waitcnt lgkmcnt(0)" ::: "memory"); __builtin_amdgcn_s_barrier(); asm volatile("" ::: "memory"); } while (0);
  }
#undef GP_PREFETCH
#undef UV_PREFETCH
}

__device__ __forceinline__ void gdn_scan(Frame& F, const int h) {
    LAS unsigned char* L = F.lds; unsigned char* ws = F.ws;
    const int lane = threadIdx.x & 63, w = F.wave, l15 = lane & 15, q = lane >> 4;
    const unsigned char* gph = ws + WS_GDNP + (size_t)h * 256 * GP_UNIT;
    const float* GLp = (const float*)(ws + WS_GL) + h * 256;
    float* Op = (float*)(ws + WS_O) + h * 128 + 16 * w + l15;
    f32x4 Sf[8];
#pragma unroll
    for (int md = 0; md < 8; ++md) Sf[md] = (f32x4){0.f, 0.f, 0.f, 0.f};
#define SCAN_ISSUE(nn) do { const unsigned char* _s = gph + (size_t)(nn) * GP_UNIT; LAS unsigned char* _d = L + ((nn) & 1) * 57344; \
        _Pragma("unroll") for (int _p = 0; _p < 7; ++_p) __builtin_amdgcn_global_load_lds((const unsigned*)(_s + (w + 8 * _p) * 1024 + lane * 16), (LAS unsigned*)(_d + (w + 8 * _p) * 1024), 16, 0, 0); } while (0)
    SCAN_ISSUE(0);
    for (int n = 0; n < 256; ++n) {
        VM_WAIT(); __syncthreads();
        if (n + 1 < 256) SCAN_ISSUE(n + 1);
        const LAS unsigned char* sl = L + (n & 1) * 57344;
        const unsigned char* up = gph + (size_t)n * GP_UNIT + GP_UT + (16 * w + l15) * 128 + q * 32;
        const v4u u0 = *(const v4u*)up, u1 = *(const v4u*)(up + 16);
        const float gl = GLp[n];
        bf16x8 sb[4];
#pragma unroll
        for (int ks = 0; ks < 4; ++ks) sb[ks] = pack8(Sf[2 * ks], Sf[2 * ks + 1]);
        f32x4 vn[4], oo[4];
        vn[0] = (f32x4){bflo(u0.x), bfhi(u0.x), bflo(u0.y), bfhi(u0.y)}; vn[1] = (f32x4){bflo(u0.z), bfhi(u0.z), bflo(u0.w), bfhi(u0.w)};
        vn[2] = (f32x4){bflo(u1.x), bfhi(u1.x), bflo(u1.y), bfhi(u1.y)}; vn[3] = (f32x4){bflo(u1.z), bfhi(u1.z), bflo(u1.w), bfhi(u1.w)};
#pragma unroll
        for (int m2 = 0; m2 < 4; ++m2) { oo[m2] = (f32x4){0.f, 0.f, 0.f, 0.f};
#pragma unroll
            for (int ks = 0; ks < 4; ++ks) { vn[m2] = mfma16(*(const LAS bf16x8*)(sl + GP_WF + (m2 * 4 + ks) * 1024 + lane * 16), sb[ks], vn[m2]);
                oo[m2] = mfma16(*(const LAS bf16x8*)(sl + GP_QGF + (m2 * 4 + ks) * 1024 + lane * 16), sb[ks], oo[m2]); } }
        const bf16x8 vb0 = pack8(vn[0], vn[1]), vb1 = pack8(vn[2], vn[3]);
#pragma unroll
        for (int m2 = 0; m2 < 4; ++m2) { oo[m2] = mfma16(*(const LAS bf16x8*)(sl + GP_AQF + (m2 * 2) * 1024 + lane * 16), vb0, oo[m2]);
            oo[m2] = mfma16(*(const LAS bf16x8*)(sl + GP_AQF + (m2 * 2 + 1) * 1024 + lane * 16), vb1, oo[m2]); }
#pragma unroll
        for (int md = 0; md < 8; ++md) { Sf[md] = Sf[md] * gl;
            Sf[md] = mfma16(*(const LAS bf16x8*)(sl + GP_KDF + (md * 2) * 1024 + lane * 16), vb0, Sf[md]);
            Sf[md] = mfma16(*(const LAS bf16x8*)(sl + GP_KDF + (md * 2 + 1) * 1024 + lane * 16), vb1, Sf[md]); }
#pragma unroll
        for (int m2 = 0; m2 < 4; ++m2)
#pragma unroll
            for (int r = 0; r < 4; ++r) Op[(size_t)(64 * n + 16 * m2 + 4 * q + r) * 1024] = oo[m2][r];
    }
#undef SCAN_ISSUE
    VM_WAIT(); __syncthreads();
}

__device__ __forceinline__ v4u fp8x8_bf16(const unsigned a, const unsigned b, const float sc) {
    typedef float f32x2_ __attribute__((ext_vector_type(2)));
    const f32x2_ p0 = __builtin_amdgcn_cvt_pk_f32_fp8(a, false), p1 = __builtin_amdgcn_cvt_pk_f32_fp8(a, true), p2 = __builtin_amdgcn_cvt_pk_f32_fp8(b, false), p3 = __builtin_amdgcn_cvt_pk_f32_fp8(b, true);
    v4u o; o.x = pg8::cvt_pk_bf16(p0[0] * sc, p0[1] * sc); o.y = pg8::cvt_pk_bf16(p1[0] * sc, p1[1] * sc); o.z = pg8::cvt_pk_bf16(p2[0] * sc, p2[1] * sc); o.w = pg8::cvt_pk_bf16(p3[0] * sc, p3[1] * sc);
    return o;
}

constexpr int NSCAN = 32, NWARM = 8;
constexpr int SC_SLOT = 36864;
constexpr int SC_WU = 20480, SC_KD = 16384;
__device__ __forceinline__ void gdn_scan2(Frame& F, const int b) {
    LAS unsigned char* L = F.lds; unsigned char* ws = F.ws;
    const int lane = threadIdx.x & 63, w = F.wave, l15 = lane & 15, q = lane >> 4;
    const int h = b & 7, part = b >> 3;
    unsigned char* gph = ws + WS_GDNP + (size_t)h * 256 * GP_UNIT;
    unsigned char* sbp = ws + WS_O + (size_t)h * 256 * 32768;
    constexpr int KDR = 4 * SC_WU, GLT = KDR + 4 * SC_KD;
#define SC_BAR() do { asm volatile("s_waitcnt lgkmcnt(0)" ::: "memory"); __builtin_amdgcn_s_barrier(); asm volatile("" ::: "memory"); } while (0)
    if (threadIdx.x < 256) ((LAS float*)(L + GLT))[threadIdx.x] = ((const float*)(ws + WS_GL))[h * 256 + threadIdx.x];
#define SC_HSTEP(n, RS) do { SC_PUT(RS, (n) + 2); SC_LOAD(RS, (n) + 10); \
            if (w == 7 && lane == 0) __hip_atomic_store(&F.ctl[CW_PROG + 64 * b], (unsigned)((n) + 1), __ATOMIC_RELAXED, __HIP_MEMORY_SCOPE_AGENT); \
            SC_BAR(); } while (0)
#define SC_LOOP() do { \
        SC_LOAD(r0, 0); SC_LOAD(r1, 1); SC_LOAD(r2, 2); SC_LOAD(r3, 3); SC_LOAD(r4, 4); SC_LOAD(r5, 5); SC_LOAD(r6, 6); SC_LOAD(r7, 7); \
        SC_PUT(r0, 0); SC_LOAD(r0, 8); SC_PUT(r1, 1); SC_LOAD(r1, 9);          \
        SC_BAR(); SC_BAR(); \
          \
        _Pragma("unroll 1") for (int n0 = 0; n0 < 256; n0 += 8) { SC_HSTEP(n0, r2); SC_HSTEP(n0 + 1, r3); SC_HSTEP(n0 + 2, r4); SC_HSTEP(n0 + 3, r5); SC_HSTEP(n0 + 4, r6); SC_HSTEP(n0 + 5, r7); SC_HSTEP(n0 + 6, r0); SC_HSTEP(n0 + 7, r1); } } while (0)
    if (w >= 6) {
        const int sok = GP_KDF + (4 * (w - 6)) * 1024 + lane * 16, dok = KDR + (8 * (w - 6) + (lane >> 5)) * 1024 + (lane & 31) * 32;
#define SC_LOAD(R, nn) do { const int _nn = (nn) < 255 ? (nn) : 255; const unsigned char* _u = gph + (size_t)_nn * GP_UNIT + sok; _Pragma("unroll") for (int _i = 0; _i < 4; ++_i) R[_i] = *(const v4u*)(_u + _i * 1024); } while (0)
#define SC_PUT(R, nn) do { LAS unsigned char* _d = L + dok + ((nn) & 3) * SC_KD; _Pragma("unroll") for (int _i = 0; _i < 4; ++_i) { \
            *(LAS v4u*)(_d + _i * 2048) = fp8x8_bf16(R[_i].x, R[_i].y, 1.f / 64.f); *(LAS v4u*)(_d + _i * 2048 + 16) = fp8x8_bf16(R[_i].z, R[_i].w, 1.f / 64.f); } } while (0)
        v4u r0[4], r1[4], r2[4], r3[4], r4[4], r5[4], r6[4], r7[4];
        SC_LOOP();
#undef SC_LOAD
#undef SC_PUT
    } else if (w >= 2) {
        const int lw = w - 2;
        const int sow = GP_WF + (2 * lw) * 1024 + lane * 16, sou = GP_UT + part * 4096 + lw * 1024 + lane * 16;
        const int dww = (4 * lw + (lane >> 5)) * 1024 + (lane & 31) * 32, dwu = 16384 + lw * 1024 + lane * 16;
#define SC_LOAD(R, nn) do { const int _nn = (nn) < 255 ? (nn) : 255; const unsigned char* _u = gph + (size_t)_nn * GP_UNIT; R[0] = *(const v4u*)(_u + sow); R[1] = *(const v4u*)(_u + sow + 1024); R[2] = *(const v4u*)(_u + sou); } while (0)
#define SC_PUT(R, nn) do { LAS unsigned char* _d = L + ((nn) & 3) * SC_WU; _Pragma("unroll") for (int _i = 0; _i < 2; ++_i) { \
            *(LAS v4u*)(_d + dww + _i * 2048) = fp8x8_bf16(R[_i].x, R[_i].y, 1.f / 32.f); *(LAS v4u*)(_d + dww + _i * 2048 + 16) = fp8x8_bf16(R[_i].z, R[_i].w, 1.f / 32.f); } \
            *(LAS v4u*)(_d + dwu) = R[2]; } while (0)
        v4u r0[3], r1[3], r2[3], r3[3], r4[3], r5[3], r6[3], r7[3];
        SC_LOOP();
#undef SC_LOAD
#undef SC_PUT
#undef SC_LOOP
#undef SC_HSTEP
    } else {
        f32x4 Sf[8];
#pragma unroll
        for (int md = 0; md < 8; ++md) Sf[md] = (f32x4){0.f, 0.f, 0.f, 0.f};
        bf16x8 wf[16], kf[16]; v4u u0, u1;
        SC_BAR();
#pragma unroll
        for (int i = 0; i < 16; ++i) wf[i] = *(const LAS bf16x8*)(L + i * 1024 + lane * 16);
        { const LAS unsigned char* up = L + 16384 + (16 * w + l15) * 128 + q * 32; u0 = *(const LAS v4u*)up; u1 = *(const LAS v4u*)(up + 16); }
#pragma unroll
        for (int i = 0; i < 16; ++i) kf[i] = *(const LAS bf16x8*)(L + KDR + i * 1024 + lane * 16);
        SC_BAR();
        const int slice = 2 * part + w;
#pragma unroll 1
        for (int n = 0; n < 256; ++n) {
            f32x4 vn[4];
            vn[0] = (f32x4){bflo(u0.x), bfhi(u0.x), bflo(u0.y), bfhi(u0.y)}; vn[1] = (f32x4){bflo(u0.z), bfhi(u0.z), bflo(u0.w), bfhi(u0.w)};
            vn[2] = (f32x4){bflo(u1.x), bfhi(u1.x), bflo(u1.y), bfhi(u1.y)}; vn[3] = (f32x4){bflo(u1.z), bfhi(u1.z), bflo(u1.w), bfhi(u1.w)};
            const float gl = ((const LAS float*)(L + GLT))[n];
            bf16x8 sb[4];
#pragma unroll
            for (int ks = 0; ks < 4; ++ks) { sb[ks] = pack8(Sf[2 * ks], Sf[2 * ks + 1]);
                *(bf16x8*)(sbp + ((size_t)n * 32 + slice * 4 + ks) * 1024 + lane * 16) = sb[ks]; }
            asm volatile("s_waitcnt lgkmcnt(0)" ::: "memory");
            __builtin_amdgcn_sched_barrier(0);
#pragma unroll
            for (int ks = 0; ks < 4; ++ks)
#pragma unroll
                for (int m2 = 0; m2 < 4; ++m2) vn[m2] = mfma16(wf[m2 * 4 + ks], sb[ks], vn[m2]);
            __builtin_amdgcn_sched_barrier(0);
#pragma unroll
            for (int md = 0; md < 8; ++md) Sf[md] = Sf[md] * gl;
            if (n + 1 < 256) { const LAS unsigned char* wu = L + ((n + 1) & 3) * SC_WU;
#pragma unroll
                for (int i = 0; i < 16; ++i) wf[i] = *(const LAS bf16x8*)(wu + i * 1024 + lane * 16);
                const LAS unsigned char* up = wu + 16384 + (16 * w + l15) * 128 + q * 32; u0 = *(const LAS v4u*)up; u1 = *(const LAS v4u*)(up + 16); }
            __builtin_amdgcn_sched_barrier(0);
            const bf16x8 vb0 = pack8(vn[0], vn[1]), vb1 = pack8(vn[2], vn[3]);
            unsigned char* vbp = gph + (size_t)n * GP_UNIT + GP_UT + slice * 2048 + lane * 16;
            *(bf16x8*)vbp = vb0; *(bf16x8*)(vbp + 1024) = vb1;
#pragma unroll
            for (int md = 0; md < 8; ++md) Sf[md] = mfma16(kf[md * 2], vb0, Sf[md]);
#pragma unroll
            for (int md = 0; md < 8; ++md) Sf[md] = mfma16(kf[md * 2 + 1], vb1, Sf[md]);
            __builtin_amdgcn_sched_barrier(0);
            if (n + 1 < 256) { const LAS unsigned char* kd = L + KDR + ((n + 1) & 3) * SC_KD;
#pragma unroll
                for (int i = 0; i < 16; ++i) kf[i] = *(const LAS bf16x8*)(kd + i * 1024 + lane * 16); }
            SC_BAR();
        }
    }
#undef SC_BAR
    VM_WAIT(); __syncthreads();
}

__device__ __forceinline__ void gdn_scan_warm(Frame& F, const int h) {
    unsigned char* ws = F.ws; const int tid = threadIdx.x;
    const unsigned char* gph = ws + WS_GDNP + (size_t)h * 256 * GP_UNIT;
    LAS unsigned* pw = (LAS unsigned*)(F.lds + 1024);
    unsigned acc = 0u;
    constexpr int WDIST = 14;
    for (int m = 0; m < 256; ++m) {
        if (m >= WDIST) {
            if (tid == 0) { unsigned sp = 0; while (__hip_atomic_load(&F.ctl[CW_PROG + 64 * h], __ATOMIC_RELAXED, __HIP_MEMORY_SCOPE_AGENT) + WDIST < (unsigned)m + 1u) { __builtin_amdgcn_s_sleep(4); if (++sp > (1u << 22)) break; } }
            __syncthreads();
        }
        const unsigned char* u = gph + (size_t)m * GP_UNIT;
#pragma unroll
        for (int i = 0; i < 2; ++i) { const int x = tid + 512 * i, p = x >> 6, o = (x & 63) * 16;
            const unsigned char* src = u + (p < 8 ? GP_WF + p * 1024 : GP_KDF + (p - 8) * 1024) + o;
            const v4u v = *(const v4u*)src; acc ^= v.x ^ v.y ^ v.z ^ v.w; }
    }
    if (acc == 0x12345u) *pw = acc;
    __syncthreads();
}

__device__ __forceinline__ void gdn_ophase(Frame& F, const float* norm_w) {
    unsigned char* ws = F.ws; const int lane = threadIdx.x & 63, w = F.wave, l15 = lane & 15, q = lane >> 4, mt = w & 3, us = w >> 2;
    LAS unsigned char* LB = F.lds + us * 49152;
    LAS unsigned char* tl = F.lds + 98304 + w * 4352;
    float nwv[8];
#pragma unroll
    for (int sl = 0; sl < 8; ++sl) nwv[sl] = norm_w[16 * sl + l15];
    v4u gq[4], gqn[4]; bf16x8 aq[4], aa[2], aqn[4], aan[2]; v4u bsh[12];
#define OP_REQ(u_, GQ, AQ, AA) do { const int _u = (u_) < 2048 ? (u_) : 2047, _h = _u >> 8, _n = _u & 255; \
        const unsigned char* _gp = ws + WS_GDNP + (size_t)_u * GP_UNIT; const unsigned char* _sbp = ws + WS_O + (size_t)_u * 32768; \
        const size_t _gidx = (size_t)(64 * _n + 16 * mt + (lane >> 2)) * 1024 + _h * 128 + (lane & 3) * 32; \
        _Pragma("unroll") for (int _c = 0; _c < 4; ++_c) GQ[_c] = *(const v4u*)((const bf16*)(ws + WS_GG) + _gidx + _c * 8); \
        _Pragma("unroll") for (int _k = 0; _k < 4; ++_k) AQ[_k] = *(const bf16x8*)(_gp + GP_QGF + (mt * 4 + _k) * 1024 + lane * 16); \
        _Pragma("unroll") for (int _k = 0; _k < 2; ++_k) AA[_k] = *(const bf16x8*)(_gp + GP_AQF + (mt * 2 + _k) * 1024 + lane * 16); \
        _Pragma("unroll") for (int _i = 0; _i < 8; ++_i) bsh[_i] = *(const v4u*)(_sbp + (8 * mt + _i) * 1024 + lane * 16); \
        _Pragma("unroll") for (int _i = 0; _i < 4; ++_i) bsh[8 + _i] = *(const v4u*)(_gp + GP_UT + (4 * mt + _i) * 1024 + lane * 16); } while (0)
    int u = 2 * F.bid + us;
    OP_REQ(u, gqn, aqn, aan);
    for (; u < 2048; u += 2 * F.G) {
        const int h = u >> 8, n = u & 255;
        __syncthreads();
#pragma unroll
        for (int i = 0; i < 8; ++i) *(LAS v4u*)(LB + (8 * mt + i) * 1024 + lane * 16) = bsh[i];
#pragma unroll
        for (int i = 0; i < 4; ++i) *(LAS v4u*)(LB + 32768 + (4 * mt + i) * 1024 + lane * 16) = bsh[8 + i];
#pragma unroll
        for (int c = 0; c < 4; ++c) { gq[c] = gqn[c]; aq[c] = aqn[c]; }
        aa[0] = aan[0]; aa[1] = aan[1];
        __syncthreads();
        OP_REQ(u + 2 * F.G, gqn, aqn, aan);
        f32x4 o[8]; float ss[4] = {0.f, 0.f, 0.f, 0.f};
#pragma unroll
        for (int sl = 0; sl < 8; ++sl) { o[sl] = (f32x4){0.f, 0.f, 0.f, 0.f};
#pragma unroll
            for (int ks = 0; ks < 4; ++ks) o[sl] = mfma16(aq[ks], *(const LAS bf16x8*)(LB + (sl * 4 + ks) * 1024 + lane * 16), o[sl]);
#pragma unroll
            for (int k2 = 0; k2 < 2; ++k2) o[sl] = mfma16(aa[k2], *(const LAS bf16x8*)(LB + 32768 + (sl * 2 + k2) * 1024 + lane * 16), o[sl]);
#pragma unroll
            for (int r = 0; r < 4; ++r) ss[r] += o[sl][r] * o[sl][r]; }
#pragma unroll
        for (int r = 0; r < 4; ++r) { float s = ss[r]; s += __shfl_xor(s, 1); s += __shfl_xor(s, 2); s += __shfl_xor(s, 4); s += __shfl_xor(s, 8); ss[r] = 1.f / sqrtf(s * (1.f / 128.f) + 1e-6f); }
#pragma unroll
        for (int sl = 0; sl < 8; ++sl) { const float nw = nwv[sl];
#pragma unroll
            for (int r = 0; r < 4; ++r) *(LAS bf16*)(tl + (4 * q + r) * 272 + (16 * sl + l15) * 2) = (bf16)f2bf(o[sl][r] * ss[r] * nw); }
        LDS_WAIT(); asm volatile("" ::: "memory");
        __builtin_amdgcn_s_waitcnt(0x0F70);
        { const int row = lane >> 2, seg = lane & 3; const size_t idx = (size_t)(64 * n + 16 * mt + row) * 1024 + h * 128 + seg * 32;
          bf16* OG = (bf16*)(ws + WS_OG);
#pragma unroll
          for (int c4 = 0; c4 < 4; ++c4) { const v4u y = *(const LAS v4u*)(tl + row * 272 + seg * 64 + c4 * 16), g = gq[c4];
              v2u d; d.x = pk4_fp8(bflo(y.x) * bflo(g.x), bfhi(y.x) * bfhi(g.x), bflo(y.y) * bflo(g.y), bfhi(y.y) * bfhi(g.y)); d.y = pk4_fp8(bflo(y.z) * bflo(g.z), bfhi(y.z) * bfhi(g.z), bflo(y.w) * bflo(g.w), bfhi(y.w) * bfhi(g.w));
              *(v2u*)((unsigned char*)OG + idx + c4 * 8) = d; } }
        LDS_WAIT(); asm volatile("" ::: "memory");
    }
#undef OP_REQ
    __syncthreads();
}

__device__ __forceinline__ void gdn_post(Frame& F, const float* norm_w) {
    unsigned char* ws = F.ws; const int lane = threadIdx.x & 63;
    const int gw = F.bid * NWAVES + F.wave, NGW = F.G * NWAVES;
    f32x4 nw[4];
#pragma unroll
    for (int j = 0; j < 4; ++j) nw[j] = *(const f32x4*)(norm_w + (lane & 7) * 16 + 4 * j);
    for (int t = gw; t < T; t += NGW) {
        const f32x4* op = (const f32x4*)((const float*)(ws + WS_O) + (size_t)t * 1024 + lane * 16);
        f32x4 o[4]; float ss = 0.f;
#pragma unroll
        for (int j = 0; j < 4; ++j) { o[j] = op[j]; ss += (o[j][0] * o[j][0] + o[j][1] * o[j][1]) + (o[j][2] * o[j][2] + o[j][3] * o[j][3]); }
        ss += __shfl_xor(ss, 1); ss += __shfl_xor(ss, 2); ss += __shfl_xor(ss, 4);
        const float r = 1.f / sqrtf(ss * (1.f / 128.f) + 1e-6f);
        const v4u* gpn = (const v4u*)((const bf16*)(ws + WS_GG) + (size_t)t * 1024 + lane * 16);
        const v4u g0 = gpn[0], g1 = gpn[1];
        const float gg[16] = {bflo(g0.x), bfhi(g0.x), bflo(g0.y), bfhi(g0.y), bflo(g0.z), bfhi(g0.z), bflo(g0.w), bfhi(g0.w), bflo(g1.x), bfhi(g1.x), bflo(g1.y), bfhi(g1.y), bflo(g1.z), bfhi(g1.z), bflo(g1.w), bfhi(g1.w)};
        float y[16];
#pragma unroll
        for (int j = 0; j < 4; ++j)
#pragma unroll
            for (int e = 0; e < 4; ++e) y[4 * j + e] = o[j][e] * r * nw[j][e] * gg[4 * j + e];
        v4u* dp = (v4u*)((bf16*)(ws + WS_OG) + (size_t)t * 1024 + lane * 16);
        v4u d0, d1; d0.x = pk2(y[0], y[1]); d0.y = pk2(y[2], y[3]); d0.z = pk2(y[4], y[5]); d0.w = pk2(y[6], y[7]); d1.x = pk2(y[8], y[9]); d1.y = pk2(y[10], y[11]); d1.z = pk2(y[12], y[13]); d1.w = pk2(y[14], y[15]);
        dp[0] = d0; dp[1] = d1;
    }
}

constexpr int ML_LTOT = 2064384;
__device__ __forceinline__ int moba_listoff(int g, int n) { return g * ML_LTOT + 4 * (n * T - 128 * n * (n + 1)); }
typedef short s16x4 __attribute__((ext_vector_type(4)));

__device__ __forceinline__ void moba_select_unit(Frame& F, const int g, const int b) {
    if (b == 0) return;
    LAS unsigned char* L = F.lds; unsigned char* ws = F.ws;
    const int tid = threadIdx.x, lane = tid & 63, w = F.wave, l15 = lane & 15, q = lane >> 4;
    constexpr int KH = 0, KL = 17408, GS = 34816, SEL = 68096, LC = 80384, LB = 80640;
    const float* km = (const float*)(ws + WS_CTL) + CW_KMEAN + (size_t)g * 64 * 128;
    for (int i = tid; i < 64 * 128; i += 512) { const int n = i >> 7, d = i & 127; const float x = (n < b) ? km[i] : 0.f; const unsigned hi = f2bf(x); const float lo = x - bf2f(hi);
        *(LAS bf16*)(L + KH + n * 272 + d * 2) = (bf16)hi; *(LAS bf16*)(L + KL + n * 272 + d * 2) = (bf16)f2bf(lo); }
    if (tid < 64) *(LAS unsigned*)(L + LC + tid * 4) = 0u;
    __syncthreads();
    const bf16* MQ = (const bf16*)(ws + WS_MQ);
    LAS float* gs = (LAS float*)(L + GS + w * 4160);
    const int nsel = b < 3 ? b : 3;
#define MS_LOADQ(dst, mt_) do { const int _r0 = (mt_) * 16 + l15; const bf16* _qp = MQ + (size_t)(256 * b + (_r0 >> 2)) * 1024 + (4 * g + (_r0 & 3)) * 128 + 8 * q; \
        _Pragma("unroll") for (int _ks = 0; _ks < 4; ++_ks) dst[_ks] = *(const bf16x8*)(_qp + 32 * _ks); } while (0)
    bf16x8 af[4], af1[4], af2[4];
    MS_LOADQ(af, w); MS_LOADQ(af1, w + 8); MS_LOADQ(af2, w + 16);
    for (int mtile = w; mtile < 64; mtile += 8) {
#pragma unroll
        for (int nt = 0; nt < 4; ++nt) { f32x4 acc = {0.f, 0.f, 0.f, 0.f};
#pragma unroll
            for (int ks = 0; ks < 4; ++ks) { acc = mfma16(af[ks], ldsfrag(L + KH, 16 * nt + l15, 272, ks, q), acc); acc = mfma16(af[ks], ldsfrag(L + KL, 16 * nt + l15, 272, ks, q), acc); }
#pragma unroll
            for (int r = 0; r < 4; ++r) gs[(4 * q + r) * 65 + 16 * nt + l15] = acc[r]; }
        LDS_WAIT(); asm volatile("" ::: "memory");
        {
            const int row = lane >> 2, part = lane & 3;
            float v0 = -INFINITY, v1 = -INFINITY, v2 = -INFINITY; int i0 = 0, i1 = 0, i2 = 0;
            const int nlo = part * 16, nhi = (nlo + 16 < b) ? nlo + 16 : b;
            for (int n = nlo; n < nhi; ++n) { const float x = gs[row * 65 + n];
                if (x > v0) { v2 = v1; i2 = i1; v1 = v0; i1 = i0; v0 = x; i0 = n; } else if (x > v1) { v2 = v1; i2 = i1; v1 = x; i1 = n; } else if (x > v2) { v2 = x; i2 = n; } }
#pragma unroll
            for (int o = 1; o < 4; o <<= 1) {
                const float w0 = __shfl_xor(v0, o), w1 = __shfl_xor(v1, o), w2 = __shfl_xor(v2, o); const int j0 = __shfl_xor(i0, o), j1 = __shfl_xor(i1, o), j2 = __shfl_xor(i2, o);
                const bool lower = (lane & o) == 0;
                const float a0 = lower ? v0 : w0, a1 = lower ? v1 : w1, a2 = lower ? v2 : w2, b0 = lower ? w0 : v0, b1 = lower ? w1 : v1, b2 = lower ? w2 : v2;
                const int ia0 = lower ? i0 : j0, ia1 = lower ? i1 : j1, ia2 = lower ? i2 : j2, ib0 = lower ? j0 : i0, ib1 = lower ? j1 : i1, ib2 = lower ? j2 : i2;
                float r0, r1, r2; int k0, k1, k2;
                if (b0 > a0) { r0 = b0; k0 = ib0;
                    if (b1 > a0) { r1 = b1; k1 = ib1; if (b2 > a0) { r2 = b2; k2 = ib2; } else { r2 = a0; k2 = ia0; } }
                    else { r1 = a0; k1 = ia0; if (b1 > a1) { r2 = b1; k2 = ib1; } else { r2 = a1; k2 = ia1; } } }
                else { r0 = a0; k0 = ia0;
                    if (b0 > a1) { r1 = b0; k1 = ib0; if (b1 > a1) { r2 = b1; k2 = ib1; } else { r2 = a1; k2 = ia1; } }
                    else { r1 = a1; k1 = ia1; if (b0 > a2) { r2 = b0; k2 = ib0; } else { r2 = a2; k2 = ia2; } } }
                v0 = r0; v1 = r1; v2 = r2; i0 = k0; i1 = k1; i2 = k2;
            }
            if (part == 0) { const int rr = mtile * 16 + row;
#pragma unroll
                for (int j = 0; j < 3; ++j) if (j < nsel) { const int blk = j == 0 ? i0 : (j == 1 ? i1 : i2);
                    const unsigned lp = __hip_atomic_fetch_add((LAS unsigned*)(L + LC + blk * 4), 1u, __ATOMIC_RELAXED, __HIP_MEMORY_SCOPE_WORKGROUP);
                    *(LAS unsigned short*)(L + SEL + (rr * 3 + j) * 2) = (unsigned short)blk; *(LAS unsigned short*)(L + SEL + 6144 + (rr * 3 + j) * 2) = (unsigned short)lp; } }
        }
        LDS_WAIT(); asm volatile("" ::: "memory");
#pragma unroll
        for (int ks = 0; ks < 4; ++ks) { af[ks] = af1[ks]; af1[ks] = af2[ks]; }
        if (mtile + 24 < 64) MS_LOADQ(af2, mtile + 24);
    }
#undef MS_LOADQ
    __syncthreads();
    if (tid < b) { const unsigned c = *(LAS unsigned*)(L + LC + tid * 4); *(LAS unsigned*)(L + LB + tid * 4) = c ? atomicAdd(&F.ctl[CW_MOBA_CNT + g * 64 + tid], c) : 0u; }
    __syncthreads();
    unsigned* lists = (unsigned*)(ws + WS_LISTS);
    for (int rr = tid; rr < 1024; rr += 512) { const int t = 256 * b + (rr >> 2), hr = rr & 3;
        for (int j = 0; j < nsel; ++j) { const int blk = *(LAS unsigned short*)(L + SEL + (rr * 3 + j) * 2); const unsigned lp = *(LAS unsigned short*)(L + SEL + 6144 + (rr * 3 + j) * 2);
            lists[moba_listoff(g, blk) + *(LAS unsigned*)(L + LB + blk * 4) + lp] = (unsigned)t | ((unsigned)hr << 14) | ((unsigned)j << 16); } }
    __syncthreads();
}

__device__ __forceinline__ void moba_attn_unit(Frame& F, const int g, const int n, const unsigned* list, const int count, const bool own) {
    LAS unsigned char* L = F.lds; unsigned char* ws = F.ws;
    const int tid = threadIdx.x, lane = tid & 63, w = F.wave, l15 = lane & 15, q = lane >> 4;
    constexpr int KS = 0, VS = 73728;
    { const bf16* MK = (const bf16*)(ws + WS_MK) + (size_t)(256 * n) * 256 + g * 128; const bf16* MV = (const bf16*)(ws + WS_MV) + (size_t)(256 * n) * 256 + g * 128;
        v4u kv[8], vv[8];
#pragma unroll
        for (int i = 0; i < 8; ++i) { const int p = tid + 512 * i, row = p >> 4, ch = p & 15; kv[i] = *(const v4u*)(MK + (size_t)row * 256 + ch * 8); vv[i] = *(const v4u*)(MV + (size_t)row * 256 + ch * 8); }
#pragma unroll
        for (int i = 0; i < 8; ++i) { const int p = tid + 512 * i, row = p >> 4, ch = p & 15; *(LAS v4u*)(L + KS + row * 288 + ch * 16) = kv[i]; *(LAS v4u*)(L + VS + row * 288 + ch * 16) = vv[i]; } }
    __syncthreads();
    const bf16* MQ = (const bf16*)(ws + WS_MQ); bf16* PO = (bf16*)(ws + WS_PO); float* LSE = (float*)(ws + WS_LSE);
    const int ntile = (count + 15) >> 4;
#define MB_ENTRY(tl) ({ int _i = (tl) * 16 + l15; if (_i >= count) _i = count - 1; own ? ((unsigned)(256 * n + (_i >> 2)) | ((unsigned)(_i & 3) << 14) | (3u << 16)) : list[_i]; })
#define MB_LOADQ(dst, e) do { const bf16* _qp = MQ + (size_t)((e) & 16383u) * 1024 + (4 * g + (int)(((e) >> 14) & 3u)) * 128 + 8 * q; \
        _Pragma("unroll") for (int _ks = 0; _ks < 4; ++_ks) dst[_ks] = *(const bf16x8*)(_qp + 32 * _ks); } while (0)
    unsigned e_cur = 0u, e_nxt = 0u; bf16x8 qf[4], qn[4];
    if (w < ntile) { e_cur = MB_ENTRY(w); MB_LOADQ(qf, e_cur); }
    if (w + 8 < ntile) e_nxt = MB_ENTRY(w + 8);
    __builtin_amdgcn_s_waitcnt(0x0F70);
    for (int tile = w; tile < ntile; tile += 8) {
        unsigned e_nn = 0u;
        if (tile + 16 < ntile) e_nn = MB_ENTRY(tile + 16);
        if (tile + 8 < ntile) MB_LOADQ(qn, e_nxt);
        const bool live = tile * 16 + l15 < count;
        const int t = (int)(e_cur & 16383u), hr = (int)((e_cur >> 14) & 3u), j = (int)((e_cur >> 16) & 3u), h = 4 * g + hr;
        f32x4 s[16];
        {
            bf16x8 ka[8], kb[8];
#define MB_LDK(dst, g) do { _Pragma("unroll") for (int _i = 0; _i < 8; ++_i) dst[_i] = ldsfrag(L + KS, 16 * (2 * (g) + (_i >> 2)) + l15, 288, _i & 3, q); } while (0)
#define MB_MMK(src, g) do { _Pragma("unroll") for (int _h = 0; _h < 2; ++_h) { _Pragma("unroll") for (int _ks = 0; _ks < 4; ++_ks) s[2 * (g) + _h] = mfma16(src[_h * 4 + _ks], qf[_ks], s[2 * (g) + _h]); } } while (0)
            const int gmax = own ? ((tile >> 2) >> 1) : 7;
#pragma unroll
            for (int kt = 0; kt < 16; ++kt) s[kt] = (f32x4){0.f, 0.f, 0.f, 0.f};
            MB_LDK(ka, 0);
#pragma unroll
            for (int g = 0; g < 8; g += 2) {
                if (g + 1 <= gmax) MB_LDK(kb, g + 1);
                __builtin_amdgcn_sched_barrier(0); if (g <= gmax) MB_MMK(ka, g); __builtin_amdgcn_sched_barrier(0);
                if (g + 2 < 8 && g + 2 <= gmax) MB_LDK(ka, g + 2);
                __builtin_amdgcn_sched_barrier(0); if (g + 1 <= gmax) MB_MMK(kb, g + 1); __builtin_amdgcn_sched_barrier(0);
            }
#undef MB_LDK
#undef MB_MMK
        }
        const int tq = own ? (t - 256 * n) : 255;
        float m = -1e30f;
#pragma unroll
        for (int kt = 0; kt < 16; ++kt)
#pragma unroll
            for (int r = 0; r < 4; ++r) { const int key = 16 * kt + 4 * q + r; const float x = (!own || key <= tq) ? s[kt][r] : -1e30f; s[kt][r] = x; m = fmaxf(m, x); }
        m = fmaxf(m, __shfl_xor(m, 16)); m = fmaxf(m, __shfl_xor(m, 32));
        float l = 0.f;
#pragma unroll
        for (int kt = 0; kt < 16; ++kt)
#pragma unroll
            for (int r = 0; r < 4; ++r) { const float p = __builtin_amdgcn_exp2f(s[kt][r] - m); s[kt][r] = p; l += p; }
        l += __shfl_xor(l, 16); l += __shfl_xor(l, 32);
        f32x4 oa[8];
#pragma unroll
        for (int md = 0; md < 8; ++md) oa[md] = (f32x4){0.f, 0.f, 0.f, 0.f};
        {
            bf16x8 va[4], vb2[4];
            const LAS unsigned char* vbase = L + VS + (4 * q + (l15 >> 2)) * 288 + (l15 & 3) * 8;
#define MB_LDV(dst, x) do { _Pragma("unroll") for (int _m = 0; _m < 4; ++_m) { const int _md = 4 * ((x) & 1) + _m, _k2 = (x) >> 1; \
                const s16x4 _a0 = __builtin_amdgcn_ds_read_tr16_b64_v4i16((LAS s16x4*)(vbase + (32 * _k2) * 288 + _md * 32)), _a1 = __builtin_amdgcn_ds_read_tr16_b64_v4i16((LAS s16x4*)(vbase + (32 * _k2 + 16) * 288 + _md * 32)); \
                dst[_m] = (bf16x8){_a0[0], _a0[1], _a0[2], _a0[3], _a1[0], _a1[1], _a1[2], _a1[3]}; } } while (0)
#define MB_MMV(src, x) do { const bf16x8 _pb = pack8(s[2 * ((x) >> 1)], s[2 * ((x) >> 1) + 1]); _Pragma("unroll") for (int _m = 0; _m < 4; ++_m) oa[4 * ((x) & 1) + _m] = mfma16(src[_m], _pb, oa[4 * ((x) & 1) + _m]); } while (0)
            const int xmax = own ? (2 * (tile >> 3) + 1) : 15;
            MB_LDV(va, 0);
#pragma unroll
            for (int x = 0; x < 16; x += 2) {
                if (x + 1 <= xmax) MB_LDV(vb2, x + 1);
                __builtin_amdgcn_sched_barrier(0); if (x <= xmax) MB_MMV(va, x); __builtin_amdgcn_sched_barrier(0);
                if (x + 2 < 16 && x + 2 <= xmax) MB_LDV(va, x + 2);
                __builtin_amdgcn_sched_barrier(0); if (x + 1 <= xmax) MB_MMV(vb2, x + 1); __builtin_amdgcn_sched_barrier(0);
            }
#undef MB_LDV
#undef MB_MMV
        }
        __builtin_amdgcn_s_waitcnt(0x0F70);
        if (live) { const float inv = 1.f / l; bf16* op = PO + (((size_t)t * 8 + h) * 4 + j) * 128 + 4 * q;
#pragma unroll
            for (int md = 0; md < 8; ++md) { v2u o; o.x = pg8::cvt_pk_bf16(oa[md][0] * inv, oa[md][1] * inv); o.y = pg8::cvt_pk_bf16(oa[md][2] * inv, oa[md][3] * inv); __builtin_nontemporal_store(o, (v2u*)(op + 16 * md)); }
            if (q == 0) __builtin_nontemporal_store((m + __builtin_amdgcn_logf(l)) * 0.6931471805599453f, &LSE[((size_t)t * 8 + h) * 4 + j]); }
        e_cur = e_nxt; e_nxt = e_nn;
#pragma unroll
        for (int ks = 0; ks < 4; ++ks) qf[ks] = qn[ks];
    }
#undef MB_ENTRY
#undef MB_LOADQ
    __syncthreads();
}

__device__ __forceinline__ void moba_own_queue(Frame& F) {
    LAS int* bc = (LAS int*)(F.lds + 148480) + 132; const int tid = threadIdx.x;
    for (;;) {
        if (tid == 0) *bc = (int)atomicAdd(&F.ctl[CW_QHEAD], 1u);
        __syncthreads();
        const int it = *bc;
        __syncthreads();
        if (it >= 128) break;
        moba_attn_unit(F, it & 1, it >> 1, nullptr, 1024, true);
    }
}
__device__ __forceinline__ void moba_attn_queue(Frame& F) {
    LAS unsigned char* L = F.lds; unsigned char* ws = F.ws; const int tid = threadIdx.x;
    LAS int* pre = (LAS int*)(L + 148480); LAS int* bc = pre + 132;
    moba_own_queue(F);
    if (tid < 128) { const int c = (int)__hip_atomic_load(&F.ctl[CW_MOBA_CNT + tid], __ATOMIC_RELAXED, __HIP_MEMORY_SCOPE_AGENT); const int nch = (c + 1023) >> 10; int v = nch;
#pragma unroll
        for (int o = 1; o < 64; o <<= 1) { const int t2 = __shfl_up(v, o); if ((tid & 63) >= o) v += t2; }
        pre[tid] = v - nch; if ((tid & 63) == 63) pre[129 + (tid >> 6)] = v; }
    __syncthreads();
    if (tid >= 64 && tid < 128) pre[tid] += pre[129];
    if (tid == 0) pre[128] = pre[129] + pre[130];
    __syncthreads();
    const int total = pre[128];
    for (;;) {
        if (tid == 0) *bc = (int)atomicAdd(&F.ctl[CW_QHEAD + 1], 1u);
        __syncthreads();
        const int x = *bc;
        __syncthreads();
        if (x >= total) break;
        int idx = 0; while (pre[idx + 1] <= x) ++idx;
        const int g = idx >> 6, n = idx & 63, ch = x - pre[idx]; const int cnt = (int)__hip_atomic_load(&F.ctl[CW_MOBA_CNT + idx], __ATOMIC_RELAXED, __HIP_MEMORY_SCOPE_AGENT);
        const int c0 = ch * 1024, cc = (cnt - c0) < 1024 ? (cnt - c0) : 1024;
        moba_attn_unit(F, g, n, (const unsigned*)(ws + WS_LISTS) + moba_listoff(g, n) + c0, cc, false);
    }
}

__device__ __forceinline__ void moba_combine(Frame& F, const int wg0) {
    unsigned char* ws = F.ws; const int lane = threadIdx.x & 63;
    const int gw = (F.bid - wg0) * NWAVES + F.wave, NGW = (F.G - wg0) * NWAVES;
    const bf16* PO = (const bf16*)(ws + WS_PO); const float* LSE = (const float*)(ws + WS_LSE);
    const int h = lane >> 3;
#define MC_LOAD(t_, L_, A_, C_) do { L_ = __builtin_nontemporal_load((const f32x4*)(LSE + ((size_t)(t_) * 8 + h) * 4)); \
        _Pragma("unroll") for (int _j = 0; _j < 4; ++_j) { const v4u* _pp = (const v4u*)(PO + (((size_t)(t_) * 8 + h) * 4 + _j) * 128 + (lane & 7) * 16); A_[_j] = __builtin_nontemporal_load(_pp); C_[_j] = __builtin_nontemporal_load(_pp + 1); } } while (0)
    f32x4 ls, lsn; v4u pa[4], pc[4], na[4], nc[4];
    int t = gw;
    if (t < T) MC_LOAD(t, ls, pa, pc);
    for (; t < T; t += NGW) {
        const int tn = t + NGW;
        if (tn < T) MC_LOAD(tn, lsn, na, nc);
        const int b = t >> 8, nsel = b < 3 ? b : 3;
        float lj[4] = {nsel > 0 ? ls[0] : -INFINITY, nsel > 1 ? ls[1] : -INFINITY, nsel > 2 ? ls[2] : -INFINITY, ls[3]};
        const float M = fmaxf(fmaxf(lj[0], lj[1]), fmaxf(lj[2], lj[3]));
        float wj[4], ws_ = 0.f;
#pragma unroll
        for (int j = 0; j < 4; ++j) { wj[j] = __expf(lj[j] - M); ws_ += wj[j]; }
        const float inv = 1.f / ws_;
        float acc[16];
#pragma unroll
        for (int e = 0; e < 16; ++e) acc[e] = 0.f;
#pragma unroll
        for (int j = 0; j < 4; ++j) { const bool on = (j == 3) || (j < nsel);
            const v4u a = pa[j], c = pc[j]; const float wv = wj[j] * inv;
#define MC_ACC(i_, x_) acc[i_] += on ? wv * (x_) : 0.f
            MC_ACC(0, bflo(a.x)); MC_ACC(1, bfhi(a.x)); MC_ACC(2, bflo(a.y)); MC_ACC(3, bfhi(a.y)); MC_ACC(4, bflo(a.z)); MC_ACC(5, bfhi(a.z)); MC_ACC(6, bflo(a.w)); MC_ACC(7, bfhi(a.w));
            MC_ACC(8, bflo(c.x)); MC_ACC(9, bfhi(c.x)); MC_ACC(10, bflo(c.y)); MC_ACC(11, bfhi(c.y)); MC_ACC(12, bflo(c.z)); MC_ACC(13, bfhi(c.z)); MC_ACC(14, bflo(c.w)); MC_ACC(15, bfhi(c.w));
#undef MC_ACC
        }
        v4u d8; d8.x = pk4_fp8(16.f * acc[0], 16.f * acc[1], 16.f * acc[2], 16.f * acc[3]); d8.y = pk4_fp8(16.f * acc[4], 16.f * acc[5], 16.f * acc[6], 16.f * acc[7]);
        d8.z = pk4_fp8(16.f * acc[8], 16.f * acc[9], 16.f * acc[10], 16.f * acc[11]); d8.w = pk4_fp8(16.f * acc[12], 16.f * acc[13], 16.f * acc[14], 16.f * acc[15]);
        __builtin_amdgcn_s_waitcnt(0x0F70);
        *(v4u*)(ws + WS_A2 + (size_t)t * 1024 + lane * 16) = d8;
        ls = lsn;
#pragma unroll
        for (int j = 0; j < 4; ++j) { pa[j] = na[j]; pc[j] = nc[j]; }
    }
#undef MC_LOAD
}

constexpr size_t WS_ELIST = 944 * MiB, WS_EDST = 960 * MiB;
constexpr size_t WS_HB8 = 976 * MiB;
__device__ __forceinline__ void moe_route(Frame& F, const float* logits, const float* bias, float* wts, unsigned* cnt, int* elist, int* edst) {
    const int lane = threadIdx.x & 63, tid = threadIdx.x;
    LAS unsigned* lcnt = (LAS unsigned*)F.lds; LAS unsigned* gb = lcnt + 256; LAS unsigned* pk = gb + 256;
    const f32x4 bz = ((const f32x4*)bias)[lane];
    for (int t0 = F.bid * 64; t0 < T; t0 += F.G * 64) {
        if (tid < 256) lcnt[tid] = 0u;
        __syncthreads();
        f32x4 lgs[8];
#pragma unroll
        for (int i = 0; i < 8; ++i) { const f32x4* lp = (const f32x4*)(logits + (size_t)(t0 + 8 * F.wave + i) * 512); lgs[i] = lp[lane] + lp[64 + lane]; }
#pragma unroll 1
        for (int i = 0; i < 8; ++i) {
            const int t = t0 + 8 * F.wave + i;
            f32x4 lg = lgs[0];
#pragma unroll
            for (int k = 1; k < 8; ++k) if (i == k) lg = lgs[k];
            float sc[4], ch[4];
#pragma unroll
            for (int e = 0; e < 4; ++e) { sc[e] = 1.f / (1.f + expf(-lg[e])); ch[e] = sc[e] + bz[e]; }
            float a = fmaxf(ch[0], ch[1]), b = fminf(ch[0], ch[1]);
            { const float a2 = fmaxf(ch[2], ch[3]), b2 = fminf(ch[2], ch[3]); const float na = fmaxf(a, a2); b = fmaxf(fminf(a, a2), fmaxf(b, b2)); a = na; }
#pragma unroll
            for (int o = 1; o < 8; o <<= 1) { const float a2 = __shfl_xor(a, o), b2 = __shfl_xor(b, o); const float na = fmaxf(a, a2); b = fmaxf(fminf(a, a2), fmaxf(b, b2)); a = na; }
            const float gs = a + b; const int g = lane >> 3;
            int rank = 0;
#pragma unroll
            for (int g2 = 0; g2 < 8; ++g2) { const float o = __shfl(gs, g2 * 8); rank += (o > gs || (o == gs && g2 < g)) ? 1 : 0; }
            const bool sel = rank < 4;
            unsigned key[4];
#pragma unroll
            for (int e = 0; e < 4; ++e) { const unsigned bb = __builtin_bit_cast(unsigned, ch[e]); key[e] = sel ? ((bb & 0x80000000u) ? ~bb : (bb | 0x80000000u)) : 0u; }
            unsigned thr = 0u;
            for (int bit = 31; bit >= 0; --bit) { const unsigned cand = thr | (1u << bit); int c = 0;
#pragma unroll
                for (int e = 0; e < 4; ++e) c += __builtin_popcountll(__ballot(key[e] >= cand));
                if (c >= 8) thr = cand;
                if (c == 8) break; }
            int G8 = 0; unsigned long long beq[4]; bool gt[4], eq[4];
#pragma unroll
            for (int e = 0; e < 4; ++e) { gt[e] = key[e] > thr; eq[e] = key[e] == thr; G8 += __builtin_popcountll(__ballot(gt[e])); beq[e] = __ballot(eq[e]); }
            const int need = 8 - G8;
            int tb_ = 0;
#pragma unroll
            for (int e = 0; e < 4; ++e) tb_ += (int)__builtin_amdgcn_mbcnt_hi((unsigned)(beq[e] >> 32), __builtin_amdgcn_mbcnt_lo((unsigned)beq[e], 0u));
            bool pick[4]; int run = tb_;
#pragma unroll
            for (int e = 0; e < 4; ++e) { pick[e] = gt[e] || (eq[e] && run < need); run += eq[e] ? 1 : 0; }
            int sb = 0; float ls = 0.f;
#pragma unroll
            for (int e = 0; e < 4; ++e) { const unsigned long long bp = __ballot(pick[e]); sb += (int)__builtin_amdgcn_mbcnt_hi((unsigned)(bp >> 32), __builtin_amdgcn_mbcnt_lo((unsigned)bp, 0u)); ls += pick[e] ? sc[e] : 0.f; }
            const float ssum = wave_sum(ls);
            int slot = sb;
#pragma unroll
            for (int e = 0; e < 4; ++e) if (pick[e]) { const int ex = 4 * lane + e;
                wts[t * 8 + slot] = sc[e] / (ssum + 1e-20f) * 2.5f;
                const unsigned lp = __hip_atomic_fetch_add(&lcnt[ex], 1u, __ATOMIC_RELAXED, __HIP_MEMORY_SCOPE_WORKGROUP);
                const int pi = ((8 * F.wave + i) * 8 + slot) * 2; pk[pi] = (unsigned)ex | (lp << 8); pk[pi + 1] = (unsigned)(t * 8 + slot); ++slot; }
        }
        __syncthreads();
        if (tid < 256) { const unsigned c = lcnt[tid]; gb[tid] = c ? atomicAdd(&cnt[tid], c) : 0u; }
        __syncthreads();
        { const unsigned x = pk[2 * tid], d = pk[2 * tid + 1]; const unsigned ex = x & 255u, p = gb[ex] + (x >> 8);
          elist[(size_t)ex * T + p] = (int)(d >> 3); edst[(size_t)ex * T + p] = (int)d; }
        __syncthreads();
    }
}
constexpr int MOE_TB_OFF = 148480;
__device__ __forceinline__ void moe_tiles(Frame& F, const unsigned* cnt) {
    LAS int* tb = (LAS int*)(F.lds + MOE_TB_OFF); LAS int* cn = tb + 260;
    if (F.wave == 0) { const int lane = threadIdx.x & 63; int c[4], nt[4], s_ = 0;
#pragma unroll
        for (int e = 0; e < 4; ++e) { c[e] = (int)__hip_atomic_load(&cnt[4 * lane + e], __ATOMIC_RELAXED, __HIP_MEMORY_SCOPE_AGENT); nt[e] = (c[e] + 255) >> 8; s_ += nt[e]; }
        int inc = s_;
#pragma unroll
        for (int o = 1; o < 64; o <<= 1) { const int v = __shfl_up(inc, o); if (lane >= o) inc += v; }
        int ex = inc - s_;
#pragma unroll
        for (int e = 0; e < 4; ++e) { tb[4 * lane + e] = ex; cn[4 * lane + e] = c[e]; ex += nt[e]; }
        if (lane == 63) tb[256] = inc; }
    __syncthreads();
}
__device__ __forceinline__ void final_rows(Frame& F, const bf16* HBp, const bf16* SHY, const unsigned char* YR, const float* wts, const float* g, const float* b, float* out, bool use_moe) {
    const int gw = F.bid * NWAVES + F.wave, NGW = F.G * NWAVES, lane = ((int)(threadIdx.x & 63));
    f32x4 gv[4], bv[4];
#pragma unroll
    for (int j = 0; j < 4; ++j) { gv[j] = ((const f32x4*)g)[lane + 64 * j]; bv[j] = ((const f32x4*)b)[lane + 64 * j]; }
#define FR_LOAD(m_, H_, S_, W_, Y_) do { const int _m = (m_) < T ? (m_) : T - 1; const v2u* _xr = (const v2u*)(HBp + (size_t)_m * D) + lane; \
        _Pragma("unroll") for (int _j = 0; _j < 4; ++_j) H_[_j] = _xr[64 * _j]; \
        if (use_moe) { const v2u* _sr = (const v2u*)(SHY + (size_t)_m * D) + lane; _Pragma("unroll") for (int _j = 0; _j < 4; ++_j) S_[_j] = _sr[64 * _j]; \
            W_ = wts[_m * 8 + (lane & 7)]; \
            _Pragma("unroll") for (int _k = 0; _k < 8; ++_k) { const unsigned* _yr = (const unsigned*)(YR + ((size_t)_m * 8 + _k) * D) + lane; \
                _Pragma("unroll") for (int _j = 0; _j < 4; ++_j) Y_[_k * 4 + _j] = _yr[64 * _j]; } } } while (0)
    v2u hA[4], sA[4], hB[4], sB[4]; float wA = 0.f, wB = 0.f; unsigned yA[32], yB[32];
    if (gw < T) FR_LOAD(gw, hA, sA, wA, yA);
    for (int m = gw; m < T; m += NGW) {
        FR_LOAD(m + NGW, hB, sB, wB, yB);
        f32x4 v[4];
#pragma unroll
        for (int j = 0; j < 4; ++j) { const v2u x = hA[j]; v[j] = (f32x4){bflo(x.x), bfhi(x.x), bflo(x.y), bfhi(x.y)} * DN_ALPHA; }
        if (use_moe) {
#pragma unroll
            for (int j = 0; j < 4; ++j) { const v2u s = sA[j]; v[j][0] += bflo(s.x); v[j][1] += bfhi(s.x); v[j][2] += bflo(s.y); v[j][3] += bfhi(s.y); }
#pragma unroll
            for (int k = 0; k < 8; ++k) { const float w = __shfl(wA, k) * 0.0625f;
#pragma unroll
                for (int j = 0; j < 4; ++j) { const unsigned x = yA[k * 4 + j];
                    v[j][0] += w * __builtin_amdgcn_cvt_f32_fp8(x, 0); v[j][1] += w * __builtin_amdgcn_cvt_f32_fp8(x, 1); v[j][2] += w * __builtin_amdgcn_cvt_f32_fp8(x, 2); v[j][3] += w * __builtin_amdgcn_cvt_f32_fp8(x, 3); } }
        }
        float s = 0.f;
#pragma unroll
        for (int j = 0; j < 4; ++j) s += (v[j][0] + v[j][1]) + (v[j][2] + v[j][3]);
        const float mean = wave_sum(s) * (1.f / D); float s2 = 0.f;
#pragma unroll
        for (int j = 0; j < 4; ++j) { v[j] = v[j] - mean; s2 += (v[j][0] * v[j][0] + v[j][1] * v[j][1]) + (v[j][2] * v[j][2] + v[j][3] * v[j][3]); }
        const float rstd = 1.f / sqrtf(wave_sum(s2) * (1.f / D) + LN_EPS);
        __builtin_amdgcn_s_waitcnt(0x0F70);
        f32x4* o = (f32x4*)(out + (size_t)m * D) + lane;
#pragma unroll
        for (int j = 0; j < 4; ++j) o[64 * j] = v[j] * rstd * gv[j] + bv[j];
#pragma unroll
        for (int j = 0; j < 4; ++j) { hA[j] = hB[j]; sA[j] = sB[j]; }
        wA = wB;
#pragma unroll
        for (int i = 0; i < 32; ++i) yA[i] = yB[i];
    }
#undef FR_LOAD
}

enum Phase { PH_PROLOGUE = 0, PH_INPROJ, PH_PREP, PH_SCAN, PH_POST, PH_PROJ, PH_WOUT, PH_LN1, PH_ROUTER, PH_ROUTE, PH_EXP1, PH_EXP2, PH_FINAL, PH_COUNT };

__global__ void __launch_bounds__(NWAVES * 64, 2) mega_fwd(Args args) {
    extern __shared__ __attribute__((aligned(16))) unsigned char lds_raw[];
    Frame F;
    F.lds = (LAS unsigned char*)lds_raw;
    F.MISC = (volatile LAS unsigned*)(F.lds + MISC_OFF);
    F.wave = __builtin_amdgcn_readfirstlane(threadIdx.x >> 6);
    F.G = gridDim.x; F.bid = blockIdx.x; F.ws = args.ws; F.ctl = (unsigned*)(args.ws + WS_CTL);
    unsigned char* ws = args.ws;
    if (((int)threadIdx.x) < 64) F.MISC[((int)threadIdx.x)] = 0u;
    __syncthreads();
    XcdBarrier bar; bar.bar = F.ctl + CW_BAR; bar.x = 0; bar.st = nullptr; bar.gtot = 0;
    if (!N_LAUNCH_SPLIT) bar = xcd_barrier_post(F.ctl + CW_BAR, F.MISC + 8);
    XcdBarrier bar2; bar2.bar = F.ctl + CW_BAR2; bar2.x = 0; bar2.st = nullptr; bar2.gtot = 0;
    if (!N_LAUNCH_SPLIT && F.bid >= NSCAN + NWARM) { bar2 = xcd_barrier_post(F.ctl + CW_BAR2, F.MISC + 10); bar2.gtot = F.G - (NSCAN + NWARM); }
    const int lo = args.ph_lo, hi = args.ph_hi;
#define IN(k) (lo <= (k) && (k) < hi)
#define SEAM(k) do { if (IN(k) && IN((k) + 1)) xcd_barrier(bar); } while (0)

    if (IN(PH_PROLOGUE)) { p0_prologue(F, args, false, 0); }
    SEAM(PH_PROLOGUE);

#if STAGE >= 3
    if (IN(PH_INPROJ)) {
        constexpr int NGEMM = 153;
        if (F.bid < NGEMM) {
            pg8::DenseOrder S; S.init(T, NIN, D / 2, NGEMM, F.bid, (const bf16*)(ws + WS_WIN));
            EpiInProj E{ws, args.in[3], args.in[4]};
            pg8::gemm_phase<EpiInProj, pg8::DenseOrder, false, 5>(F.lds, ws + WS_XB, nullptr, D / 2, S, E);
        }
        expert_convert_queue(F, args);
    }
    SEAM(PH_INPROJ);
    if (IN(PH_PREP)) {
        gdn_prep_all(F, args);
    }
    SEAM(PH_PREP);
    if (IN(PH_SCAN)) {
        if (F.bid < NSCAN) gdn_scan2(F, F.bid);
        else if (F.bid < NSCAN + NWARM) gdn_scan_warm(F, F.bid - NSCAN);
#if STAGE >= 4
        else {
            {
                const int su = F.bid - (NSCAN + NWARM);
                if (su < 126 && F.G - (NSCAN + NWARM) >= 126) moba_select_unit(F, su & 1, 63 - (su >> 1));
                else if (F.G - (NSCAN + NWARM) >= 126) moba_own_queue(F);
                else for (int u = su; u < 128; u += F.G - (NSCAN + NWARM)) moba_select_unit(F, u & 1, 63 - (u >> 1));
            }
            xcd_barrier(bar2);
            moba_attn_queue(F);
            xcd_barrier(bar2);
            moba_combine(F, NSCAN + NWARM);
        }
#endif
    }
    SEAM(PH_SCAN);
    if (IN(PH_POST)) { gdn_ophase(F, args.in[5]); }
    SEAM(PH_POST);
    if (IN(PH_PROJ)) {
#if STAGE >= 4
        {
            pg8::DenseOrder S2; S2.init(T, D, D / 2, F.G, F.bid, (const bf16*)(ws + WS_WMP));
            EpiGate<false> E2{(bf16*)(ws + WS_MBUF), (const bf16*)(ws + WS_SGM), nullptr};
            pg8::gemm_phase<EpiGate<false>, pg8::DenseOrder, false, 6, 4>(F.lds, ws + WS_A2, nullptr, D / 2, S2, E2);
        }
#endif
        pg8::DenseOrder S; S.init(T, D, D / 2, F.G, F.bid, (const bf16*)(ws + WS_WGP));
#if STAGE >= 4
        EpiGate<true, true> E{(bf16*)(ws + WS_MBUF), (const bf16*)(ws + WS_SGG), ws + WS_OG + 16 * MiB};
        pg8::gemm_phase<EpiGate<true, true>, pg8::DenseOrder, false, 6, 0>(F.lds, ws + WS_OG, nullptr, D / 2, S, E);
#else
        EpiGate<false, true> E{(bf16*)(ws + WS_MBUF), (const bf16*)(ws + WS_SGG), ws + WS_OG + 16 * MiB};
        pg8::gemm_phase<EpiGate<false, true>, pg8::DenseOrder, false, 6, 0>(F.lds, ws + WS_OG, nullptr, D / 2, S, E);
#endif
    }
    SEAM(PH_PROJ);
    if (IN(PH_WOUT)) {
        pg8::DenseOrder S; S.init(T, D, D / 2, F.G, F.bid, (const bf16*)(ws + WS_WOUT));
        EpiBf16Res E{(bf16*)(ws + WS_HB), 1024, args.in[0], DN_ALPHA};
        pg8::gemm_phase<EpiBf16Res, pg8::DenseOrder, false, 6, 2>(F.lds, ws + WS_OG + 16 * MiB, nullptr, D / 2, S, E);
    }
#else
    SEAM(PH_INPROJ); SEAM(PH_PREP); SEAM(PH_SCAN); SEAM(PH_POST); SEAM(PH_PROJ);
    if (IN(PH_WOUT)) {
        const f32x4* x4 = (const f32x4*)args.in[0]; v2u* p4 = (v2u*)(ws + WS_HB); const size_t n4 = (size_t)T * D / 4;
        for (size_t i = (size_t)F.bid * 512 + threadIdx.x; i < n4; i += (size_t)F.G * 512) { const f32x4 x = x4[i] * DN_ALPHA; v2u o; o.x = pk2(x[0], x[1]); o.y = pk2(x[2], x[3]); p4[i] = o; }
    }
#endif
    SEAM(PH_WOUT);
    if (IN(PH_LN1)) { ln_rows(F, (bf16*)(ws + WS_HB), ws + WS_HB8, args.in[9], args.in[10]);
        if (F.bid == 0 && threadIdx.x < 64) ((v4u*)(ws + WS_HB8 + (size_t)T * D))[threadIdx.x] = (v4u){0u, 0u, 0u, 0u}; }
    SEAM(PH_LN1);
#if STAGE >= 2
    if (IN(PH_ROUTER)) {
        { pg8::SplitK2Order S; S.nM = T / 256; S.G = F.G; S.c = F.bid; S.Bt = (const char*)(ws + WS_ROUTER); S.khalfB = 1024;
          EpiF32Res E{(float*)(ws + WS_LOGITS2), 512, nullptr, 0.f};
          pg8::gemm_phase<EpiF32Res, pg8::SplitK2Order, false>(F.lds, (const bf16*)(ws + WS_HB), nullptr, D / 2, S, E, 2048u); }
        { pg8::DenseOrder S; S.init(T, 512, D / 2, F.G, (F.bid + 128) % F.G, (const bf16*)(ws + WS_SHGU));
          EpiSwiGLU E{(bf16*)(ws + WS_HS)};
          pg8::gemm_phase<EpiSwiGLU, pg8::DenseOrder, false, 5>(F.lds, ws + WS_HB8, nullptr, D / 2, S, E); }
    }
    SEAM(PH_ROUTER);
    if (IN(PH_ROUTE)) { moe_route(F, (const float*)(ws + WS_LOGITS2), args.in[12], (float*)(ws + WS_WTS), F.ctl + CW_MOE_CNT, (int*)(ws + WS_ELIST), (int*)(ws + WS_EDST)); }
    SEAM(PH_ROUTE);
    if (IN(PH_EXP1)) {
        moe_tiles(F, F.ctl + CW_MOE_CNT);
        { pg8::GroupOrder<2> S; S.G = F.G; S.c = F.bid; S.tb = (const LAS int*)(F.lds + MOE_TB_OFF); S.cn = S.tb + 260; S.W = (const char*)(ws + WS_EXPGU); S.estride = (size_t)512 * 1024; S.tstepB = (size_t)256 * 1024;
          EpiSwiGLU8 E{ws + WS_HEXP};
          pg8::gemm_phase<EpiSwiGLU8, pg8::GroupOrder<2>, true, 5>(F.lds, ws + WS_HB8, (const int*)(ws + WS_ELIST), D / 2, S, E); }
        { pg8::DenseOrder S; S.init(T, 1024, 256, F.G, F.bid, (const bf16*)(ws + WS_SHD));
          EpiBf16Plain E{(bf16*)(ws + WS_SHY), 1024};
          pg8::gemm_phase<EpiBf16Plain, pg8::DenseOrder, false>(F.lds, (const bf16*)(ws + WS_HS), nullptr, 256, S, E); }
    }
    SEAM(PH_EXP1);
    if (IN(PH_EXP2)) {
        moe_tiles(F, F.ctl + CW_MOE_CNT);
        pg8::GroupOrder<4> S; S.G = F.G; S.c = F.bid; S.tb = (const LAS int*)(F.lds + MOE_TB_OFF); S.cn = S.tb + 260; S.W = (const char*)(ws + WS_EXPD); S.estride = (size_t)1024 * 256; S.tstepB = (size_t)256 * 256;
        EpiScatter8 E{ws + WS_YR, (const int*)(ws + WS_EDST)};
        pg8::gemm_phase<EpiScatter8, pg8::GroupOrder<4>, false, 5, 2>(F.lds, ws + WS_HEXP, nullptr, 128 | (args.ph_lo >> 30), S, E);
    }
    SEAM(PH_EXP2);
#else
    SEAM(PH_ROUTER); SEAM(PH_ROUTE); SEAM(PH_EXP1); SEAM(PH_EXP2);
#endif
    if (IN(PH_FINAL)) {
        final_rows(F, (const bf16*)(ws + WS_HB), (const bf16*)(ws + WS_SHY), ws + WS_YR, (const float*)(ws + WS_WTS), args.in[19], args.in[20], args.out, STAGE >= 2);
    }
#undef IN
#undef SEAM
}

extern "C" void kernel_launch(void* const* d_in, const int* in_sizes, int n_in, void* d_out, int out_size, void* d_ws, size_t ws_size, hipStream_t stream) {
    static int grid = 0;
    if (grid == 0) {
        if (n_in != 21 || out_size != T * D || ws_size < WS_END) { fprintf(stderr, "kernel_launch: unexpected shapes (n_in %d out %d ws %zu)\n", n_in, out_size, ws_size); grid = -1; return; }
        int dev = 0, cus = 0, per_cu = 0;
        if (hipGetDevice(&dev) != hipSuccess || hipDeviceGetAttribute(&cus, hipDeviceAttributeMultiprocessorCount, dev) != hipSuccess) { grid = -1; return; }
        if (hipFuncSetAttribute((const void*)mega_fwd, hipFuncAttributeMaxDynamicSharedMemorySize, LDS_BYTES) != hipSuccess) { fprintf(stderr, "kernel_launch: hipFuncSetAttribute failed\n"); grid = -1; return; }
        if (hipOccupancyMaxActiveBlocksPerMultiprocessor(&per_cu, (const void*)mega_fwd, NWAVES * 64, LDS_BYTES) != hipSuccess || per_cu < 1) { fprintf(stderr, "kernel_launch: occupancy query says %d\n", per_cu); }
        (void)hipGetLastError();
        grid = cus;
    }
    if (grid < 0) return;
    (void)hipMemsetAsync((char*)d_ws + WS_CTL, 0, CTL_ZERO_BYTES, stream);
    Args a{};
    for (int i = 0; i < 21; ++i) a.in[i] = (const float*)d_in[i];
    a.out = (float*)d_out; a.ws = (unsigned char*)d_ws;
    for (int i = 0; i < 16; ++i) a.rope_inv[i] = powf(500000.0f, -(float)i / 16.0f);
#if N_LAUNCH_SPLIT
    for (int p = 0; p < PH_COUNT; ++p) { a.ph_lo = p; a.ph_hi = p + 1; hipLaunchKernelGGL(mega_fwd, dim3(grid), dim3(NWAVES * 64), LDS_BYTES, stream, a); }
#else
    a.ph_lo = 0; a.ph_hi = PH_COUNT;
    hipLaunchKernelGGL(mega_fwd, dim3(grid), dim3(NWAVES * 64), LDS_BYTES, stream, a);
#endif
}
```

```cpp
#include <hip/hip_runtime.h>
#include <cstdio>
#include <cstdint>
#include <cmath>

#ifndef STAGE
#define STAGE 4
#endif
#ifndef N_LAUNCH_SPLIT
#define N_LAUNCH_SPLIT 0
#endif

#define GAS __attribute__((address_space(1)))
#define LAS __attribute__((address_space(3)))
typedef unsigned short bf16;
typedef unsigned v4u __attribute__((ext_vector_type(4)));
typedef unsigned v2u __attribute__((ext_vector_type(2)));
typedef float f32x4 __attribute__((ext_vector_type(4)));
typedef float f32x2 __attribute__((ext_vector_type(2)));
typedef short bf16x8 __attribute__((ext_vector_type(8)));
typedef short bf16x4 __attribute__((ext_vector_type(4)));
#define LDS_WAIT() asm volatile("s_waitcnt lgkmcnt(0)" ::: "memory")
#define VM_WAIT() asm volatile("s_waitcnt vmcnt(0)" ::: "memory")

__device__ __forceinline__ unsigned f2bf(float f) { unsigned u = __builtin_bit_cast(unsigned, f); return (u + 0x7fffu + ((u >> 16) & 1u)) >> 16; }
__device__ __forceinline__ unsigned pk2(float lo, float hi) { return f2bf(lo) | (f2bf(hi) << 16); }
__device__ __forceinline__ float bf2f(unsigned b) { return __builtin_bit_cast(float, b << 16); }
__device__ __forceinline__ float bflo(unsigned w) { return __builtin_bit_cast(float, w << 16); }
__device__ __forceinline__ float bfhi(unsigned w) { return __builtin_bit_cast(float, w & 0xffff0000u); }
__device__ __forceinline__ unsigned pk4_fp8(float a, float b, float c, float d) { unsigned w = 0u; w = __builtin_amdgcn_cvt_pk_fp8_f32(a, b, w, false); w = __builtin_amdgcn_cvt_pk_fp8_f32(c, d, w, true); return w; }
__device__ __forceinline__ float sigmoidf_(float x) { return __builtin_amdgcn_rcpf(1.f + __builtin_amdgcn_exp2f(-1.4426950408889634f * x)); }
__device__ __forceinline__ float siluf_(float x) { return x * __builtin_amdgcn_rcpf(1.f + __builtin_amdgcn_exp2f(-1.4426950408889634f * x)); }
#define DPP_STEP(v, ctrl, rmask) ((v) + __builtin_bit_cast(float, __builtin_amdgcn_update_dpp(0, __builtin_bit_cast(int, (v)), (ctrl), (rmask), 0xf, false)))
#define DPP_STEP_I(v, ctrl, rmask) ((v) + __builtin_amdgcn_update_dpp(0, (v), (ctrl), (rmask), 0xf, false))
__device__ __forceinline__ int wave_scan_dpp(int v) {
    v = DPP_STEP_I(v, 0x111, 0xf); v = DPP_STEP_I(v, 0x112, 0xf); v = DPP_STEP_I(v, 0x114, 0xf); v = DPP_STEP_I(v, 0x118, 0xf); v = DPP_STEP_I(v, 0x142, 0xa); v = DPP_STEP_I(v, 0x143, 0xc);
    return v;
}
__device__ __forceinline__ float wave_sum_dpp(float v) {
    v = DPP_STEP(v, 0x111, 0xf); v = DPP_STEP(v, 0x112, 0xf); v = DPP_STEP(v, 0x114, 0xf); v = DPP_STEP(v, 0x118, 0xf);
    v = DPP_STEP(v, 0x142, 0xa);
    v = DPP_STEP(v, 0x143, 0xc);
    return __builtin_bit_cast(float, __builtin_amdgcn_readlane(__builtin_bit_cast(int, v), 63));
}

__device__ __forceinline__ float wave_sum(float v) { return wave_sum_dpp(v); }

constexpr int T = 16384, D = 1024;
constexpr int NIN = 7936;
constexpr int NEXP = 256, TOPK = 8, EDIM = 256;
constexpr int RMAX = T * TOPK + NEXP * 256;
constexpr float LN_EPS = 1e-5f;
constexpr float DN_ALPHA = 1.189207115002721f;

constexpr size_t MiB = 1u << 20;
constexpr size_t WS_CTL = 0, CTL_ZERO_BYTES = 1 * MiB;
constexpr size_t WS_ROPE = 1 * MiB;
constexpr size_t WS_GL = 3 * MiB;
constexpr size_t WS_EIDX = 4 * MiB;
constexpr size_t WS_WTS = 4 * MiB + 512 * 1024;
constexpr size_t WS_ROWTOK = 5 * MiB;
constexpr size_t WS_ROWDST = 6 * MiB;
constexpr size_t WS_TILEE = 7 * MiB;
constexpr size_t WS_WIN = 8 * MiB;
constexpr size_t WS_WGP = 24 * MiB, WS_WMP = 26 * MiB, WS_WOUT = 28 * MiB;
constexpr size_t WS_ROUTER = 30 * MiB;
constexpr size_t WS_SHGU = 30 * MiB + 512 * 1024;
constexpr size_t WS_SHD = 31 * MiB + 512 * 1024;
constexpr size_t WS_EXPGU = 32 * MiB;
constexpr size_t WS_EXPD = 288 * MiB;
constexpr size_t WS_XB = 416 * MiB;
constexpr size_t WS_CONVIN = 448 * MiB;
constexpr size_t WS_PO = 416 * MiB;
constexpr size_t WS_GG = 544 * MiB, WS_MQ = 576 * MiB, WS_MK = 608 * MiB, WS_MV = 616 * MiB, WS_SGG = 624 * MiB, WS_SGM = 656 * MiB;
constexpr size_t WS_BETA = 688 * MiB, WS_GLOG = 688 * MiB + 512 * 1024;
constexpr size_t WS_GDNP = 690 * MiB;
constexpr size_t WS_O = 834 * MiB;
constexpr size_t WS_LISTS = 898 * MiB, WS_LSE = 914 * MiB, WS_OG = 916 * MiB, WS_A2 = 948 * MiB, WS_MBUF = 980 * MiB;
constexpr size_t WS_HF = 690 * MiB;
constexpr size_t WS_HB = 754 * MiB;
constexpr size_t WS_LOGITS = 787 * MiB;
constexpr size_t WS_LOGITS2 = 544 * MiB;
constexpr size_t WS_HS = 808 * MiB;
constexpr size_t WS_SHY = 816 * MiB;
constexpr size_t WS_HEXP = 848 * MiB;
constexpr size_t WS_YR = 416 * MiB;
constexpr size_t WS_END = 1024 * MiB;
constexpr int CW_BAR = 4096;
constexpr int CW_MOBA_CNT = 8192, CW_QHEAD = 8448, CW_MOE_CNT = 8704, CW_MOE_FILL = 8960;
constexpr int CW_CONVQ = 9300;
constexpr int CW_BAR2 = 40960;
constexpr int CW_PROG = 32768;
constexpr int CW_KMEAN = 16384;

constexpr int LDS_BYTES = 155648;
constexpr int MISC_OFF = 153600;
constexpr int NWAVES = 8;

#define XB_TMO      128
#define XB_XCNT(j)  (256  + 64 * (j))
#define XB_XSUB(j)  (1280 + 64 * (j))
#define XB_XGEN(j)  (2304 + 64 * (j))
#define XB_TOP      3328
#define XB_TOPGEN   3392
#define XCD_BAR_WORDS 3456
#define XB_SPIN_CAP (1u << 18)
__device__ __forceinline__ unsigned xb_ld(unsigned* p)              { return __hip_atomic_load(p, __ATOMIC_RELAXED, __HIP_MEMORY_SCOPE_AGENT); }
__device__ __forceinline__ unsigned xb_add(unsigned* p, unsigned v) { return __hip_atomic_fetch_add(p, v, __ATOMIC_RELAXED, __HIP_MEMORY_SCOPE_AGENT); }
__device__ __forceinline__ unsigned xb_xcc_id() { return (unsigned)__builtin_amdgcn_s_getreg((3 << 11) | 20) & 0xFu; }
#define XB_SPIN(cond, bar) do { unsigned _sp = 0; while (cond) { __builtin_amdgcn_s_sleep(1); \
    if ((++_sp & 255u) == 0u) { if (xb_ld(&(bar)[XB_TMO])) break; if (_sp > XB_SPIN_CAP) { atomicAdd(&(bar)[XB_TMO], 1u); break; } } } } while (0)
struct XcdBarrier { unsigned* bar; unsigned x; volatile LAS unsigned* st; unsigned gtot; };
__device__ __forceinline__ XcdBarrier xcd_barrier_post(unsigned* bar, volatile LAS unsigned* st) {
    XcdBarrier b; b.bar = bar; b.x = xb_xcc_id(); b.st = st; b.gtot = gridDim.x * gridDim.y * gridDim.z;
    if (threadIdx.x == 0) (void)xb_add(&bar[XB_XCNT(b.x)], 1u);
    return b;
}
__device__ __forceinline__ void xcd_barrier_complete(unsigned* bar, unsigned x, unsigned& nloc, unsigned& nx, const unsigned G) {
    unsigned sum, cnt, mine, sp = 0u;
    for (;;) {
        sum = 0u; cnt = 0u; mine = 0u;
#pragma unroll
        for (unsigned j = 0; j < 16; ++j) { const unsigned c = xb_ld(&bar[XB_XCNT(j)]); sum += c; cnt += (c > 0u) ? 1u : 0u; mine = (j == x) ? c : mine; }
        if (sum == G) break;
        __builtin_amdgcn_s_sleep(1);
        if ((++sp & 255u) == 0u) { if (xb_ld(&bar[XB_TMO])) break; if (sp > XB_SPIN_CAP) { atomicAdd(&bar[XB_TMO], 1u); break; } }
    }
    nloc = mine > 0u ? mine : 1u; nx = cnt > 0u ? cnt : 1u;
}
__device__ __forceinline__ void xcd_barrier(const XcdBarrier& b) {
    asm volatile("s_waitcnt vmcnt(0)" ::: "memory");
    __syncthreads();
    if (threadIdx.x == 0) {
        unsigned* bar = b.bar;
        __builtin_amdgcn_s_waitcnt(0);
        unsigned nloc = b.st[0], nx = b.st[1];
        if (nloc == 0u) { xcd_barrier_complete(bar, b.x, nloc, nx, b.gtot); b.st[0] = nloc; b.st[1] = nx; }
        const unsigned old = xb_add(&bar[XB_XSUB(b.x)], 1u);
        const unsigned gen = old / nloc;
        if (old + 1u == (gen + 1u) * nloc) {
            __builtin_amdgcn_fence(__ATOMIC_RELEASE, "agent");
            asm volatile("s_waitcnt vmcnt(0)" ::: "memory");
            const unsigned og = xb_add(&bar[XB_TOP], 1u);
            const unsigned tg = og / nx;
            if (og + 1u == (tg + 1u) * nx) xb_add(&bar[XB_TOPGEN], 1u);
            else XB_SPIN(xb_ld(&bar[XB_TOPGEN]) == tg, bar);
            __builtin_amdgcn_fence(__ATOMIC_ACQUIRE, "agent");
            xb_add(&bar[XB_XGEN(b.x)], 1u);
            asm volatile("s_waitcnt vmcnt(0)" ::: "memory");
        } else {
            XB_SPIN(xb_ld(&bar[XB_XGEN(b.x)]) == gen, bar);
            __builtin_amdgcn_fence(__ATOMIC_ACQUIRE, "agent");
            asm volatile("s_waitcnt vmcnt(0)" ::: "memory");
        }
    }
    __syncthreads();
}

namespace pg8 {
typedef int v4i __attribute__((ext_vector_type(4)));
typedef int v8i __attribute__((ext_vector_type(8)));
constexpr int BM = 256, BK = 64, HALF = 128, HTB = HALF * BK * 2, STAGE_BYTES = 8 * HTB, NXCD = 8, WGM = 8;
__host__ __device__ __forceinline__ int lds_byte(int r, int c) { const int st = (r >> 4) * 2 + (c >> 5), rr = r & 15, cc = c & 31, ob = rr * 64 + cc * 2; return st * 1024 + (ob ^ (((ob >> 9) & 1) << 5)); }
__host__ __device__ __forceinline__ void stage_rc(int b, int& R, int& C) { const int st = b / 1024, sb = b % 1024, swz = sb ^ (((sb >> 9) & 1) << 5); R = (st >> 1) * 16 + swz / 64; C = (st & 1) * 32 + (swz % 64) / 2; }
__host__ __device__ __forceinline__ int perm32(int rho) { const int n = rho >> 4, i = rho & 15; return 8 * (i >> 2) + 4 * n + (i & 3); }

struct Unit { int pm, pn, arow0, aux, gbase, gcnt, acolb; const char* b; };

struct DenseOrder {
    int nM, nN, nwg, G, c; const char* Bt; size_t tstepB;
    __device__ void init(int M, int N, int K, int G_, int c_, const bf16* Bt_) { nM = M / BM; nN = N / BM; nwg = nM * nN; G = G_; c = c_; Bt = (const char*)Bt_; tstepB = (size_t)BM * K * 2; }
    __device__ bool next(int i, Unit& u) const {
        int wgid;
        if (G % NXCD == 0) { const int L = i * G + c; if (L >= nwg) return false;
            const int q = nwg / NXCD, r = nwg % NXCD, xcd = L % NXCD, off = L / NXCD; wgid = (xcd < r ? xcd * (q + 1) : r * (q + 1) + (xcd - r) * q) + off; }
        else {
            const int R = (nwg + G - 1) / G, x = c % NXCD, slot = c / NXCD, gq = G / NXCD, gr = G % NXCD, nx = gq + (x < gr ? 1 : 0), pre = x * gq + (x < gr ? x : gr);
            if (i >= R) return false;
            wgid = R * pre + i * nx + slot; if (wgid >= nwg) return false; }
        const int nig = WGM * nN, gid = wgid / nig, fm = gid * WGM, gsz = (nM - fm) < WGM ? (nM - fm) : WGM;
        u.pm = fm + ((wgid % nig) % gsz); u.pn = (wgid % nig) / gsz; u.arow0 = u.pm * BM; u.aux = 0; u.gbase = 0; u.gcnt = 0; u.acolb = 0; u.b = Bt + (size_t)u.pn * tstepB; return true;
    }
};
template <int NPN> struct GroupOrder {
    int G, c; const LAS int* tb; const LAS int* cn; const char* W; size_t estride, tstepB;
    __device__ bool next(int i, Unit& u) const {
        const int cc = (G % NXCD == 0) ? (c % NXCD) * (G / NXCD) + c / NXCD : c;
        const long L = (long)i * G + cc; if (L >= (long)tb[256] * NPN) return false;
        const int tile = (int)(L / NPN), pn = (int)(L % NPN);
        const int e = ((const LAS unsigned short*)(tb + 516))[tile];
        const int j = tile - tb[e];
        u.pm = tile; u.pn = pn; u.arow0 = tile * BM; u.aux = e; u.gbase = e * 16384 + j * BM; u.gcnt = cn[e] - j * BM; u.acolb = 0; u.b = W + (size_t)e * estride + (size_t)pn * tstepB; return true;
    }
};

struct SplitK2Order {
    static constexpr bool HALF_TILES = false;
    int nM, G, c; const char* Bt;
    int khalfB;
    __device__ bool next(int i, Unit& u) const {
        const int L = i * G + c; if (L >= 2 * nM) return false;
        u.pm = L >> 1; u.pn = L & 1; u.arow0 = u.pm * BM; u.aux = 0; u.gbase = 0; u.gcnt = 0; u.acolb = (L & 1) * khalfB; u.b = Bt + (size_t)(L & 1) * 256 * khalfB; return true;
    }
};

typedef __bf16 bf16v2_t __attribute__((ext_vector_type(2)));
__device__ __forceinline__ unsigned cvt_pk_bf16(float lo, float hi) { bf16v2_t v; v[0] = (__bf16)lo; v[1] = (__bf16)hi; return __builtin_bit_cast(unsigned, v); }

template <class Epi, class Sched, bool GATHER, int F8S = -1, int F8A = 0>
__device__ __forceinline__ void gemm_phase(LAS unsigned char* lds, const void* Abase, const int* rowmap, const int K, const Sched& S, const Epi& E, const unsigned strideA = 0u) {
    const int tid = threadIdx.x, wid = __builtin_amdgcn_readfirstlane(tid >> 6), lane = tid & 63, wr = wid >> 2, wc = wid & 3, fr = lane & 15, fq = lane >> 4;
    const int nt = K / BK;
    const unsigned rowB = (unsigned)K * 2u;
    const unsigned rowA = strideA ? strideA : rowB;
    int RA[2]; unsigned vA[2], voffB[2];
#pragma unroll
    for (int i = 0; i < 2; ++i) { int R, C; stage_rc(tid * 16 + i * 8192, R, C); const int Rb = Epi::PERM ? ((R & ~31) + perm32(R & 31)) : R;
        RA[i] = R; vA[i] = (unsigned)C * 2u; voffB[i] = (unsigned)(Rb * K + C) * 2u; }
    const size_t kstep = (size_t)(BK * 2);
    const size_t hstep = (size_t)HALF * K * 2;
    const unsigned ldsw = (unsigned)wid * 1024u;
    const int aoff0 = lds_byte(wr * 64 + fr, 8 * fq), boff0 = lds_byte(wc * 32 + fr, 8 * fq);
    constexpr int KOFF = 1024;
    const char* A0 = (const char*)Abase;
    unsigned VA[2][2];
#define PG8_SA(b, h) (((b) * 2 + (h)) * HTB)
#define PG8_SB(b, h) ((4 + (b) * 2 + (h)) * HTB)
#define PG8_STAGE_B(bufoff, gbase) do { _Pragma("unroll") for (int _i = 0; _i < 2; ++_i) \
        __builtin_amdgcn_global_load_lds((const unsigned*)((const char*)(gbase) + voffB[_i]), (LAS unsigned*)(lds + (bufoff) + ldsw + _i * 8192), 16, 0, 0); } while (0)
#define PG8_STAGE_A(bufoff, gbase, h) do { _Pragma("unroll") for (int _i = 0; _i < 2; ++_i) \
        __builtin_amdgcn_global_load_lds((const unsigned*)((const char*)(gbase) + VA[h][_i]), (LAS unsigned*)(lds + (bufoff) + ldsw + _i * 8192), 16, 0, 0); } while (0)
#define PG8_CAT(lo, hi) __builtin_shufflevector(__builtin_bit_cast(v4i, lo), __builtin_bit_cast(v4i, hi), 0, 1, 2, 3, 4, 5, 6, 7)
#define PG8_LO(x) __builtin_bit_cast(bf16x8, __builtin_shufflevector(x, x, 0, 1, 2, 3))
#define PG8_HI(x) __builtin_bit_cast(bf16x8, __builtin_shufflevector(x, x, 4, 5, 6, 7))
#define PG8_LDA(dst, b, h) do { _Pragma("unroll") for (int m = 0; m < 4; ++m) dst[m] = PG8_CAT(*(const LAS bf16x8*)(lds + PG8_SA(b, h) + aoff0 + m * 2048), *(const LAS bf16x8*)(lds + PG8_SA(b, h) + aoff0 + KOFF + m * 2048)); } while (0)
#define PG8_LDB(dst, b, h) do { _Pragma("unroll") for (int n = 0; n < 2; ++n) dst[n] = PG8_CAT(*(const LAS bf16x8*)(lds + PG8_SB(b, h) + boff0 + n * 2048), *(const LAS bf16x8*)(lds + PG8_SB(b, h) + boff0 + KOFF + n * 2048)); } while (0)
#define PG8_MMA(ai, bj, At, Bt) do { __builtin_amdgcn_s_setprio(1); _Pragma("unroll") for (int m = 0; m < 4; ++m) _Pragma("unroll") for (int n = 0; n < 2; ++n) { \
        if (F8S >= 0) acc[ai][bj][m][n] = __builtin_amdgcn_mfma_scale_f32_16x16x128_f8f6f4(Bt[n], At[m], acc[ai][bj][m][n], 0, 0, 0, (127 - (F8S >= 0 ? F8S : 0)) * 0x01010101, 0, (127 - F8A) * 0x01010101); \
        else { acc[ai][bj][m][n] = __builtin_amdgcn_mfma_f32_16x16x32_bf16(PG8_LO(Bt[n]), PG8_LO(At[m]), acc[ai][bj][m][n], 0, 0, 0); \
               acc[ai][bj][m][n] = __builtin_amdgcn_mfma_f32_16x16x32_bf16(PG8_HI(Bt[n]), PG8_HI(At[m]), acc[ai][bj][m][n], 0, 0, 0); } } \
        __builtin_amdgcn_s_setprio(0); } while (0)
#define PG8_WAIT_V(n) asm volatile("s_waitcnt vmcnt(" #n ")" ::: "memory")
#define PG8_WAIT_L(n) asm volatile("s_waitcnt lgkmcnt(" #n ")" ::: "memory")
#define PG8_BAR __builtin_amdgcn_s_barrier()
#define PG8_SCHED __builtin_amdgcn_sched_barrier(0)
#define PG8_AOFFS(u) do { _Pragma("unroll") for (int _h = 0; _h < 2; ++_h) _Pragma("unroll") for (int _i = 0; _i < 2; ++_i) \
        { const int _r = _h * HALF + RA[_i]; unsigned _row; if (GATHER) { const int _rc = _r < (u).gcnt ? _r : ((u).gcnt > 0 ? (u).gcnt - 1 : 0); const unsigned _m = (unsigned)rowmap[(u).gbase + _rc]; _row = (_r < (u).gcnt) ? _m : 16384u; } else _row = (unsigned)((u).arow0 + _r); VA[_h][_i] = _row * rowA + (unsigned)(u).acolb + vA[_i]; } } while (0)
    Unit cur, nxt; int ui = 0;
    if (!S.next(0, cur)) return;
    f32x4 acc[2][2][4][2];
#pragma unroll
    for (int a = 0; a < 2; ++a)
#pragma unroll
        for (int b = 0; b < 2; ++b)
#pragma unroll
            for (int m = 0; m < 4; ++m)
#pragma unroll
                for (int n = 0; n < 2; ++n) acc[a][b][m][n] = (f32x4){0.f, 0.f, 0.f, 0.f};
    v8i At[4], B0[2], B1[2];
    PG8_AOFFS(cur);
    const char* cA = A0;
    const char* cB = cur.b;
    PG8_STAGE_B(PG8_SB(0, 0), cB); PG8_STAGE_A(PG8_SA(0, 0), cA, 0); PG8_STAGE_B(PG8_SB(0, 1), cB + hstep); PG8_STAGE_A(PG8_SA(0, 1), cA, 1);
    if (wr == 1) PG8_BAR;
    PG8_WAIT_V(4); PG8_BAR;
    PG8_STAGE_B(PG8_SB(1, 0), cB + kstep); PG8_STAGE_A(PG8_SA(1, 0), cA + kstep, 0); PG8_STAGE_B(PG8_SB(1, 1), cB + hstep + kstep);
    PG8_WAIT_V(6); PG8_BAR;
    for (;;) {
        bool has_next = false; const char* nA = cA; const char* nB = cB;
#pragma unroll 1
        for (int t = 0; t < nt; t += 2) {
            const bool last = (t == nt - 2);
            if (last) { has_next = S.next(ui + 1, nxt); if (has_next) { nB = nxt.b; } }
            const char* a1 = cA + (size_t)(t + 1) * kstep;
            const char* a2 = last ? nA : cA + (size_t)(t + 2) * kstep; const char* b2 = last ? nB : cB + (size_t)(t + 2) * kstep;
            const char* a3 = a2 + kstep; const char* b3 = b2 + kstep;
            PG8_LDB(B0, 0, 0); PG8_SCHED; PG8_LDA(At, 0, 0); PG8_STAGE_A(PG8_SA(1, 1), a1, 1);
            PG8_WAIT_L(8); PG8_BAR; PG8_WAIT_L(0); PG8_MMA(0, 0, At, B0); PG8_BAR; PG8_SCHED;
            if (last && has_next) { PG8_AOFFS(nxt); }
            PG8_LDB(B1, 0, 1); PG8_STAGE_B(PG8_SB(0, 0), b2);
            PG8_BAR; PG8_WAIT_L(0); PG8_MMA(0, 1, At, B1); PG8_BAR;
            PG8_LDA(At, 0, 1); PG8_STAGE_A(PG8_SA(0, 0), a2, 0);
            PG8_BAR; PG8_WAIT_L(0); PG8_MMA(1, 0, At, B0); PG8_BAR; PG8_SCHED;
            PG8_STAGE_B(PG8_SB(0, 1), b2 + hstep);
            PG8_WAIT_V(6); PG8_BAR; PG8_MMA(1, 1, At, B1); PG8_BAR;
            PG8_LDB(B0, 1, 0); PG8_SCHED; PG8_LDA(At, 1, 0); PG8_STAGE_A(PG8_SA(0, 1), a2, 1);
            PG8_WAIT_L(8); PG8_BAR; PG8_WAIT_L(0); PG8_MMA(0, 0, At, B0); PG8_BAR; PG8_SCHED;
            PG8_LDB(B1, 1, 1); PG8_STAGE_B(PG8_SB(1, 0), b3);
            PG8_BAR; PG8_WAIT_L(0); PG8_MMA(0, 1, At, B1); PG8_BAR;
            PG8_LDA(At, 1, 1); PG8_STAGE_A(PG8_SA(1, 0), a3, 0);
            PG8_BAR; PG8_WAIT_L(0); PG8_MMA(1, 0, At, B0); PG8_BAR; PG8_SCHED;
            PG8_STAGE_B(PG8_SB(1, 1), b3 + hstep);
            PG8_WAIT_V(6); PG8_BAR; PG8_MMA(1, 1, At, B1); PG8_BAR;
        }
        E(acc, cur, wr, wc, fr, fq);
        if (!has_next) break;
#pragma unroll
        for (int a = 0; a < 2; ++a)
#pragma unroll
            for (int b = 0; b < 2; ++b)
#pragma unroll
                for (int m = 0; m < 4; ++m)
#pragma unroll
                    for (int n = 0; n < 2; ++n) acc[a][b][m][n] = (f32x4){0.f, 0.f, 0.f, 0.f};
        cur = nxt; cA = nA; cB = nB; ++ui;
    }
    PG8_WAIT_V(0);
    if (wr == 0) PG8_BAR;
    PG8_BAR;
#undef PG8_SA
#undef PG8_SB
#undef PG8_STAGE_A
#undef PG8_STAGE_B
#undef PG8_LDA
#undef PG8_CAT
#undef PG8_LO
#undef PG8_HI
#undef PG8_LDB
#undef PG8_MMA
#undef PG8_WAIT_V
#undef PG8_WAIT_L
#undef PG8_BAR
#undef PG8_SCHED
#undef PG8_AOFFS
}
}

struct EpiF32Res {
    static constexpr bool PERM = false;
    float* C; int ldc; const float* res; float alpha;
    __device__ __forceinline__ void operator()(const f32x4 (&acc)[2][2][4][2], const pg8::Unit& u, int wr, int wc, int fr, int fq) const {
        const int row0 = u.pm * 256 + wr * 64 + fr, col0 = u.pn * 256 + wc * 32 + 4 * fq;
#pragma unroll
        for (int ai = 0; ai < 2; ++ai)
#pragma unroll
            for (int m = 0; m < 4; ++m) { const size_t ro = (size_t)(row0 + ai * 128 + m * 16) * ldc + col0;
#pragma unroll
                for (int bj = 0; bj < 2; ++bj)
#pragma unroll
                    for (int n = 0; n < 2; ++n) { f32x4 v = acc[ai][bj][m][n];
                        if (res) { const f32x4 r = *(const f32x4*)(res + ro + bj * 128 + n * 16); v = v + r * alpha; }
                        *(f32x4*)(C + ro + bj * 128 + n * 16) = v; } }
    }
};
struct EpiBf16Res {
    static constexpr bool PERM = true;
    bf16* O; int ldc; const float* res; float alpha;
    __device__ __forceinline__ void operator()(const f32x4 (&acc)[2][2][4][2], const pg8::Unit& u, int wr, int wc, int fr, int fq) const {
        const int row0 = u.pm * 256 + wr * 64 + fr, col0 = u.pn * 256 + wc * 32 + 8 * fq;
        f32x4 r[2][4][2];
#define EB_RO(st, g) ((size_t)(row0 + ((st) >> 1) * 128 + (2 * ((st) & 1) + ((g) >> 1)) * 16) * ldc + col0 + ((g) & 1) * 128)
#define EB_LOAD(st) do { _Pragma("unroll") for (int _g = 0; _g < 4; ++_g) { const float* _p = res + EB_RO(st, _g); r[(st) & 1][_g][0] = *(const f32x4*)_p; r[(st) & 1][_g][1] = *(const f32x4*)(_p + 4); } } while (0)
#define EB_STORE(st) do { _Pragma("unroll") for (int _g = 0; _g < 4; ++_g) { const int _ai = (st) >> 1, _m = 2 * ((st) & 1) + (_g >> 1), _bj = _g & 1; \
            const f32x4 v0 = acc[_ai][_bj][_m][0] + r[(st) & 1][_g][0] * alpha, v1 = acc[_ai][_bj][_m][1] + r[(st) & 1][_g][1] * alpha; \
            v4u o; o.x = pg8::cvt_pk_bf16(v0[0], v0[1]); o.y = pg8::cvt_pk_bf16(v0[2], v0[3]); o.z = pg8::cvt_pk_bf16(v1[0], v1[1]); o.w = pg8::cvt_pk_bf16(v1[2], v1[3]); \
            *(v4u*)(O + EB_RO(st, _g)) = o; } } while (0)
        EB_LOAD(0); EB_LOAD(1);
        EB_STORE(0); EB_LOAD(2);
        EB_STORE(1); EB_LOAD(3);
        EB_STORE(2); EB_STORE(3);
#undef EB_RO
#undef EB_LOAD
#undef EB_STORE
    }
};
struct EpiBf16Plain {
    static constexpr bool PERM = true;
    bf16* O; int ldc;
    __device__ __forceinline__ void operator()(const f32x4 (&acc)[2][2][4][2], const pg8::Unit& u, int wr, int wc, int fr, int fq) const {
        const int row0 = u.pm * 256 + wr * 64 + fr, col0 = u.pn * 256 + wc * 32 + 8 * fq;
#pragma unroll
        for (int ai = 0; ai < 2; ++ai)
#pragma unroll
            for (int m = 0; m < 4; ++m) { bf16* rowp = O + (size_t)(row0 + ai * 128 + m * 16) * ldc + col0;
#pragma unroll
                for (int bj = 0; bj < 2; ++bj) { const f32x4 v0 = acc[ai][bj][m][0], v1 = acc[ai][bj][m][1];
                    v4u o; o.x = pg8::cvt_pk_bf16(v0[0], v0[1]); o.y = pg8::cvt_pk_bf16(v0[2], v0[3]); o.z = pg8::cvt_pk_bf16(v1[0], v1[1]); o.w = pg8::cvt_pk_bf16(v1[2], v1[3]);
                    *(v4u*)(rowp + bj * 128) = o; } }
    }
};
struct EpiSwiGLU {
    static constexpr bool PERM = true;
    bf16* H;
    __device__ __forceinline__ void operator()(const f32x4 (&acc)[2][2][4][2], const pg8::Unit& u, int wr, int wc, int fr, int fq) const {
        const int row0 = u.pm * 256 + wr * 64 + fr, col0 = u.pn * 128 + wc * 32 + 8 * fq;
#pragma unroll
        for (int ai = 0; ai < 2; ++ai)
#pragma unroll
            for (int m = 0; m < 4; ++m) { bf16* rowp = H + (size_t)(row0 + ai * 128 + m * 16) * 256 + col0;
                const f32x4 g0 = acc[ai][0][m][0], g1 = acc[ai][0][m][1], u0 = acc[ai][1][m][0], u1 = acc[ai][1][m][1];
                float h[8];
#pragma unroll
                for (int e = 0; e < 4; ++e) { h[e] = siluf_(g0[e]) * u0[e]; h[4 + e] = siluf_(g1[e]) * u1[e]; }
                v4u o; o.x = pg8::cvt_pk_bf16(h[0], h[1]); o.y = pg8::cvt_pk_bf16(h[2], h[3]); o.z = pg8::cvt_pk_bf16(h[4], h[5]); o.w = pg8::cvt_pk_bf16(h[6], h[7]);
                *(v4u*)rowp = o; }
    }
};
struct EpiSwiGLU8 {
    static constexpr bool PERM = true;
    unsigned char* H;
    __device__ __forceinline__ void operator()(const f32x4 (&acc)[2][2][4][2], const pg8::Unit& u, int wr, int wc, int fr, int fq) const {
        const int row0 = u.pm * 256 + wr * 64 + fr, col0 = u.pn * 128 + wc * 32 + 8 * fq;
#pragma unroll
        for (int ai = 0; ai < 2; ++ai)
#pragma unroll
            for (int m = 0; m < 4; ++m) { unsigned char* rowp = H + (size_t)(row0 + ai * 128 + m * 16) * 256 + col0;
                const f32x4 g0 = acc[ai][0][m][0], g1 = acc[ai][0][m][1], u0 = acc[ai][1][m][0], u1 = acc[ai][1][m][1];
                float h[8];
#pragma unroll
                for (int e = 0; e < 4; ++e) { h[e] = 4.f * siluf_(g0[e]) * u0[e]; h[4 + e] = 4.f * siluf_(g1[e]) * u1[e]; }
                v2u o; o.x = pk4_fp8(h[0], h[1], h[2], h[3]); o.y = pk4_fp8(h[4], h[5], h[6], h[7]);
                *(v2u*)rowp = o; }
    }
};
struct EpiScatter8 {
    static constexpr bool PERM = true;
    unsigned char* Y; const int* rowdst;
    __device__ __forceinline__ void operator()(const f32x4 (&acc)[2][2][4][2], const pg8::Unit& u, int wr, int wc, int fr, int fq) const {
        const int r0 = wr * 64 + fr, col0 = u.pn * 256 + wc * 32 + 8 * fq;
        unsigned dst[8];
#pragma unroll
        for (int i = 0; i < 8; ++i) { const int rr = r0 + (i >> 2) * 128 + (i & 3) * 16; const int rc = rr < u.gcnt ? rr : (u.gcnt > 0 ? u.gcnt - 1 : 0); const unsigned dd = (unsigned)rowdst[u.gbase + rc]; dst[i] = (rr < u.gcnt) ? dd : 131072u; }
#pragma unroll
        for (int ai = 0; ai < 2; ++ai)
#pragma unroll
            for (int m = 0; m < 4; ++m) { unsigned char* rowp = Y + (size_t)dst[ai * 4 + m] * 1024 + col0;
#pragma unroll
                for (int bj = 0; bj < 2; ++bj) { const f32x4 v0 = acc[ai][bj][m][0] * 16.f, v1 = acc[ai][bj][m][1] * 16.f;
                    v2u o; o.x = pk4_fp8(v0[0], v0[1], v0[2], v0[3]); o.y = pk4_fp8(v1[0], v1[1], v1[2], v1[3]);
                    *(v2u*)(rowp + bj * 128) = o; } }
    }
};
struct EpiScatter {
    static constexpr bool PERM = true;
    bf16* Y; const int* rowdst;
    __device__ __forceinline__ void operator()(const f32x4 (&acc)[2][2][4][2], const pg8::Unit& u, int wr, int wc, int fr, int fq) const {
        const int r0 = wr * 64 + fr, col0 = u.pn * 256 + wc * 32 + 8 * fq;
        unsigned dst[8];
#pragma unroll
        for (int i = 0; i < 8; ++i) { const int rr = r0 + (i >> 2) * 128 + (i & 3) * 16; const int rc = rr < u.gcnt ? rr : (u.gcnt > 0 ? u.gcnt - 1 : 0); const unsigned dd = (unsigned)rowdst[u.gbase + rc]; dst[i] = (rr < u.gcnt) ? dd : 131072u; }
#pragma unroll
        for (int ai = 0; ai < 2; ++ai)
#pragma unroll
            for (int m = 0; m < 4; ++m) { bf16* rowp = Y + (size_t)dst[ai * 4 + m] * 1024 + col0;
#pragma unroll
                for (int bj = 0; bj < 2; ++bj) { const f32x4 v0 = acc[ai][bj][m][0], v1 = acc[ai][bj][m][1];
                    v4u o; o.x = pg8::cvt_pk_bf16(v0[0], v0[1]); o.y = pg8::cvt_pk_bf16(v0[2], v0[3]); o.z = pg8::cvt_pk_bf16(v1[0], v1[1]); o.w = pg8::cvt_pk_bf16(v1[2], v1[3]);
                    *(v4u*)(rowp + bj * 128) = o; } }
    }
};

struct Args { const float* in[21]; float* out; unsigned char* ws; float rope_inv[16]; int ph_lo, ph_hi; };
struct Frame {
    LAS unsigned char* lds; volatile LAS unsigned* MISC; unsigned* ctl; unsigned char* ws;
    int wave, G, bid;
};

__device__ __forceinline__ void transpose_item(const float* src, int ld, int k0, int n0, int nvalid, bf16* dst, int lddst, int dst_row0, LAS float* scr, int lane) {
    const int n4 = 4 * (lane & 15), kq = lane >> 4;
    f32x4 v[16];
#pragma unroll
    for (int i = 0; i < 16; ++i) v[i] = (n4 < nvalid) ? *(const f32x4*)(src + (size_t)(k0 + kq + 4 * i) * ld + n0 + n4) : (f32x4){0.f, 0.f, 0.f, 0.f};
#pragma unroll
    for (int i = 0; i < 16; ++i) { LAS float* p = scr + (kq + 4 * i) * 65 + n4; p[0] = v[i][0]; p[1] = v[i][1]; p[2] = v[i][2]; p[3] = v[i][3]; }
    LDS_WAIT(); asm volatile("" ::: "memory");
    const int c = lane & 7;
#pragma unroll
    for (int j = 0; j < 8; ++j) { const int nn = (lane >> 3) + 8 * j; const LAS float* s = scr + (8 * c) * 65 + nn;
        v4u o; o.x = pk2(s[0 * 65], s[1 * 65]); o.y = pk2(s[2 * 65], s[3 * 65]); o.z = pk2(s[4 * 65], s[5 * 65]); o.w = pk2(s[6 * 65], s[7 * 65]);
        *(v4u*)(dst + (size_t)(dst_row0 + nn) * lddst + k0 + 8 * c) = o; }
    LDS_WAIT(); asm volatile("" ::: "memory");
}
__device__ __forceinline__ void transpose_item8(const float* src, int ld, int k0, int n0, int nvalid, unsigned char* dst, int lddst, int dst_row0, float scale, LAS float* scr, int lane) {
    const int n4 = 4 * (lane & 15), kq = lane >> 4;
    f32x4 v[16];
#pragma unroll
    for (int i = 0; i < 16; ++i) v[i] = (n4 < nvalid) ? *(const f32x4*)(src + (size_t)(k0 + kq + 4 * i) * ld + n0 + n4) : (f32x4){0.f, 0.f, 0.f, 0.f};
#pragma unroll
    for (int i = 0; i < 16; ++i) { LAS float* p = scr + (kq + 4 * i) * 65 + n4; p[0] = v[i][0] * scale; p[1] = v[i][1] * scale; p[2] = v[i][2] * scale; p[3] = v[i][3] * scale; }
    LDS_WAIT(); asm volatile("" ::: "memory");
    const int c = lane & 7;
#pragma unroll
    for (int j = 0; j < 8; ++j) { const int nn = (lane >> 3) + 8 * j; const LAS float* s = scr + (8 * c) * 65 + nn;
        v2u o; o.x = pk4_fp8(s[0 * 65], s[1 * 65], s[2 * 65], s[3 * 65]); o.y = pk4_fp8(s[4 * 65], s[5 * 65], s[6 * 65], s[7 * 65]);
        *(v2u*)(dst + (size_t)(dst_row0 + nn) * lddst + k0 + 8 * c) = o; }
    LDS_WAIT(); asm volatile("" ::: "memory");
}
__device__ __forceinline__ int gu_row(int n, int is_up) { return (n >> 7) * 256 + is_up * 128 + (n & 127); }

__device__ __forceinline__ void p0_prologue(Frame& F, const Args& a, const bool experts, const int wg0) {
    LAS float* scr = (LAS float*)(F.lds + F.wave * 16896);
    const int gw = (F.bid - wg0) * NWAVES + F.wave, NGW = (F.G - wg0) * NWAVES;
    unsigned char* ws = F.ws;
    constexpr int I_IN = 16 * (NIN / 64), I_SQ = 16 * 16, I_RT = 16 * 4, I_SH = 16 * 4, I_SD = 4 * 16, I_EX = 64;
    constexpr int NSMALL = I_IN + 3 * I_SQ + I_RT + 2 * I_SH + I_SD;
    const int ln = (int)(threadIdx.x & 63);
    const int it0 = experts ? NSMALL : 0, it1 = experts ? NSMALL + NEXP * 3 * I_EX : NSMALL;
    for (int it = it0 + gw; it < it1; it += NGW) {
        int r = it;
        if (r < I_IN) { const int nblk = NIN / 64, kb = r / nblk, nb = r % nblk, j0 = nb * 64;
            int n0, nv; if (j0 < 4096) { n0 = j0; nv = 64; } else if (j0 < 7680) { n0 = j0 + 16; nv = 64; } else if (j0 == 7680) { n0 = 4096; nv = 16; } else { n0 = 0; nv = 0; }
            transpose_item8(a.in[1], 7696, kb * 64, n0, nv, ws + WS_WIN, 1024, j0, 32.f, scr, ln); continue; } r -= I_IN;
        if (r < 3 * I_SQ) { const int w = r / I_SQ, q = r % I_SQ, kb = q / 16, nb = q % 16;
            transpose_item8(a.in[6 + w], 1024, kb * 64, nb * 64, 64, ws + (w == 0 ? WS_WGP : (w == 1 ? WS_WMP : WS_WOUT)), 1024, nb * 64, 64.f, scr, ln); continue; } r -= 3 * I_SQ;
        if (r < I_RT) { const int kb = r / 4, nb = r % 4, hf = kb >> 3;
            transpose_item(a.in[11], 256, kb * 64, nb * 64, 64, (bf16*)(ws + WS_ROUTER), 512, hf * 256 + nb * 64 - hf, scr, ln); continue; } r -= I_RT;
        if (r < 2 * I_SH) { const int up = r / I_SH, q = r % I_SH, kb = q / 4, nb = q % 4;
            transpose_item8(a.in[16 + up], 256, kb * 64, nb * 64, 64, ws + WS_SHGU, 1024, gu_row(nb * 64, up), 32.f, scr, ln); continue; } r -= 2 * I_SH;
        if (r < I_SD) { const int kb = r / 16, nb = r % 16; transpose_item(a.in[18], 1024, kb * 64, nb * 64, 64, (bf16*)(ws + WS_SHD), 256, nb * 64, scr, ln); continue; } r -= I_SD;
        { const int e = r / (3 * I_EX), q = r % (3 * I_EX), w = q / I_EX, p = q % I_EX;
            if (w < 2) { const int kb = p / 4, nb = p % 4;
                transpose_item8(a.in[13 + w] + (size_t)e * 1024 * 256, 256, kb * 64, nb * 64, 64, ws + WS_EXPGU + (size_t)e * 512 * 1024, 1024, gu_row(nb * 64, w), 32.f, scr, ln); }
            else { const int kb = p / 16, nb = p % 16;
                transpose_item8(a.in[15] + (size_t)e * 256 * 1024, 1024, kb * 64, nb * 64, 64, ws + WS_EXPD + (size_t)e * 1024 * 256, 256, nb * 64, 32.f, scr, ln); } }
    }
    if (experts) return;
    { const f32x4* x4 = (const f32x4*)a.in[0]; v2u* xb = (v2u*)(ws + WS_XB); const size_t n8 = (size_t)T * D / 8;
        for (size_t i = (size_t)F.bid * 512 + threadIdx.x; i < n8; i += (size_t)F.G * 512) { const f32x4 p = x4[2 * i], q = x4[2 * i + 1];
            v2u o; o.x = pk4_fp8(p[0], p[1], p[2], p[3]); o.y = pk4_fp8(q[0], q[1], q[2], q[3]); xb[i] = o; } }
    { _Float16* rope = (_Float16*)(ws + WS_ROPE);
        for (int idx = F.bid * 512 + ((int)threadIdx.x); idx < T * 16; idx += F.G * 512) { const int t = idx >> 4, i = idx & 15;
            const float angf = (float)t * a.rope_inv[i]; double ang = (double)angf;
            const double TWO_PI = 6.283185307179586476925, PI = 3.14159265358979323846;
            const double kq = __builtin_rint(ang / TWO_PI); double rr = ang - kq * TWO_PI; double cs = 1.0;
            if (rr > 0.5 * PI) { rr = PI - rr; cs = -1.0; } else if (rr < -0.5 * PI) { rr = -PI - rr; cs = -1.0; }
            const double r2 = rr * rr;
            double s = 1.0 / 355687428096000.0;
            s = s * (-r2) + 1.0 / 1307674368000.0; s = s * (-r2) + 1.0 / 6227020800.0; s = s * (-r2) + 1.0 / 39916800.0; s = s * (-r2) + 1.0 / 362880.0;
            s = s * (-r2) + 1.0 / 5040.0; s = s * (-r2) + 1.0 / 120.0; s = s * (-r2) + 1.0 / 6.0; s = s * (-r2) + 1.0; s *= rr;
            double c = 1.0 / 20922789888000.0;
            c = c * (-r2) + 1.0 / 87178291200.0; c = c * (-r2) + 1.0 / 479001600.0; c = c * (-r2) + 1.0 / 3628800.0; c = c * (-r2) + 1.0 / 40320.0;
            c = c * (-r2) + 1.0 / 720.0; c = c * (-r2) + 1.0 / 24.0; c = c * (-r2) + 0.5; c = c * (-r2) + 1.0; c *= cs;
            rope[t * 32 + i] = (_Float16)c; rope[t * 32 + 16 + i] = (_Float16)s; } }
    if (F.bid == 0 && ((int)threadIdx.x) < 128) ((v4u*)(ws + WS_HB + (size_t)T * D * 2))[((int)threadIdx.x)] = (v4u){0u, 0u, 0u, 0u};
}

__device__ __forceinline__ void expert_convert_queue(Frame& F, const Args& a) {
    LAS float* scr = (LAS float*)(F.lds + F.wave * 16896);
    const int lane = (int)(threadIdx.x & 63); unsigned char* ws = F.ws;
    constexpr int I_EX = 64, NIT = NEXP * 3 * I_EX, CH = 8;
    const int n4 = 4 * (lane & 15), kq = lane >> 4, c8 = lane & 7;
#define EX_LOAD(V, r_) do { const int _e = (r_) / (3 * I_EX), _q = (r_) % (3 * I_EX), _w = _q / I_EX, _p = _q % I_EX; const float* _s; int _ld, _k0, _n0; \
        if (_w < 2) { _s = a.in[13 + _w] + (size_t)_e * 1024 * 256; _ld = 256; _k0 = (_p / 4) * 64; _n0 = (_p % 4) * 64; } \
        else { _s = a.in[15] + (size_t)_e * 256 * 1024; _ld = 1024; _k0 = (_p / 16) * 64; _n0 = (_p % 16) * 64; } \
        _Pragma("unroll") for (int _i = 0; _i < 16; ++_i) V[_i] = __builtin_nontemporal_load((const f32x4*)(_s + (size_t)(_k0 + kq + 4 * _i) * _ld + _n0 + n4)); } while (0)
#define EX_PROC(V, r_) do { const int _e = (r_) / (3 * I_EX), _q = (r_) % (3 * I_EX), _w = _q / I_EX, _p = _q % I_EX; unsigned char* _dst; int _lddst, _row0, _k0; \
        if (_w < 2) { _dst = ws + WS_EXPGU + (size_t)_e * 512 * 1024; _lddst = 1024; _row0 = gu_row((_p % 4) * 64, _w); _k0 = (_p / 4) * 64; } \
        else { _dst = ws + WS_EXPD + (size_t)_e * 1024 * 256; _lddst = 256; _row0 = (_p % 16) * 64; _k0 = (_p / 16) * 64; } \
        _Pragma("unroll") for (int _i = 0; _i < 16; ++_i) { LAS float* _pp = scr + (kq + 4 * _i) * 65 + n4; _pp[0] = V[_i][0] * 32.f; _pp[1] = V[_i][1] * 32.f; _pp[2] = V[_i][2] * 32.f; _pp[3] = V[_i][3] * 32.f; } \
        LDS_WAIT(); asm volatile("" ::: "memory"); \
        _Pragma("unroll") for (int _j = 0; _j < 8; ++_j) { const int _nn = (lane >> 3) + 8 * _j; const LAS float* _sp = scr + (8 * c8) * 65 + _nn; \
            v2u _o; _o.x = pk4_fp8(_sp[0 * 65], _sp[1 * 65], _sp[2 * 65], _sp[3 * 65]); _o.y = pk4_fp8(_sp[4 * 65], _sp[5 * 65], _sp[6 * 65], _sp[7 * 65]); \
            __builtin_nontemporal_store(_o, (v2u*)(_dst + (size_t)(_row0 + _nn) * _lddst + _k0 + 8 * c8)); } \
        LDS_WAIT(); asm volatile("" ::: "memory"); } while (0)
    for (;;) {
        unsigned nxt = 0u;
        if (lane == 0) nxt = atomicAdd(&F.ctl[CW_CONVQ], (unsigned)CH);
        const int r0 = __builtin_amdgcn_readfirstlane((int)nxt);
        if (r0 >= NIT) break;
#pragma unroll 1
        for (int r = r0; r < r0 + CH; r += 2) {
            f32x4 va[16], vb[16];
            EX_LOAD(va, r); EX_LOAD(vb, r + 1);
            EX_PROC(va, r); EX_PROC(vb, r + 1);
        }
    }
#undef EX_LOAD
#undef EX_PROC
}

__device__ __forceinline__ void ln_rows(Frame& F, bf16* XB_, unsigned char* X8, const float* g, const float* b) {
    const int gw = F.bid * NWAVES + F.wave, NGW = F.G * NWAVES, lane = (int)(threadIdx.x & 63);
    f32x4 gv[4], bv[4];
#pragma unroll
    for (int j = 0; j < 4; ++j) { gv[j] = ((const f32x4*)g)[lane + 64 * j]; bv[j] = ((const f32x4*)b)[lane + 64 * j]; }
    for (int m0 = gw; m0 < T; m0 += 4 * NGW) {
        v2u x[4][4];
#pragma unroll
        for (int k = 0; k < 4; ++k) { const int mk = (m0 + k * NGW < T) ? m0 + k * NGW : T - 1; const v2u* xr = (const v2u*)(XB_ + (size_t)mk * D) + lane;
#pragma unroll
            for (int j = 0; j < 4; ++j) x[k][j] = xr[64 * j]; }
#pragma unroll
        for (int k = 0; k < 4; ++k) { const int m = m0 + k * NGW;
            f32x4 v[4]; float s = 0.f;
#pragma unroll
            for (int j = 0; j < 4; ++j) { v[j] = (f32x4){bflo(x[k][j].x), bfhi(x[k][j].x), bflo(x[k][j].y), bfhi(x[k][j].y)}; s += (v[j][0] + v[j][1]) + (v[j][2] + v[j][3]); }
            const float mean = wave_sum(s) * (1.f / D); float s2 = 0.f;
#pragma unroll
            for (int j = 0; j < 4; ++j) { v[j] = v[j] - mean; s2 += (v[j][0] * v[j][0] + v[j][1] * v[j][1]) + (v[j][2] * v[j][2] + v[j][3] * v[j][3]); }
            const float rstd = 1.f / sqrtf(wave_sum(s2) * (1.f / D) + LN_EPS);
            if (k == 0) __builtin_amdgcn_s_waitcnt(0x0F70);
            if (m < T) { v2u* xw = (v2u*)(XB_ + (size_t)m * D) + lane;
#pragma unroll
                for (int j = 0; j < 4; ++j) { const f32x4 y = v[j] * rstd * gv[j] + bv[j];
                    v2u o; o.x = pk2(y[0], y[1]); o.y = pk2(y[2], y[3]); xw[64 * j] = o;
                    ((unsigned*)(X8 + (size_t)m * D))[lane + 64 * j] = pk4_fp8(y[0], y[1], y[2], y[3]); } }
        }
    }
}

__device__ __forceinline__ bf16x8 pack8(const f32x4 a, const f32x4 b) {
    v4u o; o.x = pg8::cvt_pk_bf16(a[0], a[1]); o.y = pg8::cvt_pk_bf16(a[2], a[3]); o.z = pg8::cvt_pk_bf16(b[0], b[1]); o.w = pg8::cvt_pk_bf16(b[2], b[3]);
    return __builtin_bit_cast(bf16x8, o);
}
__device__ __forceinline__ f32x4 mfma16(const bf16x8 a, const bf16x8 b, const f32x4 c) { return __builtin_amdgcn_mfma_f32_16x16x32_bf16(a, b, c, 0, 0, 0); }
__device__ __forceinline__ float softplusf_(float x) { return fmaxf(x, 0.f) + log1pf(expf(-fabsf(x))); }

constexpr float MB_QSCALE = 0.08838834764831845f * 1.4426950408889634f;
struct EpiInProj {
    static constexpr bool PERM = true;
    unsigned char* ws; const float* a_log; const float* dt_bias;
    __device__ __forceinline__ void operator()(const f32x4 (&acc)[2][2][4][2], const pg8::Unit& u, int wr, int wc, int fr, int fq) const {
        const int pn = u.pn, row0 = u.pm * 256 + wr * 64 + fr, colt = wc * 32 + 8 * fq;
        if (pn == 30) {
            if (wc == 0 && fq < 2) {
                float al[8], db[8];
#pragma unroll
                for (int j = 0; j < 8; ++j) { al[j] = -expf(a_log[j]); db[j] = dt_bias[j]; }
#pragma unroll
                for (int ai = 0; ai < 2; ++ai)
#pragma unroll
                    for (int m = 0; m < 4; ++m) { const int row = row0 + ai * 128 + m * 16; const f32x4 v0 = acc[ai][0][m][0], v1 = acc[ai][0][m][1];
                        f32x4 o0, o1;
                        if (fq == 0) {
#pragma unroll
                            for (int e = 0; e < 4; ++e) { o0[e] = 1.f / (1.f + expf(-v0[e])); o1[e] = 1.f / (1.f + expf(-v1[e])); }
                            float* p = (float*)(ws + WS_BETA) + (size_t)row * 8; *(f32x4*)p = o0; *(f32x4*)(p + 4) = o1;
                        } else {
#pragma unroll
                            for (int e = 0; e < 4; ++e) { o0[e] = al[e] * softplusf_(v0[e] + db[e]); o1[e] = al[4 + e] * softplusf_(v1[e] + db[4 + e]); }
                            float* p = (float*)(ws + WS_GLOG) + (size_t)row * 8; *(f32x4*)p = o0; *(f32x4*)(p + 4) = o1;
                        } }
            }
            return;
        }
        int kind, ld, cbase; bf16* dst;
        if (pn < 12) { kind = 0; dst = (bf16*)(ws + WS_CONVIN); ld = 3072; cbase = pn * 256; }
        else if (pn < 16) { kind = 1; dst = (bf16*)(ws + WS_GG); ld = 1024; cbase = (pn - 12) * 256; }
        else if (pn < 20) { kind = 3; dst = (bf16*)(ws + WS_MQ); ld = 1024; cbase = (pn - 16) * 256; }
        else if (pn == 20) { kind = 3; dst = (bf16*)(ws + WS_MK); ld = 256; cbase = 0; }
        else if (pn == 21) { kind = 0; dst = (bf16*)(ws + WS_MV); ld = 256; cbase = 0; }
        else if (pn < 26) { kind = 2; dst = (bf16*)(ws + WS_SGG); ld = 1024; cbase = (pn - 22) * 256; }
        else { kind = 2; dst = (bf16*)(ws + WS_SGM); ld = 1024; cbase = (pn - 26) * 256; }
        const bool rope = (kind == 3) && (wc == 0);
        const int i0 = 8 * (fq & 1);
        float ksum[2][8];
#pragma unroll
        for (int bj = 0; bj < 2; ++bj)
#pragma unroll
            for (int e = 0; e < 8; ++e) ksum[bj][e] = 0.f;
        typedef _Float16 f16x8 __attribute__((ext_vector_type(8)));
        f16x8 cq[4], sq[4];
#pragma unroll
        for (int ai = 0; ai < 2; ++ai) {
            if (rope) {
#pragma unroll
                for (int k = 0; k < 4; ++k) { const _Float16* rp = (const _Float16*)(ws + WS_ROPE) + (size_t)(row0 + ai * 128 + k * 16) * 32 + i0; cq[k] = *(const f16x8*)rp; sq[k] = *(const f16x8*)(rp + 16); }
            }
#pragma unroll
            for (int m = 0; m < 4; ++m) { const int row = row0 + ai * 128 + m * 16; bf16* rowp = dst + (size_t)row * ld + cbase + colt;
                f32x4 c0, c1, s0, s1;
                if (rope) { const f16x8 cc = cq[m], ss = sq[m];
#pragma unroll
                    for (int e = 0; e < 4; ++e) { c0[e] = (float)cc[e]; c1[e] = (float)cc[4 + e]; s0[e] = (float)ss[e]; s1[e] = (float)ss[4 + e]; } }
#pragma unroll
                for (int bj = 0; bj < 2; ++bj) { f32x4 v0 = acc[ai][bj][m][0], v1 = acc[ai][bj][m][1];
                    if (kind == 1) {
#pragma unroll
                        for (int e = 0; e < 4; ++e) { v0[e] = siluf_(v0[e]); v1[e] = siluf_(v1[e]); }
                    } else if (kind == 2) {
#pragma unroll
                        for (int e = 0; e < 4; ++e) { v0[e] = sigmoidf_(v0[e]); v1[e] = sigmoidf_(v1[e]); }
                    } else if (rope) {
                        const float sg = fq < 2 ? -1.f : 1.f;
#pragma unroll
                        for (int e = 0; e < 4; ++e) { const float p0 = __shfl_xor(v0[e], 32), p1 = __shfl_xor(v1[e], 32);
                            v0[e] = v0[e] * c0[e] + sg * p0 * s0[e]; v1[e] = v1[e] * c1[e] + sg * p1 * s1[e]; }
                    }
                    if (pn == 20) {
#pragma unroll
                        for (int e = 0; e < 4; ++e) { ksum[bj][e] += v0[e]; ksum[bj][4 + e] += v1[e]; }
                    }
                    if (pn >= 16 && pn < 20) { v0 = v0 * MB_QSCALE; v1 = v1 * MB_QSCALE; }
                    v4u o; o.x = pg8::cvt_pk_bf16(v0[0], v0[1]); o.y = pg8::cvt_pk_bf16(v0[2], v0[3]); o.z = pg8::cvt_pk_bf16(v1[0], v1[1]); o.w = pg8::cvt_pk_bf16(v1[2], v1[3]);
                    *(v4u*)(rowp + bj * 128) = o; } }
        }
        if (pn == 20) {
            float* km = (float*)(ws + WS_CTL) + CW_KMEAN;
#pragma unroll
            for (int bj = 0; bj < 2; ++bj)
#pragma unroll
                for (int e = 0; e < 8; ++e) { float s = ksum[bj][e];
#pragma unroll
                    for (int o = 1; o < 16; o <<= 1) s += __shfl_xor(s, o);
                    if (fr == 0) atomicAdd(km + ((size_t)bj * 64 + u.pm) * 128 + colt + e, s * (1.f / 256.f)); }
        }
    }
};
template <bool ACCUM, bool F8OUT = false> struct EpiGate {
    static constexpr bool PERM = true;
    bf16* M; const bf16* gate; unsigned char* M8;
    __device__ __forceinline__ void operator()(const f32x4 (&acc)[2][2][4][2], const pg8::Unit& u, int wr, int wc, int fr, int fq) const {
        const int row0 = u.pm * 256 + wr * 64 + fr, col0 = u.pn * 256 + wc * 32 + 8 * fq;
        v4u gq[2][4], pq[2][4];
#define EG_RO(st, g) ((size_t)(row0 + ((st) >> 1) * 128 + (2 * ((st) & 1) + ((g) >> 1)) * 16) * 1024 + col0 + ((g) & 1) * 128)
#define EG_LOAD(st) do { _Pragma("unroll") for (int _g = 0; _g < 4; ++_g) { gq[(st) & 1][_g] = *(const v4u*)(gate + EG_RO(st, _g)); if (ACCUM) pq[(st) & 1][_g] = *(const v4u*)(M + EG_RO(st, _g)); } } while (0)
#define EG_STORE(st) do { _Pragma("unroll") for (int _g = 0; _g < 4; ++_g) { const int _ai = (st) >> 1, _m = 2 * ((st) & 1) + (_g >> 1), _bj = _g & 1; \
            const f32x4 v0 = acc[_ai][_bj][_m][0], v1 = acc[_ai][_bj][_m][1]; const v4u g = gq[(st) & 1][_g]; \
            float r[8] = {v0[0] * bflo(g.x), v0[1] * bfhi(g.x), v0[2] * bflo(g.y), v0[3] * bfhi(g.y), v1[0] * bflo(g.z), v1[1] * bfhi(g.z), v1[2] * bflo(g.w), v1[3] * bfhi(g.w)}; \
            if (ACCUM) { const v4u p = pq[(st) & 1][_g]; \
                r[0] += bflo(p.x); r[1] += bfhi(p.x); r[2] += bflo(p.y); r[3] += bfhi(p.y); r[4] += bflo(p.z); r[5] += bfhi(p.z); r[6] += bflo(p.w); r[7] += bfhi(p.w); } \
            if (F8OUT) { v2u o8; o8.x = pk4_fp8(4.f * r[0], 4.f * r[1], 4.f * r[2], 4.f * r[3]); o8.y = pk4_fp8(4.f * r[4], 4.f * r[5], 4.f * r[6], 4.f * r[7]); *(v2u*)(M8 + EG_RO(st, _g)) = o8; } \
            else { v4u o; o.x = pg8::cvt_pk_bf16(r[0], r[1]); o.y = pg8::cvt_pk_bf16(r[2], r[3]); o.z = pg8::cvt_pk_bf16(r[4], r[5]); o.w = pg8::cvt_pk_bf16(r[6], r[7]); \
                *(v4u*)(M + EG_RO(st, _g)) = o; } } } while (0)
        EG_LOAD(0); EG_LOAD(1);
        EG_STORE(0); EG_LOAD(2);
        EG_STORE(1); EG_LOAD(3);
        EG_STORE(2); EG_STORE(3);
#undef EG_RO
#undef EG_LOAD
#undef EG_STORE
    }
};

constexpr int GP_WF = 0, GP_QGF = 16384, GP_KDF = 32768, GP_AQF = 49152, GP_UT = 57344, GP_UNIT = 73728;
constexpr int PL_KB = 0, PL_QB = 17408, PL_RH = 34816, PL_X = 71680, PL_XT = 80896, PL_P = 99328, PL_SC = 108544;
__device__ __forceinline__ bf16x8 ldsfrag(const LAS unsigned char* base, int row, int stride, int ks, int q) { return *(const LAS bf16x8*)(base + row * stride + ks * 64 + q * 16); }

constexpr int PL_STG = 109056;
__device__ __forceinline__ void gdn_prep_all(Frame& F, const Args& a) {
    LAS unsigned char* L = F.lds; unsigned char* ws = F.ws;
    const int tid = threadIdx.x, lane = tid & 63, w = F.wave, l15 = lane & 15, q = lane >> 4;
    LAS float* sc_gc = (LAS float*)(L + PL_SC); LAS float* sc_beta = sc_gc + 64;
    const bf16* cin = (const bf16*)(ws + WS_CONVIN);
    float gpre = 0.f, bpre = 0.f;
#define GP_PREFETCH(uu_) do { const int _h = (uu_) & 7, _t0 = 64 * ((uu_) >> 3); \
        if (w == 0) { gpre = ((const float*)(ws + WS_GLOG))[(size_t)(_t0 + lane) * 8 + _h]; bpre = ((const float*)(ws + WS_BETA))[(size_t)(_t0 + lane) * 8 + _h]; } \
        _Pragma("unroll") for (int _i = 0; _i < 5; ++_i) { const int _pc = w + 8 * _i;     \
            if (_pc < 34) { const int _p = _pc / 17, _r0 = 4 * (_pc % 17); int _row = _r0 + (lane >> 4); if (_row > 66) _row = 66; int _t = _t0 - 3 + _row; if (_t < 0) _t = 0; \
                __builtin_amdgcn_global_load_lds((const unsigned*)(cin + (size_t)_t * 3072 + _p * 1024 + _h * 128 + (lane & 15) * 8), (LAS unsigned*)(L + PL_STG + _p * 17408 + _r0 * 256), 16, 0, 0); } } } while (0)
    unsigned uvn[11];
#define UV_PREFETCH(uu_) do { const int _h = (uu_) & 7, _t0 = 64 * ((uu_) >> 3); \
        _Pragma("unroll") for (int _jj = 0; _jj < 11; ++_jj) { int _t = _t0 + 8 * w - 3 + _jj; if (_t < 0) _t = 0; uvn[_jj] = *(const unsigned*)(cin + (size_t)_t * 3072 + 2048 + _h * 128 + 2 * lane); } } while (0)
    { const int u0 = F.bid < 2048 ? F.bid : 2047; UV_PREFETCH(u0); }
    if (F.bid < 2048) GP_PREFETCH(F.bid);
    int hcw = -1;
    constexpr int PL_CW = 144384;
  for (int u = F.bid; u < 2048; u += F.G) {
    const int h = u & 7, n = u >> 3, t0 = 64 * n;
    unsigned char* gp = ws + WS_GDNP + (size_t)(h * 256 + n) * GP_UNIT;
    if (h != hcw) { hcw = h;
        if (w == 0) {
#pragma unroll
            for (int p = 0; p < 3; ++p) { f32x2 tmpc[4];
#pragma unroll
                for (int j = 0; j < 4; ++j) tmpc[j] = *(const f32x2*)(a.in[2] + (size_t)j * 3072 + p * 1024 + h * 128 + 2 * lane);
                __builtin_amdgcn_sched_barrier(0);
#pragma unroll
                for (int j = 0; j < 4; ++j) *(LAS f32x2*)(L + PL_CW + ((p * 4 + j) * 64 + lane) * 8) = tmpc[j];
                __builtin_amdgcn_sched_barrier(0); }
        } }
    if (w == 0) { float g = gpre; const float b = bpre;
        g = DPP_STEP(g, 0x111, 0xf); g = DPP_STEP(g, 0x112, 0xf); g = DPP_STEP(g, 0x114, 0xf); g = DPP_STEP(g, 0x118, 0xf); g = DPP_STEP(g, 0x142, 0xa); g = DPP_STEP(g, 0x143, 0xc);
        sc_gc[lane] = g; sc_beta[lane] = b; if (lane == 63) ((float*)(ws + WS_GL))[h * 256 + n] = expf(g); }
    __syncthreads();
    {
        unsigned uv[11];
#pragma unroll
        for (int jj = 0; jj < 11; ++jj) { const int t = t0 + 8 * w - 3 + jj; uv[jj] = (t >= 0) ? uvn[jj] : 0u; }
#pragma unroll
        for (int p = 0; p < 3; ++p) {
            f32x2 cw[4]; unsigned uu[11];
#pragma unroll
            for (int j = 0; j < 4; ++j) cw[j] = *(const LAS f32x2*)(L + PL_CW + ((p * 4 + j) * 64 + lane) * 8);
#pragma unroll
            for (int jj = 0; jj < 11; ++jj) { const int t = t0 + 8 * w - 3 + jj; uu[jj] = (p == 2) ? uv[jj] : ((t >= 0) ? *(const LAS unsigned*)(L + PL_STG + p * 17408 + (8 * w + jj) * 256 + lane * 4) : 0u); }
            float y0[8], y1[8], ss[8];
#pragma unroll
            for (int i = 0; i < 8; ++i) { float a0 = 0.f, a1 = 0.f;
#pragma unroll
                for (int j = 0; j < 4; ++j) { a0 += cw[j][0] * bflo(uu[i + j]); a1 += cw[j][1] * bfhi(uu[i + j]); }
                y0[i] = siluf_(a0); y1[i] = siluf_(a1); ss[i] = y0[i] * y0[i] + y1[i] * y1[i]; }
            if (p < 2) {
#pragma unroll
                for (int i = 0; i < 8; ++i) ss[i] = wave_sum_dpp(ss[i]);
#pragma unroll
                for (int i = 0; i < 8; ++i) { const float r = __builtin_amdgcn_rsqf(ss[i] + 1e-6f) * (p == 0 ? 0.08838834764831845f : 1.f); y0[i] *= r; y1[i] *= r; }
            }
            if (p < 2) {
#pragma unroll
                for (int i = 0; i < 8; ++i) *(LAS unsigned*)(L + (p == 0 ? PL_QB : PL_KB) + (8 * w + i) * 272 + lane * 4) = pg8::cvt_pk_bf16(y0[i], y1[i]);
            }
            if (p >= 1) {
                float f[8];
#pragma unroll
                for (int i = 0; i < 8; ++i) { const int c = 8 * w + i; f[i] = (p == 1) ? sc_beta[c] * __expf(sc_gc[c]) : sc_beta[c]; }
                v4u r0, r1;
                r0.x = pg8::cvt_pk_bf16(y0[0] * f[0], y0[1] * f[1]); r0.y = pg8::cvt_pk_bf16(y0[2] * f[2], y0[3] * f[3]); r0.z = pg8::cvt_pk_bf16(y0[4] * f[4], y0[5] * f[5]); r0.w = pg8::cvt_pk_bf16(y0[6] * f[6], y0[7] * f[7]);
                r1.x = pg8::cvt_pk_bf16(y1[0] * f[0], y1[1] * f[1]); r1.y = pg8::cvt_pk_bf16(y1[2] * f[2], y1[3] * f[3]); r1.z = pg8::cvt_pk_bf16(y1[4] * f[4], y1[5] * f[5]); r1.w = pg8::cvt_pk_bf16(y1[6] * f[6], y1[7] * f[7]);
                const int rb = (p == 1) ? 128 : 0;
                *(LAS v4u*)(L + PL_RH + (rb + 2 * lane) * 144 + 16 * w) = r0; *(LAS v4u*)(L + PL_RH + (rb + 2 * lane + 1) * 144 + 16 * w) = r1;
            }
        }
    }
    __syncthreads();
    if (u + F.G < 2048) GP_PREFETCH(u + F.G);
    { const int un = u + F.G < 2048 ? u + F.G : 2047; UV_PREFETCH(un); }
    const int mt = w & 3;
    f32x4 Pacc[4];
    {
        bf16x8 af[4];
#pragma unroll
        for (int ks = 0; ks < 4; ++ks) af[ks] = ldsfrag(L + PL_KB, 16 * mt + l15, 272, ks, q);
#pragma unroll
        for (int nt = 0; nt < 4; ++nt) { f32x4 acc = {0.f, 0.f, 0.f, 0.f};
#pragma unroll
            for (int ks = 0; ks < 4; ++ks) acc = mfma16(af[ks], ldsfrag(L + PL_KB, 16 * nt + l15, 272, ks, q), acc);
            const int s = 16 * nt + l15; const float gs = sc_gc[s]; f32x4 val;
#pragma unroll
            for (int r = 0; r < 4; ++r) { const int c = 16 * mt + 4 * q + r; val[r] = (s < c) ? sc_beta[c] * acc[r] * __expf(sc_gc[c] - gs) : 0.f; }
            if (w < 4) {
#pragma unroll
                for (int r = 0; r < 4; ++r) *(LAS bf16*)(L + PL_X + (16 * mt + 4 * q + r) * 144 + s * 2) = (bf16)f2bf(val[r]);
                v2u o; o.x = pg8::cvt_pk_bf16(val[0], val[1]); o.y = pg8::cvt_pk_bf16(val[2], val[3]);
                *(LAS v2u*)(L + PL_XT + s * 144 + (16 * mt + 4 * q) * 2) = o;
            } else {
#pragma unroll
                for (int r = 0; r < 4; ++r) { const int c = 16 * mt + 4 * q + r; Pacc[nt][r] = ((c == s) ? 1.f : 0.f) - val[r]; *(LAS bf16*)(L + PL_P + c * 144 + s * 2) = (bf16)f2bf(Pacc[nt][r]); }
            }
        }
        if (w >= 4) {
            bf16x8 qf[4];
#pragma unroll
            for (int ks = 0; ks < 4; ++ks) qf[ks] = ldsfrag(L + PL_QB, 16 * mt + l15, 272, ks, q);
            const int c = 16 * mt + l15; const float gcq = sc_gc[c];
            f32x4 aq[4];
#pragma unroll
            for (int m2 = 0; m2 < 4; ++m2) { f32x4 acc = {0.f, 0.f, 0.f, 0.f};
#pragma unroll
                for (int ks = 0; ks < 4; ++ks) acc = mfma16(ldsfrag(L + PL_KB, 16 * m2 + l15, 272, ks, q), qf[ks], acc);
#pragma unroll
                for (int r = 0; r < 4; ++r) { const int cp = 16 * m2 + 4 * q + r; aq[m2][r] = (cp <= c) ? acc[r] * __expf(gcq - sc_gc[cp]) : 0.f; } }
#pragma unroll
            for (int k2 = 0; k2 < 2; ++k2) *(bf16x8*)(gp + GP_AQF + (mt * 2 + k2) * 1024 + lane * 16) = pack8(aq[2 * k2], aq[2 * k2 + 1]);
        }
    }
    do { asm volatile("s_waitcnt lgkmcnt(0)" ::: "memory"); __builtin_amdgcn_s_barrier(); asm volatile("" ::: "memory"); } while (0);
#pragma unroll
    for (int lev = 0; lev < 6; ++lev) {
        const int cur = lev & 1;
        const LAS unsigned char* xt = L + PL_XT + cur * 9216;
        if (w < 4) {
            if (lev < 5) {
                bf16x8 af[2]; f32x4 xa[4];
#pragma unroll
                for (int ks = 0; ks < 2; ++ks) af[ks] = ldsfrag(L + PL_X, 16 * mt + l15, 144, ks, q);
#pragma unroll
                for (int nt = 0; nt < 4; ++nt) { xa[nt] = (f32x4){0.f, 0.f, 0.f, 0.f};
#pragma unroll
                    for (int ks = 0; ks < 2; ++ks) xa[nt] = mfma16(af[ks], ldsfrag(xt, 16 * nt + l15, 144, ks, q), xa[nt]); }
                LAS unsigned char* xtn = L + PL_XT + (cur ^ 1) * 9216;
#pragma unroll
                for (int nt = 0; nt < 4; ++nt) { const int s = 16 * nt + l15;
#pragma unroll
                    for (int r = 0; r < 4; ++r) *(LAS bf16*)(L + PL_X + (16 * mt + 4 * q + r) * 144 + s * 2) = (bf16)f2bf(xa[nt][r]);
                    v2u o; o.x = pg8::cvt_pk_bf16(xa[nt][0], xa[nt][1]); o.y = pg8::cvt_pk_bf16(xa[nt][2], xa[nt][3]);
                    *(LAS v2u*)(xtn + s * 144 + (16 * mt + 4 * q) * 2) = o; }
            }
        } else if (lev >= 1) {
            bf16x8 af[2];
#pragma unroll
            for (int ks = 0; ks < 2; ++ks) af[ks] = ldsfrag(L + PL_P, 16 * mt + l15, 144, ks, q);
#pragma unroll
            for (int nt = 0; nt < 4; ++nt)
#pragma unroll
                for (int ks = 0; ks < 2; ++ks) Pacc[nt] = mfma16(af[ks], ldsfrag(xt, 16 * nt + l15, 144, ks, q), Pacc[nt]);
#pragma unroll
            for (int nt = 0; nt < 4; ++nt)
#pragma unroll
                for (int r = 0; r < 4; ++r) *(LAS bf16*)(L + PL_P + (16 * mt + 4 * q + r) * 144 + (16 * nt + l15) * 2) = (bf16)f2bf(Pacc[nt][r]);
        }
        do { asm volatile("s_waitcnt lgkmcnt(0)" ::: "memory"); __builtin_amdgcn_s_barrier(); asm volatile("" ::: "memory"); } while (0);
    }
    __builtin_amdgcn_s_waitcnt(0x0F70);
    if (w < 4) {
#pragma unroll
        for (int i = 0; i < 2; ++i) { const int nt = 2 * w + i; f32x4 uu[4];
            const bf16x8 b0 = ldsfrag(L + PL_RH, 16 * nt + l15, 144, 0, q), b1 = ldsfrag(L + PL_RH, 16 * nt + l15, 144, 1, q);
#pragma unroll
            for (int m2 = 0; m2 < 4; ++m2) { uu[m2] = mfma16(ldsfrag(L + PL_P, 16 * m2 + l15, 144, 0, q), b0, (f32x4){0.f, 0.f, 0.f, 0.f}); uu[m2] = mfma16(ldsfrag(L + PL_P, 16 * m2 + l15, 144, 1, q), b1, uu[m2]); }
            unsigned char* up = gp + GP_UT + (16 * nt + l15) * 128 + q * 32;
            *(bf16x8*)up = pack8(uu[0], uu[1]); *(bf16x8*)(up + 16) = pack8(uu[2], uu[3]); }
    } else {
        const bf16x8 b0 = ldsfrag(L + PL_P, 16 * mt + l15, 144, 0, q), b1 = ldsfrag(L + PL_P, 16 * mt + l15, 144, 1, q);
        f32x4 wa[8];
#pragma unroll
        for (int md = 0; md < 8; ++md) { wa[md] = mfma16(ldsfrag(L + PL_RH, 128 + 16 * md + l15, 144, 0, q), b0, (f32x4){0.f, 0.f, 0.f, 0.f}); wa[md] = mfma16(ldsfrag(L + PL_RH, 128 + 16 * md + l15, 144, 1, q), b1, wa[md]); wa[md] = -wa[md]; }
#pragma unroll
        for (int ks = 0; ks < 4; ++ks) { const f32x4 a0 = wa[2 * ks] * 32.f, a1 = wa[2 * ks + 1] * 32.f; v2u o8; o8.x = pk4_fp8(a0[0], a0[1], a0[2], a0[3]); o8.y = pk4_fp8(a1[0], a1[1], a1[2], a1[3]);
            *(v2u*)(gp + GP_WF + (mt * 4 + ks) * 512 + lane * 8) = o8; }
    }
    {
        const float gl = sc_gc[63];
#pragma unroll
        for (int i = 0; i < 2; ++i) { const int f = 2 * w + i;
            { const int m2 = f >> 2, ks = f & 3, c = 16 * m2 + l15; const float eg = __expf(sc_gc[c]);
              const v2u x0 = *(const LAS v2u*)(L + PL_QB + c * 272 + (32 * ks + 4 * q) * 2), x1 = *(const LAS v2u*)(L + PL_QB + c * 272 + (32 * ks + 16 + 4 * q) * 2);
              const f32x4 v0 = {bflo(x0.x) * eg, bfhi(x0.x) * eg, bflo(x0.y) * eg, bfhi(x0.y) * eg}, v1 = {bflo(x1.x) * eg, bfhi(x1.x) * eg, bflo(x1.y) * eg, bfhi(x1.y) * eg};
              *(bf16x8*)(gp + GP_QGF + f * 1024 + lane * 16) = pack8(v0, v1); }
            { const int md = f >> 1, ks = f & 1, d = 16 * md + l15; f32x4 v0, v1;
#pragma unroll
              for (int r = 0; r < 4; ++r) { const int c0 = 32 * ks + 4 * q + r, c1 = c0 + 16;
                  v0[r] = bf2f(*(const LAS bf16*)(L + PL_KB + c0 * 272 + d * 2)) * __expf(gl - sc_gc[c0]); v1[r] = bf2f(*(const LAS bf16*)(L + PL_KB + c1 * 272 + d * 2)) * __expf(gl - sc_gc[c1]); }
              v2u o8; o8.x = pk4_fp8(64.f * v0[0], 64.f * v0[1], 64.f * v0[2], 64.f * v0[3]); o8.y = pk4_fp8(64.f * v1[0], 64.f * v1[1], 64.f * v1[2], 64.f * v1[3]);
              *(v2u*)(gp + GP_KDF + f * 512 + lane * 8) = o8; }
        }
    }
    do { asm volatile("s_waitcnt lgkmcnt(0)" ::: "memory"); __builtin_amdgcn_s_barrier(); asm volatile("" ::: "memory"); } while (0);
  }
#undef GP_PREFETCH
#undef UV_PREFETCH
}

__device__ __forceinline__ void gdn_scan(Frame& F, const int h) {
    LAS unsigned char* L = F.lds; unsigned char* ws = F.ws;
    const int lane = threadIdx.x & 63, w = F.wave, l15 = lane & 15, q = lane >> 4;
    const unsigned char* gph = ws + WS_GDNP + (size_t)h * 256 * GP_UNIT;
    const float* GLp = (const float*)(ws + WS_GL) + h * 256;
    float* Op = (float*)(ws + WS_O) + h * 128 + 16 * w + l15;
    f32x4 Sf[8];
#pragma unroll
    for (int md = 0; md < 8; ++md) Sf[md] = (f32x4){0.f, 0.f, 0.f, 0.f};
#define SCAN_ISSUE(nn) do { const unsigned char* _s = gph + (size_t)(nn) * GP_UNIT; LAS unsigned char* _d = L + ((nn) & 1) * 57344; \
        _Pragma("unroll") for (int _p = 0; _p < 7; ++_p) __builtin_amdgcn_global_load_lds((const unsigned*)(_s + (w + 8 * _p) * 1024 + lane * 16), (LAS unsigned*)(_d + (w + 8 * _p) * 1024), 16, 0, 0); } while (0)
    SCAN_ISSUE(0);
    for (int n = 0; n < 256; ++n) {
        VM_WAIT(); __syncthreads();
        if (n + 1 < 256) SCAN_ISSUE(n + 1);
        const LAS unsigned char* sl = L + (n & 1) * 57344;
        const unsigned char* up = gph + (size_t)n * GP_UNIT + GP_UT + (16 * w + l15) * 128 + q * 32;
        const v4u u0 = *(const v4u*)up, u1 = *(const v4u*)(up + 16);
        const float gl = GLp[n];
        bf16x8 sb[4];
#pragma unroll
        for (int ks = 0; ks < 4; ++ks) sb[ks] = pack8(Sf[2 * ks], Sf[2 * ks + 1]);
        f32x4 vn[4], oo[4];
        vn[0] = (f32x4){bflo(u0.x), bfhi(u0.x), bflo(u0.y), bfhi(u0.y)}; vn[1] = (f32x4){bflo(u0.z), bfhi(u0.z), bflo(u0.w), bfhi(u0.w)};
        vn[2] = (f32x4){bflo(u1.x), bfhi(u1.x), bflo(u1.y), bfhi(u1.y)}; vn[3] = (f32x4){bflo(u1.z), bfhi(u1.z), bflo(u1.w), bfhi(u1.w)};
#pragma unroll
        for (int m2 = 0; m2 < 4; ++m2) { oo[m2] = (f32x4){0.f, 0.f, 0.f, 0.f};
#pragma unroll
            for (int ks = 0; ks < 4; ++ks) { vn[m2] = mfma16(*(const LAS bf16x8*)(sl + GP_WF + (m2 * 4 + ks) * 1024 + lane * 16), sb[ks], vn[m2]);
                oo[m2] = mfma16(*(const LAS bf16x8*)(sl + GP_QGF + (m2 * 4 + ks) * 1024 + lane * 16), sb[ks], oo[m2]); } }
        const bf16x8 vb0 = pack8(vn[0], vn[1]), vb1 = pack8(vn[2], vn[3]);
#pragma unroll
        for (int m2 = 0; m2 < 4; ++m2) { oo[m2] = mfma16(*(const LAS bf16x8*)(sl + GP_AQF + (m2 * 2) * 1024 + lane * 16), vb0, oo[m2]);
            oo[m2] = mfma16(*(const LAS bf16x8*)(sl + GP_AQF + (m2 * 2 + 1) * 1024 + lane * 16), vb1, oo[m2]); }
#pragma unroll
        for (int md = 0; md < 8; ++md) { Sf[md] = Sf[md] * gl;
            Sf[md] = mfma16(*(const LAS bf16x8*)(sl + GP_KDF + (md * 2) * 1024 + lane * 16), vb0, Sf[md]);
            Sf[md] = mfma16(*(const LAS bf16x8*)(sl + GP_KDF + (md * 2 + 1) * 1024 + lane * 16), vb1, Sf[md]); }
#pragma unroll
        for (int m2 = 0; m2 < 4; ++m2)
#pragma unroll
            for (int r = 0; r < 4; ++r) Op[(size_t)(64 * n + 16 * m2 + 4 * q + r) * 1024] = oo[m2][r];
    }
#undef SCAN_ISSUE
    VM_WAIT(); __syncthreads();
}

__device__ __forceinline__ v4u fp8x8_bf16(const unsigned a, const unsigned b, const float sc) {
    typedef float f32x2_ __attribute__((ext_vector_type(2)));
    const f32x2_ p0 = __builtin_amdgcn_cvt_pk_f32_fp8(a, false), p1 = __builtin_amdgcn_cvt_pk_f32_fp8(a, true), p2 = __builtin_amdgcn_cvt_pk_f32_fp8(b, false), p3 = __builtin_amdgcn_cvt_pk_f32_fp8(b, true);
    v4u o; o.x = pg8::cvt_pk_bf16(p0[0] * sc, p0[1] * sc); o.y = pg8::cvt_pk_bf16(p1[0] * sc, p1[1] * sc); o.z = pg8::cvt_pk_bf16(p2[0] * sc, p2[1] * sc); o.w = pg8::cvt_pk_bf16(p3[0] * sc, p3[1] * sc);
    return o;
}

constexpr int NSCAN = 32, NWARM = 8;
constexpr int SC_SLOT = 36864;
constexpr int SC_WU = 20480, SC_KD = 16384;
__device__ __forceinline__ void gdn_scan2(Frame& F, const int b) {
    LAS unsigned char* L = F.lds; unsigned char* ws = F.ws;
    const int lane = threadIdx.x & 63, w = F.wave, l15 = lane & 15, q = lane >> 4;
    const int h = b & 7, part = b >> 3;
    unsigned char* gph = ws + WS_GDNP + (size_t)h * 256 * GP_UNIT;
    unsigned char* sbp = ws + WS_O + (size_t)h * 256 * 32768;
    constexpr int KDR = 4 * SC_WU, GLT = KDR + 4 * SC_KD;
#define SC_BAR() do { asm volatile("s_waitcnt lgkmcnt(0)" ::: "memory"); __builtin_amdgcn_s_barrier(); asm volatile("" ::: "memory"); } while (0)
    if (threadIdx.x < 256) ((LAS float*)(L + GLT))[threadIdx.x] = ((const float*)(ws + WS_GL))[h * 256 + threadIdx.x];
#define SC_HSTEP(n, RS) do { SC_PUT(RS, (n) + 2); SC_LOAD(RS, (n) + 10); \
            if (w == 7 && lane == 0) __hip_atomic_store(&F.ctl[CW_PROG + 64 * b], (unsigned)((n) + 1), __ATOMIC_RELAXED, __HIP_MEMORY_SCOPE_AGENT); \
            SC_BAR(); } while (0)
#define SC_LOOP() do { \
        SC_LOAD(r0, 0); SC_LOAD(r1, 1); SC_LOAD(r2, 2); SC_LOAD(r3, 3); SC_LOAD(r4, 4); SC_LOAD(r5, 5); SC_LOAD(r6, 6); SC_LOAD(r7, 7); \
        SC_PUT(r0, 0); SC_LOAD(r0, 8); SC_PUT(r1, 1); SC_LOAD(r1, 9);          \
        SC_BAR(); SC_BAR(); \
          \
        _Pragma("unroll 1") for (int n0 = 0; n0 < 256; n0 += 8) { SC_HSTEP(n0, r2); SC_HSTEP(n0 + 1, r3); SC_HSTEP(n0 + 2, r4); SC_HSTEP(n0 + 3, r5); SC_HSTEP(n0 + 4, r6); SC_HSTEP(n0 + 5, r7); SC_HSTEP(n0 + 6, r0); SC_HSTEP(n0 + 7, r1); } } while (0)
    if (w >= 6) {
        const int sok = GP_KDF + (4 * (w - 6)) * 1024 + lane * 16, dok = KDR + (8 * (w - 6) + (lane >> 5)) * 1024 + (lane & 31) * 32;
#define SC_LOAD(R, nn) do { const int _nn = (nn) < 255 ? (nn) : 255; const unsigned char* _u = gph + (size_t)_nn * GP_UNIT + sok; _Pragma("unroll") for (int _i = 0; _i < 4; ++_i) R[_i] = *(const v4u*)(_u + _i * 1024); } while (0)
#define SC_PUT(R, nn) do { LAS unsigned char* _d = L + dok + ((nn) & 3) * SC_KD; _Pragma("unroll") for (int _i = 0; _i < 4; ++_i) { \
            *(LAS v4u*)(_d + _i * 2048) = fp8x8_bf16(R[_i].x, R[_i].y, 1.f / 64.f); *(LAS v4u*)(_d + _i * 2048 + 16) = fp8x8_bf16(R[_i].z, R[_i].w, 1.f / 64.f); } } while (0)
        v4u r0[4], r1[4], r2[4], r3[4], r4[4], r5[4], r6[4], r7[4];
        SC_LOOP();
#undef SC_LOAD
#undef SC_PUT
    } else if (w >= 2) {
        const int lw = w - 2;
        const int sow = GP_WF + (2 * lw) * 1024 + lane * 16, sou = GP_UT + part * 4096 + lw * 1024 + lane * 16;
        const int dww = (4 * lw + (lane >> 5)) * 1024 + (lane & 31) * 32, dwu = 16384 + lw * 1024 + lane * 16;
#define SC_LOAD(R, nn) do { const int _nn = (nn) < 255 ? (nn) : 255; const unsigned char* _u = gph + (size_t)_nn * GP_UNIT; R[0] = *(const v4u*)(_u + sow); R[1] = *(const v4u*)(_u + sow + 1024); R[2] = *(const v4u*)(_u + sou); } while (0)
#define SC_PUT(R, nn) do { LAS unsigned char* _d = L + ((nn) & 3) * SC_WU; _Pragma("unroll") for (int _i = 0; _i < 2; ++_i) { \
            *(LAS v4u*)(_d + dww + _i * 2048) = fp8x8_bf16(R[_i].x, R[_i].y, 1.f / 32.f); *(LAS v4u*)(_d + dww + _i * 2048 + 16) = fp8x8_bf16(R[_i].z, R[_i].w, 1.f / 32.f); } \
            *(LAS v4u*)(_d + dwu) = R[2]; } while (0)
        v4u r0[3], r1[3], r2[3], r3[3], r4[3], r5[3], r6[3], r7[3];
        SC_LOOP();
#undef SC_LOAD
#undef SC_PUT
#undef SC_LOOP
#undef SC_HSTEP
    } else {
        f32x4 Sf[8];
#pragma unroll
        for (int md = 0; md < 8; ++md) Sf[md] = (f32x4){0.f, 0.f, 0.f, 0.f};
        bf16x8 wf[16], kf[16]; v4u u0, u1;
        SC_BAR();
#pragma unroll
        for (int i = 0; i < 16; ++i) wf[i] = *(const LAS bf16x8*)(L + i * 1024 + lane * 16);
        { const LAS unsigned char* up = L + 16384 + (16 * w + l15) * 128 + q * 32; u0 = *(const LAS v4u*)up; u1 = *(const LAS v4u*)(up + 16); }
#pragma unroll
        for (int i = 0; i < 16; ++i) kf[i] = *(const LAS bf16x8*)(L + KDR + i * 1024 + lane * 16);
        SC_BAR();
        const int slice = 2 * part + w;
#pragma unroll 1
        for (int n = 0; n < 256; ++n) {
            f32x4 vn[4];
            vn[0] = (f32x4){bflo(u0.x), bfhi(u0.x), bflo(u0.y), bfhi(u0.y)}; vn[1] = (f32x4){bflo(u0.z), bfhi(u0.z), bflo(u0.w), bfhi(u0.w)};
            vn[2] = (f32x4){bflo(u1.x), bfhi(u1.x), bflo(u1.y), bfhi(u1.y)}; vn[3] = (f32x4){bflo(u1.z), bfhi(u1.z), bflo(u1.w), bfhi(u1.w)};
            const float gl = ((const LAS float*)(L + GLT))[n];
            bf16x8 sb[4];
#pragma unroll
            for (int ks = 0; ks < 4; ++ks) { sb[ks] = pack8(Sf[2 * ks], Sf[2 * ks + 1]);
                *(bf16x8*)(sbp + ((size_t)n * 32 + slice * 4 + ks) * 1024 + lane * 16) = sb[ks]; }
            asm volatile("s_waitcnt lgkmcnt(0)" ::: "memory");
            __builtin_amdgcn_sched_barrier(0);
#pragma unroll
            for (int ks = 0; ks < 4; ++ks)
#pragma unroll
                for (int m2 = 0; m2 < 4; ++m2) vn[m2] = mfma16(wf[m2 * 4 + ks], sb[ks], vn[m2]);
            __builtin_amdgcn_sched_barrier(0);
#pragma unroll
            for (int md = 0; md < 8; ++md) Sf[md] = Sf[md] * gl;
            if (n + 1 < 256) { const LAS unsigned char* wu = L + ((n + 1) & 3) * SC_WU;
#pragma unroll
                for (int i = 0; i < 16; ++i) wf[i] = *(const LAS bf16x8*)(wu + i * 1024 + lane * 16);
                const LAS unsigned char* up = wu + 16384 + (16 * w + l15) * 128 + q * 32; u0 = *(const LAS v4u*)up; u1 = *(const LAS v4u*)(up + 16); }
            __builtin_amdgcn_sched_barrier(0);
            const bf16x8 vb0 = pack8(vn[0], vn[1]), vb1 = pack8(vn[2], vn[3]);
            unsigned char* vbp = gph + (size_t)n * GP_UNIT + GP_UT + slice * 2048 + lane * 16;
            *(bf16x8*)vbp = vb0; *(bf16x8*)(vbp + 1024) = vb1;
#pragma unroll
            for (int md = 0; md < 8; ++md) Sf[md] = mfma16(kf[md * 2], vb0, Sf[md]);
#pragma unroll
            for (int md = 0; md < 8; ++md) Sf[md] = mfma16(kf[md * 2 + 1], vb1, Sf[md]);
            __builtin_amdgcn_sched_barrier(0);
            if (n + 1 < 256) { const LAS unsigned char* kd = L + KDR + ((n + 1) & 3) * SC_KD;
#pragma unroll
                for (int i = 0; i < 16; ++i) kf[i] = *(const LAS bf16x8*)(kd + i * 1024 + lane * 16); }
            SC_BAR();
        }
    }
#undef SC_BAR
    VM_WAIT(); __syncthreads();
}

__device__ __forceinline__ void gdn_scan_warm(Frame& F, const int h) {
    unsigned char* ws = F.ws; const int tid = threadIdx.x;
    const unsigned char* gph = ws + WS_GDNP + (size_t)h * 256 * GP_UNIT;
    LAS unsigned* pw = (LAS unsigned*)(F.lds + 1024);
    unsigned acc = 0u;
    constexpr int WDIST = 14;
    for (int m = 0; m < 256; ++m) {
        if (m >= WDIST) {
            if (tid == 0) { unsigned sp = 0; while (__hip_atomic_load(&F.ctl[CW_PROG + 64 * h], __ATOMIC_RELAXED, __HIP_MEMORY_SCOPE_AGENT) + WDIST < (unsigned)m + 1u) { __builtin_amdgcn_s_sleep(4); if (++sp > (1u << 22)) break; } }
            __syncthreads();
        }
        const unsigned char* u = gph + (size_t)m * GP_UNIT;
#pragma unroll
        for (int i = 0; i < 2; ++i) { const int x = tid + 512 * i, p = x >> 6, o = (x & 63) * 16;
            const unsigned char* src = u + (p < 8 ? GP_WF + p * 1024 : GP_KDF + (p - 8) * 1024) + o;
            const v4u v = *(const v4u*)src; acc ^= v.x ^ v.y ^ v.z ^ v.w; }
    }
    if (acc == 0x12345u) *pw = acc;
    __syncthreads();
}

__device__ __forceinline__ void gdn_ophase(Frame& F, const float* norm_w) {
    unsigned char* ws = F.ws; const int lane = threadIdx.x & 63, w = F.wave, l15 = lane & 15, q = lane >> 4, mt = w & 3, us = w >> 2;
    LAS unsigned char* LB = F.lds + us * 49152;
    LAS unsigned char* tl = F.lds + 98304 + w * 4352;
    float nwv[8];
#pragma unroll
    for (int sl = 0; sl < 8; ++sl) nwv[sl] = norm_w[16 * sl + l15];
    v4u gq[4], gqn[4]; bf16x8 aq[4], aa[2], aqn[4], aan[2]; v4u bsh[12];
#define OP_REQ(u_, GQ, AQ, AA) do { const int _u = (u_) < 2048 ? (u_) : 2047, _h = _u >> 8, _n = _u & 255; \
        const unsigned char* _gp = ws + WS_GDNP + (size_t)_u * GP_UNIT; const unsigned char* _sbp = ws + WS_O + (size_t)_u * 32768; \
        const size_t _gidx = (size_t)(64 * _n + 16 * mt + (lane >> 2)) * 1024 + _h * 128 + (lane & 3) * 32; \
        _Pragma("unroll") for (int _c = 0; _c < 4; ++_c) GQ[_c] = *(const v4u*)((const bf16*)(ws + WS_GG) + _gidx + _c * 8); \
        _Pragma("unroll") for (int _k = 0; _k < 4; ++_k) AQ[_k] = *(const bf16x8*)(_gp + GP_QGF + (mt * 4 + _k) * 1024 + lane * 16); \
        _Pragma("unroll") for (int _k = 0; _k < 2; ++_k) AA[_k] = *(const bf16x8*)(_gp + GP_AQF + (mt * 2 + _k) * 1024 + lane * 16); \
        _Pragma("unroll") for (int _i = 0; _i < 8; ++_i) bsh[_i] = *(const v4u*)(_sbp + (8 * mt + _i) * 1024 + lane * 16); \
        _Pragma("unroll") for (int _i = 0; _i < 4; ++_i) bsh[8 + _i] = *(const v4u*)(_gp + GP_UT + (4 * mt + _i) * 1024 + lane * 16); } while (0)
    int u = 2 * F.bid + us;
    OP_REQ(u, gqn, aqn, aan);
    for (; u < 2048; u += 2 * F.G) {
        const int h = u >> 8, n = u & 255;
        __syncthreads();
#pragma unroll
        for (int i = 0; i < 8; ++i) *(LAS v4u*)(LB + (8 * mt + i) * 1024 + lane * 16) = bsh[i];
#pragma unroll
        for (int i = 0; i < 4; ++i) *(LAS v4u*)(LB + 32768 + (4 * mt + i) * 1024 + lane * 16) = bsh[8 + i];
#pragma unroll
        for (int c = 0; c < 4; ++c) { gq[c] = gqn[c]; aq[c] = aqn[c]; }
        aa[0] = aan[0]; aa[1] = aan[1];
        __syncthreads();
        OP_REQ(u + 2 * F.G, gqn, aqn, aan);
        f32x4 o[8]; float ss[4] = {0.f, 0.f, 0.f, 0.f};
#pragma unroll
        for (int sl = 0; sl < 8; ++sl) { o[sl] = (f32x4){0.f, 0.f, 0.f, 0.f};
#pragma unroll
            for (int ks = 0; ks < 4; ++ks) o[sl] = mfma16(aq[ks], *(const LAS bf16x8*)(LB + (sl * 4 + ks) * 1024 + lane * 16), o[sl]);
#pragma unroll
            for (int k2 = 0; k2 < 2; ++k2) o[sl] = mfma16(aa[k2], *(const LAS bf16x8*)(LB + 32768 + (sl * 2 + k2) * 1024 + lane * 16), o[sl]);
#pragma unroll
            for (int r = 0; r < 4; ++r) ss[r] += o[sl][r] * o[sl][r]; }
#pragma unroll
        for (int r = 0; r < 4; ++r) { float s = ss[r]; s += __shfl_xor(s, 1); s += __shfl_xor(s, 2); s += __shfl_xor(s, 4); s += __shfl_xor(s, 8); ss[r] = 1.f / sqrtf(s * (1.f / 128.f) + 1e-6f); }
#pragma unroll
        for (int sl = 0; sl < 8; ++sl) { const float nw = nwv[sl];
#pragma unroll
            for (int r = 0; r < 4; ++r) *(LAS bf16*)(tl + (4 * q + r) * 272 + (16 * sl + l15) * 2) = (bf16)f2bf(o[sl][r] * ss[r] * nw); }
        LDS_WAIT(); asm volatile("" ::: "memory");
        __builtin_amdgcn_s_waitcnt(0x0F70);
        { const int row = lane >> 2, seg = lane & 3; const size_t idx = (size_t)(64 * n + 16 * mt + row) * 1024 + h * 128 + seg * 32;
          bf16* OG = (bf16*)(ws + WS_OG);
#pragma unroll
          for (int c4 = 0; c4 < 4; ++c4) { const v4u y = *(const LAS v4u*)(tl + row * 272 + seg * 64 + c4 * 16), g = gq[c4];
              v2u d; d.x = pk4_fp8(bflo(y.x) * bflo(g.x), bfhi(y.x) * bfhi(g.x), bflo(y.y) * bflo(g.y), bfhi(y.y) * bfhi(g.y)); d.y = pk4_fp8(bflo(y.z) * bflo(g.z), bfhi(y.z) * bfhi(g.z), bflo(y.w) * bflo(g.w), bfhi(y.w) * bfhi(g.w));
              *(v2u*)((unsigned char*)OG + idx + c4 * 8) = d; } }
        LDS_WAIT(); asm volatile("" ::: "memory");
    }
#undef OP_REQ
    __syncthreads();
}

__device__ __forceinline__ void gdn_post(Frame& F, const float* norm_w) {
    unsigned char* ws = F.ws; const int lane = threadIdx.x & 63;
    const int gw = F.bid * NWAVES + F.wave, NGW = F.G * NWAVES;
    f32x4 nw[4];
#pragma unroll
    for (int j = 0; j < 4; ++j) nw[j] = *(const f32x4*)(norm_w + (lane & 7) * 16 + 4 * j);
    for (int t = gw; t < T; t += NGW) {
        const f32x4* op = (const f32x4*)((const float*)(ws + WS_O) + (size_t)t * 1024 + lane * 16);
        f32x4 o[4]; float ss = 0.f;
#pragma unroll
        for (int j = 0; j < 4; ++j) { o[j] = op[j]; ss += (o[j][0] * o[j][0] + o[j][1] * o[j][1]) + (o[j][2] * o[j][2] + o[j][3] * o[j][3]); }
        ss += __shfl_xor(ss, 1); ss += __shfl_xor(ss, 2); ss += __shfl_xor(ss, 4);
        const float r = 1.f / sqrtf(ss * (1.f / 128.f) + 1e-6f);
        const v4u* gpn = (const v4u*)((const bf16*)(ws + WS_GG) + (size_t)t * 1024 + lane * 16);
        const v4u g0 = gpn[0], g1 = gpn[1];
        const float gg[16] = {bflo(g0.x), bfhi(g0.x), bflo(g0.y), bfhi(g0.y), bflo(g0.z), bfhi(g0.z), bflo(g0.w), bfhi(g0.w), bflo(g1.x), bfhi(g1.x), bflo(g1.y), bfhi(g1.y), bflo(g1.z), bfhi(g1.z), bflo(g1.w), bfhi(g1.w)};
        float y[16];
#pragma unroll
        for (int j = 0; j < 4; ++j)
#pragma unroll
            for (int e = 0; e < 4; ++e) y[4 * j + e] = o[j][e] * r * nw[j][e] * gg[4 * j + e];
        v4u* dp = (v4u*)((bf16*)(ws + WS_OG) + (size_t)t * 1024 + lane * 16);
        v4u d0, d1; d0.x = pk2(y[0], y[1]); d0.y = pk2(y[2], y[3]); d0.z = pk2(y[4], y[5]); d0.w = pk2(y[6], y[7]); d1.x = pk2(y[8], y[9]); d1.y = pk2(y[10], y[11]); d1.z = pk2(y[12], y[13]); d1.w = pk2(y[14], y[15]);
        dp[0] = d0; dp[1] = d1;
    }
}

constexpr int ML_LTOT = 2064384;
__device__ __forceinline__ int moba_listoff(int g, int n) { return g * ML_LTOT + 4 * (n * T - 128 * n * (n + 1)); }
typedef short s16x4 __attribute__((ext_vector_type(4)));

__device__ __forceinline__ void moba_select_unit(Frame& F, const int g, const int b) {
    if (b == 0) return;
    LAS unsigned char* L = F.lds; unsigned char* ws = F.ws;
    const int tid = threadIdx.x, lane = tid & 63, w = F.wave, l15 = lane & 15, q = lane >> 4;
    constexpr int KH = 0, KL = 17408, GS = 34816, SEL = 68096, LC = 80384, LB = 80640;
    const float* km = (const float*)(ws + WS_CTL) + CW_KMEAN + (size_t)g * 64 * 128;
    for (int i = tid; i < 64 * 128; i += 512) { const int n = i >> 7, d = i & 127; const float x = (n < b) ? km[i] : 0.f; const unsigned hi = f2bf(x); const float lo = x - bf2f(hi);
        *(LAS bf16*)(L + KH + n * 272 + d * 2) = (bf16)hi; *(LAS bf16*)(L + KL + n * 272 + d * 2) = (bf16)f2bf(lo); }
    if (tid < 64) *(LAS unsigned*)(L + LC + tid * 4) = 0u;
    __syncthreads();
    const bf16* MQ = (const bf16*)(ws + WS_MQ);
    LAS float* gs = (LAS float*)(L + GS + w * 4160);
    const int nsel = b < 3 ? b : 3;
#define MS_LOADQ(dst, mt_) do { const int _r0 = (mt_) * 16 + l15; const bf16* _qp = MQ + (size_t)(256 * b + (_r0 >> 2)) * 1024 + (4 * g + (_r0 & 3)) * 128 + 8 * q; \
        _Pragma("unroll") for (int _ks = 0; _ks < 4; ++_ks) dst[_ks] = *(const bf16x8*)(_qp + 32 * _ks); } while (0)
    bf16x8 af[4], af1[4], af2[4];
    MS_LOADQ(af, w); MS_LOADQ(af1, w + 8); MS_LOADQ(af2, w + 16);
    for (int mtile = w; mtile < 64; mtile += 8) {
#pragma unroll
        for (int nt = 0; nt < 4; ++nt) { f32x4 acc = {0.f, 0.f, 0.f, 0.f};
#pragma unroll
            for (int ks = 0; ks < 4; ++ks) { acc = mfma16(af[ks], ldsfrag(L + KH, 16 * nt + l15, 272, ks, q), acc); acc = mfma16(af[ks], ldsfrag(L + KL, 16 * nt + l15, 272, ks, q), acc); }
#pragma unroll
            for (int r = 0; r < 4; ++r) gs[(4 * q + r) * 65 + 16 * nt + l15] = acc[r]; }
        LDS_WAIT(); asm volatile("" ::: "memory");
        {
            const int row = lane >> 2, part = lane & 3;
            float v0 = -INFINITY, v1 = -INFINITY, v2 = -INFINITY; int i0 = 0, i1 = 0, i2 = 0;
            const int nlo = part * 16, nhi = (nlo + 16 < b) ? nlo + 16 : b;
            for (int n = nlo; n < nhi; ++n) { const float x = gs[row * 65 + n];
                if (x > v0) { v2 = v1; i2 = i1; v1 = v0; i1 = i0; v0 = x; i0 = n; } else if (x > v1) { v2 = v1; i2 = i1; v1 = x; i1 = n; } else if (x > v2) { v2 = x; i2 = n; } }
#pragma unroll
            for (int o = 1; o < 4; o <<= 1) {
                const float w0 = __shfl_xor(v0, o), w1 = __shfl_xor(v1, o), w2 = __shfl_xor(v2, o); const int j0 = __shfl_xor(i0, o), j1 = __shfl_xor(i1, o), j2 = __shfl_xor(i2, o);
                const bool lower = (lane & o) == 0;
                const float a0 = lower ? v0 : w0, a1 = lower ? v1 : w1, a2 = lower ? v2 : w2, b0 = lower ? w0 : v0, b1 = lower ? w1 : v1, b2 = lower ? w2 : v2;
                const int ia0 = lower ? i0 : j0, ia1 = lower ? i1 : j1, ia2 = lower ? i2 : j2, ib0 = lower ? j0 : i0, ib1 = lower ? j1 : i1, ib2 = lower ? j2 : i2;
                float r0, r1, r2; int k0, k1, k2;
                if (b0 > a0) { r0 = b0; k0 = ib0;
                    if (b1 > a0) { r1 = b1; k1 = ib1; if (b2 > a0) { r2 = b2; k2 = ib2; } else { r2 = a0; k2 = ia0; } }
                    else { r1 = a0; k1 = ia0; if (b1 > a1) { r2 = b1; k2 = ib1; } else { r2 = a1; k2 = ia1; } } }
                else { r0 = a0; k0 = ia0;
                    if (b0 > a1) { r1 = b0; k1 = ib0; if (b1 > a1) { r2 = b1; k2 = ib1; } else { r2 = a1; k2 = ia1; } }
                    else { r1 = a1; k1 = ia1; if (b0 > a2) { r2 = b0; k2 = ib0; } else { r2 = a2; k2 = ia2; } } }
                v0 = r0; v1 = r1; v2 = r2; i0 = k0; i1 = k1; i2 = k2;
            }
            if (part == 0) { const int rr = mtile * 16 + row;
#pragma unroll
                for (int j = 0; j < 3; ++j) if (j < nsel) { const int blk = j == 0 ? i0 : (j == 1 ? i1 : i2);
                    const unsigned lp = __hip_atomic_fetch_add((LAS unsigned*)(L + LC + blk * 4), 1u, __ATOMIC_RELAXED, __HIP_MEMORY_SCOPE_WORKGROUP);
                    *(LAS unsigned short*)(L + SEL + (rr * 3 + j) * 2) = (unsigned short)blk; *(LAS unsigned short*)(L + SEL + 6144 + (rr * 3 + j) * 2) = (unsigned short)lp; } }
        }
        LDS_WAIT(); asm volatile("" ::: "memory");
#pragma unroll
        for (int ks = 0; ks < 4; ++ks) { af[ks] = af1[ks]; af1[ks] = af2[ks]; }
        if (mtile + 24 < 64) MS_LOADQ(af2, mtile + 24);
    }
#undef MS_LOADQ
    __syncthreads();
    if (tid < b) { const unsigned c = *(LAS unsigned*)(L + LC + tid * 4); *(LAS unsigned*)(L + LB + tid * 4) = c ? atomicAdd(&F.ctl[CW_MOBA_CNT + g * 64 + tid], c) : 0u; }
    __syncthreads();
    unsigned* lists = (unsigned*)(ws + WS_LISTS);
    for (int rr = tid; rr < 1024; rr += 512) { const int t = 256 * b + (rr >> 2), hr = rr & 3;
        for (int j = 0; j < nsel; ++j) { const int blk = *(LAS unsigned short*)(L + SEL + (rr * 3 + j) * 2); const unsigned lp = *(LAS unsigned short*)(L + SEL + 6144 + (rr * 3 + j) * 2);
            lists[moba_listoff(g, blk) + *(LAS unsigned*)(L + LB + blk * 4) + lp] = (unsigned)t | ((unsigned)hr << 14) | ((unsigned)j << 16); } }
    __syncthreads();
}

__device__ __forceinline__ void moba_attn_unit(Frame& F, const int g, const int n, const unsigned* list, const int count, const bool own) {
    LAS unsigned char* L = F.lds; unsigned char* ws = F.ws;
    const int tid = threadIdx.x, lane = tid & 63, w = F.wave, l15 = lane & 15, q = lane >> 4;
    constexpr int KS = 0, VS = 73728;
    { const bf16* MK = (const bf16*)(ws + WS_MK) + (size_t)(256 * n) * 256 + g * 128; const bf16* MV = (const bf16*)(ws + WS_MV) + (size_t)(256 * n) * 256 + g * 128;
        v4u kv[8], vv[8];
#pragma unroll
        for (int i = 0; i < 8; ++i) { const int p = tid + 512 * i, row = p >> 4, ch = p & 15; kv[i] = *(const v4u*)(MK + (size_t)row * 256 + ch * 8); vv[i] = *(const v4u*)(MV + (size_t)row * 256 + ch * 8); }
#pragma unroll
        for (int i = 0; i < 8; ++i) { const int p = tid + 512 * i, row = p >> 4, ch = p & 15; *(LAS v4u*)(L + KS + row * 288 + ch * 16) = kv[i]; *(LAS v4u*)(L + VS + row * 288 + ch * 16) = vv[i]; } }
    __syncthreads();
    const bf16* MQ = (const bf16*)(ws + WS_MQ); bf16* PO = (bf16*)(ws + WS_PO); float* LSE = (float*)(ws + WS_LSE);
    const int ntile = (count + 15) >> 4;
#define MB_ENTRY(tl) ({ int _i = (tl) * 16 + l15; if (_i >= count) _i = count - 1; own ? ((unsigned)(256 * n + (_i >> 2)) | ((unsigned)(_i & 3) << 14) | (3u << 16)) : list[_i]; })
#define MB_LOADQ(dst, e) do { const bf16* _qp = MQ + (size_t)((e) & 16383u) * 1024 + (4 * g + (int)(((e) >> 14) & 3u)) * 128 + 8 * q; \
        _Pragma("unroll") for (int _ks = 0; _ks < 4; ++_ks) dst[_ks] = *(const bf16x8*)(_qp + 32 * _ks); } while (0)
    unsigned e_cur = 0u, e_nxt = 0u; bf16x8 qf[4], qn[4];
    if (w < ntile) { e_cur = MB_ENTRY(w); MB_LOADQ(qf, e_cur); }
    if (w + 8 < ntile) e_nxt = MB_ENTRY(w + 8);
    __builtin_amdgcn_s_waitcnt(0x0F70);
    for (int tile = w; tile < ntile; tile += 8) {
        unsigned e_nn = 0u;
        if (tile + 16 < ntile) e_nn = MB_ENTRY(tile + 16);
        if (tile + 8 < ntile) MB_LOADQ(qn, e_nxt);
        const bool live = tile * 16 + l15 < count;
        const int t = (int)(e_cur & 16383u), hr = (int)((e_cur >> 14) & 3u), j = (int)((e_cur >> 16) & 3u), h = 4 * g + hr;
        f32x4 s[16];
        {
            bf16x8 ka[8], kb[8];
#define MB_LDK(dst, g) do { _Pragma("unroll") for (int _i = 0; _i < 8; ++_i) dst[_i] = ldsfrag(L + KS, 16 * (2 * (g) + (_i >> 2)) + l15, 288, _i & 3, q); } while (0)
#define MB_MMK(src, g) do { _Pragma("unroll") for (int _h = 0; _h < 2; ++_h) { _Pragma("unroll") for (int _ks = 0; _ks < 4; ++_ks) s[2 * (g) + _h] = mfma16(src[_h * 4 + _ks], qf[_ks], s[2 * (g) + _h]); } } while (0)
            const int gmax = own ? ((tile >> 2) >> 1) : 7;
#pragma unroll
            for (int kt = 0; kt < 16; ++kt) s[kt] = (f32x4){0.f, 0.f, 0.f, 0.f};
            MB_LDK(ka, 0);
#pragma unroll
            for (int g = 0; g < 8; g += 2) {
                if (g + 1 <= gmax) MB_LDK(kb, g + 1);
                __builtin_amdgcn_sched_barrier(0); if (g <= gmax) MB_MMK(ka, g); __builtin_amdgcn_sched_barrier(0);
                if (g + 2 < 8 && g + 2 <= gmax) MB_LDK(ka, g + 2);
                __builtin_amdgcn_sched_barrier(0); if (g + 1 <= gmax) MB_MMK(kb, g + 1); __builtin_amdgcn_sched_barrier(0);
            }
#undef MB_LDK
#undef MB_MMK
        }
        const int tq = own ? (t - 256 * n) : 255;
        float m = -1e30f;
#pragma unroll
        for (int kt = 0; kt < 16; ++kt)
#pragma unroll
            for (int r = 0; r < 4; ++r) { const int key = 16 * kt + 4 * q + r; const float x = (!own || key <= tq) ? s[kt][r] : -1e30f; s[kt][r] = x; m = fmaxf(m, x); }
        m = fmaxf(m, __shfl_xor(m, 16)); m = fmaxf(m, __shfl_xor(m, 32));
        float l = 0.f;
#pragma unroll
        for (int kt = 0; kt < 16; ++kt)
#pragma unroll
            for (int r = 0; r < 4; ++r) { const float p = __builtin_amdgcn_exp2f(s[kt][r] - m); s[kt][r] = p; l += p; }
        l += __shfl_xor(l, 16); l += __shfl_xor(l, 32);
        f32x4 oa[8];
#pragma unroll
        for (int md = 0; md < 8; ++md) oa[md] = (f32x4){0.f, 0.f, 0.f, 0.f};
        {
            bf16x8 va[4], vb2[4];
            const LAS unsigned char* vbase = L + VS + (4 * q + (l15 >> 2)) * 288 + (l15 & 3) * 8;
#define MB_LDV(dst, x) do { _Pragma("unroll") for (int _m = 0; _m < 4; ++_m) { const int _md = 4 * ((x) & 1) + _m, _k2 = (x) >> 1; \
                const s16x4 _a0 = __builtin_amdgcn_ds_read_tr16_b64_v4i16((LAS s16x4*)(vbase + (32 * _k2) * 288 + _md * 32)), _a1 = __builtin_amdgcn_ds_read_tr16_b64_v4i16((LAS s16x4*)(vbase + (32 * _k2 + 16) * 288 + _md * 32)); \
                dst[_m] = (bf16x8){_a0[0], _a0[1], _a0[2], _a0[3], _a1[0], _a1[1], _a1[2], _a1[3]}; } } while (0)
#define MB_MMV(src, x) do { const bf16x8 _pb = pack8(s[2 * ((x) >> 1)], s[2 * ((x) >> 1) + 1]); _Pragma("unroll") for (int _m = 0; _m < 4; ++_m) oa[4 * ((x) & 1) + _m] = mfma16(src[_m], _pb, oa[4 * ((x) & 1) + _m]); } while (0)
            const int xmax = own ? (2 * (tile >> 3) + 1) : 15;
            MB_LDV(va, 0);
#pragma unroll
            for (int x = 0; x < 16; x += 2) {
                if (x + 1 <= xmax) MB_LDV(vb2, x + 1);
                __builtin_amdgcn_sched_barrier(0); if (x <= xmax) MB_MMV(va, x); __builtin_amdgcn_sched_barrier(0);
                if (x + 2 < 16 && x + 2 <= xmax) MB_LDV(va, x + 2);
                __builtin_amdgcn_sched_barrier(0); if (x + 1 <= xmax) MB_MMV(vb2, x + 1); __builtin_amdgcn_sched_barrier(0);
            }
#undef MB_LDV
#undef MB_MMV
        }
        __builtin_amdgcn_s_waitcnt(0x0F70);
        if (live) { const float inv = 1.f / l; bf16* op = PO + (((size_t)t * 8 + h) * 4 + j) * 128 + 4 * q;
#pragma unroll
            for (int md = 0; md < 8; ++md) { v2u o; o.x = pg8::cvt_pk_bf16(oa[md][0] * inv, oa[md][1] * inv); o.y = pg8::cvt_pk_bf16(oa[md][2] * inv, oa[md][3] * inv); __builtin_nontemporal_store(o, (v2u*)(op + 16 * md)); }
            if (q == 0) __builtin_nontemporal_store((m + __builtin_amdgcn_logf(l)) * 0.6931471805599453f, &LSE[((size_t)t * 8 + h) * 4 + j]); }
        e_cur = e_nxt; e_nxt = e_nn;
#pragma unroll
        for (int ks = 0; ks < 4; ++ks) qf[ks] = qn[ks];
    }
#undef MB_ENTRY
#undef MB_LOADQ
    __syncthreads();
}

__device__ __forceinline__ void moba_own_queue(Frame& F) {
    LAS int* bc = (LAS int*)(F.lds + 148480) + 132; const int tid = threadIdx.x;
    for (;;) {
        if (tid == 0) *bc = (int)atomicAdd(&F.ctl[CW_QHEAD], 1u);
        __syncthreads();
        const int it = *bc;
        __syncthreads();
        if (it >= 128) break;
        moba_attn_unit(F, it & 1, it >> 1, nullptr, 1024, true);
    }
}
__device__ __forceinline__ void moba_attn_queue(Frame& F) {
    LAS unsigned char* L = F.lds; unsigned char* ws = F.ws; const int tid = threadIdx.x;
    LAS int* pre = (LAS int*)(L + 148480); LAS int* bc = pre + 132;
    moba_own_queue(F);
    if (tid < 128) { const int c = (int)__hip_atomic_load(&F.ctl[CW_MOBA_CNT + tid], __ATOMIC_RELAXED, __HIP_MEMORY_SCOPE_AGENT); const int nch = (c + 1023) >> 10; const int v = wave_scan_dpp(nch);
        pre[tid] = v - nch; if ((tid & 63) == 63) pre[129 + (tid >> 6)] = v; }
    __syncthreads();
    if (tid >= 64 && tid < 128) pre[tid] += pre[129];
    if (tid == 0) pre[128] = pre[129] + pre[130];
    __syncthreads();
    const int total = pre[128];
    for (;;) {
        if (tid == 0) *bc = (int)atomicAdd(&F.ctl[CW_QHEAD + 1], 1u);
        __syncthreads();
        const int x = *bc;
        __syncthreads();
        if (x >= total) break;
        int idx = 0; while (pre[idx + 1] <= x) ++idx;
        const int g = idx >> 6, n = idx & 63, ch = x - pre[idx]; const int cnt = (int)__hip_atomic_load(&F.ctl[CW_MOBA_CNT + idx], __ATOMIC_RELAXED, __HIP_MEMORY_SCOPE_AGENT);
        const int c0 = ch * 1024, cc = (cnt - c0) < 1024 ? (cnt - c0) : 1024;
        moba_attn_unit(F, g, n, (const unsigned*)(ws + WS_LISTS) + moba_listoff(g, n) + c0, cc, false);
    }
}

__device__ __forceinline__ void moba_combine(Frame& F, const int wg0) {
    unsigned char* ws = F.ws; const int lane = threadIdx.x & 63;
    const int gw = (F.bid - wg0) * NWAVES + F.wave, NGW = (F.G - wg0) * NWAVES;
    const bf16* PO = (const bf16*)(ws + WS_PO); const float* LSE = (const float*)(ws + WS_LSE);
    const int h = lane >> 3;
#define MC_LOAD(t_, L_, A_, C_) do { L_ = __builtin_nontemporal_load((const f32x4*)(LSE + ((size_t)(t_) * 8 + h) * 4)); \
        _Pragma("unroll") for (int _j = 0; _j < 4; ++_j) { const v4u* _pp = (const v4u*)(PO + (((size_t)(t_) * 8 + h) * 4 + _j) * 128 + (lane & 7) * 16); A_[_j] = __builtin_nontemporal_load(_pp); C_[_j] = __builtin_nontemporal_load(_pp + 1); } } while (0)
    f32x4 ls, lsn; v4u pa[4], pc[4], na[4], nc[4];
    int t = gw;
    if (t < T) MC_LOAD(t, ls, pa, pc);
    for (; t < T; t += NGW) {
        const int tn = t + NGW;
        if (tn < T) MC_LOAD(tn, lsn, na, nc);
        const int b = t >> 8, nsel = b < 3 ? b : 3;
        float lj[4] = {nsel > 0 ? ls[0] : -INFINITY, nsel > 1 ? ls[1] : -INFINITY, nsel > 2 ? ls[2] : -INFINITY, ls[3]};
        const float M = fmaxf(fmaxf(lj[0], lj[1]), fmaxf(lj[2], lj[3]));
        float wj[4], ws_ = 0.f;
#pragma unroll
        for (int j = 0; j < 4; ++j) { wj[j] = __expf(lj[j] - M); ws_ += wj[j]; }
        const float inv = 1.f / ws_;
        float acc[16];
#pragma unroll
        for (int e = 0; e < 16; ++e) acc[e] = 0.f;
#pragma unroll
        for (int j = 0; j < 4; ++j) { const bool on = (j == 3) || (j < nsel);
            const v4u a = pa[j], c = pc[j]; const float wv = wj[j] * inv;
#define MC_ACC(i_, x_) acc[i_] += on ? wv * (x_) : 0.f
            MC_ACC(0, bflo(a.x)); MC_ACC(1, bfhi(a.x)); MC_ACC(2, bflo(a.y)); MC_ACC(3, bfhi(a.y)); MC_ACC(4, bflo(a.z)); MC_ACC(5, bfhi(a.z)); MC_ACC(6, bflo(a.w)); MC_ACC(7, bfhi(a.w));
            MC_ACC(8, bflo(c.x)); MC_ACC(9, bfhi(c.x)); MC_ACC(10, bflo(c.y)); MC_ACC(11, bfhi(c.y)); MC_ACC(12, bflo(c.z)); MC_ACC(13, bfhi(c.z)); MC_ACC(14, bflo(c.w)); MC_ACC(15, bfhi(c.w));
#undef MC_ACC
        }
        v4u d8; d8.x = pk4_fp8(16.f * acc[0], 16.f * acc[1], 16.f * acc[2], 16.f * acc[3]); d8.y = pk4_fp8(16.f * acc[4], 16.f * acc[5], 16.f * acc[6], 16.f * acc[7]);
        d8.z = pk4_fp8(16.f * acc[8], 16.f * acc[9], 16.f * acc[10], 16.f * acc[11]); d8.w = pk4_fp8(16.f * acc[12], 16.f * acc[13], 16.f * acc[14], 16.f * acc[15]);
        __builtin_amdgcn_s_waitcnt(0x0F70);
        *(v4u*)(ws + WS_A2 + (size_t)t * 1024 + lane * 16) = d8;
        ls = lsn;
#pragma unroll
        for (int j = 0; j < 4; ++j) { pa[j] = na[j]; pc[j] = nc[j]; }
    }
#undef MC_LOAD
}

constexpr size_t WS_ELIST = 944 * MiB, WS_EDST = 960 * MiB;
constexpr size_t WS_HB8 = 976 * MiB;
__device__ __forceinline__ void moe_route(Frame& F, const float* logits, const float* bias, float* wts, unsigned* cnt, int* elist, int* edst) {
    const int lane = threadIdx.x & 63, tid = threadIdx.x;
    LAS unsigned* lcnt = (LAS unsigned*)F.lds; LAS unsigned* gb = lcnt + 256; LAS unsigned* pk = gb + 256;
    const f32x4 bz = ((const f32x4*)bias)[lane];
    for (int t0 = F.bid * 64; t0 < T; t0 += F.G * 64) {
        if (tid < 256) lcnt[tid] = 0u;
        __syncthreads();
        f32x4 lgs[8];
#pragma unroll
        for (int i = 0; i < 8; ++i) { const f32x4* lp = (const f32x4*)(logits + (size_t)(t0 + 8 * F.wave + i) * 512); lgs[i] = lp[lane] + lp[64 + lane]; }
#pragma unroll 1
        for (int i = 0; i < 8; ++i) {
            const int t = t0 + 8 * F.wave + i;
            f32x4 lg = lgs[0];
#pragma unroll
            for (int k = 1; k < 8; ++k) if (i == k) lg = lgs[k];
            float sc[4], ch[4];
#pragma unroll
            for (int e = 0; e < 4; ++e) { sc[e] = 1.f / (1.f + expf(-lg[e])); ch[e] = sc[e] + bz[e]; }
            float a = fmaxf(ch[0], ch[1]), b = fminf(ch[0], ch[1]);
            { const float a2 = fmaxf(ch[2], ch[3]), b2 = fminf(ch[2], ch[3]); const float na = fmaxf(a, a2); b = fmaxf(fminf(a, a2), fmaxf(b, b2)); a = na; }
#pragma unroll
            for (int o = 1; o < 8; o <<= 1) { const float a2 = __shfl_xor(a, o), b2 = __shfl_xor(b, o); const float na = fmaxf(a, a2); b = fmaxf(fminf(a, a2), fmaxf(b, b2)); a = na; }
            const float gs = a + b; const int g = lane >> 3;
            int rank = 0;
#pragma unroll
            for (int g2 = 0; g2 < 8; ++g2) { const float o = __builtin_bit_cast(float, __builtin_amdgcn_readlane(__builtin_bit_cast(int, gs), g2 * 8)); rank += (o > gs || (o == gs && g2 < g)) ? 1 : 0; }
            const bool sel = rank < 4;
            unsigned key[4];
#pragma unroll
            for (int e = 0; e < 4; ++e) { const unsigned bb = __builtin_bit_cast(unsigned, ch[e]); key[e] = sel ? ((bb & 0x80000000u) ? ~bb : (bb | 0x80000000u)) : 0u; }
            unsigned thr = 0u;
            for (int bit = 31; bit >= 0; --bit) { const unsigned cand = thr | (1u << bit); int c = 0;
#pragma unroll
                for (int e = 0; e < 4; ++e) c += __builtin_popcountll(__ballot(key[e] >= cand));
                if (c >= 8) thr = cand;
                if (c == 8) break; }
            int G8 = 0; unsigned long long beq[4]; bool gt[4], eq[4];
#pragma unroll
            for (int e = 0; e < 4; ++e) { gt[e] = key[e] > thr; eq[e] = key[e] == thr; G8 += __builtin_popcountll(__ballot(gt[e])); beq[e] = __ballot(eq[e]); }
            const int need = 8 - G8;
            int tb_ = 0;
#pragma unroll
            for (int e = 0; e < 4; ++e) tb_ += (int)__builtin_amdgcn_mbcnt_hi((unsigned)(beq[e] >> 32), __builtin_amdgcn_mbcnt_lo((unsigned)beq[e], 0u));
            bool pick[4]; int run = tb_;
#pragma unroll
            for (int e = 0; e < 4; ++e) { pick[e] = gt[e] || (eq[e] && run < need); run += eq[e] ? 1 : 0; }
            int sb = 0; float ls = 0.f;
#pragma unroll
            for (int e = 0; e < 4; ++e) { const unsigned long long bp = __ballot(pick[e]); sb += (int)__builtin_amdgcn_mbcnt_hi((unsigned)(bp >> 32), __builtin_amdgcn_mbcnt_lo((unsigned)bp, 0u)); ls += pick[e] ? sc[e] : 0.f; }
            const float ssum = wave_sum(ls);
            int slot = sb;
#pragma unroll
            for (int e = 0; e < 4; ++e) if (pick[e]) { const int ex = 4 * lane + e;
                wts[t * 8 + slot] = sc[e] / (ssum + 1e-20f) * 2.5f;
                const unsigned lp = __hip_atomic_fetch_add(&lcnt[ex], 1u, __ATOMIC_RELAXED, __HIP_MEMORY_SCOPE_WORKGROUP);
                const int pi = ((8 * F.wave + i) * 8 + slot) * 2; pk[pi] = (unsigned)ex | (lp << 8); pk[pi + 1] = (unsigned)(t * 8 + slot); ++slot; }
        }
        __syncthreads();
        if (tid < 256) { const unsigned c = lcnt[tid]; gb[tid] = c ? atomicAdd(&cnt[tid], c) : 0u; }
        __syncthreads();
        { const unsigned x = pk[2 * tid], d = pk[2 * tid + 1]; const unsigned ex = x & 255u, p = gb[ex] + (x >> 8);
          elist[(size_t)ex * T + p] = (int)(d >> 3); edst[(size_t)ex * T + p] = (int)d; }
        __syncthreads();
    }
}
constexpr int MOE_TB_OFF = 148480;
__device__ __forceinline__ void moe_tiles(Frame& F, const unsigned* cnt) {
    LAS int* tb = (LAS int*)(F.lds + MOE_TB_OFF); LAS int* cn = tb + 260;
    if (F.wave == 0) { const int lane = threadIdx.x & 63; int c[4], nt[4], s_ = 0;
#pragma unroll
        for (int e = 0; e < 4; ++e) { c[e] = (int)__hip_atomic_load(&cnt[4 * lane + e], __ATOMIC_RELAXED, __HIP_MEMORY_SCOPE_AGENT); nt[e] = (c[e] + 255) >> 8; s_ += nt[e]; }
        const int inc = wave_scan_dpp(s_);
        int ex = inc - s_;
#pragma unroll
        for (int e = 0; e < 4; ++e) { tb[4 * lane + e] = ex; cn[4 * lane + e] = c[e];
            for (int j = 0; j < nt[e]; ++j) ((LAS unsigned short*)(tb + 516))[ex + j] = (unsigned short)(4 * lane + e);
            ex += nt[e]; }
        if (lane == 63) tb[256] = inc; }
    __syncthreads();
}
__device__ __forceinline__ void final_rows(Frame& F, const bf16* HBp, const bf16* SHY, const unsigned char* YR, const float* wts, const float* g, const float* b, float* out, bool use_moe) {
    const int gw = F.bid * NWAVES + F.wave, NGW = F.G * NWAVES, lane = ((int)(threadIdx.x & 63));
    f32x4 gv[4], bv[4];
#pragma unroll
    for (int j = 0; j < 4; ++j) { gv[j] = ((const f32x4*)g)[lane + 64 * j]; bv[j] = ((const f32x4*)b)[lane + 64 * j]; }
#define FR_LOAD(m_, H_, S_, W_, Y_) do { const int _m = (m_) < T ? (m_) : T - 1; const v2u* _xr = (const v2u*)(HBp + (size_t)_m * D) + lane; \
        _Pragma("unroll") for (int _j = 0; _j < 4; ++_j) H_[_j] = _xr[64 * _j]; \
        if (use_moe) { const v2u* _sr = (const v2u*)(SHY + (size_t)_m * D) + lane; _Pragma("unroll") for (int _j = 0; _j < 4; ++_j) S_[_j] = _sr[64 * _j]; \
            W_ = wts[_m * 8 + (lane & 7)]; \
            _Pragma("unroll") for (int _k = 0; _k < 8; ++_k) { const unsigned* _yr = (const unsigned*)(YR + ((size_t)_m * 8 + _k) * D) + lane; \
                _Pragma("unroll") for (int _j = 0; _j < 4; ++_j) Y_[_k * 4 + _j] = _yr[64 * _j]; } } } while (0)
    v2u hA[4], sA[4], hB[4], sB[4]; float wA = 0.f, wB = 0.f; unsigned yA[32], yB[32];
    if (gw < T) FR_LOAD(gw, hA, sA, wA, yA);
    for (int m = gw; m < T; m += NGW) {
        FR_LOAD(m + NGW, hB, sB, wB, yB);
        f32x4 v[4];
#pragma unroll
        for (int j = 0; j < 4; ++j) { const v2u x = hA[j]; v[j] = (f32x4){bflo(x.x), bfhi(x.x), bflo(x.y), bfhi(x.y)} * DN_ALPHA; }
        if (use_moe) {
#pragma unroll
            for (int j = 0; j < 4; ++j) { const v2u s = sA[j]; v[j][0] += bflo(s.x); v[j][1] += bfhi(s.x); v[j][2] += bflo(s.y); v[j][3] += bfhi(s.y); }
#pragma unroll
            for (int k = 0; k < 8; ++k) { const float w = __shfl(wA, k) * 0.0625f;
#pragma unroll
                for (int j = 0; j < 4; ++j) { const unsigned x = yA[k * 4 + j];
                    v[j][0] += w * __builtin_amdgcn_cvt_f32_fp8(x, 0); v[j][1] += w * __builtin_amdgcn_cvt_f32_fp8(x, 1); v[j][2] += w * __builtin_amdgcn_cvt_f32_fp8(x, 2); v[j][3] += w * __builtin_amdgcn_cvt_f32_fp8(x, 3); } }
        }
        float s = 0.f;
#pragma unroll
        for (int j = 0; j < 4; ++j) s += (v[j][0] + v[j][1]) + (v[j][2] + v[j][3]);
        const float mean = wave_sum(s) * (1.f / D); float s2 = 0.f;
#pragma unroll
        for (int j = 0; j < 4; ++j) { v[j] = v[j] - mean; s2 += (v[j][0] * v[j][0] + v[j][1] * v[j][1]) + (v[j][2] * v[j][2] + v[j][3] * v[j][3]); }
        const float rstd = 1.f / sqrtf(wave_sum(s2) * (1.f / D) + LN_EPS);
        __builtin_amdgcn_s_waitcnt(0x0F70);
        f32x4* o = (f32x4*)(out + (size_t)m * D) + lane;
#pragma unroll
        for (int j = 0; j < 4; ++j) o[64 * j] = v[j] * rstd * gv[j] + bv[j];
#pragma unroll
        for (int j = 0; j < 4; ++j) { hA[j] = hB[j]; sA[j] = sB[j]; }
        wA = wB;
#pragma unroll
        for (int i = 0; i < 32; ++i) yA[i] = yB[i];
    }
#undef FR_LOAD
}

enum Phase { PH_PROLOGUE = 0, PH_INPROJ, PH_PREP, PH_SCAN, PH_POST, PH_PROJ, PH_WOUT, PH_LN1, PH_ROUTER, PH_ROUTE, PH_EXP1, PH_EXP2, PH_FINAL, PH_COUNT };

__global__ void __launch_bounds__(NWAVES * 64, 2) mega_fwd(Args args) {
    extern __shared__ __attribute__((aligned(16))) unsigned char lds_raw[];
    Frame F;
    F.lds = (LAS unsigned char*)lds_raw;
    F.MISC = (volatile LAS unsigned*)(F.lds + MISC_OFF);
    F.wave = __builtin_amdgcn_readfirstlane(threadIdx.x >> 6);
    F.G = gridDim.x; F.bid = blockIdx.x; F.ws = args.ws; F.ctl = (unsigned*)(args.ws + WS_CTL);
    unsigned char* ws = args.ws;
    if (((int)threadIdx.x) < 64) F.MISC[((int)threadIdx.x)] = 0u;
    __syncthreads();
    XcdBarrier bar; bar.bar = F.ctl + CW_BAR; bar.x = 0; bar.st = nullptr; bar.gtot = 0;
    if (!N_LAUNCH_SPLIT) bar = xcd_barrier_post(F.ctl + CW_BAR, F.MISC + 8);
    XcdBarrier bar2; bar2.bar = F.ctl + CW_BAR2; bar2.x = 0; bar2.st = nullptr; bar2.gtot = 0;
    if (!N_LAUNCH_SPLIT && F.bid >= NSCAN + NWARM) { bar2 = xcd_barrier_post(F.ctl + CW_BAR2, F.MISC + 10); bar2.gtot = F.G - (NSCAN + NWARM); }
    const int lo = args.ph_lo, hi = args.ph_hi;
#define IN(k) (lo <= (k) && (k) < hi)
#define SEAM(k) do { if (IN(k) && IN((k) + 1)) xcd_barrier(bar); } while (0)

    if (IN(PH_PROLOGUE)) { p0_prologue(F, args, false, 0); }
    SEAM(PH_PROLOGUE);

#if STAGE >= 3
    if (IN(PH_INPROJ)) {
        constexpr int NGEMM = 153;
        if (F.bid < NGEMM) {
            pg8::DenseOrder S; S.init(T, NIN, D / 2, NGEMM, F.bid, (const bf16*)(ws + WS_WIN));
            EpiInProj E{ws, args.in[3], args.in[4]};
            pg8::gemm_phase<EpiInProj, pg8::DenseOrder, false, 5>(F.lds, ws + WS_XB, nullptr, D / 2, S, E);
        }
        expert_convert_queue(F, args);
    }
    SEAM(PH_INPROJ);
    if (IN(PH_PREP)) {
        gdn_prep_all(F, args);
    }
    SEAM(PH_PREP);
    if (IN(PH_SCAN)) {
        if (F.bid < NSCAN) gdn_scan2(F, F.bid);
        else if (F.bid < NSCAN + NWARM) gdn_scan_warm(F, F.bid - NSCAN);
#if STAGE >= 4
        else {
            {
                const int su = F.bid - (NSCAN + NWARM);
                if (su < 126 && F.G - (NSCAN + NWARM) >= 126) moba_select_unit(F, su & 1, 63 - (su >> 1));
                else if (F.G - (NSCAN + NWARM) >= 126) moba_own_queue(F);
                else for (int u = su; u < 128; u += F.G - (NSCAN + NWARM)) moba_select_unit(F, u & 1, 63 - (u >> 1));
            }
            xcd_barrier(bar2);
            moba_attn_queue(F);
            xcd_barrier(bar2);
            moba_combine(F, NSCAN + NWARM);
        }
#endif
    }
    SEAM(PH_SCAN);
    if (IN(PH_POST)) { gdn_ophase(F, args.in[5]); }
    SEAM(PH_POST);
    if (IN(PH_PROJ)) {
#if STAGE >= 4
        {
            pg8::DenseOrder S2; S2.init(T, D, D / 2, F.G, F.bid, (const bf16*)(ws + WS_WMP));
            EpiGate<false> E2{(bf16*)(ws + WS_MBUF), (const bf16*)(ws + WS_SGM), nullptr};
            pg8::gemm_phase<EpiGate<false>, pg8::DenseOrder, false, 6, 4>(F.lds, ws + WS_A2, nullptr, D / 2, S2, E2);
        }
#endif
        pg8::DenseOrder S; S.init(T, D, D / 2, F.G, F.bid, (const bf16*)(ws + WS_WGP));
#if STAGE >= 4
        EpiGate<true, true> E{(bf16*)(ws + WS_MBUF), (const bf16*)(ws + WS_SGG), ws + WS_OG + 16 * MiB};
        pg8::gemm_phase<EpiGate<true, true>, pg8::DenseOrder, false, 6, 0>(F.lds, ws + WS_OG, nullptr, D / 2, S, E);
#else
        EpiGate<false, true> E{(bf16*)(ws + WS_MBUF), (const bf16*)(ws + WS_SGG), ws + WS_OG + 16 * MiB};
        pg8::gemm_phase<EpiGate<false, true>, pg8::DenseOrder, false, 6, 0>(F.lds, ws + WS_OG, nullptr, D / 2, S, E);
#endif
    }
    SEAM(PH_PROJ);
    if (IN(PH_WOUT)) {
        pg8::DenseOrder S; S.init(T, D, D / 2, F.G, F.bid, (const bf16*)(ws + WS_WOUT));
        EpiBf16Res E{(bf16*)(ws + WS_HB), 1024, args.in[0], DN_ALPHA};
        pg8::gemm_phase<EpiBf16Res, pg8::DenseOrder, false, 6, 2>(F.lds, ws + WS_OG + 16 * MiB, nullptr, D / 2, S, E);
    }
#else
    SEAM(PH_INPROJ); SEAM(PH_PREP); SEAM(PH_SCAN); SEAM(PH_POST); SEAM(PH_PROJ);
    if (IN(PH_WOUT)) {
        const f32x4* x4 = (const f32x4*)args.in[0]; v2u* p4 = (v2u*)(ws + WS_HB); const size_t n4 = (size_t)T * D / 4;
        for (size_t i = (size_t)F.bid * 512 + threadIdx.x; i < n4; i += (size_t)F.G * 512) { const f32x4 x = x4[i] * DN_ALPHA; v2u o; o.x = pk2(x[0], x[1]); o.y = pk2(x[2], x[3]); p4[i] = o; }
    }
#endif
    SEAM(PH_WOUT);
    if (IN(PH_LN1)) { ln_rows(F, (bf16*)(ws + WS_HB), ws + WS_HB8, args.in[9], args.in[10]);
        if (F.bid == 0 && threadIdx.x < 64) ((v4u*)(ws + WS_HB8 + (size_t)T * D))[threadIdx.x] = (v4u){0u, 0u, 0u, 0u}; }
    SEAM(PH_LN1);
#if STAGE >= 2
    if (IN(PH_ROUTER)) {
        { pg8::SplitK2Order S; S.nM = T / 256; S.G = F.G; S.c = F.bid; S.Bt = (const char*)(ws + WS_ROUTER); S.khalfB = 1024;
          EpiF32Res E{(float*)(ws + WS_LOGITS2), 512, nullptr, 0.f};
          pg8::gemm_phase<EpiF32Res, pg8::SplitK2Order, false>(F.lds, (const bf16*)(ws + WS_HB), nullptr, D / 2, S, E, 2048u); }
        { pg8::DenseOrder S; S.init(T, 512, D / 2, F.G, (F.bid + 128) % F.G, (const bf16*)(ws + WS_SHGU));
          EpiSwiGLU E{(bf16*)(ws + WS_HS)};
          pg8::gemm_phase<EpiSwiGLU, pg8::DenseOrder, false, 5>(F.lds, ws + WS_HB8, nullptr, D / 2, S, E); }
    }
    SEAM(PH_ROUTER);
    if (IN(PH_ROUTE)) { moe_route(F, (const float*)(ws + WS_LOGITS2), args.in[12], (float*)(ws + WS_WTS), F.ctl + CW_MOE_CNT, (int*)(ws + WS_ELIST), (int*)(ws + WS_EDST)); }
    SEAM(PH_ROUTE);
    if (IN(PH_EXP1)) {
        moe_tiles(F, F.ctl + CW_MOE_CNT);
        { pg8::GroupOrder<2> S; S.G = F.G; S.c = F.bid; S.tb = (const LAS int*)(F.lds + MOE_TB_OFF); S.cn = S.tb + 260; S.W = (const char*)(ws + WS_EXPGU); S.estride = (size_t)512 * 1024; S.tstepB = (size_t)256 * 1024;
          EpiSwiGLU8 E{ws + WS_HEXP};
          pg8::gemm_phase<EpiSwiGLU8, pg8::GroupOrder<2>, true, 5>(F.lds, ws + WS_HB8, (const int*)(ws + WS_ELIST), D / 2, S, E); }
        { pg8::DenseOrder S; S.init(T, 1024, 256, F.G, F.bid, (const bf16*)(ws + WS_SHD));
          EpiBf16Plain E{(bf16*)(ws + WS_SHY), 1024};
          pg8::gemm_phase<EpiBf16Plain, pg8::DenseOrder, false>(F.lds, (const bf16*)(ws + WS_HS), nullptr, 256, S, E); }
    }
    SEAM(PH_EXP1);
    if (IN(PH_EXP2)) {
        moe_tiles(F, F.ctl + CW_MOE_CNT);
        pg8::GroupOrder<4> S; S.G = F.G; S.c = F.bid; S.tb = (const LAS int*)(F.lds + MOE_TB_OFF); S.cn = S.tb + 260; S.W = (const char*)(ws + WS_EXPD); S.estride = (size_t)1024 * 256; S.tstepB = (size_t)256 * 256;
        EpiScatter8 E{ws + WS_YR, (const int*)(ws + WS_EDST)};
        pg8::gemm_phase<EpiScatter8, pg8::GroupOrder<4>, false, 5, 2>(F.lds, ws + WS_HEXP, nullptr, 128 | (args.ph_lo >> 30), S, E);
    }
    SEAM(PH_EXP2);
#else
    SEAM(PH_ROUTER); SEAM(PH_ROUTE); SEAM(PH_EXP1); SEAM(PH_EXP2);
#endif
    if (IN(PH_FINAL)) {
        final_rows(F, (const bf16*)(ws + WS_HB), (const bf16*)(ws + WS_SHY), ws + WS_YR, (const float*)(ws + WS_WTS), args.in[19], args.in[20], args.out, STAGE >= 2);
    }
#undef IN
#undef SEAM
}

extern "C" void kernel_launch(void* const* d_in, const int* in_sizes, int n_in, void* d_out, int out_size, void* d_ws, size_t ws_size, hipStream_t stream) {
    static int grid = 0;
    if (grid == 0) {
        if (n_in != 21 || out_size != T * D || ws_size < WS_END) { fprintf(stderr, "kernel_launch: unexpected shapes (n_in %d out %d ws %zu)\n", n_in, out_size, ws_size); grid = -1; return; }
        int dev = 0, cus = 0, per_cu = 0;
        if (hipGetDevice(&dev) != hipSuccess || hipDeviceGetAttribute(&cus, hipDeviceAttributeMultiprocessorCount, dev) != hipSuccess) { grid = -1; return; }
        if (hipFuncSetAttribute((const void*)mega_fwd, hipFuncAttributeMaxDynamicSharedMemorySize, LDS_BYTES) != hipSuccess) { fprintf(stderr, "kernel_launch: hipFuncSetAttribute failed\n"); grid = -1; return; }
        if (hipOccupancyMaxActiveBlocksPerMultiprocessor(&per_cu, (const void*)mega_fwd, NWAVES * 64, LDS_BYTES) != hipSuccess || per_cu < 1) { fprintf(stderr, "kernel_launch: occupancy query says %d\n", per_cu); }
        (void)hipGetLastError();
        grid = cus;
    }
    if (grid < 0) return;
    (void)hipMemsetAsync((char*)d_ws + WS_CTL, 0, CTL_ZERO_BYTES, stream);
    Args a{};
    for (int i = 0; i < 21; ++i) a.in[i] = (const float*)d_in[i];
    a.out = (float*)d_out; a.ws = (unsigned char*)d_ws;
    for (int i = 0; i < 16; ++i) a.rope_inv[i] = powf(500000.0f, -(float)i / 16.0f);
#if N_LAUNCH_SPLIT
    for (int p = 0; p < PH_COUNT; ++p) { a.ph_lo = p; a.ph_hi = p + 1; hipLaunchKernelGGL(mega_fwd, dim3(grid), dim3(NWAVES * 64), LDS_BYTES, stream, a); }
#else
    a.ph_lo = 0; a.ph_hi = PH_COUNT;
    hipLaunchKernelGGL(mega_fwd, dim3(grid), dim3(NWAVES * 64), LDS_BYTES, stream, a);
#endif
}
```

```cpp
#include <hip/hip_runtime.h>
#include <cstdio>
#include <cstdint>
#include <cmath>

#ifndef STAGE
#define STAGE 4
#endif
#ifndef N_LAUNCH_SPLIT
#define N_LAUNCH_SPLIT 0
#endif

#define GAS __attribute__((address_space(1)))
#define LAS __attribute__((address_space(3)))
typedef unsigned short bf16;
typedef unsigned v4u __attribute__((ext_vector_type(4)));
typedef unsigned v2u __attribute__((ext_vector_type(2)));
typedef float f32x4 __attribute__((ext_vector_type(4)));
typedef float f32x2 __attribute__((ext_vector_type(2)));
typedef short bf16x8 __attribute__((ext_vector_type(8)));
typedef short bf16x4 __attribute__((ext_vector_type(4)));
#define LDS_WAIT() asm volatile("s_waitcnt lgkmcnt(0)" ::: "memory")
#define VM_WAIT() asm volatile("s_waitcnt vmcnt(0)" ::: "memory")

__device__ __forceinline__ unsigned f2bf(float f) { unsigned u = __builtin_bit_cast(unsigned, f); return (u + 0x7fffu + ((u >> 16) & 1u)) >> 16; }
__device__ __forceinline__ unsigned pk2(float lo, float hi) { return f2bf(lo) | (f2bf(hi) << 16); }
__device__ __forceinline__ float bf2f(unsigned b) { return __builtin_bit_cast(float, b << 16); }
__device__ __forceinline__ float bflo(unsigned w) { return __builtin_bit_cast(float, w << 16); }
__device__ __forceinline__ float bfhi(unsigned w) { return __builtin_bit_cast(float, w & 0xffff0000u); }
__device__ __forceinline__ unsigned pk4_fp8(float a, float b, float c, float d) { unsigned w = 0u; w = __builtin_amdgcn_cvt_pk_fp8_f32(a, b, w, false); w = __builtin_amdgcn_cvt_pk_fp8_f32(c, d, w, true); return w; }
__device__ __forceinline__ float sigmoidf_(float x) { return __builtin_amdgcn_rcpf(1.f + __builtin_amdgcn_exp2f(-1.4426950408889634f * x)); }
__device__ __forceinline__ float siluf_(float x) { return x * __builtin_amdgcn_rcpf(1.f + __builtin_amdgcn_exp2f(-1.4426950408889634f * x)); }
#define DPP_STEP(v, ctrl, rmask) ((v) + __builtin_bit_cast(float, __builtin_amdgcn_update_dpp(0, __builtin_bit_cast(int, (v)), (ctrl), (rmask), 0xf, false)))
#define DPP_STEP_I(v, ctrl, rmask) ((v) + __builtin_amdgcn_update_dpp(0, (v), (ctrl), (rmask), 0xf, false))
__device__ __forceinline__ int wave_scan_dpp(int v) {
    v = DPP_STEP_I(v, 0x111, 0xf); v = DPP_STEP_I(v, 0x112, 0xf); v = DPP_STEP_I(v, 0x114, 0xf); v = DPP_STEP_I(v, 0x118, 0xf); v = DPP_STEP_I(v, 0x142, 0xa); v = DPP_STEP_I(v, 0x143, 0xc);
    return v;
}
__device__ __forceinline__ float wave_sum_dpp(float v) {
    v = DPP_STEP(v, 0x111, 0xf); v = DPP_STEP(v, 0x112, 0xf); v = DPP_STEP(v, 0x114, 0xf); v = DPP_STEP(v, 0x118, 0xf);
    v = DPP_STEP(v, 0x142, 0xa);
    v = DPP_STEP(v, 0x143, 0xc);
    return __builtin_bit_cast(float, __builtin_amdgcn_readlane(__builtin_bit_cast(int, v), 63));
}

__device__ __forceinline__ float wave_sum(float v) { return wave_sum_dpp(v); }

constexpr int T = 16384, D = 1024;
constexpr int NIN = 7936;
constexpr int NEXP = 256, TOPK = 8, EDIM = 256;
constexpr int RMAX = T * TOPK + NEXP * 256;
constexpr float LN_EPS = 1e-5f;
constexpr float DN_ALPHA = 1.189207115002721f;

constexpr size_t MiB = 1u << 20;
constexpr size_t WS_CTL = 0, CTL_ZERO_BYTES = 1 * MiB;
constexpr size_t WS_ROPE = 1 * MiB;
constexpr size_t WS_GL = 3 * MiB;
constexpr size_t WS_EIDX = 4 * MiB;
constexpr size_t WS_WTS = 4 * MiB + 512 * 1024;
constexpr size_t WS_ROWTOK = 5 * MiB;
constexpr size_t WS_ROWDST = 6 * MiB;
constexpr size_t WS_TILEE = 7 * MiB;
constexpr size_t WS_WIN = 8 * MiB;
constexpr size_t WS_WGP = 24 * MiB, WS_WMP = 26 * MiB, WS_WOUT = 28 * MiB;
constexpr size_t WS_ROUTER = 30 * MiB;
constexpr size_t WS_SHGU = 30 * MiB + 512 * 1024;
constexpr size_t WS_SHD = 31 * MiB + 512 * 1024;
constexpr size_t WS_EXPGU = 32 * MiB;
constexpr size_t WS_EXPD = 288 * MiB;
constexpr size_t WS_XB = 416 * MiB;
constexpr size_t WS_CONVIN = 448 * MiB;
constexpr size_t WS_PO = 416 * MiB;
constexpr size_t WS_GG = 544 * MiB, WS_MQ = 576 * MiB, WS_MK = 608 * MiB, WS_MV = 616 * MiB, WS_SGG = 624 * MiB, WS_SGM = 656 * MiB;
constexpr size_t WS_BETA = 688 * MiB, WS_GLOG = 688 * MiB + 512 * 1024;
constexpr size_t WS_GDNP = 690 * MiB;
constexpr size_t WS_O = 834 * MiB;
constexpr size_t WS_LISTS = 898 * MiB, WS_LSE = 914 * MiB, WS_OG = 916 * MiB, WS_A2 = 948 * MiB, WS_MBUF = 980 * MiB;
constexpr size_t WS_HF = 690 * MiB;
constexpr size_t WS_HB = 754 * MiB;
constexpr size_t WS_LOGITS = 787 * MiB;
constexpr size_t WS_LOGITS2 = 544 * MiB;
constexpr size_t WS_HS = 808 * MiB;
constexpr size_t WS_SHY = 816 * MiB;
constexpr size_t WS_HEXP = 848 * MiB;
constexpr size_t WS_YR = 416 * MiB;
constexpr size_t WS_END = 1024 * MiB;
constexpr int CW_BAR = 4096;
constexpr int CW_MOBA_CNT = 8192, CW_QHEAD = 8448, CW_MOE_CNT = 8704, CW_MOE_FILL = 8960;
constexpr int CW_CONVQ = 9300;
constexpr int CW_BAR2 = 40960;
constexpr int CW_PROG = 32768;
constexpr int CW_KMEAN = 16384;

constexpr int LDS_BYTES = 155648;
constexpr int MISC_OFF = 153600;
constexpr int NWAVES = 8;

#define XB_TMO      128
#define XB_XCNT(j)  (256  + 64 * (j))
#define XB_XSUB(j)  (1280 + 64 * (j))
#define XB_XGEN(j)  (2304 + 64 * (j))
#define XB_TOP      3328
#define XB_TOPGEN   3392
#define XCD_BAR_WORDS 3456
#define XB_SPIN_CAP (1u << 18)
__device__ __forceinline__ unsigned xb_ld(unsigned* p)              { return __hip_atomic_load(p, __ATOMIC_RELAXED, __HIP_MEMORY_SCOPE_AGENT); }
__device__ __forceinline__ unsigned xb_add(unsigned* p, unsigned v) { return __hip_atomic_fetch_add(p, v, __ATOMIC_RELAXED, __HIP_MEMORY_SCOPE_AGENT); }
__device__ __forceinline__ unsigned xb_xcc_id() { return (unsigned)__builtin_amdgcn_s_getreg((3 << 11) | 20) & 0xFu; }
#define XB_SPIN(cond, bar) do { unsigned _sp = 0; while (cond) { __builtin_amdgcn_s_sleep(1); \
    if ((++_sp & 255u) == 0u) { if (xb_ld(&(bar)[XB_TMO])) break; if (_sp > XB_SPIN_CAP) { atomicAdd(&(bar)[XB_TMO], 1u); break; } } } } while (0)
struct XcdBarrier { unsigned* bar; unsigned x; volatile LAS unsigned* st; unsigned gtot; };
__device__ __forceinline__ XcdBarrier xcd_barrier_post(unsigned* bar, volatile LAS unsigned* st) {
    XcdBarrier b; b.bar = bar; b.x = xb_xcc_id(); b.st = st; b.gtot = gridDim.x * gridDim.y * gridDim.z;
    if (threadIdx.x == 0) (void)xb_add(&bar[XB_XCNT(b.x)], 1u);
    return b;
}
__device__ __forceinline__ void xcd_barrier_complete(unsigned* bar, unsigned x, unsigned& nloc, unsigned& nx, const unsigned G) {
    unsigned sum, cnt, mine, sp = 0u;
    for (;;) {
        sum = 0u; cnt = 0u; mine = 0u;
#pragma unroll
        for (unsigned j = 0; j < 16; ++j) { const unsigned c = xb_ld(&bar[XB_XCNT(j)]); sum += c; cnt += (c > 0u) ? 1u : 0u; mine = (j == x) ? c : mine; }
        if (sum == G) break;
        __builtin_amdgcn_s_sleep(1);
        if ((++sp & 255u) == 0u) { if (xb_ld(&bar[XB_TMO])) break; if (sp > XB_SPIN_CAP) { atomicAdd(&bar[XB_TMO], 1u); break; } }
    }
    nloc = mine > 0u ? mine : 1u; nx = cnt > 0u ? cnt : 1u;
}
__device__ __forceinline__ void xcd_barrier(const XcdBarrier& b) {
    asm volatile("s_waitcnt vmcnt(0)" ::: "memory");
    __syncthreads();
    if (threadIdx.x == 0) {
        unsigned* bar = b.bar;
        __builtin_amdgcn_s_waitcnt(0);
        unsigned nloc = b.st[0], nx = b.st[1];
        if (nloc == 0u) { xcd_barrier_complete(bar, b.x, nloc, nx, b.gtot); b.st[0] = nloc; b.st[1] = nx; }
        const unsigned old = xb_add(&bar[XB_XSUB(b.x)], 1u);
        const unsigned gen = old / nloc;
        if (old + 1u == (gen + 1u) * nloc) {
            __builtin_amdgcn_fence(__ATOMIC_RELEASE, "agent");
            asm volatile("s_waitcnt vmcnt(0)" ::: "memory");
            const unsigned og = xb_add(&bar[XB_TOP], 1u);
            const unsigned tg = og / nx;
            if (og + 1u == (tg + 1u) * nx) xb_add(&bar[XB_TOPGEN], 1u);
            else XB_SPIN(xb_ld(&bar[XB_TOPGEN]) == tg, bar);
            __builtin_amdgcn_fence(__ATOMIC_ACQUIRE, "agent");
            xb_add(&bar[XB_XGEN(b.x)], 1u);
            asm volatile("s_waitcnt vmcnt(0)" ::: "memory");
        } else {
            XB_SPIN(xb_ld(&bar[XB_XGEN(b.x)]) == gen, bar);
            __builtin_amdgcn_fence(__ATOMIC_ACQUIRE, "agent");
            asm volatile("s_waitcnt vmcnt(0)" ::: "memory");
        }
    }
    __syncthreads();
}

namespace pg8 {
typedef int v4i __attribute__((ext_vector_type(4)));
typedef int v8i __attribute__((ext_vector_type(8)));
constexpr int BM = 256, BK = 64, HALF = 128, HTB = HALF * BK * 2, STAGE_BYTES = 8 * HTB, NXCD = 8, WGM = 8;
__host__ __device__ __forceinline__ int lds_byte(int r, int c) { const int st = (r >> 4) * 2 + (c >> 5), rr = r & 15, cc = c & 31, ob = rr * 64 + cc * 2; return st * 1024 + (ob ^ (((ob >> 9) & 1) << 5)); }
__host__ __device__ __forceinline__ void stage_rc(int b, int& R, int& C) { const int st = b / 1024, sb = b % 1024, swz = sb ^ (((sb >> 9) & 1) << 5); R = (st >> 1) * 16 + swz / 64; C = (st & 1) * 32 + (swz % 64) / 2; }
__host__ __device__ __forceinline__ int perm32(int rho) { const int n = rho >> 4, i = rho & 15; return 8 * (i >> 2) + 4 * n + (i & 3); }

struct Unit { int pm, pn, arow0, aux, gbase, gcnt, acolb; const char* b; };

struct DenseOrder {
    int nM, nN, nwg, G, c; const char* Bt; size_t tstepB;
    __device__ void init(int M, int N, int K, int G_, int c_, const bf16* Bt_) { nM = M / BM; nN = N / BM; nwg = nM * nN; G = G_; c = c_; Bt = (const char*)Bt_; tstepB = (size_t)BM * K * 2; }
    __device__ bool next(int i, Unit& u) const {
        int wgid;
        if (G % NXCD == 0) { const int L = i * G + c; if (L >= nwg) return false;
            const int q = nwg / NXCD, r = nwg % NXCD, xcd = L % NXCD, off = L / NXCD; wgid = (xcd < r ? xcd * (q + 1) : r * (q + 1) + (xcd - r) * q) + off; }
        else {
            const int R = (nwg + G - 1) / G, x = c % NXCD, slot = c / NXCD, gq = G / NXCD, gr = G % NXCD, nx = gq + (x < gr ? 1 : 0), pre = x * gq + (x < gr ? x : gr);
            if (i >= R) return false;
            wgid = R * pre + i * nx + slot; if (wgid >= nwg) return false; }
        const int nig = WGM * nN, gid = wgid / nig, fm = gid * WGM, gsz = (nM - fm) < WGM ? (nM - fm) : WGM;
        u.pm = fm + ((wgid % nig) % gsz); u.pn = (wgid % nig) / gsz; u.arow0 = u.pm * BM; u.aux = 0; u.gbase = 0; u.gcnt = 0; u.acolb = 0; u.b = Bt + (size_t)u.pn * tstepB; return true;
    }
};
template <int NPN> struct GroupOrder {
    int G, c; const LAS int* tb; const LAS int* cn; const char* W; size_t estride, tstepB;
    __device__ bool next(int i, Unit& u) const {
        const int cc = (G % NXCD == 0) ? (c % NXCD) * (G / NXCD) + c / NXCD : c;
        const long L = (long)i * G + cc; if (L >= (long)tb[256] * NPN) return false;
        const int tile = (int)(L / NPN), pn = (int)(L % NPN);
        const int e = ((const LAS unsigned short*)(tb + 516))[tile];
        const int j = tile - tb[e];
        u.pm = tile; u.pn = pn; u.arow0 = tile * BM; u.aux = e; u.gbase = e * 16384 + j * BM; u.gcnt = cn[e] - j * BM; u.acolb = 0; u.b = W + (size_t)e * estride + (size_t)pn * tstepB; return true;
    }
};

struct SplitK2Order {
    static constexpr bool HALF_TILES = false;
    int nM, G, c; const char* Bt;
    int khalfB;
    __device__ bool next(int i, Unit& u) const {
        const int L = i * G + c; if (L >= 2 * nM) return false;
        u.pm = L >> 1; u.pn = L & 1; u.arow0 = u.pm * BM; u.aux = 0; u.gbase = 0; u.gcnt = 0; u.acolb = (L & 1) * khalfB; u.b = Bt + (size_t)(L & 1) * 256 * khalfB; return true;
    }
};

typedef __bf16 bf16v2_t __attribute__((ext_vector_type(2)));
__device__ __forceinline__ unsigned cvt_pk_bf16(float lo, float hi) { bf16v2_t v; v[0] = (__bf16)lo; v[1] = (__bf16)hi; return __builtin_bit_cast(unsigned, v); }

template <class E, class = void> struct epi_has_pre { static constexpr bool value = false; };
template <class E> struct epi_has_pre<E, decltype((void)E::HAS_PRE)> { static constexpr bool value = true; };
template <class Epi, class Sched, bool GATHER, int F8S = -1, int F8A = 0>
__device__ __forceinline__ void gemm_phase(LAS unsigned char* lds, const void* Abase, const int* rowmap, const int K, const Sched& S, const Epi& E, const unsigned strideA = 0u) {
    const int tid = threadIdx.x, wid = __builtin_amdgcn_readfirstlane(tid >> 6), lane = tid & 63, wr = wid >> 2, wc = wid & 3, fr = lane & 15, fq = lane >> 4;
    const int nt = K / BK;
    const unsigned rowB = (unsigned)K * 2u;
    const unsigned rowA = strideA ? strideA : rowB;
    int RA[2]; unsigned vA[2], voffB[2];
#pragma unroll
    for (int i = 0; i < 2; ++i) { int R, C; stage_rc(tid * 16 + i * 8192, R, C); const int Rb = Epi::PERM ? ((R & ~31) + perm32(R & 31)) : R;
        RA[i] = R; vA[i] = (unsigned)C * 2u; voffB[i] = (unsigned)(Rb * K + C) * 2u; }
    const size_t kstep = (size_t)(BK * 2);
    const size_t hstep = (size_t)HALF * K * 2;
    const unsigned ldsw = (unsigned)wid * 1024u;
    const int aoff0 = lds_byte(wr * 64 + fr, 8 * fq), boff0 = lds_byte(wc * 32 + fr, 8 * fq);
    constexpr int KOFF = 1024;
    const char* A0 = (const char*)Abase;
    unsigned VA[2][2];
#define PG8_SA(b, h) (((b) * 2 + (h)) * HTB)
#define PG8_SB(b, h) ((4 + (b) * 2 + (h)) * HTB)
#define PG8_STAGE_B(bufoff, gbase) do { _Pragma("unroll") for (int _i = 0; _i < 2; ++_i) \
        __builtin_amdgcn_global_load_lds((const unsigned*)((const char*)(gbase) + voffB[_i]), (LAS unsigned*)(lds + (bufoff) + ldsw + _i * 8192), 16, 0, 0); } while (0)
#define PG8_STAGE_A(bufoff, gbase, h) do { _Pragma("unroll") for (int _i = 0; _i < 2; ++_i) \
        __builtin_amdgcn_global_load_lds((const unsigned*)((const char*)(gbase) + VA[h][_i]), (LAS unsigned*)(lds + (bufoff) + ldsw + _i * 8192), 16, 0, 0); } while (0)
#define PG8_CAT(lo, hi) __builtin_shufflevector(__builtin_bit_cast(v4i, lo), __builtin_bit_cast(v4i, hi), 0, 1, 2, 3, 4, 5, 6, 7)
#define PG8_LO(x) __builtin_bit_cast(bf16x8, __builtin_shufflevector(x, x, 0, 1, 2, 3))
#define PG8_HI(x) __builtin_bit_cast(bf16x8, __builtin_shufflevector(x, x, 4, 5, 6, 7))
#define PG8_LDA(dst, b, h) do { _Pragma("unroll") for (int m = 0; m < 4; ++m) dst[m] = PG8_CAT(*(const LAS bf16x8*)(lds + PG8_SA(b, h) + aoff0 + m * 2048), *(const LAS bf16x8*)(lds + PG8_SA(b, h) + aoff0 + KOFF + m * 2048)); } while (0)
#define PG8_LDB(dst, b, h) do { _Pragma("unroll") for (int n = 0; n < 2; ++n) dst[n] = PG8_CAT(*(const LAS bf16x8*)(lds + PG8_SB(b, h) + boff0 + n * 2048), *(const LAS bf16x8*)(lds + PG8_SB(b, h) + boff0 + KOFF + n * 2048)); } while (0)
#define PG8_MMA(ai, bj, At, Bt) do { __builtin_amdgcn_s_setprio(1); _Pragma("unroll") for (int m = 0; m < 4; ++m) _Pragma("unroll") for (int n = 0; n < 2; ++n) { \
        if (F8S >= 0) acc[ai][bj][m][n] = __builtin_amdgcn_mfma_scale_f32_16x16x128_f8f6f4(Bt[n], At[m], acc[ai][bj][m][n], 0, 0, 0, (127 - (F8S >= 0 ? F8S : 0)) * 0x01010101, 0, (127 - F8A) * 0x01010101); \
        else { acc[ai][bj][m][n] = __builtin_amdgcn_mfma_f32_16x16x32_bf16(PG8_LO(Bt[n]), PG8_LO(At[m]), acc[ai][bj][m][n], 0, 0, 0); \
               acc[ai][bj][m][n] = __builtin_amdgcn_mfma_f32_16x16x32_bf16(PG8_HI(Bt[n]), PG8_HI(At[m]), acc[ai][bj][m][n], 0, 0, 0); } } \
        __builtin_amdgcn_s_setprio(0); } while (0)
#define PG8_WAIT_V(n) asm volatile("s_waitcnt vmcnt(" #n ")" ::: "memory")
#define PG8_WAIT_L(n) asm volatile("s_waitcnt lgkmcnt(" #n ")" ::: "memory")
#define PG8_BAR __builtin_amdgcn_s_barrier()
#define PG8_SCHED __builtin_amdgcn_sched_barrier(0)
#define PG8_AOFFS(u) do { _Pragma("unroll") for (int _h = 0; _h < 2; ++_h) _Pragma("unroll") for (int _i = 0; _i < 2; ++_i) \
        { const int _r = _h * HALF + RA[_i]; unsigned _row; if (GATHER) { const int _rc = _r < (u).gcnt ? _r : ((u).gcnt > 0 ? (u).gcnt - 1 : 0); const unsigned _m = (unsigned)rowmap[(u).gbase + _rc]; _row = (_r < (u).gcnt) ? _m : 16384u; } else _row = (unsigned)((u).arow0 + _r); VA[_h][_i] = _row * rowA + (unsigned)(u).acolb + vA[_i]; } } while (0)
    Unit cur, nxt; int ui = 0;
    if (!S.next(0, cur)) return;
    f32x4 acc[2][2][4][2];
#pragma unroll
    for (int a = 0; a < 2; ++a)
#pragma unroll
        for (int b = 0; b < 2; ++b)
#pragma unroll
            for (int m = 0; m < 4; ++m)
#pragma unroll
                for (int n = 0; n < 2; ++n) acc[a][b][m][n] = (f32x4){0.f, 0.f, 0.f, 0.f};
    v8i At[4], B0[2], B1[2];
    PG8_AOFFS(cur);
    const char* cA = A0;
    const char* cB = cur.b;
    PG8_STAGE_B(PG8_SB(0, 0), cB); PG8_STAGE_A(PG8_SA(0, 0), cA, 0); PG8_STAGE_B(PG8_SB(0, 1), cB + hstep); PG8_STAGE_A(PG8_SA(0, 1), cA, 1);
    if (wr == 1) PG8_BAR;
    PG8_WAIT_V(4); PG8_BAR;
    PG8_STAGE_B(PG8_SB(1, 0), cB + kstep); PG8_STAGE_A(PG8_SA(1, 0), cA + kstep, 0); PG8_STAGE_B(PG8_SB(1, 1), cB + hstep + kstep);
    PG8_WAIT_V(6); PG8_BAR;
    for (;;) {
        bool has_next = false; const char* nA = cA; const char* nB = cB;
        if constexpr (epi_has_pre<Epi>::value) E.pre(lds, cur, wr, fr, wid, lane);
#pragma unroll 1
        for (int t = 0; t < nt; t += 2) {
            const bool last = (t == nt - 2);
            if (last) { has_next = S.next(ui + 1, nxt); if (has_next) { nB = nxt.b; } }
            const char* a1 = cA + (size_t)(t + 1) * kstep;
            const char* a2 = last ? nA : cA + (size_t)(t + 2) * kstep; const char* b2 = last ? nB : cB + (size_t)(t + 2) * kstep;
            const char* a3 = a2 + kstep; const char* b3 = b2 + kstep;
            PG8_LDB(B0, 0, 0); PG8_SCHED; PG8_LDA(At, 0, 0); PG8_STAGE_A(PG8_SA(1, 1), a1, 1);
            PG8_WAIT_L(8); PG8_BAR; PG8_WAIT_L(0); PG8_MMA(0, 0, At, B0); PG8_BAR; PG8_SCHED;
            if (last && has_next) { PG8_AOFFS(nxt); }
            PG8_LDB(B1, 0, 1); PG8_STAGE_B(PG8_SB(0, 0), b2);
            PG8_BAR; PG8_WAIT_L(0); PG8_MMA(0, 1, At, B1); PG8_BAR;
            PG8_LDA(At, 0, 1); PG8_STAGE_A(PG8_SA(0, 0), a2, 0);
            PG8_BAR; PG8_WAIT_L(0); PG8_MMA(1, 0, At, B0); PG8_BAR; PG8_SCHED;
            PG8_STAGE_B(PG8_SB(0, 1), b2 + hstep);
            PG8_WAIT_V(6); PG8_BAR; PG8_MMA(1, 1, At, B1); PG8_BAR;
            PG8_LDB(B0, 1, 0); PG8_SCHED; PG8_LDA(At, 1, 0); PG8_STAGE_A(PG8_SA(0, 1), a2, 1);
            PG8_WAIT_L(8); PG8_BAR; PG8_WAIT_L(0); PG8_MMA(0, 0, At, B0); PG8_BAR; PG8_SCHED;
            PG8_LDB(B1, 1, 1); PG8_STAGE_B(PG8_SB(1, 0), b3);
            PG8_BAR; PG8_WAIT_L(0); PG8_MMA(0, 1, At, B1); PG8_BAR;
            PG8_LDA(At, 1, 1); PG8_STAGE_A(PG8_SA(1, 0), a3, 0);
            PG8_BAR; PG8_WAIT_L(0); PG8_MMA(1, 0, At, B0); PG8_BAR; PG8_SCHED;
            PG8_STAGE_B(PG8_SB(1, 1), b3 + hstep);
            PG8_WAIT_V(6); PG8_BAR; PG8_MMA(1, 1, At, B1); PG8_BAR;
        }
        if constexpr (epi_has_pre<Epi>::value) E(acc, cur, wr, wc, fr, fq, lds, wid, lane); else E(acc, cur, wr, wc, fr, fq);
        if (!has_next) break;
#pragma unroll
        for (int a = 0; a < 2; ++a)
#pragma unroll
            for (int b = 0; b < 2; ++b)
#pragma unroll
                for (int m = 0; m < 4; ++m)
#pragma unroll
                    for (int n = 0; n < 2; ++n) acc[a][b][m][n] = (f32x4){0.f, 0.f, 0.f, 0.f};
        cur = nxt; cA = nA; cB = nB; ++ui;
    }
    PG8_WAIT_V(0);
    if (wr == 0) PG8_BAR;
    PG8_BAR;
#undef PG8_SA
#undef PG8_SB
#undef PG8_STAGE_A
#undef PG8_STAGE_B
#undef PG8_LDA
#undef PG8_CAT
#undef PG8_LO
#undef PG8_HI
#undef PG8_LDB
#undef PG8_MMA
#undef PG8_WAIT_V
#undef PG8_WAIT_L
#undef PG8_BAR
#undef PG8_SCHED
#undef PG8_AOFFS
}
}

struct EpiF32Res {
    static constexpr bool PERM = false;
    float* C; int ldc; const float* res; float alpha;
    __device__ __forceinline__ void operator()(const f32x4 (&acc)[2][2][4][2], const pg8::Unit& u, int wr, int wc, int fr, int fq) const {
        const int row0 = u.pm * 256 + wr * 64 + fr, col0 = u.pn * 256 + wc * 32 + 4 * fq;
#pragma unroll
        for (int ai = 0; ai < 2; ++ai)
#pragma unroll
            for (int m = 0; m < 4; ++m) { const size_t ro = (size_t)(row0 + ai * 128 + m * 16) * ldc + col0;
#pragma unroll
                for (int bj = 0; bj < 2; ++bj)
#pragma unroll
                    for (int n = 0; n < 2; ++n) { f32x4 v = acc[ai][bj][m][n];
                        if (res) { const f32x4 r = *(const f32x4*)(res + ro + bj * 128 + n * 16); v = v + r * alpha; }
                        *(f32x4*)(C + ro + bj * 128 + n * 16) = v; } }
    }
};
struct EpiBf16Res {
    static constexpr bool PERM = true;
    bf16* O; int ldc; const float* res; float alpha;
    __device__ __forceinline__ void operator()(const f32x4 (&acc)[2][2][4][2], const pg8::Unit& u, int wr, int wc, int fr, int fq) const {
        const int row0 = u.pm * 256 + wr * 64 + fr, col0 = u.pn * 256 + wc * 32 + 8 * fq;
        f32x4 r[2][4][2];
#define EB_RO(st, g) ((size_t)(row0 + ((st) >> 1) * 128 + (2 * ((st) & 1) + ((g) >> 1)) * 16) * ldc + col0 + ((g) & 1) * 128)
#define EB_LOAD(st) do { _Pragma("unroll") for (int _g = 0; _g < 4; ++_g) { const float* _p = res + EB_RO(st, _g); r[(st) & 1][_g][0] = *(const f32x4*)_p; r[(st) & 1][_g][1] = *(const f32x4*)(_p + 4); } } while (0)
#define EB_STORE(st) do { _Pragma("unroll") for (int _g = 0; _g < 4; ++_g) { const int _ai = (st) >> 1, _m = 2 * ((st) & 1) + (_g >> 1), _bj = _g & 1; \
            const f32x4 v0 = acc[_ai][_bj][_m][0] + r[(st) & 1][_g][0] * alpha, v1 = acc[_ai][_bj][_m][1] + r[(st) & 1][_g][1] * alpha; \
            v4u o; o.x = pg8::cvt_pk_bf16(v0[0], v0[1]); o.y = pg8::cvt_pk_bf16(v0[2], v0[3]); o.z = pg8::cvt_pk_bf16(v1[0], v1[1]); o.w = pg8::cvt_pk_bf16(v1[2], v1[3]); \
            *(v4u*)(O + EB_RO(st, _g)) = o; } } while (0)
        EB_LOAD(0); EB_LOAD(1);
        EB_STORE(0); EB_LOAD(2);
        EB_STORE(1); EB_LOAD(3);
        EB_STORE(2); EB_STORE(3);
#undef EB_RO
#undef EB_LOAD
#undef EB_STORE
    }
};
struct EpiBf16Plain {
    static constexpr bool PERM = true;
    bf16* O; int ldc;
    __device__ __forceinline__ void operator()(const f32x4 (&acc)[2][2][4][2], const pg8::Unit& u, int wr, int wc, int fr, int fq) const {
        const int row0 = u.pm * 256 + wr * 64 + fr, col0 = u.pn * 256 + wc * 32 + 8 * fq;
#pragma unroll
        for (int ai = 0; ai < 2; ++ai)
#pragma unroll
            for (int m = 0; m < 4; ++m) { bf16* rowp = O + (size_t)(row0 + ai * 128 + m * 16) * ldc + col0;
#pragma unroll
                for (int bj = 0; bj < 2; ++bj) { const f32x4 v0 = acc[ai][bj][m][0], v1 = acc[ai][bj][m][1];
                    v4u o; o.x = pg8::cvt_pk_bf16(v0[0], v0[1]); o.y = pg8::cvt_pk_bf16(v0[2], v0[3]); o.z = pg8::cvt_pk_bf16(v1[0], v1[1]); o.w = pg8::cvt_pk_bf16(v1[2], v1[3]);
                    *(v4u*)(rowp + bj * 128) = o; } }
    }
};
struct EpiSwiGLU {
    static constexpr bool PERM = true;
    bf16* H;
    __device__ __forceinline__ void operator()(const f32x4 (&acc)[2][2][4][2], const pg8::Unit& u, int wr, int wc, int fr, int fq) const {
        const int row0 = u.pm * 256 + wr * 64 + fr, col0 = u.pn * 128 + wc * 32 + 8 * fq;
#pragma unroll
        for (int ai = 0; ai < 2; ++ai)
#pragma unroll
            for (int m = 0; m < 4; ++m) { bf16* rowp = H + (size_t)(row0 + ai * 128 + m * 16) * 256 + col0;
                const f32x4 g0 = acc[ai][0][m][0], g1 = acc[ai][0][m][1], u0 = acc[ai][1][m][0], u1 = acc[ai][1][m][1];
                float h[8];
#pragma unroll
                for (int e = 0; e < 4; ++e) { h[e] = siluf_(g0[e]) * u0[e]; h[4 + e] = siluf_(g1[e]) * u1[e]; }
                v4u o; o.x = pg8::cvt_pk_bf16(h[0], h[1]); o.y = pg8::cvt_pk_bf16(h[2], h[3]); o.z = pg8::cvt_pk_bf16(h[4], h[5]); o.w = pg8::cvt_pk_bf16(h[6], h[7]);
                *(v4u*)rowp = o; }
    }
};
struct EpiSwiGLU8 {
    static constexpr bool PERM = true;
    unsigned char* H;
    __device__ __forceinline__ void operator()(const f32x4 (&acc)[2][2][4][2], const pg8::Unit& u, int wr, int wc, int fr, int fq) const {
        const int row0 = u.pm * 256 + wr * 64 + fr, col0 = u.pn * 128 + wc * 32 + 8 * fq;
#pragma unroll
        for (int ai = 0; ai < 2; ++ai)
#pragma unroll
            for (int m = 0; m < 4; ++m) { unsigned char* rowp = H + (size_t)(row0 + ai * 128 + m * 16) * 256 + col0;
                const f32x4 g0 = acc[ai][0][m][0], g1 = acc[ai][0][m][1], u0 = acc[ai][1][m][0], u1 = acc[ai][1][m][1];
                float h[8];
#pragma unroll
                for (int e = 0; e < 4; ++e) { h[e] = 4.f * siluf_(g0[e]) * u0[e]; h[4 + e] = 4.f * siluf_(g1[e]) * u1[e]; }
                v2u o; o.x = pk4_fp8(h[0], h[1], h[2], h[3]); o.y = pk4_fp8(h[4], h[5], h[6], h[7]);
                *(v2u*)rowp = o; }
    }
};
struct EpiScatter8 {
    static constexpr bool PERM = true;
    unsigned char* Y; const int* rowdst;
    static constexpr bool HAS_PRE = true;
    __device__ __forceinline__ void pre(LAS unsigned char* lds, const pg8::Unit& u, int wr, int fr, int wid, int lane) const {
        const int r0 = wr * 64 + fr;
#pragma unroll
        for (int i = 0; i < 8; ++i) { const int rr = r0 + (i >> 2) * 128 + (i & 3) * 16; const int rc = rr < u.gcnt ? rr : (u.gcnt > 0 ? u.gcnt - 1 : 0);
            __builtin_amdgcn_global_load_lds((const unsigned*)(rowdst + u.gbase + rc), (LAS unsigned*)(lds + 132096 + wid * 2048 + i * 256), 4, 0, 0); }
    }
    __device__ __forceinline__ void operator()(const f32x4 (&acc)[2][2][4][2], const pg8::Unit& u, int wr, int wc, int fr, int fq, LAS unsigned char* lds, int wid, int lane) const {
        const int r0 = wr * 64 + fr, col0 = u.pn * 256 + wc * 32 + 8 * fq;
        unsigned dst[8];
#pragma unroll
        for (int i = 0; i < 8; ++i) { const int rr = r0 + (i >> 2) * 128 + (i & 3) * 16; const unsigned dd = *(const LAS unsigned*)(lds + 132096 + wid * 2048 + i * 256 + lane * 4); dst[i] = (rr < u.gcnt) ? dd : 131072u; }
#pragma unroll
        for (int ai = 0; ai < 2; ++ai)
#pragma unroll
            for (int m = 0; m < 4; ++m) { unsigned char* rowp = Y + (size_t)dst[ai * 4 + m] * 1024 + col0;
#pragma unroll
                for (int bj = 0; bj < 2; ++bj) { const f32x4 v0 = acc[ai][bj][m][0] * 16.f, v1 = acc[ai][bj][m][1] * 16.f;
                    v2u o; o.x = pk4_fp8(v0[0], v0[1], v0[2], v0[3]); o.y = pk4_fp8(v1[0], v1[1], v1[2], v1[3]);
                    *(v2u*)(rowp + bj * 128) = o; } }
    }
};
struct EpiScatter {
    static constexpr bool PERM = true;
    bf16* Y; const int* rowdst;
    __device__ __forceinline__ void operator()(const f32x4 (&acc)[2][2][4][2], const pg8::Unit& u, int wr, int wc, int fr, int fq) const {
        const int r0 = wr * 64 + fr, col0 = u.pn * 256 + wc * 32 + 8 * fq;
        unsigned dst[8];
#pragma unroll
        for (int i = 0; i < 8; ++i) { const int rr = r0 + (i >> 2) * 128 + (i & 3) * 16; const int rc = rr < u.gcnt ? rr : (u.gcnt > 0 ? u.gcnt - 1 : 0); const unsigned dd = (unsigned)rowdst[u.gbase + rc]; dst[i] = (rr < u.gcnt) ? dd : 131072u; }
#pragma unroll
        for (int ai = 0; ai < 2; ++ai)
#pragma unroll
            for (int m = 0; m < 4; ++m) { bf16* rowp = Y + (size_t)dst[ai * 4 + m] * 1024 + col0;
#pragma unroll
                for (int bj = 0; bj < 2; ++bj) { const f32x4 v0 = acc[ai][bj][m][0], v1 = acc[ai][bj][m][1];
                    v4u o; o.x = pg8::cvt_pk_bf16(v0[0], v0[1]); o.y = pg8::cvt_pk_bf16(v0[2], v0[3]); o.z = pg8::cvt_pk_bf16(v1[0], v1[1]); o.w = pg8::cvt_pk_bf16(v1[2], v1[3]);
                    *(v4u*)(rowp + bj * 128) = o; } }
    }
};

struct Args { const float* in[21]; float* out; unsigned char* ws; float rope_inv[16]; int ph_lo, ph_hi; };
struct Frame {
    LAS unsigned char* lds; volatile LAS unsigned* MISC; unsigned* ctl; unsigned char* ws;
    int wave, G, bid;
};

__device__ __forceinline__ void transpose_item(const float* src, int ld, int k0, int n0, int nvalid, bf16* dst, int lddst, int dst_row0, LAS float* scr, int lane) {
    const int n4 = 4 * (lane & 15), kq = lane >> 4;
    f32x4 v[16];
#pragma unroll
    for (int i = 0; i < 16; ++i) v[i] = (n4 < nvalid) ? *(const f32x4*)(src + (size_t)(k0 + kq + 4 * i) * ld + n0 + n4) : (f32x4){0.f, 0.f, 0.f, 0.f};
#pragma unroll
    for (int i = 0; i < 16; ++i) { LAS float* p = scr + (kq + 4 * i) * 65 + n4; p[0] = v[i][0]; p[1] = v[i][1]; p[2] = v[i][2]; p[3] = v[i][3]; }
    LDS_WAIT(); asm volatile("" ::: "memory");
    const int c = lane & 7;
#pragma unroll
    for (int j = 0; j < 8; ++j) { const int nn = (lane >> 3) + 8 * j; const LAS float* s = scr + (8 * c) * 65 + nn;
        v4u o; o.x = pk2(s[0 * 65], s[1 * 65]); o.y = pk2(s[2 * 65], s[3 * 65]); o.z = pk2(s[4 * 65], s[5 * 65]); o.w = pk2(s[6 * 65], s[7 * 65]);
        *(v4u*)(dst + (size_t)(dst_row0 + nn) * lddst + k0 + 8 * c) = o; }
    LDS_WAIT(); asm volatile("" ::: "memory");
}
__device__ __forceinline__ void transpose_item8(const float* src, int ld, int k0, int n0, int nvalid, unsigned char* dst, int lddst, int dst_row0, float scale, LAS float* scr, int lane) {
    const int n4 = 4 * (lane & 15), kq = lane >> 4;
    f32x4 v[16];
#pragma unroll
    for (int i = 0; i < 16; ++i) v[i] = (n4 < nvalid) ? *(const f32x4*)(src + (size_t)(k0 + kq + 4 * i) * ld + n0 + n4) : (f32x4){0.f, 0.f, 0.f, 0.f};
#pragma unroll
    for (int i = 0; i < 16; ++i) { LAS float* p = scr + (kq + 4 * i) * 65 + n4; p[0] = v[i][0] * scale; p[1] = v[i][1] * scale; p[2] = v[i][2] * scale; p[3] = v[i][3] * scale; }
    LDS_WAIT(); asm volatile("" ::: "memory");
    const int c = lane & 7;
#pragma unroll
    for (int j = 0; j < 8; ++j) { const int nn = (lane >> 3) + 8 * j; const LAS float* s = scr + (8 * c) * 65 + nn;
        v2u o; o.x = pk4_fp8(s[0 * 65], s[1 * 65], s[2 * 65], s[3 * 65]); o.y = pk4_fp8(s[4 * 65], s[5 * 65], s[6 * 65], s[7 * 65]);
        *(v2u*)(dst + (size_t)(dst_row0 + nn) * lddst + k0 + 8 * c) = o; }
    LDS_WAIT(); asm volatile("" ::: "memory");
}
__device__ __forceinline__ int gu_row(int n, int is_up) { return (n >> 7) * 256 + is_up * 128 + (n & 127); }

__device__ __forceinline__ void p0_prologue(Frame& F, const Args& a, const bool experts, const int wg0) {
    LAS float* scr = (LAS float*)(F.lds + F.wave * 16896);
    const int gw = (F.bid - wg0) * NWAVES + F.wave, NGW = (F.G - wg0) * NWAVES;
    unsigned char* ws = F.ws;
    constexpr int I_IN = 16 * (NIN / 64), I_SQ = 16 * 16, I_RT = 16 * 4, I_SH = 16 * 4, I_SD = 4 * 16, I_EX = 64;
    constexpr int NSMALL = I_IN + 3 * I_SQ + I_RT + 2 * I_SH + I_SD;
    const int ln = (int)(threadIdx.x & 63);
    const int it0 = experts ? NSMALL : 0, it1 = experts ? NSMALL + NEXP * 3 * I_EX : NSMALL;
    for (int it = it0 + gw; it < it1; it += NGW) {
        int r = it;
        if (r < I_IN) { const int nblk = NIN / 64, kb = r / nblk, nb = r % nblk, j0 = nb * 64;
            int n0, nv; if (j0 < 4096) { n0 = j0; nv = 64; } else if (j0 < 7680) { n0 = j0 + 16; nv = 64; } else if (j0 == 7680) { n0 = 4096; nv = 16; } else { n0 = 0; nv = 0; }
            transpose_item8(a.in[1], 7696, kb * 64, n0, nv, ws + WS_WIN, 1024, j0, 32.f, scr, ln); continue; } r -= I_IN;
        if (r < 3 * I_SQ) { const int w = r / I_SQ, q = r % I_SQ, kb = q / 16, nb = q % 16;
            transpose_item8(a.in[6 + w], 1024, kb * 64, nb * 64, 64, ws + (w == 0 ? WS_WGP : (w == 1 ? WS_WMP : WS_WOUT)), 1024, nb * 64, 64.f, scr, ln); continue; } r -= 3 * I_SQ;
        if (r < I_RT) { const int kb = r / 4, nb = r % 4, hf = kb >> 3;
            transpose_item(a.in[11], 256, kb * 64, nb * 64, 64, (bf16*)(ws + WS_ROUTER), 512, hf * 256 + nb * 64 - hf, scr, ln); continue; } r -= I_RT;
        if (r < 2 * I_SH) { const int up = r / I_SH, q = r % I_SH, kb = q / 4, nb = q % 4;
            transpose_item8(a.in[16 + up], 256, kb * 64, nb * 64, 64, ws + WS_SHGU, 1024, gu_row(nb * 64, up), 32.f, scr, ln); continue; } r -= 2 * I_SH;
        if (r < I_SD) { const int kb = r / 16, nb = r % 16; transpose_item(a.in[18], 1024, kb * 64, nb * 64, 64, (bf16*)(ws + WS_SHD), 256, nb * 64, scr, ln); continue; } r -= I_SD;
        { const int e = r / (3 * I_EX), q = r % (3 * I_EX), w = q / I_EX, p = q % I_EX;
            if (w < 2) { const int kb = p / 4, nb = p % 4;
                transpose_item8(a.in[13 + w] + (size_t)e * 1024 * 256, 256, kb * 64, nb * 64, 64, ws + WS_EXPGU + (size_t)e * 512 * 1024, 1024, gu_row(nb * 64, w), 32.f, scr, ln); }
            else { const int kb = p / 16, nb = p % 16;
                transpose_item8(a.in[15] + (size_t)e * 256 * 1024, 1024, kb * 64, nb * 64, 64, ws + WS_EXPD + (size_t)e * 1024 * 256, 256, nb * 64, 32.f, scr, ln); } }
    }
    if (experts) return;
    { const f32x4* x4 = (const f32x4*)a.in[0]; v2u* xb = (v2u*)(ws + WS_XB); const size_t n8 = (size_t)T * D / 8;
        for (size_t i = (size_t)F.bid * 512 + threadIdx.x; i < n8; i += (size_t)F.G * 512) { const f32x4 p = x4[2 * i], q = x4[2 * i + 1];
            v2u o; o.x = pk4_fp8(p[0], p[1], p[2], p[3]); o.y = pk4_fp8(q[0], q[1], q[2], q[3]); xb[i] = o; } }
    { _Float16* rope = (_Float16*)(ws + WS_ROPE);
        for (int idx = F.bid * 512 + ((int)threadIdx.x); idx < T * 16; idx += F.G * 512) { const int t = idx >> 4, i = idx & 15;
            const float angf = (float)t * a.rope_inv[i]; double ang = (double)angf;
            const double TWO_PI = 6.283185307179586476925, PI = 3.14159265358979323846;
            const double kq = __builtin_rint(ang / TWO_PI); double rr = ang - kq * TWO_PI; double cs = 1.0;
            if (rr > 0.5 * PI) { rr = PI - rr; cs = -1.0; } else if (rr < -0.5 * PI) { rr = -PI - rr; cs = -1.0; }
            const double r2 = rr * rr;
            double s = 1.0 / 355687428096000.0;
            s = s * (-r2) + 1.0 / 1307674368000.0; s = s * (-r2) + 1.0 / 6227020800.0; s = s * (-r2) + 1.0 / 39916800.0; s = s * (-r2) + 1.0 / 362880.0;
            s = s * (-r2) + 1.0 / 5040.0; s = s * (-r2) + 1.0 / 120.0; s = s * (-r2) + 1.0 / 6.0; s = s * (-r2) + 1.0; s *= rr;
            double c = 1.0 / 20922789888000.0;
            c = c * (-r2) + 1.0 / 87178291200.0; c = c * (-r2) + 1.0 / 479001600.0; c = c * (-r2) + 1.0 / 3628800.0; c = c * (-r2) + 1.0 / 40320.0;
            c = c * (-r2) + 1.0 / 720.0; c = c * (-r2) + 1.0 / 24.0; c = c * (-r2) + 0.5; c = c * (-r2) + 1.0; c *= cs;
            rope[t * 32 + i] = (_Float16)c; rope[t * 32 + 16 + i] = (_Float16)s; } }
    if (F.bid == 0 && ((int)threadIdx.x) < 128) ((v4u*)(ws + WS_HB + (size_t)T * D * 2))[((int)threadIdx.x)] = (v4u){0u, 0u, 0u, 0u};
}

__device__ __forceinline__ void expert_convert_queue(Frame& F, const Args& a) {
    LAS float* scr = (LAS float*)(F.lds + F.wave * 16896);
    const int lane = (int)(threadIdx.x & 63); unsigned char* ws = F.ws;
    constexpr int I_EX = 64, NIT = NEXP * 3 * I_EX, CH = 8;
    const int n4 = 4 * (lane & 15), kq = lane >> 4, c8 = lane & 7;
#define EX_LOAD(V, r_) do { const int _e = (r_) / (3 * I_EX), _q = (r_) % (3 * I_EX), _w = _q / I_EX, _p = _q % I_EX; const float* _s; int _ld, _k0, _n0; \
        if (_w < 2) { _s = a.in[13 + _w] + (size_t)_e * 1024 * 256; _ld = 256; _k0 = (_p / 4) * 64; _n0 = (_p % 4) * 64; } \
        else { _s = a.in[15] + (size_t)_e * 256 * 1024; _ld = 1024; _k0 = (_p / 16) * 64; _n0 = (_p % 16) * 64; } \
        _Pragma("unroll") for (int _i = 0; _i < 16; ++_i) V[_i] = __builtin_nontemporal_load((const f32x4*)(_s + (size_t)(_k0 + kq + 4 * _i) * _ld + _n0 + n4)); } while (0)
#define EX_PROC(V, r_) do { const int _e = (r_) / (3 * I_EX), _q = (r_) % (3 * I_EX), _w = _q / I_EX, _p = _q % I_EX; unsigned char* _dst; int _lddst, _row0, _k0; \
        if (_w < 2) { _dst = ws + WS_EXPGU + (size_t)_e * 512 * 1024; _lddst = 1024; _row0 = gu_row((_p % 4) * 64, _w); _k0 = (_p / 4) * 64; } \
        else { _dst = ws + WS_EXPD + (size_t)_e * 1024 * 256; _lddst = 256; _row0 = (_p % 16) * 64; _k0 = (_p / 16) * 64; } \
        _Pragma("unroll") for (int _i = 0; _i < 16; ++_i) { LAS float* _pp = scr + (kq + 4 * _i) * 65 + n4; _pp[0] = V[_i][0] * 32.f; _pp[1] = V[_i][1] * 32.f; _pp[2] = V[_i][2] * 32.f; _pp[3] = V[_i][3] * 32.f; } \
        LDS_WAIT(); asm volatile("" ::: "memory"); \
        _Pragma("unroll") for (int _j = 0; _j < 8; ++_j) { const int _nn = (lane >> 3) + 8 * _j; const LAS float* _sp = scr + (8 * c8) * 65 + _nn; \
            v2u _o; _o.x = pk4_fp8(_sp[0 * 65], _sp[1 * 65], _sp[2 * 65], _sp[3 * 65]); _o.y = pk4_fp8(_sp[4 * 65], _sp[5 * 65], _sp[6 * 65], _sp[7 * 65]); \
            __builtin_nontemporal_store(_o, (v2u*)(_dst + (size_t)(_row0 + _nn) * _lddst + _k0 + 8 * c8)); } \
        LDS_WAIT(); asm volatile("" ::: "memory"); } while (0)
    for (;;) {
        unsigned nxt = 0u;
        if (lane == 0) nxt = atomicAdd(&F.ctl[CW_CONVQ], (unsigned)CH);
        const int r0 = __builtin_amdgcn_readfirstlane((int)nxt);
        if (r0 >= NIT) break;
#pragma unroll 1
        for (int r = r0; r < r0 + CH; r += 2) {
            f32x4 va[16], vb[16];
            EX_LOAD(va, r); EX_LOAD(vb, r + 1);
            EX_PROC(va, r); EX_PROC(vb, r + 1);
        }
    }
#undef EX_LOAD
#undef EX_PROC
}

__device__ __forceinline__ void ln_rows(Frame& F, bf16* XB_, unsigned char* X8, const float* g, const float* b) {
    const int gw = F.bid * NWAVES + F.wave, NGW = F.G * NWAVES, lane = (int)(threadIdx.x & 63);
    f32x4 gv[4], bv[4];
#pragma unroll
    for (int j = 0; j < 4; ++j) { gv[j] = ((const f32x4*)g)[lane + 64 * j]; bv[j] = ((const f32x4*)b)[lane + 64 * j]; }
    for (int m0 = gw; m0 < T; m0 += 4 * NGW) {
        v2u x[4][4];
#pragma unroll
        for (int k = 0; k < 4; ++k) { const int mk = (m0 + k * NGW < T) ? m0 + k * NGW : T - 1; const v2u* xr = (const v2u*)(XB_ + (size_t)mk * D) + lane;
#pragma unroll
            for (int j = 0; j < 4; ++j) x[k][j] = xr[64 * j]; }
#pragma unroll
        for (int k = 0; k < 4; ++k) { const int m = m0 + k * NGW;
            f32x4 v[4]; float s = 0.f;
#pragma unroll
            for (int j = 0; j < 4; ++j) { v[j] = (f32x4){bflo(x[k][j].x), bfhi(x[k][j].x), bflo(x[k][j].y), bfhi(x[k][j].y)}; s += (v[j][0] + v[j][1]) + (v[j][2] + v[j][3]); }
            const float mean = wave_sum(s) * (1.f / D); float s2 = 0.f;
#pragma unroll
            for (int j = 0; j < 4; ++j) { v[j] = v[j] - mean; s2 += (v[j][0] * v[j][0] + v[j][1] * v[j][1]) + (v[j][2] * v[j][2] + v[j][3] * v[j][3]); }
            const float rstd = 1.f / sqrtf(wave_sum(s2) * (1.f / D) + LN_EPS);
            if (k == 0) __builtin_amdgcn_s_waitcnt(0x0F70);
            if (m < T) { v2u* xw = (v2u*)(XB_ + (size_t)m * D) + lane;
#pragma unroll
                for (int j = 0; j < 4; ++j) { const f32x4 y = v[j] * rstd * gv[j] + bv[j];
                    v2u o; o.x = pk2(y[0], y[1]); o.y = pk2(y[2], y[3]); xw[64 * j] = o;
                    ((unsigned*)(X8 + (size_t)m * D))[lane + 64 * j] = pk4_fp8(y[0], y[1], y[2], y[3]); } }
        }
    }
}

__device__ __forceinline__ bf16x8 pack8(const f32x4 a, const f32x4 b) {
    v4u o; o.x = pg8::cvt_pk_bf16(a[0], a[1]); o.y = pg8::cvt_pk_bf16(a[2], a[3]); o.z = pg8::cvt_pk_bf16(b[0], b[1]); o.w = pg8::cvt_pk_bf16(b[2], b[3]);
    return __builtin_bit_cast(bf16x8, o);
}
__device__ __forceinline__ f32x4 mfma16(const bf16x8 a, const bf16x8 b, const f32x4 c) { return __builtin_amdgcn_mfma_f32_16x16x32_bf16(a, b, c, 0, 0, 0); }
__device__ __forceinline__ float softplusf_(float x) { return fmaxf(x, 0.f) + log1pf(expf(-fabsf(x))); }

constexpr float MB_QSCALE = 0.08838834764831845f * 1.4426950408889634f;
struct EpiInProj {
    static constexpr bool PERM = true;
    unsigned char* ws; const float* a_log; const float* dt_bias;
    __device__ __forceinline__ void operator()(const f32x4 (&acc)[2][2][4][2], const pg8::Unit& u, int wr, int wc, int fr, int fq) const {
        const int pn = u.pn, row0 = u.pm * 256 + wr * 64 + fr, colt = wc * 32 + 8 * fq;
        if (pn == 30) {
            if (wc == 0 && fq < 2) {
                float al[8], db[8];
#pragma unroll
                for (int j = 0; j < 8; ++j) { al[j] = -expf(a_log[j]); db[j] = dt_bias[j]; }
#pragma unroll
                for (int ai = 0; ai < 2; ++ai)
#pragma unroll
                    for (int m = 0; m < 4; ++m) { const int row = row0 + ai * 128 + m * 16; const f32x4 v0 = acc[ai][0][m][0], v1 = acc[ai][0][m][1];
                        f32x4 o0, o1;
                        if (fq == 0) {
#pragma unroll
                            for (int e = 0; e < 4; ++e) { o0[e] = 1.f / (1.f + expf(-v0[e])); o1[e] = 1.f / (1.f + expf(-v1[e])); }
                            float* p = (float*)(ws + WS_BETA) + (size_t)row * 8; *(f32x4*)p = o0; *(f32x4*)(p + 4) = o1;
                        } else {
#pragma unroll
                            for (int e = 0; e < 4; ++e) { o0[e] = al[e] * softplusf_(v0[e] + db[e]); o1[e] = al[4 + e] * softplusf_(v1[e] + db[4 + e]); }
                            float* p = (float*)(ws + WS_GLOG) + (size_t)row * 8; *(f32x4*)p = o0; *(f32x4*)(p + 4) = o1;
                        } }
            }
            return;
        }
        int kind, ld, cbase; bf16* dst;
        if (pn < 12) { kind = 0; dst = (bf16*)(ws + WS_CONVIN); ld = 3072; cbase = pn * 256; }
        else if (pn < 16) { kind = 1; dst = (bf16*)(ws + WS_GG); ld = 1024; cbase = (pn - 12) * 256; }
        else if (pn < 20) { kind = 3; dst = (bf16*)(ws + WS_MQ); ld = 1024; cbase = (pn - 16) * 256; }
        else if (pn == 20) { kind = 3; dst = (bf16*)(ws + WS_MK); ld = 256; cbase = 0; }
        else if (pn == 21) { kind = 0; dst = (bf16*)(ws + WS_MV); ld = 256; cbase = 0; }
        else if (pn < 26) { kind = 2; dst = (bf16*)(ws + WS_SGG); ld = 1024; cbase = (pn - 22) * 256; }
        else { kind = 2; dst = (bf16*)(ws + WS_SGM); ld = 1024; cbase = (pn - 26) * 256; }
        const bool rope = (kind == 3) && (wc == 0);
        const int i0 = 8 * (fq & 1);
        float ksum[2][8];
#pragma unroll
        for (int bj = 0; bj < 2; ++bj)
#pragma unroll
            for (int e = 0; e < 8; ++e) ksum[bj][e] = 0.f;
        typedef _Float16 f16x8 __attribute__((ext_vector_type(8)));
        f16x8 cq[4], sq[4];
#pragma unroll
        for (int ai = 0; ai < 2; ++ai) {
            if (rope) {
#pragma unroll
                for (int k = 0; k < 4; ++k) { const _Float16* rp = (const _Float16*)(ws + WS_ROPE) + (size_t)(row0 + ai * 128 + k * 16) * 32 + i0; cq[k] = *(const f16x8*)rp; sq[k] = *(const f16x8*)(rp + 16); }
            }
#pragma unroll
            for (int m = 0; m < 4; ++m) { const int row = row0 + ai * 128 + m * 16; bf16* rowp = dst + (size_t)row * ld + cbase + colt;
                f32x4 c0, c1, s0, s1;
                if (rope) { const f16x8 cc = cq[m], ss = sq[m];
#pragma unroll
                    for (int e = 0; e < 4; ++e) { c0[e] = (float)cc[e]; c1[e] = (float)cc[4 + e]; s0[e] = (float)ss[e]; s1[e] = (float)ss[4 + e]; } }
#pragma unroll
                for (int bj = 0; bj < 2; ++bj) { f32x4 v0 = acc[ai][bj][m][0], v1 = acc[ai][bj][m][1];
                    if (kind == 1) {
#pragma unroll
                        for (int e = 0; e < 4; ++e) { v0[e] = siluf_(v0[e]); v1[e] = siluf_(v1[e]); }
                    } else if (kind == 2) {
#pragma unroll
                        for (int e = 0; e < 4; ++e) { v0[e] = sigmoidf_(v0[e]); v1[e] = sigmoidf_(v1[e]); }
                    } else if (rope) {
                        const float sg = fq < 2 ? -1.f : 1.f;
#pragma unroll
                        for (int e = 0; e < 4; ++e) { const float p0 = __shfl_xor(v0[e], 32), p1 = __shfl_xor(v1[e], 32);
                            v0[e] = v0[e] * c0[e] + sg * p0 * s0[e]; v1[e] = v1[e] * c1[e] + sg * p1 * s1[e]; }
                    }
                    if (pn == 20) {
#pragma unroll
                        for (int e = 0; e < 4; ++e) { ksum[bj][e] += v0[e]; ksum[bj][4 + e] += v1[e]; }
                    }
                    if (pn >= 16 && pn < 20) { v0 = v0 * MB_QSCALE; v1 = v1 * MB_QSCALE; }
                    v4u o; o.x = pg8::cvt_pk_bf16(v0[0], v0[1]); o.y = pg8::cvt_pk_bf16(v0[2], v0[3]); o.z = pg8::cvt_pk_bf16(v1[0], v1[1]); o.w = pg8::cvt_pk_bf16(v1[2], v1[3]);
                    *(v4u*)(rowp + bj * 128) = o; } }
        }
        if (pn == 20) {
            float* km = (float*)(ws + WS_CTL) + CW_KMEAN;
#pragma unroll
            for (int bj = 0; bj < 2; ++bj)
#pragma unroll
                for (int e = 0; e < 8; ++e) { float s = ksum[bj][e];
#pragma unroll
                    for (int o = 1; o < 16; o <<= 1) s += __shfl_xor(s, o);
                    if (fr == 0) atomicAdd(km + ((size_t)bj * 64 + u.pm) * 128 + colt + e, s * (1.f / 256.f)); }
        }
    }
};
template <bool ACCUM, bool F8OUT = false> struct EpiGate {
    static constexpr bool PERM = true;
    bf16* M; const bf16* gate; unsigned char* M8;
    __device__ __forceinline__ void operator()(const f32x4 (&acc)[2][2][4][2], const pg8::Unit& u, int wr, int wc, int fr, int fq) const {
        const int row0 = u.pm * 256 + wr * 64 + fr, col0 = u.pn * 256 + wc * 32 + 8 * fq;
        v4u gq[2][4], pq[2][4];
#define EG_RO(st, g) ((size_t)(row0 + ((st) >> 1) * 128 + (2 * ((st) & 1) + ((g) >> 1)) * 16) * 1024 + col0 + ((g) & 1) * 128)
#define EG_LOAD(st) do { _Pragma("unroll") for (int _g = 0; _g < 4; ++_g) { gq[(st) & 1][_g] = *(const v4u*)(gate + EG_RO(st, _g)); if (ACCUM) pq[(st) & 1][_g] = *(const v4u*)(M + EG_RO(st, _g)); } } while (0)
#define EG_STORE(st) do { _Pragma("unroll") for (int _g = 0; _g < 4; ++_g) { const int _ai = (st) >> 1, _m = 2 * ((st) & 1) + (_g >> 1), _bj = _g & 1; \
            const f32x4 v0 = acc[_ai][_bj][_m][0], v1 = acc[_ai][_bj][_m][1]; const v4u g = gq[(st) & 1][_g]; \
            float r[8] = {v0[0] * bflo(g.x), v0[1] * bfhi(g.x), v0[2] * bflo(g.y), v0[3] * bfhi(g.y), v1[0] * bflo(g.z), v1[1] * bfhi(g.z), v1[2] * bflo(g.w), v1[3] * bfhi(g.w)}; \
            if (ACCUM) { const v4u p = pq[(st) & 1][_g]; \
                r[0] += bflo(p.x); r[1] += bfhi(p.x); r[2] += bflo(p.y); r[3] += bfhi(p.y); r[4] += bflo(p.z); r[5] += bfhi(p.z); r[6] += bflo(p.w); r[7] += bfhi(p.w); } \
            if (F8OUT) { v2u o8; o8.x = pk4_fp8(4.f * r[0], 4.f * r[1], 4.f * r[2], 4.f * r[3]); o8.y = pk4_fp8(4.f * r[4], 4.f * r[5], 4.f * r[6], 4.f * r[7]); *(v2u*)(M8 + EG_RO(st, _g)) = o8; } \
            else { v4u o; o.x = pg8::cvt_pk_bf16(r[0], r[1]); o.y = pg8::cvt_pk_bf16(r[2], r[3]); o.z = pg8::cvt_pk_bf16(r[4], r[5]); o.w = pg8::cvt_pk_bf16(r[6], r[7]); \
                *(v4u*)(M + EG_RO(st, _g)) = o; } } } while (0)
        EG_LOAD(0); EG_LOAD(1);
        EG_STORE(0); EG_LOAD(2);
        EG_STORE(1); EG_LOAD(3);
        EG_STORE(2); EG_STORE(3);
#undef EG_RO
#undef EG_LOAD
#undef EG_STORE
    }
};

constexpr int GP_WF = 0, GP_QGF = 16384, GP_KDF = 32768, GP_AQF = 49152, GP_UT = 57344, GP_UNIT = 73728;
constexpr int PL_KB = 0, PL_QB = 17408, PL_RH = 34816, PL_X = 71680, PL_XT = 80896, PL_P = 99328, PL_SC = 108544;
__device__ __forceinline__ bf16x8 ldsfrag(const LAS unsigned char* base, int row, int stride, int ks, int q) { return *(const LAS bf16x8*)(base + row * stride + ks * 64 + q * 16); }

constexpr int PL_STG = 109056;
__device__ __forceinline__ void gdn_prep_all(Frame& F, const Args& a) {
    LAS unsigned char* L = F.lds; unsigned char* ws = F.ws;
    const int tid = threadIdx.x, lane = tid & 63, w = F.wave, l15 = lane & 15, q = lane >> 4;
    LAS float* sc_gc = (LAS float*)(L + PL_SC); LAS float* sc_beta = sc_gc + 64;
    const bf16* cin = (const bf16*)(ws + WS_CONVIN);
    float gpre = 0.f, bpre = 0.f;
#define GP_PREFETCH(uu_) do { const int _h = (uu_) & 7, _t0 = 64 * ((uu_) >> 3); \
        if (w == 0) { gpre = ((const float*)(ws + WS_GLOG))[(size_t)(_t0 + lane) * 8 + _h]; bpre = ((const float*)(ws + WS_BETA))[(size_t)(_t0 + lane) * 8 + _h]; } \
        _Pragma("unroll") for (int _i = 0; _i < 5; ++_i) { const int _pc = w + 8 * _i;     \
            if (_pc < 34) { const int _p = _pc / 17, _r0 = 4 * (_pc % 17); int _row = _r0 + (lane >> 4); if (_row > 66) _row = 66; int _t = _t0 - 3 + _row; if (_t < 0) _t = 0; \
                __builtin_amdgcn_global_load_lds((const unsigned*)(cin + (size_t)_t * 3072 + _p * 1024 + _h * 128 + (lane & 15) * 8), (LAS unsigned*)(L + PL_STG + _p * 17408 + _r0 * 256), 16, 0, 0); } } } while (0)
    unsigned uvn[11];
#define UV_PREFETCH(uu_) do { const int _h = (uu_) & 7, _t0 = 64 * ((uu_) >> 3); \
        _Pragma("unroll") for (int _jj = 0; _jj < 11; ++_jj) { int _t = _t0 + 8 * w - 3 + _jj; if (_t < 0) _t = 0; uvn[_jj] = *(const unsigned*)(cin + (size_t)_t * 3072 + 2048 + _h * 128 + 2 * lane); } } while (0)
    { const int u0 = F.bid < 2048 ? F.bid : 2047; UV_PREFETCH(u0); }
    if (F.bid < 2048) GP_PREFETCH(F.bid);
    int hcw = -1;
    constexpr int PL_CW = 144384;
  for (int u = F.bid; u < 2048; u += F.G) {
    const int h = u & 7, n = u >> 3, t0 = 64 * n;
    unsigned char* gp = ws + WS_GDNP + (size_t)(h * 256 + n) * GP_UNIT;
    if (h != hcw) { hcw = h;
        if (w == 0) {
#pragma unroll
            for (int p = 0; p < 3; ++p) { f32x2 tmpc[4];
#pragma unroll
                for (int j = 0; j < 4; ++j) tmpc[j] = *(const f32x2*)(a.in[2] + (size_t)j * 3072 + p * 1024 + h * 128 + 2 * lane);
                __builtin_amdgcn_sched_barrier(0);
#pragma unroll
                for (int j = 0; j < 4; ++j) *(LAS f32x2*)(L + PL_CW + ((p * 4 + j) * 64 + lane) * 8) = tmpc[j];
                __builtin_amdgcn_sched_barrier(0); }
        } }
    if (w == 0) { float g = gpre; const float b = bpre;
        g = DPP_STEP(g, 0x111, 0xf); g = DPP_STEP(g, 0x112, 0xf); g = DPP_STEP(g, 0x114, 0xf); g = DPP_STEP(g, 0x118, 0xf); g = DPP_STEP(g, 0x142, 0xa); g = DPP_STEP(g, 0x143, 0xc);
        sc_gc[lane] = g; sc_beta[lane] = b; if (lane == 63) ((float*)(ws + WS_GL))[h * 256 + n] = expf(g); }
    __syncthreads();
    {
        unsigned uv[11];
#pragma unroll
        for (int jj = 0; jj < 11; ++jj) { const int t = t0 + 8 * w - 3 + jj; uv[jj] = (t >= 0) ? uvn[jj] : 0u; }
#pragma unroll
        for (int p = 0; p < 3; ++p) {
            f32x2 cw[4]; unsigned uu[11];
#pragma unroll
            for (int j = 0; j < 4; ++j) cw[j] = *(const LAS f32x2*)(L + PL_CW + ((p * 4 + j) * 64 + lane) * 8);
#pragma unroll
            for (int jj = 0; jj < 11; ++jj) { const int t = t0 + 8 * w - 3 + jj; uu[jj] = (p == 2) ? uv[jj] : ((t >= 0) ? *(const LAS unsigned*)(L + PL_STG + p * 17408 + (8 * w + jj) * 256 + lane * 4) : 0u); }
            float y0[8], y1[8], ss[8];
#pragma unroll
            for (int i = 0; i < 8; ++i) { float a0 = 0.f, a1 = 0.f;
#pragma unroll
                for (int j = 0; j < 4; ++j) { a0 += cw[j][0] * bflo(uu[i + j]); a1 += cw[j][1] * bfhi(uu[i + j]); }
                y0[i] = siluf_(a0); y1[i] = siluf_(a1); ss[i] = y0[i] * y0[i] + y1[i] * y1[i]; }
            if (p < 2) {
#pragma unroll
                for (int i = 0; i < 8; ++i) ss[i] = wave_sum_dpp(ss[i]);
#pragma unroll
                for (int i = 0; i < 8; ++i) { const float r = __builtin_amdgcn_rsqf(ss[i] + 1e-6f) * (p == 0 ? 0.08838834764831845f : 1.f); y0[i] *= r; y1[i] *= r; }
            }
            if (p < 2) {
#pragma unroll
                for (int i = 0; i < 8; ++i) *(LAS unsigned*)(L + (p == 0 ? PL_QB : PL_KB) + (8 * w + i) * 272 + lane * 4) = pg8::cvt_pk_bf16(y0[i], y1[i]);
            }
            if (p >= 1) {
                float f[8];
#pragma unroll
                for (int i = 0; i < 8; ++i) { const int c = 8 * w + i; f[i] = (p == 1) ? sc_beta[c] * __expf(sc_gc[c]) : sc_beta[c]; }
                v4u r0, r1;
                r0.x = pg8::cvt_pk_bf16(y0[0] * f[0], y0[1] * f[1]); r0.y = pg8::cvt_pk_bf16(y0[2] * f[2], y0[3] * f[3]); r0.z = pg8::cvt_pk_bf16(y0[4] * f[4], y0[5] * f[5]); r0.w = pg8::cvt_pk_bf16(y0[6] * f[6], y0[7] * f[7]);
                r1.x = pg8::cvt_pk_bf16(y1[0] * f[0], y1[1] * f[1]); r1.y = pg8::cvt_pk_bf16(y1[2] * f[2], y1[3] * f[3]); r1.z = pg8::cvt_pk_bf16(y1[4] * f[4], y1[5] * f[5]); r1.w = pg8::cvt_pk_bf16(y1[6] * f[6], y1[7] * f[7]);
                const int rb = (p == 1) ? 128 : 0;
                *(LAS v4u*)(L + PL_RH + (rb + 2 * lane) * 144 + 16 * w) = r0; *(LAS v4u*)(L + PL_RH + (rb + 2 * lane + 1) * 144 + 16 * w) = r1;
            }
        }
    }
    __syncthreads();
    if (u + F.G < 2048) GP_PREFETCH(u + F.G);
    { const int un = u + F.G < 2048 ? u + F.G : 2047; UV_PREFETCH(un); }
    const int mt = w & 3;
    f32x4 Pacc[4];
    {
        bf16x8 af[4];
#pragma unroll
        for (int ks = 0; ks < 4; ++ks) af[ks] = ldsfrag(L + PL_KB, 16 * mt + l15, 272, ks, q);
#pragma unroll
        for (int nt = 0; nt < 4; ++nt) { f32x4 acc = {0.f, 0.f, 0.f, 0.f};
#pragma unroll
            for (int ks = 0; ks < 4; ++ks) acc = mfma16(af[ks], ldsfrag(L + PL_KB, 16 * nt + l15, 272, ks, q), acc);
            const int s = 16 * nt + l15; const float gs = sc_gc[s]; f32x4 val;
#pragma unroll
            for (int r = 0; r < 4; ++r) { const int c = 16 * mt + 4 * q + r; val[r] = (s < c) ? sc_beta[c] * acc[r] * __expf(sc_gc[c] - gs) : 0.f; }
            if (w < 4) {
#pragma unroll
                for (int r = 0; r < 4; ++r) *(LAS bf16*)(L + PL_X + (16 * mt + 4 * q + r) * 144 + s * 2) = (bf16)f2bf(val[r]);
                v2u o; o.x = pg8::cvt_pk_bf16(val[0], val[1]); o.y = pg8::cvt_pk_bf16(val[2], val[3]);
                *(LAS v2u*)(L + PL_XT + s * 144 + (16 * mt + 4 * q) * 2) = o;
            } else {
#pragma unroll
                for (int r = 0; r < 4; ++r) { const int c = 16 * mt + 4 * q + r; Pacc[nt][r] = ((c == s) ? 1.f : 0.f) - val[r]; *(LAS bf16*)(L + PL_P + c * 144 + s * 2) = (bf16)f2bf(Pacc[nt][r]); }
            }
        }
        if (w >= 4) {
            bf16x8 qf[4];
#pragma unroll
            for (int ks = 0; ks < 4; ++ks) qf[ks] = ldsfrag(L + PL_QB, 16 * mt + l15, 272, ks, q);
            const int c = 16 * mt + l15; const float gcq = sc_gc[c];
            f32x4 aq[4];
#pragma unroll
            for (int m2 = 0; m2 < 4; ++m2) { f32x4 acc = {0.f, 0.f, 0.f, 0.f};
#pragma unroll
                for (int ks = 0; ks < 4; ++ks) acc = mfma16(ldsfrag(L + PL_KB, 16 * m2 + l15, 272, ks, q), qf[ks], acc);
#pragma unroll
                for (int r = 0; r < 4; ++r) { const int cp = 16 * m2 + 4 * q + r; aq[m2][r] = (cp <= c) ? acc[r] * __expf(gcq - sc_gc[cp]) : 0.f; } }
#pragma unroll
            for (int k2 = 0; k2 < 2; ++k2) *(bf16x8*)(gp + GP_AQF + (mt * 2 + k2) * 1024 + lane * 16) = pack8(aq[2 * k2], aq[2 * k2 + 1]);
        }
    }
    do { asm volatile("s_waitcnt lgkmcnt(0)" ::: "memory"); __builtin_amdgcn_s_barrier(); asm volatile("" ::: "memory"); } while (0);
#pragma unroll
    for (int lev = 0; lev < 6; ++lev) {
        const int cur = lev & 1;
        const LAS unsigned char* xt = L + PL_XT + cur * 9216;
        if (w < 4) {
            if (lev < 5) {
                bf16x8 af[2]; f32x4 xa[4];
#pragma unroll
                for (int ks = 0; ks < 2; ++ks) af[ks] = ldsfrag(L + PL_X, 16 * mt + l15, 144, ks, q);
#pragma unroll
                for (int nt = 0; nt < 4; ++nt) { xa[nt] = (f32x4){0.f, 0.f, 0.f, 0.f};
#pragma unroll
                    for (int ks = 0; ks < 2; ++ks) xa[nt] = mfma16(af[ks], ldsfrag(xt, 16 * nt + l15, 144, ks, q), xa[nt]); }
                LAS unsigned char* xtn = L + PL_XT + (cur ^ 1) * 9216;
#pragma unroll
                for (int nt = 0; nt < 4; ++nt) { const int s = 16 * nt + l15;
#pragma unroll
                    for (int r = 0; r < 4; ++r) *(LAS bf16*)(L + PL_X + (16 * mt + 4 * q + r) * 144 + s * 2) = (bf16)f2bf(xa[nt][r]);
                    v2u o; o.x = pg8::cvt_pk_bf16(xa[nt][0], xa[nt][1]); o.y = pg8::cvt_pk_bf16(xa[nt][2], xa[nt][3]);
                    *(LAS v2u*)(xtn + s * 144 + (16 * mt + 4 * q) * 2) = o; }
            }
        } else if (lev >= 1) {
            bf16x8 af[2];
#pragma unroll
            for (int ks = 0; ks < 2; ++ks) af[ks] = ldsfrag(L + PL_P, 16 * mt + l15, 144, ks, q);
#pragma unroll
            for (int nt = 0; nt < 4; ++nt)
#pragma unroll
                for (int ks = 0; ks < 2; ++ks) Pacc[nt] = mfma16(af[ks], ldsfrag(xt, 16 * nt + l15, 144, ks, q), Pacc[nt]);
#pragma unroll
            for (int nt = 0; nt < 4; ++nt)
#pragma unroll
                for (int r = 0; r < 4; ++r) *(LAS bf16*)(L + PL_P + (16 * mt + 4 * q + r) * 144 + (16 * nt + l15) * 2) = (bf16)f2bf(Pacc[nt][r]);
        }
        do { asm volatile("s_waitcnt lgkmcnt(0)" ::: "memory"); __builtin_amdgcn_s_barrier(); asm volatile("" ::: "memory"); } while (0);
    }
    __builtin_amdgcn_s_waitcnt(0x0F70);
    if (w < 4) {
#pragma unroll
        for (int i = 0; i < 2; ++i) { const int nt = 2 * w + i; f32x4 uu[4];
            const bf16x8 b0 = ldsfrag(L + PL_RH, 16 * nt + l15, 144, 0, q), b1 = ldsfrag(L + PL_RH, 16 * nt + l15, 144, 1, q);
#pragma unroll
            for (int m2 = 0; m2 < 4; ++m2) { uu[m2] = mfma16(ldsfrag(L + PL_P, 16 * m2 + l15, 144, 0, q), b0, (f32x4){0.f, 0.f, 0.f, 0.f}); uu[m2] = mfma16(ldsfrag(L + PL_P, 16 * m2 + l15, 144, 1, q), b1, uu[m2]); }
            unsigned char* up = gp + GP_UT + (16 * nt + l15) * 128 + q * 32;
            *(bf16x8*)up = pack8(uu[0], uu[1]); *(bf16x8*)(up + 16) = pack8(uu[2], uu[3]); }
    } else {
        const bf16x8 b0 = ldsfrag(L + PL_P, 16 * mt + l15, 144, 0, q), b1 = ldsfrag(L + PL_P, 16 * mt + l15, 144, 1, q);
        f32x4 wa[8];
#pragma unroll
        for (int md = 0; md < 8; ++md) { wa[md] = mfma16(ldsfrag(L + PL_RH, 128 + 16 * md + l15, 144, 0, q), b0, (f32x4){0.f, 0.f, 0.f, 0.f}); wa[md] = mfma16(ldsfrag(L + PL_RH, 128 + 16 * md + l15, 144, 1, q), b1, wa[md]); wa[md] = -wa[md]; }
#pragma unroll
        for (int ks = 0; ks < 4; ++ks) { const f32x4 a0 = wa[2 * ks] * 32.f, a1 = wa[2 * ks + 1] * 32.f; v2u o8; o8.x = pk4_fp8(a0[0], a0[1], a0[2], a0[3]); o8.y = pk4_fp8(a1[0], a1[1], a1[2], a1[3]);
            *(v2u*)(gp + GP_WF + (mt * 4 + ks) * 512 + lane * 8) = o8; }
    }
    {
        const float gl = sc_gc[63];
#pragma unroll
        for (int i = 0; i < 2; ++i) { const int f = 2 * w + i;
            { const int m2 = f >> 2, ks = f & 3, c = 16 * m2 + l15; const float eg = __expf(sc_gc[c]);
              const v2u x0 = *(const LAS v2u*)(L + PL_QB + c * 272 + (32 * ks + 4 * q) * 2), x1 = *(const LAS v2u*)(L + PL_QB + c * 272 + (32 * ks + 16 + 4 * q) * 2);
              const f32x4 v0 = {bflo(x0.x) * eg, bfhi(x0.x) * eg, bflo(x0.y) * eg, bfhi(x0.y) * eg}, v1 = {bflo(x1.x) * eg, bfhi(x1.x) * eg, bflo(x1.y) * eg, bfhi(x1.y) * eg};
              *(bf16x8*)(gp + GP_QGF + f * 1024 + lane * 16) = pack8(v0, v1); }
            { const int md = f >> 1, ks = f & 1, d = 16 * md + l15; f32x4 v0, v1;
#pragma unroll
              for (int r = 0; r < 4; ++r) { const int c0 = 32 * ks + 4 * q + r, c1 = c0 + 16;
                  v0[r] = bf2f(*(const LAS bf16*)(L + PL_KB + c0 * 272 + d * 2)) * __expf(gl - sc_gc[c0]); v1[r] = bf2f(*(const LAS bf16*)(L + PL_KB + c1 * 272 + d * 2)) * __expf(gl - sc_gc[c1]); }
              v2u o8; o8.x = pk4_fp8(64.f * v0[0], 64.f * v0[1], 64.f * v0[2], 64.f * v0[3]); o8.y = pk4_fp8(64.f * v1[0], 64.f * v1[1], 64.f * v1[2], 64.f * v1[3]);
              *(v2u*)(gp + GP_KDF + f * 512 + lane * 8) = o8; }
        }
    }
    do { asm volatile("s_waitcnt lgkmcnt(0)" ::: "memory"); __builtin_amdgcn_s_barrier(); asm volatile("" ::: "memory"); } while (0);
  }
#undef GP_PREFETCH
#undef UV_PREFETCH
}

__device__ __forceinline__ void gdn_scan(Frame& F, const int h) {
    LAS unsigned char* L = F.lds; unsigned char* ws = F.ws;
    const int lane = threadIdx.x & 63, w = F.wave, l15 = lane & 15, q = lane >> 4;
    const unsigned char* gph = ws + WS_GDNP + (size_t)h * 256 * GP_UNIT;
    const float* GLp = (const float*)(ws + WS_GL) + h * 256;
    float* Op = (float*)(ws + WS_O) + h * 128 + 16 * w + l15;
    f32x4 Sf[8];
#pragma unroll
    for (int md = 0; md < 8; ++md) Sf[md] = (f32x4){0.f, 0.f, 0.f, 0.f};
#define SCAN_ISSUE(nn) do { const unsigned char* _s = gph + (size_t)(nn) * GP_UNIT; LAS unsigned char* _d = L + ((nn) & 1) * 57344; \
        _Pragma("unroll") for (int _p = 0; _p < 7; ++_p) __builtin_amdgcn_global_load_lds((const unsigned*)(_s + (w + 8 * _p) * 1024 + lane * 16), (LAS unsigned*)(_d + (w + 8 * _p) * 1024), 16, 0, 0); } while (0)
    SCAN_ISSUE(0);
    for (int n = 0; n < 256; ++n) {
        VM_WAIT(); __syncthreads();
        if (n + 1 < 256) SCAN_ISSUE(n + 1);
        const LAS unsigned char* sl = L + (n & 1) * 57344;
        const unsigned char* up = gph + (size_t)n * GP_UNIT + GP_UT + (16 * w + l15) * 128 + q * 32;
        const v4u u0 = *(const v4u*)up, u1 = *(const v4u*)(up + 16);
        const float gl = GLp[n];
        bf16x8 sb[4];
#pragma unroll
        for (int ks = 0; ks < 4; ++ks) sb[ks] = pack8(Sf[2 * ks], Sf[2 * ks + 1]);
        f32x4 vn[4], oo[4];
        vn[0] = (f32x4){bflo(u0.x), bfhi(u0.x), bflo(u0.y), bfhi(u0.y)}; vn[1] = (f32x4){bflo(u0.z), bfhi(u0.z), bflo(u0.w), bfhi(u0.w)};
        vn[2] = (f32x4){bflo(u1.x), bfhi(u1.x), bflo(u1.y), bfhi(u1.y)}; vn[3] = (f32x4){bflo(u1.z), bfhi(u1.z), bflo(u1.w), bfhi(u1.w)};
#pragma unroll
        for (int m2 = 0; m2 < 4; ++m2) { oo[m2] = (f32x4){0.f, 0.f, 0.f, 0.f};
#pragma unroll
            for (int ks = 0; ks < 4; ++ks) { vn[m2] = mfma16(*(const LAS bf16x8*)(sl + GP_WF + (m2 * 4 + ks) * 1024 + lane * 16), sb[ks], vn[m2]);
                oo[m2] = mfma16(*(const LAS bf16x8*)(sl + GP_QGF + (m2 * 4 + ks) * 1024 + lane * 16), sb[ks], oo[m2]); } }
        const bf16x8 vb0 = pack8(vn[0], vn[1]), vb1 = pack8(vn[2], vn[3]);
#pragma unroll
        for (int m2 = 0; m2 < 4; ++m2) { oo[m2] = mfma16(*(const LAS bf16x8*)(sl + GP_AQF + (m2 * 2) * 1024 + lane * 16), vb0, oo[m2]);
            oo[m2] = mfma16(*(const LAS bf16x8*)(sl + GP_AQF + (m2 * 2 + 1) * 1024 + lane * 16), vb1, oo[m2]); }
#pragma unroll
        for (int md = 0; md < 8; ++md) { Sf[md] = Sf[md] * gl;
            Sf[md] = mfma16(*(const LAS bf16x8*)(sl + GP_KDF + (md * 2) * 1024 + lane * 16), vb0, Sf[md]);
            Sf[md] = mfma16(*(const LAS bf16x8*)(sl + GP_KDF + (md * 2 + 1) * 1024 + lane * 16), vb1, Sf[md]); }
#pragma unroll
        for (int m2 = 0; m2 < 4; ++m2)
#pragma unroll
            for (int r = 0; r < 4; ++r) Op[(size_t)(64 * n + 16 * m2 + 4 * q + r) * 1024] = oo[m2][r];
    }
#undef SCAN_ISSUE
    VM_WAIT(); __syncthreads();
}

__device__ __forceinline__ v4u fp8x8_bf16(const unsigned a, const unsigned b, const float sc) {
    typedef float f32x2_ __attribute__((ext_vector_type(2)));
    const f32x2_ p0 = __builtin_amdgcn_cvt_pk_f32_fp8(a, false), p1 = __builtin_amdgcn_cvt_pk_f32_fp8(a, true), p2 = __builtin_amdgcn_cvt_pk_f32_fp8(b, false), p3 = __builtin_amdgcn_cvt_pk_f32_fp8(b, true);
    v4u o; o.x = pg8::cvt_pk_bf16(p0[0] * sc, p0[1] * sc); o.y = pg8::cvt_pk_bf16(p1[0] * sc, p1[1] * sc); o.z = pg8::cvt_pk_bf16(p2[0] * sc, p2[1] * sc); o.w = pg8::cvt_pk_bf16(p3[0] * sc, p3[1] * sc);
    return o;
}

constexpr int NSCAN = 32, NWARM = 8;
constexpr int SC_SLOT = 36864;
constexpr int SC_WU = 20480, SC_KD = 16384;
__device__ __forceinline__ void gdn_scan2(Frame& F, const int b) {
    LAS unsigned char* L = F.lds; unsigned char* ws = F.ws;
    const int lane = threadIdx.x & 63, w = F.wave, l15 = lane & 15, q = lane >> 4;
    const int h = b & 7, part = b >> 3;
    unsigned char* gph = ws + WS_GDNP + (size_t)h * 256 * GP_UNIT;
    unsigned char* sbp = ws + WS_O + (size_t)h * 256 * 32768;
    constexpr int KDR = 4 * SC_WU, GLT = KDR + 4 * SC_KD;
#define SC_BAR() do { asm volatile("s_waitcnt lgkmcnt(0)" ::: "memory"); __builtin_amdgcn_s_barrier(); asm volatile("" ::: "memory"); } while (0)
    if (threadIdx.x < 256) ((LAS float*)(L + GLT))[threadIdx.x] = ((const float*)(ws + WS_GL))[h * 256 + threadIdx.x];
#define SC_HSTEP(n, RS) do { SC_PUT(RS, (n) + 2); SC_LOAD(RS, (n) + 10); \
            if (w == 7 && lane == 0) __hip_atomic_store(&F.ctl[CW_PROG + 64 * b], (unsigned)((n) + 1), __ATOMIC_RELAXED, __HIP_MEMORY_SCOPE_AGENT); \
            SC_BAR(); } while (0)
#define SC_LOOP() do { \
        SC_LOAD(r0, 0); SC_LOAD(r1, 1); SC_LOAD(r2, 2); SC_LOAD(r3, 3); SC_LOAD(r4, 4); SC_LOAD(r5, 5); SC_LOAD(r6, 6); SC_LOAD(r7, 7); \
        SC_PUT(r0, 0); SC_LOAD(r0, 8); SC_PUT(r1, 1); SC_LOAD(r1, 9);          \
        SC_BAR(); SC_BAR(); \
          \
        _Pragma("unroll 1") for (int n0 = 0; n0 < 256; n0 += 8) { SC_HSTEP(n0, r2); SC_HSTEP(n0 + 1, r3); SC_HSTEP(n0 + 2, r4); SC_HSTEP(n0 + 3, r5); SC_HSTEP(n0 + 4, r6); SC_HSTEP(n0 + 5, r7); SC_HSTEP(n0 + 6, r0); SC_HSTEP(n0 + 7, r1); } } while (0)
    if (w >= 6) {
        const int sok = GP_KDF + (4 * (w - 6)) * 1024 + lane * 16, dok = KDR + (8 * (w - 6) + (lane >> 5)) * 1024 + (lane & 31) * 32;
#define SC_LOAD(R, nn) do { const int _nn = (nn) < 255 ? (nn) : 255; const unsigned char* _u = gph + (size_t)_nn * GP_UNIT + sok; _Pragma("unroll") for (int _i = 0; _i < 4; ++_i) R[_i] = *(const v4u*)(_u + _i * 1024); } while (0)
#define SC_PUT(R, nn) do { LAS unsigned char* _d = L + dok + ((nn) & 3) * SC_KD; _Pragma("unroll") for (int _i = 0; _i < 4; ++_i) { \
            *(LAS v4u*)(_d + _i * 2048) = fp8x8_bf16(R[_i].x, R[_i].y, 1.f / 64.f); *(LAS v4u*)(_d + _i * 2048 + 16) = fp8x8_bf16(R[_i].z, R[_i].w, 1.f / 64.f); } } while (0)
        v4u r0[4], r1[4], r2[4], r3[4], r4[4], r5[4], r6[4], r7[4];
        SC_LOOP();
#undef SC_LOAD
#undef SC_PUT
    } else if (w >= 2) {
        const int lw = w - 2;
        const int sow = GP_WF + (2 * lw) * 1024 + lane * 16, sou = GP_UT + part * 4096 + lw * 1024 + lane * 16;
        const int dww = (4 * lw + (lane >> 5)) * 1024 + (lane & 31) * 32, dwu = 16384 + lw * 1024 + lane * 16;
#define SC_LOAD(R, nn) do { const int _nn = (nn) < 255 ? (nn) : 255; const unsigned char* _u = gph + (size_t)_nn * GP_UNIT; R[0] = *(const v4u*)(_u + sow); R[1] = *(const v4u*)(_u + sow + 1024); R[2] = *(const v4u*)(_u + sou); } while (0)
#define SC_PUT(R, nn) do { LAS unsigned char* _d = L + ((nn) & 3) * SC_WU; _Pragma("unroll") for (int _i = 0; _i < 2; ++_i) { \
            *(LAS v4u*)(_d + dww + _i * 2048) = fp8x8_bf16(R[_i].x, R[_i].y, 1.f / 32.f); *(LAS v4u*)(_d + dww + _i * 2048 + 16) = fp8x8_bf16(R[_i].z, R[_i].w, 1.f / 32.f); } \
            *(LAS v4u*)(_d + dwu) = R[2]; } while (0)
        v4u r0[3], r1[3], r2[3], r3[3], r4[3], r5[3], r6[3], r7[3];
        SC_LOOP();
#undef SC_LOAD
#undef SC_PUT
#undef SC_LOOP
#undef SC_HSTEP
    } else {
        f32x4 Sf[8];
#pragma unroll
        for (int md = 0; md < 8; ++md) Sf[md] = (f32x4){0.f, 0.f, 0.f, 0.f};
        bf16x8 wf[16], kf[16]; v4u u0, u1;
        SC_BAR();
#pragma unroll
        for (int i = 0; i < 16; ++i) wf[i] = *(const LAS bf16x8*)(L + i * 1024 + lane * 16);
        { const LAS unsigned char* up = L + 16384 + (16 * w + l15) * 128 + q * 32; u0 = *(const LAS v4u*)up; u1 = *(const LAS v4u*)(up + 16); }
#pragma unroll
        for (int i = 0; i < 16; ++i) kf[i] = *(const LAS bf16x8*)(L + KDR + i * 1024 + lane * 16);
        SC_BAR();
        const int slice = 2 * part + w;
#pragma unroll 1
        for (int n = 0; n < 256; ++n) {
            f32x4 vn[4];
            vn[0] = (f32x4){bflo(u0.x), bfhi(u0.x), bflo(u0.y), bfhi(u0.y)}; vn[1] = (f32x4){bflo(u0.z), bfhi(u0.z), bflo(u0.w), bfhi(u0.w)};
            vn[2] = (f32x4){bflo(u1.x), bfhi(u1.x), bflo(u1.y), bfhi(u1.y)}; vn[3] = (f32x4){bflo(u1.z), bfhi(u1.z), bflo(u1.w), bfhi(u1.w)};
            const float gl = ((const LAS float*)(L + GLT))[n];
            bf16x8 sb[4];
#pragma unroll
            for (int ks = 0; ks < 4; ++ks) { sb[ks] = pack8(Sf[2 * ks], Sf[2 * ks + 1]);
                *(bf16x8*)(sbp + ((size_t)n * 32 + slice * 4 + ks) * 1024 + lane * 16) = sb[ks]; }
            asm volatile("s_waitcnt lgkmcnt(0)" ::: "memory");
            __builtin_amdgcn_sched_barrier(0);
#pragma unroll
            for (int ks = 0; ks < 4; ++ks)
#pragma unroll
                for (int m2 = 0; m2 < 4; ++m2) vn[m2] = mfma16(wf[m2 * 4 + ks], sb[ks], vn[m2]);
            __builtin_amdgcn_sched_barrier(0);
#pragma unroll
            for (int md = 0; md < 8; ++md) Sf[md] = Sf[md] * gl;
            if (n + 1 < 256) { const LAS unsigned char* wu = L + ((n + 1) & 3) * SC_WU;
#pragma unroll
                for (int i = 0; i < 16; ++i) wf[i] = *(const LAS bf16x8*)(wu + i * 1024 + lane * 16);
                const LAS unsigned char* up = wu + 16384 + (16 * w + l15) * 128 + q * 32; u0 = *(const LAS v4u*)up; u1 = *(const LAS v4u*)(up + 16); }
            __builtin_amdgcn_sched_barrier(0);
            const bf16x8 vb0 = pack8(vn[0], vn[1]), vb1 = pack8(vn[2], vn[3]);
            unsigned char* vbp = gph + (size_t)n * GP_UNIT + GP_UT + slice * 2048 + lane * 16;
            *(bf16x8*)vbp = vb0; *(bf16x8*)(vbp + 1024) = vb1;
#pragma unroll
            for (int md = 0; md < 8; ++md) Sf[md] = mfma16(kf[md * 2], vb0, Sf[md]);
#pragma unroll
            for (int md = 0; md < 8; ++md) Sf[md] = mfma16(kf[md * 2 + 1], vb1, Sf[md]);
            __builtin_amdgcn_sched_barrier(0);
            if (n + 1 < 256) { const LAS unsigned char* kd = L + KDR + ((n + 1) & 3) * SC_KD;
#pragma unroll
                for (int i = 0; i < 16; ++i) kf[i] = *(const LAS bf16x8*)(kd + i * 1024 + lane * 16); }
            SC_BAR();
        }
    }
#undef SC_BAR
    VM_WAIT(); __syncthreads();
}

__device__ __forceinline__ void gdn_scan_warm(Frame& F, const int h) {
    unsigned char* ws = F.ws; const int tid = threadIdx.x;
    const unsigned char* gph = ws + WS_GDNP + (size_t)h * 256 * GP_UNIT;
    LAS unsigned* pw = (LAS unsigned*)(F.lds + 1024);
    unsigned acc = 0u;
    constexpr int WDIST = 14;
    for (int m = 0; m < 256; ++m) {
        if (m >= WDIST) {
            if (tid == 0) { unsigned sp = 0; while (__hip_atomic_load(&F.ctl[CW_PROG + 64 * h], __ATOMIC_RELAXED, __HIP_MEMORY_SCOPE_AGENT) + WDIST < (unsigned)m + 1u) { __builtin_amdgcn_s_sleep(4); if (++sp > (1u << 22)) break; } }
            __syncthreads();
        }
        const unsigned char* u = gph + (size_t)m * GP_UNIT;
#pragma unroll
        for (int i = 0; i < 2; ++i) { const int x = tid + 512 * i, p = x >> 6, o = (x & 63) * 16;
            const unsigned char* src = u + (p < 8 ? GP_WF + p * 1024 : GP_KDF + (p - 8) * 1024) + o;
            const v4u v = *(const v4u*)src; acc ^= v.x ^ v.y ^ v.z ^ v.w; }
    }
    if (acc == 0x12345u) *pw = acc;
    __syncthreads();
}

__device__ __forceinline__ void gdn_ophase(Frame& F, const float* norm_w) {
    unsigned char* ws = F.ws; const int lane = threadIdx.x & 63, w = F.wave, l15 = lane & 15, q = lane >> 4, mt = w & 3, us = w >> 2;
    LAS unsigned char* LB = F.lds + us * 49152;
    LAS unsigned char* tl = F.lds + 98304 + w * 4352;
    float nwv[8];
#pragma unroll
    for (int sl = 0; sl < 8; ++sl) nwv[sl] = norm_w[16 * sl + l15];
    v4u gq[4], gqn[4]; bf16x8 aq[4], aa[2], aqn[4], aan[2]; v4u bsh[12];
#define OP_REQ(u_, GQ, AQ, AA) do { const int _u = (u_) < 2048 ? (u_) : 2047, _h = _u >> 8, _n = _u & 255; \
        const unsigned char* _gp = ws + WS_GDNP + (size_t)_u * GP_UNIT; const unsigned char* _sbp = ws + WS_O + (size_t)_u * 32768; \
        const size_t _gidx = (size_t)(64 * _n + 16 * mt + (lane >> 2)) * 1024 + _h * 128 + (lane & 3) * 32; \
        _Pragma("unroll") for (int _c = 0; _c < 4; ++_c) GQ[_c] = *(const v4u*)((const bf16*)(ws + WS_GG) + _gidx + _c * 8); \
        _Pragma("unroll") for (int _k = 0; _k < 4; ++_k) AQ[_k] = *(const bf16x8*)(_gp + GP_QGF + (mt * 4 + _k) * 1024 + lane * 16); \
        _Pragma("unroll") for (int _k = 0; _k < 2; ++_k) AA[_k] = *(const bf16x8*)(_gp + GP_AQF + (mt * 2 + _k) * 1024 + lane * 16); \
        _Pragma("unroll") for (int _i = 0; _i < 8; ++_i) bsh[_i] = *(const v4u*)(_sbp + (8 * mt + _i) * 1024 + lane * 16); \
        _Pragma("unroll") for (int _i = 0; _i < 4; ++_i) bsh[8 + _i] = *(const v4u*)(_gp + GP_UT + (4 * mt + _i) * 1024 + lane * 16); } while (0)
    int u = 2 * F.bid + us;
    OP_REQ(u, gqn, aqn, aan);
    for (; u < 2048; u += 2 * F.G) {
        const int h = u >> 8, n = u & 255;
        __syncthreads();
#pragma unroll
        for (int i = 0; i < 8; ++i) *(LAS v4u*)(LB + (8 * mt + i) * 1024 + lane * 16) = bsh[i];
#pragma unroll
        for (int i = 0; i < 4; ++i) *(LAS v4u*)(LB + 32768 + (4 * mt + i) * 1024 + lane * 16) = bsh[8 + i];
#pragma unroll
        for (int c = 0; c < 4; ++c) { gq[c] = gqn[c]; aq[c] = aqn[c]; }
        aa[0] = aan[0]; aa[1] = aan[1];
        __syncthreads();
        OP_REQ(u + 2 * F.G, gqn, aqn, aan);
        f32x4 o[8]; float ss[4] = {0.f, 0.f, 0.f, 0.f};
#pragma unroll
        for (int sl = 0; sl < 8; ++sl) { o[sl] = (f32x4){0.f, 0.f, 0.f, 0.f};
#pragma unroll
            for (int ks = 0; ks < 4; ++ks) o[sl] = mfma16(aq[ks], *(const LAS bf16x8*)(LB + (sl * 4 + ks) * 1024 + lane * 16), o[sl]);
#pragma unroll
            for (int k2 = 0; k2 < 2; ++k2) o[sl] = mfma16(aa[k2], *(const LAS bf16x8*)(LB + 32768 + (sl * 2 + k2) * 1024 + lane * 16), o[sl]);
#pragma unroll
            for (int r = 0; r < 4; ++r) ss[r] += o[sl][r] * o[sl][r]; }
#pragma unroll
        for (int r = 0; r < 4; ++r) { float s = ss[r]; s = DPP_STEP(s, 0xB1, 0xf); s = DPP_STEP(s, 0x4E, 0xf); s = DPP_STEP(s, 0x141, 0xf); s = DPP_STEP(s, 0x140, 0xf);     ss[r] = 1.f / sqrtf(s * (1.f / 128.f) + 1e-6f); }
#pragma unroll
        for (int sl = 0; sl < 8; ++sl) { const float nw = nwv[sl];
#pragma unroll
            for (int r = 0; r < 4; ++r) *(LAS bf16*)(tl + (4 * q + r) * 272 + (16 * sl + l15) * 2) = (bf16)f2bf(o[sl][r] * ss[r] * nw); }
        LDS_WAIT(); asm volatile("" ::: "memory");
        __builtin_amdgcn_s_waitcnt(0x0F70);
        { const int row = lane >> 2, seg = lane & 3; const size_t idx = (size_t)(64 * n + 16 * mt + row) * 1024 + h * 128 + seg * 32;
          bf16* OG = (bf16*)(ws + WS_OG);
#pragma unroll
          for (int c4 = 0; c4 < 4; ++c4) { const v4u y = *(const LAS v4u*)(tl + row * 272 + seg * 64 + c4 * 16), g = gq[c4];
              v2u d; d.x = pk4_fp8(bflo(y.x) * bflo(g.x), bfhi(y.x) * bfhi(g.x), bflo(y.y) * bflo(g.y), bfhi(y.y) * bfhi(g.y)); d.y = pk4_fp8(bflo(y.z) * bflo(g.z), bfhi(y.z) * bfhi(g.z), bflo(y.w) * bflo(g.w), bfhi(y.w) * bfhi(g.w));
              *(v2u*)((unsigned char*)OG + idx + c4 * 8) = d; } }
        LDS_WAIT(); asm volatile("" ::: "memory");
    }
#undef OP_REQ
    __syncthreads();
}

__device__ __forceinline__ void gdn_post(Frame& F, const float* norm_w) {
    unsigned char* ws = F.ws; const int lane = threadIdx.x & 63;
    const int gw = F.bid * NWAVES + F.wave, NGW = F.G * NWAVES;
    f32x4 nw[4];
#pragma unroll
    for (int j = 0; j < 4; ++j) nw[j] = *(const f32x4*)(norm_w + (lane & 7) * 16 + 4 * j);
    for (int t = gw; t < T; t += NGW) {
        const f32x4* op = (const f32x4*)((const float*)(ws + WS_O) + (size_t)t * 1024 + lane * 16);
        f32x4 o[4]; float ss = 0.f;
#pragma unroll
        for (int j = 0; j < 4; ++j) { o[j] = op[j]; ss += (o[j][0] * o[j][0] + o[j][1] * o[j][1]) + (o[j][2] * o[j][2] + o[j][3] * o[j][3]); }
        ss += __shfl_xor(ss, 1); ss += __shfl_xor(ss, 2); ss += __shfl_xor(ss, 4);
        const float r = 1.f / sqrtf(ss * (1.f / 128.f) + 1e-6f);
        const v4u* gpn = (const v4u*)((const bf16*)(ws + WS_GG) + (size_t)t * 1024 + lane * 16);
        const v4u g0 = gpn[0], g1 = gpn[1];
        const float gg[16] = {bflo(g0.x), bfhi(g0.x), bflo(g0.y), bfhi(g0.y), bflo(g0.z), bfhi(g0.z), bflo(g0.w), bfhi(g0.w), bflo(g1.x), bfhi(g1.x), bflo(g1.y), bfhi(g1.y), bflo(g1.z), bfhi(g1.z), bflo(g1.w), bfhi(g1.w)};
        float y[16];
#pragma unroll
        for (int j = 0; j < 4; ++j)
#pragma unroll
            for (int e = 0; e < 4; ++e) y[4 * j + e] = o[j][e] * r * nw[j][e] * gg[4 * j + e];
        v4u* dp = (v4u*)((bf16*)(ws + WS_OG) + (size_t)t * 1024 + lane * 16);
        v4u d0, d1; d0.x = pk2(y[0], y[1]); d0.y = pk2(y[2], y[3]); d0.z = pk2(y[4], y[5]); d0.w = pk2(y[6], y[7]); d1.x = pk2(y[8], y[9]); d1.y = pk2(y[10], y[11]); d1.z = pk2(y[12], y[13]); d1.w = pk2(y[14], y[15]);
        dp[0] = d0; dp[1] = d1;
    }
}

constexpr int ML_LTOT = 2064384;
__device__ __forceinline__ int moba_listoff(int g, int n) { return g * ML_LTOT + 4 * (n * T - 128 * n * (n + 1)); }
typedef short s16x4 __attribute__((ext_vector_type(4)));

__device__ __forceinline__ void moba_select_unit(Frame& F, const int g, const int b) {
    if (b == 0) return;
    LAS unsigned char* L = F.lds; unsigned char* ws = F.ws;
    const int tid = threadIdx.x, lane = tid & 63, w = F.wave, l15 = lane & 15, q = lane >> 4;
    constexpr int KH = 0, KL = 17408, GS = 34816, SEL = 68096, LC = 80384, LB = 80640;
    const float* km = (const float*)(ws + WS_CTL) + CW_KMEAN + (size_t)g * 64 * 128;
    for (int i = tid; i < 64 * 128; i += 512) { const int n = i >> 7, d = i & 127; const float x = (n < b) ? km[i] : 0.f; const unsigned hi = f2bf(x); const float lo = x - bf2f(hi);
        *(LAS bf16*)(L + KH + n * 272 + d * 2) = (bf16)hi; *(LAS bf16*)(L + KL + n * 272 + d * 2) = (bf16)f2bf(lo); }
    if (tid < 64) *(LAS unsigned*)(L + LC + tid * 4) = 0u;
    __syncthreads();
    const bf16* MQ = (const bf16*)(ws + WS_MQ);
    LAS float* gs = (LAS float*)(L + GS + w * 4160);
    const int nsel = b < 3 ? b : 3;
#define MS_LOADQ(dst, mt_) do { const int _r0 = (mt_) * 16 + l15; const bf16* _qp = MQ + (size_t)(256 * b + (_r0 >> 2)) * 1024 + (4 * g + (_r0 & 3)) * 128 + 8 * q; \
        _Pragma("unroll") for (int _ks = 0; _ks < 4; ++_ks) dst[_ks] = *(const bf16x8*)(_qp + 32 * _ks); } while (0)
    bf16x8 af[4], af1[4], af2[4];
    MS_LOADQ(af, w); MS_LOADQ(af1, w + 8); MS_LOADQ(af2, w + 16);
    for (int mtile = w; mtile < 64; mtile += 8) {
#pragma unroll
        for (int nt = 0; nt < 4; ++nt) { f32x4 acc = {0.f, 0.f, 0.f, 0.f};
#pragma unroll
            for (int ks = 0; ks < 4; ++ks) { acc = mfma16(af[ks], ldsfrag(L + KH, 16 * nt + l15, 272, ks, q), acc); acc = mfma16(af[ks], ldsfrag(L + KL, 16 * nt + l15, 272, ks, q), acc); }
#pragma unroll
            for (int r = 0; r < 4; ++r) gs[(4 * q + r) * 65 + 16 * nt + l15] = acc[r]; }
        LDS_WAIT(); asm volatile("" ::: "memory");
        {
            const int row = lane >> 2, part = lane & 3;
            float v0 = -INFINITY, v1 = -INFINITY, v2 = -INFINITY; int i0 = 0, i1 = 0, i2 = 0;
            const int nlo = part * 16, nhi = (nlo + 16 < b) ? nlo + 16 : b;
            for (int n = nlo; n < nhi; ++n) { const float x = gs[row * 65 + n];
                if (x > v0) { v2 = v1; i2 = i1; v1 = v0; i1 = i0; v0 = x; i0 = n; } else if (x > v1) { v2 = v1; i2 = i1; v1 = x; i1 = n; } else if (x > v2) { v2 = x; i2 = n; } }
#pragma unroll
            for (int o = 1; o < 4; o <<= 1) {
                const float w0 = __shfl_xor(v0, o), w1 = __shfl_xor(v1, o), w2 = __shfl_xor(v2, o); const int j0 = __shfl_xor(i0, o), j1 = __shfl_xor(i1, o), j2 = __shfl_xor(i2, o);
                const bool lower = (lane & o) == 0;
                const float a0 = lower ? v0 : w0, a1 = lower ? v1 : w1, a2 = lower ? v2 : w2, b0 = lower ? w0 : v0, b1 = lower ? w1 : v1, b2 = lower ? w2 : v2;
                const int ia0 = lower ? i0 : j0, ia1 = lower ? i1 : j1, ia2 = lower ? i2 : j2, ib0 = lower ? j0 : i0, ib1 = lower ? j1 : i1, ib2 = lower ? j2 : i2;
                float r0, r1, r2; int k0, k1, k2;
                if (b0 > a0) { r0 = b0; k0 = ib0;
                    if (b1 > a0) { r1 = b1; k1 = ib1; if (b2 > a0) { r2 = b2; k2 = ib2; } else { r2 = a0; k2 = ia0; } }
                    else { r1 = a0; k1 = ia0; if (b1 > a1) { r2 = b1; k2 = ib1; } else { r2 = a1; k2 = ia1; } } }
                else { r0 = a0; k0 = ia0;
                    if (b0 > a1) { r1 = b0; k1 = ib0; if (b1 > a1) { r2 = b1; k2 = ib1; } else { r2 = a1; k2 = ia1; } }
                    else { r1 = a1; k1 = ia1; if (b0 > a2) { r2 = b0; k2 = ib0; } else { r2 = a2; k2 = ia2; } } }
                v0 = r0; v1 = r1; v2 = r2; i0 = k0; i1 = k1; i2 = k2;
            }
            if (part == 0) { const int rr = mtile * 16 + row;
#pragma unroll
                for (int j = 0; j < 3; ++j) if (j < nsel) { const int blk = j == 0 ? i0 : (j == 1 ? i1 : i2);
                    const unsigned lp = __hip_atomic_fetch_add((LAS unsigned*)(L + LC + blk * 4), 1u, __ATOMIC_RELAXED, __HIP_MEMORY_SCOPE_WORKGROUP);
                    *(LAS unsigned short*)(L + SEL + (rr * 3 + j) * 2) = (unsigned short)blk; *(LAS unsigned short*)(L + SEL + 6144 + (rr * 3 + j) * 2) = (unsigned short)lp; } }
        }
        LDS_WAIT(); asm volatile("" ::: "memory");
#pragma unroll
        for (int ks = 0; ks < 4; ++ks) { af[ks] = af1[ks]; af1[ks] = af2[ks]; }
        if (mtile + 24 < 64) MS_LOADQ(af2, mtile + 24);
    }
#undef MS_LOADQ
    __syncthreads();
    if (tid < b) { const unsigned c = *(LAS unsigned*)(L + LC + tid * 4); *(LAS unsigned*)(L + LB + tid * 4) = c ? atomicAdd(&F.ctl[CW_MOBA_CNT + g * 64 + tid], c) : 0u; }
    __syncthreads();
    unsigned* lists = (unsigned*)(ws + WS_LISTS);
    for (int rr = tid; rr < 1024; rr += 512) { const int t = 256 * b + (rr >> 2), hr = rr & 3;
        for (int j = 0; j < nsel; ++j) { const int blk = *(LAS unsigned short*)(L + SEL + (rr * 3 + j) * 2); const unsigned lp = *(LAS unsigned short*)(L + SEL + 6144 + (rr * 3 + j) * 2);
            lists[moba_listoff(g, blk) + *(LAS unsigned*)(L + LB + blk * 4) + lp] = (unsigned)t | ((unsigned)hr << 14) | ((unsigned)j << 16); } }
    __syncthreads();
}

__device__ __forceinline__ void moba_attn_unit(Frame& F, const int g, const int n, const unsigned* list, const int count, const bool own) {
    LAS unsigned char* L = F.lds; unsigned char* ws = F.ws;
    const int tid = threadIdx.x, lane = tid & 63, w = F.wave, l15 = lane & 15, q = lane >> 4;
    constexpr int KS = 0, VS = 73728;
    { const bf16* MK = (const bf16*)(ws + WS_MK) + (size_t)(256 * n) * 256 + g * 128; const bf16* MV = (const bf16*)(ws + WS_MV) + (size_t)(256 * n) * 256 + g * 128;
        v4u kv[8], vv[8];
#pragma unroll
        for (int i = 0; i < 8; ++i) { const int p = tid + 512 * i, row = p >> 4, ch = p & 15; kv[i] = *(const v4u*)(MK + (size_t)row * 256 + ch * 8); vv[i] = *(const v4u*)(MV + (size_t)row * 256 + ch * 8); }
#pragma unroll
        for (int i = 0; i < 8; ++i) { const int p = tid + 512 * i, row = p >> 4, ch = p & 15; *(LAS v4u*)(L + KS + row * 288 + ch * 16) = kv[i]; *(LAS v4u*)(L + VS + row * 288 + ch * 16) = vv[i]; } }
    __syncthreads();
    const bf16* MQ = (const bf16*)(ws + WS_MQ); bf16* PO = (bf16*)(ws + WS_PO); float* LSE = (float*)(ws + WS_LSE);
    const int ntile = (count + 15) >> 4;
#define MB_ENTRY(tl) ({ int _i = (tl) * 16 + l15; if (_i >= count) _i = count - 1; own ? ((unsigned)(256 * n + (_i >> 2)) | ((unsigned)(_i & 3) << 14) | (3u << 16)) : list[_i]; })
#define MB_LOADQ(dst, e) do { const bf16* _qp = MQ + (size_t)((e) & 16383u) * 1024 + (4 * g + (int)(((e) >> 14) & 3u)) * 128 + 8 * q; \
        _Pragma("unroll") for (int _ks = 0; _ks < 4; ++_ks) dst[_ks] = *(const bf16x8*)(_qp + 32 * _ks); } while (0)
    unsigned e_cur = 0u, e_nxt = 0u; bf16x8 qf[4], qn[4];
    if (w < ntile) { e_cur = MB_ENTRY(w); MB_LOADQ(qf, e_cur); }
    if (w + 8 < ntile) e_nxt = MB_ENTRY(w + 8);
    __builtin_amdgcn_s_waitcnt(0x0F70);
    for (int tile = w; tile < ntile; tile += 8) {
        unsigned e_nn = 0u;
        if (tile + 16 < ntile) e_nn = MB_ENTRY(tile + 16);
        if (tile + 8 < ntile) MB_LOADQ(qn, e_nxt);
        const bool live = tile * 16 + l15 < count;
        const int t = (int)(e_cur & 16383u), hr = (int)((e_cur >> 14) & 3u), j = (int)((e_cur >> 16) & 3u), h = 4 * g + hr;
        f32x4 s[16];
        {
            bf16x8 ka[8], kb[8];
#define MB_LDK(dst, g) do { _Pragma("unroll") for (int _i = 0; _i < 8; ++_i) dst[_i] = ldsfrag(L + KS, 16 * (2 * (g) + (_i >> 2)) + l15, 288, _i & 3, q); } while (0)
#define MB_MMK(src, g) do { _Pragma("unroll") for (int _h = 0; _h < 2; ++_h) { _Pragma("unroll") for (int _ks = 0; _ks < 4; ++_ks) s[2 * (g) + _h] = mfma16(src[_h * 4 + _ks], qf[_ks], s[2 * (g) + _h]); } } while (0)
            const int gmax = own ? ((tile >> 2) >> 1) : 7;
#pragma unroll
            for (int kt = 0; kt < 16; ++kt) s[kt] = (f32x4){0.f, 0.f, 0.f, 0.f};
            MB_LDK(ka, 0);
#pragma unroll
            for (int g = 0; g < 8; g += 2) {
                if (g + 1 <= gmax) MB_LDK(kb, g + 1);
                __builtin_amdgcn_sched_barrier(0); if (g <= gmax) MB_MMK(ka, g); __builtin_amdgcn_sched_barrier(0);
                if (g + 2 < 8 && g + 2 <= gmax) MB_LDK(ka, g + 2);
                __builtin_amdgcn_sched_barrier(0); if (g + 1 <= gmax) MB_MMK(kb, g + 1); __builtin_amdgcn_sched_barrier(0);
            }
#undef MB_LDK
#undef MB_MMK
        }
        const int tq = own ? (t - 256 * n) : 255;
        float m = -1e30f;
#pragma unroll
        for (int kt = 0; kt < 16; ++kt)
#pragma unroll
            for (int r = 0; r < 4; ++r) { const int key = 16 * kt + 4 * q + r; const float x = (!own || key <= tq) ? s[kt][r] : -1e30f; s[kt][r] = x; m = fmaxf(m, x); }
        m = fmaxf(m, __shfl_xor(m, 16)); m = fmaxf(m, __shfl_xor(m, 32));
        float l = 0.f;
#pragma unroll
        for (int kt = 0; kt < 16; ++kt)
#pragma unroll
            for (int r = 0; r < 4; ++r) { const float p = __builtin_amdgcn_exp2f(s[kt][r] - m); s[kt][r] = p; l += p; }
        l += __shfl_xor(l, 16); l += __shfl_xor(l, 32);
        f32x4 oa[8];
#pragma unroll
        for (int md = 0; md < 8; ++md) oa[md] = (f32x4){0.f, 0.f, 0.f, 0.f};
        {
            bf16x8 va[4], vb2[4];
            const LAS unsigned char* vbase = L + VS + (4 * q + (l15 >> 2)) * 288 + (l15 & 3) * 8;
#define MB_LDV(dst, x) do { _Pragma("unroll") for (int _m = 0; _m < 4; ++_m) { const int _md = 4 * ((x) & 1) + _m, _k2 = (x) >> 1; \
                const s16x4 _a0 = __builtin_amdgcn_ds_read_tr16_b64_v4i16((LAS s16x4*)(vbase + (32 * _k2) * 288 + _md * 32)), _a1 = __builtin_amdgcn_ds_read_tr16_b64_v4i16((LAS s16x4*)(vbase + (32 * _k2 + 16) * 288 + _md * 32)); \
                dst[_m] = (bf16x8){_a0[0], _a0[1], _a0[2], _a0[3], _a1[0], _a1[1], _a1[2], _a1[3]}; } } while (0)
#define MB_MMV(src, x) do { const bf16x8 _pb = pack8(s[2 * ((x) >> 1)], s[2 * ((x) >> 1) + 1]); _Pragma("unroll") for (int _m = 0; _m < 4; ++_m) oa[4 * ((x) & 1) + _m] = mfma16(src[_m], _pb, oa[4 * ((x) & 1) + _m]); } while (0)
            const int xmax = own ? (2 * (tile >> 3) + 1) : 15;
            MB_LDV(va, 0);
#pragma unroll
            for (int x = 0; x < 16; x += 2) {
                if (x + 1 <= xmax) MB_LDV(vb2, x + 1);
                __builtin_amdgcn_sched_barrier(0); if (x <= xmax) MB_MMV(va, x); __builtin_amdgcn_sched_barrier(0);
                if (x + 2 < 16 && x + 2 <= xmax) MB_LDV(va, x + 2);
                __builtin_amdgcn_sched_barrier(0); if (x + 1 <= xmax) MB_MMV(vb2, x + 1); __builtin_amdgcn_sched_barrier(0);
            }
#undef MB_LDV
#undef MB_MMV
        }
        __builtin_amdgcn_s_waitcnt(0x0F70);
        if (live) { const float inv = 1.f / l; bf16* op = PO + (((size_t)t * 8 + h) * 4 + j) * 128 + 4 * q;
#pragma unroll
            for (int md = 0; md < 8; ++md) { v2u o; o.x = pg8::cvt_pk_bf16(oa[md][0] * inv, oa[md][1] * inv); o.y = pg8::cvt_pk_bf16(oa[md][2] * inv, oa[md][3] * inv); __builtin_nontemporal_store(o, (v2u*)(op + 16 * md)); }
            if (q == 0) __builtin_nontemporal_store((m + __builtin_amdgcn_logf(l)) * 0.6931471805599453f, &LSE[((size_t)t * 8 + h) * 4 + j]); }
        e_cur = e_nxt; e_nxt = e_nn;
#pragma unroll
        for (int ks = 0; ks < 4; ++ks) qf[ks] = qn[ks];
    }
#undef MB_ENTRY
#undef MB_LOADQ
    __syncthreads();
}

__device__ __forceinline__ void moba_own_queue(Frame& F) {
    LAS int* bc = (LAS int*)(F.lds + 148480) + 132; const int tid = threadIdx.x;
    for (;;) {
        if (tid == 0) *bc = (int)atomicAdd(&F.ctl[CW_QHEAD], 1u);
        __syncthreads();
        const int it = *bc;
        __syncthreads();
        if (it >= 128) break;
        moba_attn_unit(F, it & 1, it >> 1, nullptr, 1024, true);
    }
}
__device__ __forceinline__ void moba_attn_queue(Frame& F) {
    LAS unsigned char* L = F.lds; unsigned char* ws = F.ws; const int tid = threadIdx.x;
    LAS int* pre = (LAS int*)(L + 148480); LAS int* bc = pre + 132;
    moba_own_queue(F);
    if (tid < 128) { const int c = (int)__hip_atomic_load(&F.ctl[CW_MOBA_CNT + tid], __ATOMIC_RELAXED, __HIP_MEMORY_SCOPE_AGENT); const int nch = (c + 1023) >> 10; const int v = wave_scan_dpp(nch);
        pre[tid] = v - nch; if ((tid & 63) == 63) pre[129 + (tid >> 6)] = v; }
    __syncthreads();
    if (tid >= 64 && tid < 128) pre[tid] += pre[129];
    if (tid == 0) pre[128] = pre[129] + pre[130];
    __syncthreads();
    const int total = pre[128];
    for (;;) {
        if (tid == 0) *bc = (int)atomicAdd(&F.ctl[CW_QHEAD + 1], 1u);
        __syncthreads();
        const int x = *bc;
        __syncthreads();
        if (x >= total) break;
        int idx = 0; while (pre[idx + 1] <= x) ++idx;
        const int g = idx >> 6, n = idx & 63, ch = x - pre[idx]; const int cnt = (int)__hip_atomic_load(&F.ctl[CW_MOBA_CNT + idx], __ATOMIC_RELAXED, __HIP_MEMORY_SCOPE_AGENT);
        const int c0 = ch * 1024, cc = (cnt - c0) < 1024 ? (cnt - c0) : 1024;
        moba_attn_unit(F, g, n, (const unsigned*)(ws + WS_LISTS) + moba_listoff(g, n) + c0, cc, false);
    }
}

__device__ __forceinline__ void moba_combine(Frame& F, const int wg0) {
    unsigned char* ws = F.ws; const int lane = threadIdx.x & 63;
    const int gw = (F.bid - wg0) * NWAVES + F.wave, NGW = (F.G - wg0) * NWAVES;
    const bf16* PO = (const bf16*)(ws + WS_PO); const float* LSE = (const float*)(ws + WS_LSE);
    const int h = lane >> 3;
#define MC_LOAD(t_, L_, A_, C_) do { L_ = __builtin_nontemporal_load((const f32x4*)(LSE + ((size_t)(t_) * 8 + h) * 4)); \
        _Pragma("unroll") for (int _j = 0; _j < 4; ++_j) { const v4u* _pp = (const v4u*)(PO + (((size_t)(t_) * 8 + h) * 4 + _j) * 128 + (lane & 7) * 16); A_[_j] = __builtin_nontemporal_load(_pp); C_[_j] = __builtin_nontemporal_load(_pp + 1); } } while (0)
    f32x4 ls, lsn; v4u pa[4], pc[4], na[4], nc[4];
    int t = gw;
    if (t < T) MC_LOAD(t, ls, pa, pc);
    for (; t < T; t += NGW) {
        const int tn = t + NGW;
        if (tn < T) MC_LOAD(tn, lsn, na, nc);
        const int b = t >> 8, nsel = b < 3 ? b : 3;
        float lj[4] = {nsel > 0 ? ls[0] : -INFINITY, nsel > 1 ? ls[1] : -INFINITY, nsel > 2 ? ls[2] : -INFINITY, ls[3]};
        const float M = fmaxf(fmaxf(lj[0], lj[1]), fmaxf(lj[2], lj[3]));
        float wj[4], ws_ = 0.f;
#pragma unroll
        for (int j = 0; j < 4; ++j) { wj[j] = __expf(lj[j] - M); ws_ += wj[j]; }
        const float inv = 1.f / ws_;
        float acc[16];
#pragma unroll
        for (int e = 0; e < 16; ++e) acc[e] = 0.f;
#pragma unroll
        for (int j = 0; j < 4; ++j) { const bool on = (j == 3) || (j < nsel);
            const v4u a = pa[j], c = pc[j]; const float wv = wj[j] * inv;
#define MC_ACC(i_, x_) acc[i_] += on ? wv * (x_) : 0.f
            MC_ACC(0, bflo(a.x)); MC_ACC(1, bfhi(a.x)); MC_ACC(2, bflo(a.y)); MC_ACC(3, bfhi(a.y)); MC_ACC(4, bflo(a.z)); MC_ACC(5, bfhi(a.z)); MC_ACC(6, bflo(a.w)); MC_ACC(7, bfhi(a.w));
            MC_ACC(8, bflo(c.x)); MC_ACC(9, bfhi(c.x)); MC_ACC(10, bflo(c.y)); MC_ACC(11, bfhi(c.y)); MC_ACC(12, bflo(c.z)); MC_ACC(13, bfhi(c.z)); MC_ACC(14, bflo(c.w)); MC_ACC(15, bfhi(c.w));
#undef MC_ACC
        }
        v4u d8; d8.x = pk4_fp8(16.f * acc[0], 16.f * acc[1], 16.f * acc[2], 16.f * acc[3]); d8.y = pk4_fp8(16.f * acc[4], 16.f * acc[5], 16.f * acc[6], 16.f * acc[7]);
        d8.z = pk4_fp8(16.f * acc[8], 16.f * acc[9], 16.f * acc[10], 16.f * acc[11]); d8.w = pk4_fp8(16.f * acc[12], 16.f * acc[13], 16.f * acc[14], 16.f * acc[15]);
        __builtin_amdgcn_s_waitcnt(0x0F70);
        *(v4u*)(ws + WS_A2 + (size_t)t * 1024 + lane * 16) = d8;
        ls = lsn;
#pragma unroll
        for (int j = 0; j < 4; ++j) { pa[j] = na[j]; pc[j] = nc[j]; }
    }
#undef MC_LOAD
}

constexpr size_t WS_ELIST = 944 * MiB, WS_EDST = 960 * MiB;
constexpr size_t WS_HB8 = 976 * MiB;
__device__ __forceinline__ void moe_route(Frame& F, const float* logits, const float* bias, float* wts, unsigned* cnt, int* elist, int* edst) {
    const int lane = threadIdx.x & 63, tid = threadIdx.x;
    LAS unsigned* lcnt = (LAS unsigned*)F.lds; LAS unsigned* gb = lcnt + 256; LAS unsigned* pk = gb + 256;
    const f32x4 bz = ((const f32x4*)bias)[lane];
    for (int t0 = F.bid * 64; t0 < T; t0 += F.G * 64) {
        if (tid < 256) lcnt[tid] = 0u;
        __syncthreads();
        f32x4 lgs[8];
#pragma unroll
        for (int i = 0; i < 8; ++i) { const f32x4* lp = (const f32x4*)(logits + (size_t)(t0 + 8 * F.wave + i) * 512); lgs[i] = lp[lane] + lp[64 + lane]; }
#pragma unroll 1
        for (int i = 0; i < 8; ++i) {
            const int t = t0 + 8 * F.wave + i;
            f32x4 lg = lgs[0];
#pragma unroll
            for (int k = 1; k < 8; ++k) if (i == k) lg = lgs[k];
            float sc[4], ch[4];
#pragma unroll
            for (int e = 0; e < 4; ++e) { sc[e] = 1.f / (1.f + expf(-lg[e])); ch[e] = sc[e] + bz[e]; }
            float a = fmaxf(ch[0], ch[1]), b = fminf(ch[0], ch[1]);
            { const float a2 = fmaxf(ch[2], ch[3]), b2 = fminf(ch[2], ch[3]); const float na = fmaxf(a, a2); b = fmaxf(fminf(a, a2), fmaxf(b, b2)); a = na; }
#pragma unroll
            for (int o = 1; o < 8; o <<= 1) { const float a2 = __shfl_xor(a, o), b2 = __shfl_xor(b, o); const float na = fmaxf(a, a2); b = fmaxf(fminf(a, a2), fmaxf(b, b2)); a = na; }
            const float gs = a + b; const int g = lane >> 3;
            int rank = 0;
#pragma unroll
            for (int g2 = 0; g2 < 8; ++g2) { const float o = __builtin_bit_cast(float, __builtin_amdgcn_readlane(__builtin_bit_cast(int, gs), g2 * 8)); rank += (o > gs || (o == gs && g2 < g)) ? 1 : 0; }
            const bool sel = rank < 4;
            unsigned key[4];
#pragma unroll
            for (int e = 0; e < 4; ++e) { const unsigned bb = __builtin_bit_cast(unsigned, ch[e]); key[e] = sel ? ((bb & 0x80000000u) ? ~bb : (bb | 0x80000000u)) : 0u; }
            unsigned thr = 0u;
            for (int bit = 31; bit >= 0; --bit) { const unsigned cand = thr | (1u << bit); int c = 0;
#pragma unroll
                for (int e = 0; e < 4; ++e) c += __builtin_popcountll(__ballot(key[e] >= cand));
                if (c >= 8) thr = cand;
                if (c == 8) break; }
            int G8 = 0; unsigned long long beq[4]; bool gt[4], eq[4];
#pragma unroll
            for (int e = 0; e < 4; ++e) { gt[e] = key[e] > thr; eq[e] = key[e] == thr; G8 += __builtin_popcountll(__ballot(gt[e])); beq[e] = __ballot(eq[e]); }
            const int need = 8 - G8;
            int tb_ = 0;
#pragma unroll
            for (int e = 0; e < 4; ++e) tb_ += (int)__builtin_amdgcn_mbcnt_hi((unsigned)(beq[e] >> 32), __builtin_amdgcn_mbcnt_lo((unsigned)beq[e], 0u));
            bool pick[4]; int run = tb_;
#pragma unroll
            for (int e = 0; e < 4; ++e) { pick[e] = gt[e] || (eq[e] && run < need); run += eq[e] ? 1 : 0; }
            int sb = 0; float ls = 0.f;
#pragma unroll
            for (int e = 0; e < 4; ++e) { const unsigned long long bp = __ballot(pick[e]); sb += (int)__builtin_amdgcn_mbcnt_hi((unsigned)(bp >> 32), __builtin_amdgcn_mbcnt_lo((unsigned)bp, 0u)); ls += pick[e] ? sc[e] : 0.f; }
            const float ssum = wave_sum(ls);
            int slot = sb;
#pragma unroll
            for (int e = 0; e < 4; ++e) if (pick[e]) { const int ex = 4 * lane + e;
                wts[t * 8 + slot] = sc[e] / (ssum + 1e-20f) * 2.5f;
                const unsigned lp = __hip_atomic_fetch_add(&lcnt[ex], 1u, __ATOMIC_RELAXED, __HIP_MEMORY_SCOPE_WORKGROUP);
                const int pi = ((8 * F.wave + i) * 8 + slot) * 2; pk[pi] = (unsigned)ex | (lp << 8); pk[pi + 1] = (unsigned)(t * 8 + slot); ++slot; }
        }
        __syncthreads();
        if (tid < 256) { const unsigned c = lcnt[tid]; gb[tid] = c ? atomicAdd(&cnt[tid], c) : 0u; }
        __syncthreads();
        { const unsigned x = pk[2 * tid], d = pk[2 * tid + 1]; const unsigned ex = x & 255u, p = gb[ex] + (x >> 8);
          elist[(size_t)ex * T + p] = (int)(d >> 3); edst[(size_t)ex * T + p] = (int)d; }
        __syncthreads();
    }
}
constexpr int MOE_TB_OFF = 148480;
__device__ __forceinline__ void moe_tiles(Frame& F, const unsigned* cnt) {
    LAS int* tb = (LAS int*)(F.lds + MOE_TB_OFF); LAS int* cn = tb + 260;
    if (F.wave == 0) { const int lane = threadIdx.x & 63; int c[4], nt[4], s_ = 0;
#pragma unroll
        for (int e = 0; e < 4; ++e) { c[e] = (int)__hip_atomic_load(&cnt[4 * lane + e], __ATOMIC_RELAXED, __HIP_MEMORY_SCOPE_AGENT); nt[e] = (c[e] + 255) >> 8; s_ += nt[e]; }
        const int inc = wave_scan_dpp(s_);
        int ex = inc - s_;
#pragma unroll
        for (int e = 0; e < 4; ++e) { tb[4 * lane + e] = ex; cn[4 * lane + e] = c[e];
            for (int j = 0; j < nt[e]; ++j) ((LAS unsigned short*)(tb + 516))[ex + j] = (unsigned short)(4 * lane + e);
            ex += nt[e]; }
        if (lane == 63) tb[256] = inc; }
    __syncthreads();
}
__device__ __forceinline__ void final_rows(Frame& F, const bf16* HBp, const bf16* SHY, const unsigned char* YR, const float* wts, const float* g, const float* b, float* out, bool use_moe) {
    const int gw = F.bid * NWAVES + F.wave, NGW = F.G * NWAVES, lane = ((int)(threadIdx.x & 63));
    f32x4 gv[4], bv[4];
#pragma unroll
    for (int j = 0; j < 4; ++j) { gv[j] = ((const f32x4*)g)[lane + 64 * j]; bv[j] = ((const f32x4*)b)[lane + 64 * j]; }
#define FR_LOAD(m_, H_, S_, W_, Y_) do { const int _m = (m_) < T ? (m_) : T - 1; const v2u* _xr = (const v2u*)(HBp + (size_t)_m * D) + lane; \
        _Pragma("unroll") for (int _j = 0; _j < 4; ++_j) H_[_j] = _xr[64 * _j]; \
        if (use_moe) { const v2u* _sr = (const v2u*)(SHY + (size_t)_m * D) + lane; _Pragma("unroll") for (int _j = 0; _j < 4; ++_j) S_[_j] = _sr[64 * _j]; \
            W_ = wts[_m * 8 + (lane & 7)]; \
            _Pragma("unroll") for (int _k = 0; _k < 8; ++_k) { const unsigned* _yr = (const unsigned*)(YR + ((size_t)_m * 8 + _k) * D) + lane; \
                _Pragma("unroll") for (int _j = 0; _j < 4; ++_j) Y_[_k * 4 + _j] = _yr[64 * _j]; } } } while (0)
    v2u hA[4], sA[4], hB[4], sB[4]; float wA = 0.f, wB = 0.f; unsigned yA[32], yB[32];
    if (gw < T) FR_LOAD(gw, hA, sA, wA, yA);
    for (int m = gw; m < T; m += NGW) {
        FR_LOAD(m + NGW, hB, sB, wB, yB);
        f32x4 v[4];
#pragma unroll
        for (int j = 0; j < 4; ++j) { const v2u x = hA[j]; v[j] = (f32x4){bflo(x.x), bfhi(x.x), bflo(x.y), bfhi(x.y)} * DN_ALPHA; }
        if (use_moe) {
#pragma unroll
            for (int j = 0; j < 4; ++j) { const v2u s = sA[j]; v[j][0] += bflo(s.x); v[j][1] += bfhi(s.x); v[j][2] += bflo(s.y); v[j][3] += bfhi(s.y); }
#pragma unroll
            for (int k = 0; k < 8; ++k) { const float w = __builtin_bit_cast(float, __builtin_amdgcn_readlane(__builtin_bit_cast(int, wA), k)) * 0.0625f;
#pragma unroll
                for (int j = 0; j < 4; ++j) { const unsigned x = yA[k * 4 + j];
                    v[j][0] += w * __builtin_amdgcn_cvt_f32_fp8(x, 0); v[j][1] += w * __builtin_amdgcn_cvt_f32_fp8(x, 1); v[j][2] += w * __builtin_amdgcn_cvt_f32_fp8(x, 2); v[j][3] += w * __builtin_amdgcn_cvt_f32_fp8(x, 3); } }
        }
        float s = 0.f;
#pragma unroll
        for (int j = 0; j < 4; ++j) s += (v[j][0] + v[j][1]) + (v[j][2] + v[j][3]);
        const float mean = wave_sum(s) * (1.f / D); float s2 = 0.f;
#pragma unroll
        for (int j = 0; j < 4; ++j) { v[j] = v[j] - mean; s2 += (v[j][0] * v[j][0] + v[j][1] * v[j][1]) + (v[j][2] * v[j][2] + v[j][3] * v[j][3]); }
        const float rstd = 1.f / sqrtf(wave_sum(s2) * (1.f / D) + LN_EPS);
        __builtin_amdgcn_s_waitcnt(0x0F70);
        f32x4* o = (f32x4*)(out + (size_t)m * D) + lane;
#pragma unroll
        for (int j = 0; j < 4; ++j) o[64 * j] = v[j] * rstd * gv[j] + bv[j];
#pragma unroll
        for (int j = 0; j < 4; ++j) { hA[j] = hB[j]; sA[j] = sB[j]; }
        wA = wB;
#pragma unroll
        for (int i = 0; i < 32; ++i) yA[i] = yB[i];
    }
#undef FR_LOAD
}

enum Phase { PH_PROLOGUE = 0, PH_INPROJ, PH_PREP, PH_SCAN, PH_POST, PH_PROJ, PH_WOUT, PH_LN1, PH_ROUTER, PH_ROUTE, PH_EXP1, PH_EXP2, PH_FINAL, PH_COUNT };

__global__ void __launch_bounds__(NWAVES * 64, 2) mega_fwd(Args args) {
    extern __shared__ __attribute__((aligned(16))) unsigned char lds_raw[];
    Frame F;
    F.lds = (LAS unsigned char*)lds_raw;
    F.MISC = (volatile LAS unsigned*)(F.lds + MISC_OFF);
    F.wave = __builtin_amdgcn_readfirstlane(threadIdx.x >> 6);
    F.G = gridDim.x; F.bid = blockIdx.x; F.ws = args.ws; F.ctl = (unsigned*)(args.ws + WS_CTL);
    unsigned char* ws = args.ws;
    if (((int)threadIdx.x) < 64) F.MISC[((int)threadIdx.x)] = 0u;
    __syncthreads();
    XcdBarrier bar; bar.bar = F.ctl + CW_BAR; bar.x = 0; bar.st = nullptr; bar.gtot = 0;
    if (!N_LAUNCH_SPLIT) bar = xcd_barrier_post(F.ctl + CW_BAR, F.MISC + 8);
    XcdBarrier bar2; bar2.bar = F.ctl + CW_BAR2; bar2.x = 0; bar2.st = nullptr; bar2.gtot = 0;
    if (!N_LAUNCH_SPLIT && F.bid >= NSCAN + NWARM) { bar2 = xcd_barrier_post(F.ctl + CW_BAR2, F.MISC + 10); bar2.gtot = F.G - (NSCAN + NWARM); }
    const int lo = args.ph_lo, hi = args.ph_hi;
#define IN(k) (lo <= (k) && (k) < hi)
#define SEAM(k) do { if (IN(k) && IN((k) + 1)) xcd_barrier(bar); } while (0)

    if (IN(PH_PROLOGUE)) { p0_prologue(F, args, false, 0); }
    SEAM(PH_PROLOGUE);

#if STAGE >= 3
    if (IN(PH_INPROJ)) {
        constexpr int NGEMM = 153;
        if (F.bid < NGEMM) {
            pg8::DenseOrder S; S.init(T, NIN, D / 2, NGEMM, F.bid, (const bf16*)(ws + WS_WIN));
            EpiInProj E{ws, args.in[3], args.in[4]};
            pg8::gemm_phase<EpiInProj, pg8::DenseOrder, false, 5>(F.lds, ws + WS_XB, nullptr, D / 2, S, E);
        }
        expert_convert_queue(F, args);
    }
    SEAM(PH_INPROJ);
    if (IN(PH_PREP)) {
        gdn_prep_all(F, args);
    }
    SEAM(PH_PREP);
    if (IN(PH_SCAN)) {
        if (F.bid < NSCAN) gdn_scan2(F, F.bid);
        else if (F.bid < NSCAN + NWARM) gdn_scan_warm(F, F.bid - NSCAN);
#if STAGE >= 4
        else {
            {
                const int su = F.bid - (NSCAN + NWARM);
                if (su < 126 && F.G - (NSCAN + NWARM) >= 126) moba_select_unit(F, su & 1, 63 - (su >> 1));
                else if (F.G - (NSCAN + NWARM) >= 126) moba_own_queue(F);
                else for (int u = su; u < 128; u += F.G - (NSCAN + NWARM)) moba_select_unit(F, u & 1, 63 - (u >> 1));
            }
            xcd_barrier(bar2);
            moba_attn_queue(F);
            xcd_barrier(bar2);
            moba_combine(F, NSCAN + NWARM);
        }
#endif
    }
    SEAM(PH_SCAN);
    if (IN(PH_POST)) { gdn_ophase(F, args.in[5]); }
    SEAM(PH_POST);
    if (IN(PH_PROJ)) {
#if STAGE >= 4
        {
            pg8::DenseOrder S2; S2.init(T, D, D / 2, F.G, F.bid, (const bf16*)(ws + WS_WMP));
            EpiGate<false> E2{(bf16*)(ws + WS_MBUF), (const bf16*)(ws + WS_SGM), nullptr};
            pg8::gemm_phase<EpiGate<false>, pg8::DenseOrder, false, 6, 4>(F.lds, ws + WS_A2, nullptr, D / 2, S2, E2);
        }
#endif
        pg8::DenseOrder S; S.init(T, D, D / 2, F.G, F.bid, (const bf16*)(ws + WS_WGP));
#if STAGE >= 4
        EpiGate<true, true> E{(bf16*)(ws + WS_MBUF), (const bf16*)(ws + WS_SGG), ws + WS_OG + 16 * MiB};
        pg8::gemm_phase<EpiGate<true, true>, pg8::DenseOrder, false, 6, 0>(F.lds, ws + WS_OG, nullptr, D / 2, S, E);
#else
        EpiGate<false, true> E{(bf16*)(ws + WS_MBUF), (const bf16*)(ws + WS_SGG), ws + WS_OG + 16 * MiB};
        pg8::gemm_phase<EpiGate<false, true>, pg8::DenseOrder, false, 6, 0>(F.lds, ws + WS_OG, nullptr, D / 2, S, E);
#endif
    }
    SEAM(PH_PROJ);
    if (IN(PH_WOUT)) {
        pg8::DenseOrder S; S.init(T, D, D / 2, F.G, F.bid, (const bf16*)(ws + WS_WOUT));
        EpiBf16Res E{(bf16*)(ws + WS_HB), 1024, args.in[0], DN_ALPHA};
        pg8::gemm_phase<EpiBf16Res, pg8::DenseOrder, false, 6, 2>(F.lds, ws + WS_OG + 16 * MiB, nullptr, D / 2, S, E);
    }
#else
    SEAM(PH_INPROJ); SEAM(PH_PREP); SEAM(PH_SCAN); SEAM(PH_POST); SEAM(PH_PROJ);
    if (IN(PH_WOUT)) {
        const f32x4* x4 = (const f32x4*)args.in[0]; v2u* p4 = (v2u*)(ws + WS_HB); const size_t n4 = (size_t)T * D / 4;
        for (size_t i = (size_t)F.bid * 512 + threadIdx.x; i < n4; i += (size_t)F.G * 512) { const f32x4 x = x4[i] * DN_ALPHA; v2u o; o.x = pk2(x[0], x[1]); o.y = pk2(x[2], x[3]); p4[i] = o; }
    }
#endif
    SEAM(PH_WOUT);
    if (IN(PH_LN1)) { ln_rows(F, (bf16*)(ws + WS_HB), ws + WS_HB8, args.in[9], args.in[10]);
        if (F.bid == 0 && threadIdx.x < 64) ((v4u*)(ws + WS_HB8 + (size_t)T * D))[threadIdx.x] = (v4u){0u, 0u, 0u, 0u}; }
    SEAM(PH_LN1);
#if STAGE >= 2
    if (IN(PH_ROUTER)) {
        { pg8::SplitK2Order S; S.nM = T / 256; S.G = F.G; S.c = F.bid; S.Bt = (const char*)(ws + WS_ROUTER); S.khalfB = 1024;
          EpiF32Res E{(float*)(ws + WS_LOGITS2), 512, nullptr, 0.f};
          pg8::gemm_phase<EpiF32Res, pg8::SplitK2Order, false>(F.lds, (const bf16*)(ws + WS_HB), nullptr, D / 2, S, E, 2048u); }
        { pg8::DenseOrder S; S.init(T, 512, D / 2, F.G, (F.bid + 128) % F.G, (const bf16*)(ws + WS_SHGU));
          EpiSwiGLU E{(bf16*)(ws + WS_HS)};
          pg8::gemm_phase<EpiSwiGLU, pg8::DenseOrder, false, 5>(F.lds, ws + WS_HB8, nullptr, D / 2, S, E); }
    }
    SEAM(PH_ROUTER);
    if (IN(PH_ROUTE)) { moe_route(F, (const float*)(ws + WS_LOGITS2), args.in[12], (float*)(ws + WS_WTS), F.ctl + CW_MOE_CNT, (int*)(ws + WS_ELIST), (int*)(ws + WS_EDST)); }
    SEAM(PH_ROUTE);
    if (IN(PH_EXP1)) {
        moe_tiles(F, F.ctl + CW_MOE_CNT);
        { pg8::GroupOrder<2> S; S.G = F.G; S.c = F.bid; S.tb = (const LAS int*)(F.lds + MOE_TB_OFF); S.cn = S.tb + 260; S.W = (const char*)(ws + WS_EXPGU); S.estride = (size_t)512 * 1024; S.tstepB = (size_t)256 * 1024;
          EpiSwiGLU8 E{ws + WS_HEXP};
          pg8::gemm_phase<EpiSwiGLU8, pg8::GroupOrder<2>, true, 5>(F.lds, ws + WS_HB8, (const int*)(ws + WS_ELIST), D / 2, S, E); }
        { pg8::DenseOrder S; S.init(T, 1024, 256, F.G, F.bid, (const bf16*)(ws + WS_SHD));
          EpiBf16Plain E{(bf16*)(ws + WS_SHY), 1024};
          pg8::gemm_phase<EpiBf16Plain, pg8::DenseOrder, false>(F.lds, (const bf16*)(ws + WS_HS), nullptr, 256, S, E); }
    }
    SEAM(PH_EXP1);
    if (IN(PH_EXP2)) {
        moe_tiles(F, F.ctl + CW_MOE_CNT);
        pg8::GroupOrder<4> S; S.G = F.G; S.c = F.bid; S.tb = (const LAS int*)(F.lds + MOE_TB_OFF); S.cn = S.tb + 260; S.W = (const char*)(ws + WS_EXPD); S.estride = (size_t)1024 * 256; S.tstepB = (size_t)256 * 256;
        EpiScatter8 E{ws + WS_YR, (const int*)(ws + WS_EDST)};
        pg8::gemm_phase<EpiScatter8, pg8::GroupOrder<4>, false, 5, 2>(F.lds, ws + WS_HEXP, nullptr, 128 | (args.ph_lo >> 30), S, E);
    }
    SEAM(PH_EXP2);
#else
    SEAM(PH_ROUTER); SEAM(PH_ROUTE); SEAM(PH_EXP1); SEAM(PH_EXP2);
#endif
    if (IN(PH_FINAL)) {
        final_rows(F, (const bf16*)(ws + WS_HB), (const bf16*)(ws + WS_SHY), ws + WS_YR, (const float*)(ws + WS_WTS), args.in[19], args.in[20], args.out, STAGE >= 2);
    }
#undef IN
#undef SEAM
}

extern "C" void kernel_launch(void* const* d_in, const int* in_sizes, int n_in, void* d_out, int out_size, void* d_ws, size_t ws_size, hipStream_t stream) {
    static int grid = 0;
    if (grid == 0) {
        if (n_in != 21 || out_size != T * D || ws_size < WS_END) { fprintf(stderr, "kernel_launch: unexpected shapes (n_in %d out %d ws %zu)\n", n_in, out_size, ws_size); grid = -1; return; }
        int dev = 0, cus = 0, per_cu = 0;
        if (hipGetDevice(&dev) != hipSuccess || hipDeviceGetAttribute(&cus, hipDeviceAttributeMultiprocessorCount, dev) != hipSuccess) { grid = -1; return; }
        if (hipFuncSetAttribute((const void*)mega_fwd, hipFuncAttributeMaxDynamicSharedMemorySize, LDS_BYTES) != hipSuccess) { fprintf(stderr, "kernel_launch: hipFuncSetAttribute failed\n"); grid = -1; return; }
        if (hipOccupancyMaxActiveBlocksPerMultiprocessor(&per_cu, (const void*)mega_fwd, NWAVES * 64, LDS_BYTES) != hipSuccess || per_cu < 1) { fprintf(stderr, "kernel_launch: occupancy query says %d\n", per_cu); }
        (void)hipGetLastError();
        grid = cus;
    }
    if (grid < 0) return;
    (void)hipMemsetAsync((char*)d_ws + WS_CTL, 0, CTL_ZERO_BYTES, stream);
    Args a{};
    for (int i = 0; i < 21; ++i) a.in[i] = (const float*)d_in[i];
    a.out = (float*)d_out; a.ws = (unsigned char*)d_ws;
    for (int i = 0; i < 16; ++i) a.rope_inv[i] = powf(500000.0f, -(float)i / 16.0f);
#if N_LAUNCH_SPLIT
    for (int p = 0; p < PH_COUNT; ++p) { a.ph_lo = p; a.ph_hi = p + 1; hipLaunchKernelGGL(mega_fwd, dim3(grid), dim3(NWAVES * 64), LDS_BYTES, stream, a); }
#else
    a.ph_lo = 0; a.ph_hi = PH_COUNT;
    hipLaunchKernelGGL(mega_fwd, dim3(grid), dim3(NWAVES * 64), LDS_BYTES, stream, a);
#endif
}
```
